# Optimizing an MI355X kernel written in HIP

```python
import math
import jax, jax.numpy as jnp
from jax import lax
import numpy as np

D_MODEL = 2048
BATCH = 2
SEQ = 4096
DEPTH = 1

M_WIDTH = D_MODEL
M_HEADS = 8
M_HEAD_DIM = M_WIDTH // M_HEADS
M_QKV_BLOCK = 4
M_CHUNK = 64
CONV_WIDTH = 4
R_BLOCK = 256
R_WIDTH = (4 * D_MODEL // 3) // R_BLOCK * R_BLOCK
R_HEADS = R_WIDTH // R_BLOCK
LRU_C = 8.0
N_BRANCH = 2
IN_COLS = 2 * M_WIDTH + 2 * R_WIDTH + N_BRANCH * D_MODEL
N_EXPERTS = 64
TOP_K = 8
N_GROUPS = 8
TOPK_GROUPS = 4
D_EXPERT = D_MODEL // 4
ROUTED_SCALE = 2.5
MOE_BLOCK = 128
ALPHA = (2.0 * DEPTH) ** 0.25
BETA = (8.0 * DEPTH) ** -0.25
LN_EPS = 1e-5

kernel_name = "hybrid_mlstm_rglru_moe_block"

F32 = jnp.float32


def layer_norm(x, g, b):
    xf = x.astype(F32)
    mu = jnp.mean(xf, axis=-1, keepdims=True)
    var = jnp.mean(jnp.square(xf - mu), axis=-1, keepdims=True)
    return ((xf - mu) * lax.rsqrt(var + LN_EPS) * g + b).astype(x.dtype)


def causal_depthwise_conv(x, w, b):
    width = w.shape[0]
    S = x.shape[1]
    xp = jnp.pad(x, ((0, 0), (width - 1, 0), (0, 0)))
    y = b + xp[:, 0:S] * w[0]
    for j in range(1, width):
        y = y + xp[:, j:j + S] * w[j]
    return y


def block_diag(x, w):
    nb, bi, bo = w.shape
    xs = x.reshape(x.shape[:-1] + (nb, bi))
    return jnp.einsum('...ni,nio->...no', xs, w).reshape(x.shape[:-1] + (nb * bo,))


def mlstm_chunkwise(q, k, v, ig, lf):
    B, H, S, dk = q.shape
    dv = v.shape[-1]
    L = M_CHUNK
    NC = S // L

    def chunks(t):
        return jnp.moveaxis(t.reshape((B, H, NC, L) + t.shape[3:]), 2, 0)

    causal = jnp.tril(jnp.ones((L, L), dtype=bool))

    def step(carry, inp):
        C, n, m = carry
        q_, k_, v_, i_, f_ = inp
        b = jnp.cumsum(f_, axis=-1)
        dmat = b[..., :, None] - b[..., None, :] + i_[..., None, :]
        dmat = jnp.where(causal, dmat, -jnp.inf)
        a = b + m[..., None]
        m_row = jnp.maximum(a, jnp.max(dmat, axis=-1))
        s = jnp.einsum('bhld,bhsd->bhls', q_, k_) * jnp.exp(dmat - m_row[..., None])
        inter = jnp.exp(a - m_row)
        num = inter[..., None] * jnp.einsum('bhld,bhde->bhle', q_, C) + jnp.einsum('bhls,bhse->bhle', s, v_)
        den = inter * jnp.einsum('bhld,bhd->bhl', q_, n) + jnp.sum(s, axis=-1)
        h = num / jnp.maximum(jnp.abs(den), jnp.exp(-m_row))[..., None]
        b_last = b[..., -1]
        w_log = b_last[..., None] - b + i_
        m_new = jnp.maximum(b_last + m, jnp.max(w_log, axis=-1))
        decay = jnp.exp(b_last + m - m_new)
        w_s = jnp.exp(w_log - m_new[..., None])
        C_new = decay[..., None, None] * C + jnp.einsum('bhs,bhsd,bhse->bhde', w_s, k_, v_)
        n_new = decay[..., None] * n + jnp.einsum('bhs,bhsd->bhd', w_s, k_)
        return (C_new, n_new, m_new), h

    init = (jnp.zeros((B, H, dk, dv), F32), jnp.zeros((B, H, dk), F32), jnp.zeros((B, H), F32))
    _, hs = lax.scan(step, init, (chunks(q), chunks(k), chunks(v), chunks(ig), chunks(lf)))
    return jnp.moveaxis(hs, 0, 2).reshape(B, H, S, dv)


def mlstm_branch(xm, z, conv_w, conv_b, wq, wk, wv, w_if, b_if, norm_w, skip):
    B, S, _ = xm.shape
    xc = jax.nn.silu(causal_depthwise_conv(xm, conv_w, conv_b))
    q = block_diag(xc, wq)
    k = block_diag(xc, wk)
    v = block_diag(xm, wv)
    gates = (jnp.concatenate([q, k, v], axis=-1) @ w_if + b_if).astype(F32)
    ig = jnp.moveaxis(gates[..., :M_HEADS], -1, 1)
    lf = jax.nn.log_sigmoid(jnp.moveaxis(gates[..., M_HEADS:], -1, 1))

    def heads(t):
        return t.reshape(B, S, M_HEADS, M_HEAD_DIM).transpose(0, 2, 1, 3).astype(F32)

    h = mlstm_chunkwise(heads(q), heads(k) * (M_HEAD_DIM ** -0.5), heads(v), ig, lf)
    mu = jnp.mean(h, axis=-1, keepdims=True)
    var = jnp.mean(jnp.square(h - mu), axis=-1, keepdims=True)
    h = (h - mu) * lax.rsqrt(var + LN_EPS)
    h = h.transpose(0, 2, 1, 3).reshape(B, S, M_WIDTH) * norm_w
    h = h.astype(xm.dtype)
    return (h + skip * xc) * jax.nn.silu(z)


def _lin_combine(left, right):
    a1, b1 = left
    a2, b2 = right
    return a1 * a2, a2 * b1 + b2


def rglru_branch(xr, xg, conv_w, conv_b, wa, ba, wx, bx, lam):
    xc = causal_depthwise_conv(xr, conv_w, conv_b)
    r = jax.nn.sigmoid(block_diag(xc, wa) + ba).astype(F32)
    i = jax.nn.sigmoid(block_diag(xc, wx) + bx).astype(F32)
    log_a = -LRU_C * jax.nn.softplus(-lam.astype(F32)) * r
    a = jnp.exp(log_a)
    b_in = jnp.sqrt(-jnp.expm1(2.0 * log_a)) * (i * xc.astype(F32))
    _, h = lax.associative_scan(_lin_combine, (a, b_in), axis=1)
    return h.astype(xr.dtype) * jax.nn.gelu(xg)


def moe_ffn(x, router_w, router_bias, w_gate, w_up, w_down, s_gate, s_up, s_down):
    B, S, D = x.shape
    N = B * S
    E = N_EXPERTS
    xt = x.reshape(N, D)
    scores = jax.nn.sigmoid((xt @ router_w).astype(F32))
    biased = scores + router_bias.astype(F32)
    grp = biased.reshape(N, N_GROUPS, E // N_GROUPS)
    grp_score = jnp.sum(lax.top_k(grp, 2)[0], axis=-1)
    _, top_grp = lax.top_k(grp_score, TOPK_GROUPS)
    grp_mask = jnp.any(top_grp[..., None] == jnp.arange(N_GROUPS), axis=-2)
    exp_mask = jnp.repeat(grp_mask, E // N_GROUPS, axis=-1)
    _, top_e = lax.top_k(jnp.where(exp_mask, biased, -jnp.inf), TOP_K)
    w = jnp.take_along_axis(scores, top_e, axis=-1)
    w = w / jnp.sum(w, axis=-1, keepdims=True) * ROUTED_SCALE

    A = N * TOP_K
    e_flat = top_e.reshape(A)
    tok_flat = jnp.repeat(jnp.arange(N, dtype=jnp.int32), TOP_K)
    w_flat = w.reshape(A)
    order = jnp.argsort(e_flat)
    e_sorted = e_flat[order]
    tok_sorted = tok_flat[order]
    w_sorted = w_flat[order]
    counts = jnp.bincount(e_flat, length=E)
    starts = jnp.cumsum(counts) - counts
    padded = (counts + MOE_BLOCK - 1) // MOE_BLOCK * MOE_BLOCK
    pad_ends = jnp.cumsum(padded)
    pad_starts = pad_ends - padded
    dest = pad_starts[e_sorted] + jnp.arange(A) - starts[e_sorted]
    n_blocks = -(-(A + E * (MOE_BLOCK - 1)) // MOE_BLOCK)
    P = n_blocks * MOE_BLOCK
    row_tok = jnp.full((P,), N, dtype=jnp.int32).at[dest].set(tok_sorted)
    row_w = jnp.zeros((P,), F32).at[dest].set(w_sorted)
    block_e = jnp.minimum(jnp.searchsorted(pad_ends, jnp.arange(n_blocks) * MOE_BLOCK, side='right'), E - 1)
    x_pad = jnp.concatenate([xt, jnp.zeros((1, D), xt.dtype)], axis=0)

    def run_block(args):
        toks, e = args
        xb = x_pad[toks]
        hb = jax.nn.silu(xb @ w_gate[e]) * (xb @ w_up[e])
        return hb @ w_down[e]

    yb = lax.map(run_block, (row_tok.reshape(n_blocks, MOE_BLOCK), block_e))
    routed = jnp.zeros((N + 1, D), F32).at[row_tok].add(yb.reshape(P, D).astype(F32) * row_w[:, None])[:N]
    shared = (jax.nn.silu(xt @ s_gate) * (xt @ s_up)) @ s_down
    return (routed.astype(x.dtype) + shared).reshape(B, S, D)


def hybrid_layer(x, w_in, b_gate, m_conv_w, m_conv_b, m_wq, m_wk, m_wv, m_w_if, m_b_if, m_norm_w, m_skip,
                 r_conv_w, r_conv_b, r_wa, r_ba, r_wx, r_bx, r_lambda, w_pm, w_pr, w_o, ln1_g, ln1_b,
                 router_w, router_bias, e_w_gate, e_w_up, e_w_down, s_w_gate, s_w_up, s_w_down, ln2_g, ln2_b):
    B, S, D = x.shape
    proj = x @ w_in
    o1 = M_WIDTH
    o2 = o1 + M_WIDTH
    o3 = o2 + R_WIDTH
    o4 = o3 + R_WIDTH
    xm, z, xr, xg, gpre = proj[..., :o1], proj[..., o1:o2], proj[..., o2:o3], proj[..., o3:o4], proj[..., o4:]
    y_m = mlstm_branch(xm, z, m_conv_w, m_conv_b, m_wq, m_wk, m_wv, m_w_if, m_b_if, m_norm_w, m_skip)
    y_r = rglru_branch(xr, xg, r_conv_w, r_conv_b, r_wa, r_ba, r_wx, r_bx, r_lambda)
    g = jax.nn.sigmoid(gpre.reshape(B, S, N_BRANCH, D) + b_gate)
    merged = g[..., 0, :] * (y_m @ w_pm) + g[..., 1, :] * (y_r @ w_pr)
    x = layer_norm(ALPHA * x + merged @ w_o, ln1_g, ln1_b)
    y = moe_ffn(x, router_w, router_bias, e_w_gate, e_w_up, e_w_down, s_w_gate, s_w_up, s_w_down)
    return layer_norm(ALPHA * x + y, ln2_g, ln2_b)


def setup_inputs(seed: int = 0) -> dict:
    key = jax.random.key(seed)
    ks = iter(jax.random.split(key, 48))
    L = DEPTH

    def nrm(shape, scale):
        return jax.random.normal(next(ks), shape, F32) * scale

    x = nrm((BATCH, SEQ, D_MODEL), 1.0)
    w_in = nrm((L, D_MODEL, IN_COLS), D_MODEL ** -0.5)
    b_gate = nrm((L, N_BRANCH, D_MODEL), 0.02)
    m_conv_w = nrm((L, CONV_WIDTH, M_WIDTH), CONV_WIDTH ** -0.5)
    m_conv_b = nrm((L, M_WIDTH), 0.02)
    nbq = M_WIDTH // M_QKV_BLOCK
    m_wq = nrm((L, nbq, M_QKV_BLOCK, M_QKV_BLOCK), M_QKV_BLOCK ** -0.5)
    m_wk = nrm((L, nbq, M_QKV_BLOCK, M_QKV_BLOCK), M_QKV_BLOCK ** -0.5)
    m_wv = nrm((L, nbq, M_QKV_BLOCK, M_QKV_BLOCK), M_QKV_BLOCK ** -0.5)
    m_w_if = nrm((L, 3 * M_WIDTH, 2 * M_HEADS), (3 * M_WIDTH) ** -0.5)
    i_bias = nrm((L, M_HEADS), 0.1)
    f_bias = jnp.broadcast_to(jnp.linspace(3.0, 6.0, M_HEADS, dtype=F32), (L, M_HEADS)) + nrm((L, M_HEADS), 0.05)
    m_b_if = jnp.concatenate([i_bias, f_bias], axis=-1)
    m_norm_w = 1.0 + nrm((L, M_WIDTH), 0.02)
    m_skip = 1.0 + nrm((L, M_WIDTH), 0.02)
    r_conv_w = nrm((L, CONV_WIDTH, R_WIDTH), CONV_WIDTH ** -0.5)
    r_conv_b = nrm((L, R_WIDTH), 0.02)
    r_wa = nrm((L, R_HEADS, R_BLOCK, R_BLOCK), R_BLOCK ** -0.5)
    r_ba = nrm((L, R_WIDTH), 0.02)
    r_wx = nrm((L, R_HEADS, R_BLOCK, R_BLOCK), R_BLOCK ** -0.5)
    r_bx = nrm((L, R_WIDTH), 0.02)
    u = jax.random.uniform(next(ks), (L, R_WIDTH), F32, minval=0.9, maxval=0.999)
    a0 = u ** (1.0 / LRU_C)
    r_lambda = jnp.log(a0) - jnp.log1p(-a0)
    w_pm = nrm((L, M_WIDTH, D_MODEL), M_WIDTH ** -0.5 * BETA)
    w_pr = nrm((L, R_WIDTH, D_MODEL), R_WIDTH ** -0.5 * BETA)
    w_o = nrm((L, D_MODEL, D_MODEL), D_MODEL ** -0.5 * BETA)
    ln1_g = 1.0 + nrm((L, D_MODEL), 0.02)
    ln1_b = nrm((L, D_MODEL), 0.02)
    router_w = nrm((L, D_MODEL, N_EXPERTS), D_MODEL ** -0.5)
    router_bias = nrm((L, N_EXPERTS), 0.01)
    e_w_gate = nrm((L, N_EXPERTS, D_MODEL, D_EXPERT), D_MODEL ** -0.5)
    e_w_up = nrm((L, N_EXPERTS, D_MODEL, D_EXPERT), D_MODEL ** -0.5)
    e_w_down = nrm((L, N_EXPERTS, D_EXPERT, D_MODEL), D_EXPERT ** -0.5 * BETA)
    s_w_gate = nrm((L, D_MODEL, D_EXPERT), D_MODEL ** -0.5)
    s_w_up = nrm((L, D_MODEL, D_EXPERT), D_MODEL ** -0.5)
    s_w_down = nrm((L, D_EXPERT, D_MODEL), D_EXPERT ** -0.5 * BETA)
    ln2_g = 1.0 + nrm((L, D_MODEL), 0.02)
    ln2_b = nrm((L, D_MODEL), 0.02)
    return {"x": x, "w_in": w_in, "b_gate": b_gate, "m_conv_w": m_conv_w, "m_conv_b": m_conv_b,
            "m_wq": m_wq, "m_wk": m_wk, "m_wv": m_wv, "m_w_if": m_w_if, "m_b_if": m_b_if,
            "m_norm_w": m_norm_w, "m_skip": m_skip, "r_conv_w": r_conv_w, "r_conv_b": r_conv_b,
            "r_wa": r_wa, "r_ba": r_ba, "r_wx": r_wx, "r_bx": r_bx, "r_lambda": r_lambda,
            "w_pm": w_pm, "w_pr": w_pr, "w_o": w_o, "ln1_g": ln1_g, "ln1_b": ln1_b,
            "router_w": router_w, "router_bias": router_bias, "e_w_gate": e_w_gate, "e_w_up": e_w_up,
            "e_w_down": e_w_down, "s_w_gate": s_w_gate, "s_w_up": s_w_up, "s_w_down": s_w_down,
            "ln2_g": ln2_g, "ln2_b": ln2_b}


def reference(x, w_in, b_gate, m_conv_w, m_conv_b, m_wq, m_wk, m_wv, m_w_if, m_b_if, m_norm_w, m_skip,
              r_conv_w, r_conv_b, r_wa, r_ba, r_wx, r_bx, r_lambda, w_pm, w_pr, w_o, ln1_g, ln1_b,
              router_w, router_bias, e_w_gate, e_w_up, e_w_down, s_w_gate, s_w_up, s_w_down, ln2_g, ln2_b):
    for l in range(DEPTH):
        x = hybrid_layer(x, w_in[l], b_gate[l], m_conv_w[l], m_conv_b[l], m_wq[l], m_wk[l], m_wv[l],
                         m_w_if[l], m_b_if[l], m_norm_w[l], m_skip[l], r_conv_w[l], r_conv_b[l],
                         r_wa[l], r_ba[l], r_wx[l], r_bx[l], r_lambda[l], w_pm[l], w_pr[l], w_o[l],
                         ln1_g[l], ln1_b[l], router_w[l], router_bias[l], e_w_gate[l], e_w_up[l],
                         e_w_down[l], s_w_gate[l], s_w_up[l], s_w_down[l], ln2_g[l], ln2_b[l])
    return x
```

```cpp
#include <hip/hip_runtime.h>
#include <hip/hip_cooperative_groups.h>
#include <cstdio>
#include <cstdint>
namespace cg = cooperative_groups;

#define LAS __attribute__((address_space(3)))
typedef unsigned short bf16_t;
typedef short bf16x8 __attribute__((ext_vector_type(8)));
typedef float f32x4 __attribute__((ext_vector_type(4)));
typedef float f32x2 __attribute__((ext_vector_type(2)));
typedef unsigned u32x4 __attribute__((ext_vector_type(4)));
typedef unsigned u32x2 __attribute__((ext_vector_type(2)));
typedef int i32x8 __attribute__((ext_vector_type(8)));
typedef int i32x4 __attribute__((ext_vector_type(4)));

constexpr int NTOK = 8192, DM = 2048, SEQ = 4096, MW = 2048, RW = 2560, INC = 13312, NH = 8, HD = 256, NE = 64, DE = 512;
constexpr int O_Z = 2048, O_XR = 4096, O_XG = 6656, O_G0 = 9216, O_G1 = 11264;
constexpr float LN_EPS = 1e-5f;
constexpr float ALPHA = 1.189207115002721f;
constexpr int NCH = 64;

constexpr size_t MiB = 1u << 20;
constexpr size_t WS_CTL = 0;
constexpr size_t WS_WIN = 1 * MiB, WS_RB = 1 * MiB, WS_M2TAB = 41 * MiB;
constexpr size_t WS_WPM = 53 * MiB  , WS_WPR = 63 * MiB, WS_WO = 73 * MiB, WS_WRAX = 81 * MiB, WS_WSGU = 84 * MiB, WS_WSD = 1014 * MiB;
constexpr size_t WS_WEGU = 88 * MiB, WS_WED = 344 * MiB;
constexpr size_t WS_XB = 472 * MiB, WS_HNI = 472 * MiB, WS_HMOE = 472 * MiB;
constexpr size_t WS_PROJ = 504 * MiB;
constexpr size_t WS_YRM = 560 * MiB;
constexpr size_t WS_Q = 712 * MiB, WS_K = 744 * MiB, WS_V = 776 * MiB, WS_YM = 712 * MiB  , WS_YR = 752 * MiB;
constexpr size_t WS_XCM = 808 * MiB, WS_MERGED = 808 * MiB;
constexpr size_t WS_XCR = 840 * MiB;
constexpr size_t WS_SMALL = 880 * MiB;
constexpr size_t WS_RA = 886 * MiB, WS_T1 = 886 * MiB, WS_X1B = 886 * MiB  ;
constexpr size_t WS_LIST = 918 * MiB, WS_LISTW = 920 * MiB  , WS_TOKES = 923 * MiB;
constexpr size_t WS_X1 = 950 * MiB;
constexpr size_t WS_HNE = 966 * MiB;
constexpr size_t WS_END = 1016 * MiB;
constexpr size_t SM_IG = 0, SM_LF = 256 * 1024, SM_INTER = 512 * 1024, SM_EMR = 768 * 1024, SM_DENI = 1024 * 1024, SM_QN = 1280 * 1024;
constexpr size_t SM_WIFT = 1536 * 1024;
constexpr size_t SM_C8 = 1792 * 1024;
constexpr size_t SM_RWH = 4608 * 1024, SM_RWL = 4864 * 1024;
constexpr size_t SM_AGGA = 2 * MiB, SM_AGGB = 2 * MiB + 1310720;

constexpr int LDS_BYTES = 147456;
constexpr int LDS_X = 131072;

struct Params {
  const float* in[34];
  float* out;
  unsigned char* ws;
};

typedef __bf16 hbf2_t __attribute__((ext_vector_type(2)));
typedef float hf2_t __attribute__((ext_vector_type(2)));
__device__ __forceinline__ unsigned pk2(float lo, float hi) { const hf2_t f = {lo, hi}; return __builtin_bit_cast(unsigned, __builtin_convertvector(f, hbf2_t)); }
__device__ __forceinline__ unsigned f2bf(float f) { return pk2(f, 0.f) & 0xffffu; }
__device__ __forceinline__ float bflo(unsigned w) { return __uint_as_float(w << 16); }
__device__ __forceinline__ float bfhi(unsigned w) { return __uint_as_float(w & 0xffff0000u); }
__device__ __forceinline__ float bf1(bf16_t b) { return __uint_as_float(((unsigned)b) << 16); }
__device__ __forceinline__ float sigmoidf_(float x) { return 1.0f / (1.0f + __expf(-x)); }
__device__ __forceinline__ float siluf_(float x) { return x / (1.0f + __expf(-x)); }
__device__ __forceinline__ float gelu_tanh(float x) { const float u = 0.7978845608028654f * (x + 0.044715f * x * x * x); return 0.5f * x * (1.0f + tanhf(u)); }
__device__ __forceinline__ float wave_sum(float v) {
#pragma unroll
  for (int o = 1; o < 64; o <<= 1) v += __shfl_xor(v, o);
  return v;
}
__device__ __forceinline__ float wave_max(float v) {
#pragma unroll
  for (int o = 1; o < 64; o <<= 1) v = fmaxf(v, __shfl_xor(v, o));
  return v;
}
__device__ __forceinline__ float wave_scan_sum(float v, int lane) {
#pragma unroll
  for (int o = 1; o < 64; o <<= 1) { const float t = __shfl_up(v, o); if (lane >= o) v += t; }
  return v;
}
__device__ __forceinline__ float wave_scan_max(float v, int lane) {
#pragma unroll
  for (int o = 1; o < 64; o <<= 1) { const float t = __shfl_up(v, o); if (lane >= o) v = fmaxf(v, t); }
  return v;
}
#define LDS_WAIT() asm volatile("s_waitcnt lgkmcnt(0)" ::: "memory")
#define LBAR() do { asm volatile("s_waitcnt lgkmcnt(0)" ::: "memory"); __builtin_amdgcn_s_barrier(); asm volatile("" ::: "memory"); } while (0)

namespace pg8 {
constexpr int BM = 256, BK = 64, HALF = 128, HTB = HALF * BK * 2, NXCD = 8, WGM = 8;
__device__ __forceinline__ int lds_byte(int r, int c) { const int st = (r >> 4) * 2 + (c >> 5), rr = r & 15, cc = c & 31, ob = rr * 64 + cc * 2; return st * 1024 + (ob ^ (((ob >> 9) & 1) << 5)); }
__device__ __forceinline__ void stage_rc(int b, int& R, int& C) { const int st = b / 1024, sb = b % 1024, swz = sb ^ (((sb >> 9) & 1) << 5); R = (st >> 1) * 16 + swz / 64; C = (st & 1) * 32 + (swz % 64) / 2; }

__device__ __forceinline__ int perm32(int rho) { const int n = rho >> 4, i = rho & 15; return 8 * (i >> 2) + 4 * n + (i & 3); }
struct UnitG { const char* A; const char* B; int pm, pn, e, cnt, mt, row0, nt, keep; };

__device__ __forceinline__ bool dense_order(int i, int G, int c, int nM, int nN, int& pm, int& pn) {
  const int nwg = nM * nN; const long L = (long)i * G + c; if (L >= nwg) return false;
  int wgid = (int)L; { const int q = nwg / NXCD, r = nwg % NXCD, xcd = wgid % NXCD, off = wgid / NXCD; wgid = (xcd < r ? xcd * (q + 1) : r * (q + 1) + (xcd - r) * q) + off; }
  const int nig = WGM * nN, gid = wgid / nig, fm = gid * WGM, gsz = (nM - fm) < WGM ? (nM - fm) : WGM;
  pm = fm + ((wgid % nig) % gsz); pn = (wgid % nig) / gsz; return true;
}

template <class Epi, class Sched, bool GATHER>
__device__ __forceinline__ void gemm_phase(LAS unsigned char* lds, const int lda, const int ldb, const Sched& S, const Epi& E) {
  const int tid = threadIdx.x, wid = __builtin_amdgcn_readfirstlane(tid >> 6), lane = tid & 63, wr = wid >> 2, wc = wid & 3, fr = lane & 15, fq = lane >> 4;
  int Rr[2], Cc[2];
  unsigned voffB[2];
  unsigned vA[2][2];
  unsigned nvA[2][2];
#pragma unroll
  for (int i = 0; i < 2; ++i) { stage_rc(tid * 16 + i * 8192, Rr[i], Cc[i]); const int Rb = Epi::PERM ? ((Rr[i] & ~31) + perm32(Rr[i] & 31)) : Rr[i]; voffB[i] = (unsigned)(Rb * ldb + Cc[i]) * 2u; }
  const size_t kstep = (size_t)(BK * 2);
  const size_t hstepA = (size_t)HALF * lda * 2, hstepB = (size_t)HALF * ldb * 2;
  const unsigned ldsw = (unsigned)wid * 1024u;
  const int aoff = lds_byte(wr * 64 + fr, fq * 8), boff = lds_byte(wc * 32 + fr, fq * 8);
#define PG8_SA(b, h) (((b) * 2 + (h)) * HTB)
#define PG8_SB(b, h) ((4 + (b) * 2 + (h)) * HTB)
#define PG8_STAGE_B(bufoff, gbase) do { _Pragma("unroll") for (int _i = 0; _i < 2; ++_i) \
    __builtin_amdgcn_global_load_lds((const unsigned*)((const char*)(gbase) + voffB[_i]), (LAS unsigned*)(lds + (bufoff) + ldsw + _i * 8192), 16, 0, 0); } while (0)
#define PG8_STAGE_A(bufoff, gbase, h) do { _Pragma("unroll") for (int _i = 0; _i < 2; ++_i) { \
    const char* _p = GATHER ? ((const char*)(gbase) + vA[h][_i]) : ((const char*)(gbase) + (h) * hstepA + vA[0][_i]); \
    __builtin_amdgcn_global_load_lds((const unsigned*)_p, (LAS unsigned*)(lds + (bufoff) + ldsw + _i * 8192), 16, 0, 0); } } while (0)
#define PG8_LD8(p) __builtin_shufflevector(*(const LAS i32x4*)(p), *(const LAS i32x4*)((p) + 1024), 0, 1, 2, 3, 4, 5, 6, 7)
#define PG8_LO(x) __builtin_bit_cast(bf16x8, __builtin_shufflevector(x, x, 0, 1, 2, 3))
#define PG8_HI(x) __builtin_bit_cast(bf16x8, __builtin_shufflevector(x, x, 4, 5, 6, 7))
#define PG8_LDA(dst, b, h) do { _Pragma("unroll") for (int m = 0; m < 4; ++m) dst[m] = PG8_LD8(lds + PG8_SA(b, h) + aoff + m * 2048); } while (0)
#define PG8_LDB(dst, b, h) do { _Pragma("unroll") for (int n = 0; n < 2; ++n) dst[n] = PG8_LD8(lds + PG8_SB(b, h) + boff + n * 2048); } while (0)
#define PG8_MMA(ai, bj, At, Bt) do { __builtin_amdgcn_s_setprio(1); _Pragma("unroll") for (int m = 0; m < 4; ++m) _Pragma("unroll") for (int n = 0; n < 2; ++n) { \
    acc[ai][bj][m][n] = __builtin_amdgcn_mfma_f32_16x16x32_bf16(PG8_LO(Bt[n]), PG8_LO(At[m]), acc[ai][bj][m][n], 0, 0, 0); \
    acc[ai][bj][m][n] = __builtin_amdgcn_mfma_f32_16x16x32_bf16(PG8_HI(Bt[n]), PG8_HI(At[m]), acc[ai][bj][m][n], 0, 0, 0); } __builtin_amdgcn_s_setprio(0); } while (0)
#define PG8_MMA8(ai, bj, At, Bt) do { __builtin_amdgcn_s_setprio(1); _Pragma("unroll") for (int m = 0; m < 4; ++m) _Pragma("unroll") for (int n = 0; n < 2; ++n) \
    acc[ai][bj][m][n] = __builtin_amdgcn_mfma_scale_f32_16x16x128_f8f6f4(Bt[n], At[m], acc[ai][bj][m][n], 0, 0, 0, 0x7F7F7F7F, 0, 0x7F7F7F7F); __builtin_amdgcn_s_setprio(0); } while (0)
#define PG8_MM(ai, bj, At, Bt) do { if (Epi::FP8) PG8_MMA8(ai, bj, At, Bt); else PG8_MMA(ai, bj, At, Bt); } while (0)
#define PG8_WAIT_V(n) asm volatile("s_waitcnt vmcnt(" #n ")" ::: "memory")
#define PG8_WAIT_L(n) asm volatile("s_waitcnt lgkmcnt(" #n ")" ::: "memory")
#define PG8_BAR __builtin_amdgcn_s_barrier()
#define PG8_SCHED __builtin_amdgcn_sched_barrier(0)
  UnitG cur, nxt; int ui = 0;
  if (!S.next(0, cur)) return;
#pragma unroll
  for (int h = 0; h < 2; ++h)
#pragma unroll
    for (int i = 0; i < 2; ++i) {
      if (GATHER) vA[h][i] = (unsigned)(S.arow(cur, h * HALF + Rr[i]) * lda + Cc[i]) * 2u;
      else vA[h][i] = (unsigned)(Rr[i] * lda + Cc[i]) * 2u;
      nvA[h][i] = vA[h][i];
    }
  f32x4 acc[2][2][4][2];
#pragma unroll
  for (int a = 0; a < 2; ++a)
#pragma unroll
    for (int b = 0; b < 2; ++b)
#pragma unroll
      for (int m = 0; m < 4; ++m)
#pragma unroll
        for (int n = 0; n < 2; ++n) acc[a][b][m][n] = (f32x4){0.f, 0.f, 0.f, 0.f};
  i32x8 At[4], B0[2], B1[2];
  const char* cA = cur.A; const char* cB = cur.B;
  { const char* pB0 = cB; const char* pB1 = cB + hstepB; const char* pA0 = cA; const char* pB2 = cB + kstep; const char* pA1 = cA + kstep; const char* pB3 = cB + hstepB + kstep;
    asm volatile("" : "+s"(pB0), "+s"(pB1), "+s"(pA0), "+s"(pB2), "+s"(pA1), "+s"(pB3));
  PG8_STAGE_B(PG8_SB(0, 0), pB0); PG8_STAGE_B(PG8_SB(0, 1), pB1); PG8_STAGE_A(PG8_SA(0, 0), pA0, 0); PG8_STAGE_A(PG8_SA(0, 1), pA0, 1);
  if (wr == 1) PG8_BAR;
  PG8_WAIT_V(2); PG8_BAR;
  PG8_STAGE_B(PG8_SB(1, 0), pB2); PG8_STAGE_A(PG8_SA(1, 0), pA1, 0); PG8_STAGE_B(PG8_SB(1, 1), pB3); }
  PG8_WAIT_V(6); PG8_BAR;
  for (;;) {
    const bool has_next = S.next(ui + 1, nxt);
    const char* nA = has_next ? nxt.A : cA; const char* nB = has_next ? nxt.B : cB;
    if (GATHER) {
      if (has_next) {
#pragma unroll
        for (int h = 0; h < 2; ++h)
#pragma unroll
          for (int i = 0; i < 2; ++i) nvA[h][i] = (unsigned)(S.arow(nxt, h * HALF + Rr[i]) * lda + Cc[i]) * 2u;
      }
    }
    const int nt = cur.nt;
#pragma unroll 1
    for (int t = 0; t < nt; t += 2) {
      const bool last = (t == nt - 2);
      const char* a1 = cA + (size_t)(t + 1) * kstep;
      const char* a2 = last ? nA : cA + (size_t)(t + 2) * kstep; const char* b2 = last ? nB : cB + (size_t)(t + 2) * kstep;
      const char* a3 = a2 + kstep; const char* b3 = b2 + kstep;
      asm volatile("" : "+s"(a1), "+s"(a2), "+s"(a3), "+s"(b2), "+s"(b3));
      PG8_LDB(B0, 0, 0); PG8_LDB(B1, 0, 1); PG8_SCHED; PG8_LDA(At, 0, 0); PG8_STAGE_A(PG8_SA(1, 1), a1, 1);
      if (GATHER) { if (last) {
#pragma unroll
        for (int h = 0; h < 2; ++h)
#pragma unroll
          for (int i = 0; i < 2; ++i) vA[h][i] = nvA[h][i]; } }
      PG8_WAIT_V(8); PG8_WAIT_L(0); PG8_BAR; PG8_MM(0, 0, At, B0); PG8_MM(0, 1, At, B1); PG8_BAR; PG8_SCHED;
      PG8_LDA(At, 0, 1); PG8_STAGE_B(PG8_SB(0, 0), b2); PG8_STAGE_B(PG8_SB(0, 1), b2 + hstepB); PG8_STAGE_A(PG8_SA(0, 0), a2, 0);
      PG8_WAIT_V(8); PG8_WAIT_L(0); PG8_BAR; PG8_MM(1, 0, At, B0); PG8_MM(1, 1, At, B1); PG8_BAR; PG8_SCHED;
      PG8_LDB(B0, 1, 0); PG8_LDB(B1, 1, 1); PG8_SCHED; PG8_LDA(At, 1, 0); PG8_STAGE_A(PG8_SA(0, 1), a2, 1);
      PG8_WAIT_V(8); PG8_WAIT_L(0); PG8_BAR; PG8_MM(0, 0, At, B0); PG8_MM(0, 1, At, B1); PG8_BAR; PG8_SCHED;
      PG8_LDA(At, 1, 1); PG8_STAGE_B(PG8_SB(1, 0), b3); PG8_STAGE_B(PG8_SB(1, 1), b3 + hstepB); PG8_STAGE_A(PG8_SA(1, 0), a3, 0);
      PG8_WAIT_V(8); PG8_WAIT_L(0); PG8_BAR; PG8_MM(1, 0, At, B0); PG8_MM(1, 1, At, B1); PG8_BAR; PG8_SCHED;
    }
    if (wr == 0) PG8_BAR;
    { int l2 = (int)__builtin_amdgcn_mbcnt_hi(~0u, __builtin_amdgcn_mbcnt_lo(~0u, 0u)); asm volatile("" : "+v"(l2));
      E(acc, cur, wr, wc, l2 & 15, l2 >> 4); }
    if (!has_next) break;
    if (!cur.keep) {
#pragma unroll
      for (int a = 0; a < 2; ++a)
#pragma unroll
        for (int b = 0; b < 2; ++b)
#pragma unroll
          for (int m = 0; m < 4; ++m)
#pragma unroll
            for (int n = 0; n < 2; ++n) acc[a][b][m][n] = (f32x4){0.f, 0.f, 0.f, 0.f};
    }
    cur = nxt; cA = nA; cB = nB; ++ui;
    if (wr == 1) PG8_BAR;
  }
  PG8_WAIT_V(0);
  PG8_BAR;
#undef PG8_SA
#undef PG8_SB
#undef PG8_STAGE_A
#undef PG8_STAGE_B
#undef PG8_LDA
#undef PG8_LDB
#undef PG8_MMA
#undef PG8_MMA8
#undef PG8_MM
#undef PG8_LD8
#undef PG8_LO
#undef PG8_HI
#undef PG8_WAIT_V
#undef PG8_WAIT_L
#undef PG8_BAR
#undef PG8_SCHED
}
}

__device__ __forceinline__ const char* uni_ptr(const char* p) {
  const unsigned long long v = (unsigned long long)p;
  const unsigned lo = __builtin_amdgcn_readfirstlane((unsigned)v), hi = __builtin_amdgcn_readfirstlane((unsigned)(v >> 32));
  return (const char*)(((unsigned long long)hi << 32) | lo);
}

struct SchedDense {
  const char* A; const char* B; int nM, nN, G, c, lda, ldb, nt;
  __device__ __forceinline__ bool next(int i, pg8::UnitG& u) const {
    int pm, pn; if (!pg8::dense_order(i, G, c, nM, nN, pm, pn)) return false;
    u.pm = pm; u.pn = pn; u.e = 0; u.cnt = 0; u.mt = 0; u.row0 = pm * 256; u.nt = nt; u.keep = 0;
    u.A = A + (size_t)pm * 256 * lda * 2; u.B = B + (size_t)pn * 256 * ldb * 2; return true;
  }
  __device__ __forceinline__ unsigned arow(const pg8::UnitG&, int r) const { return (unsigned)r; }
};

struct EpiStoreBf16 {
  static constexpr bool PERM = true, FP8 = false;
  bf16_t* O; int ldc;
  __device__ __forceinline__ void operator()(const f32x4 (&acc)[2][2][4][2], const pg8::UnitG& u, int wr, int wc, int fr, int fq) const {
    const int row0 = u.pm * 256 + wr * 64 + fr, col0 = u.pn * 256 + wc * 32 + 8 * fq;
#pragma unroll
    for (int ai = 0; ai < 2; ++ai)
#pragma unroll
      for (int m = 0; m < 4; ++m) { bf16_t* rowp = O + (size_t)(row0 + ai * 128 + m * 16) * ldc + col0;
#pragma unroll
        for (int bj = 0; bj < 2; ++bj) { const f32x4 v0 = acc[ai][bj][m][0], v1 = acc[ai][bj][m][1]; u32x4 w; w.x = pk2(v0[0], v0[1]); w.y = pk2(v0[2], v0[3]); w.z = pk2(v1[0], v1[1]); w.w = pk2(v1[2], v1[3]); *(u32x4*)(rowp + bj * 128) = w; } }
  }
};

struct SchedRglru {
  const char* XCR; const char* W; int G, c, nt4;
  __device__ __forceinline__ bool next(int i, pg8::UnitG& u) const {
    const int L = i * G + c; if (L >= 640) return false;
    const int blk = L >> 6, rem = L & 63; u.e = blk; u.pm = rem >> 1; u.pn = rem & 1; u.cnt = 0; u.mt = 0; u.row0 = u.pm * 256; u.nt = nt4; u.keep = 0;
    u.A = XCR + ((size_t)u.pm * 256 * RW + 256 * blk) * 2; u.B = W + ((size_t)(blk * 512 + u.pn * 256) * 256) * 2; return true;
  }
  __device__ __forceinline__ unsigned arow(const pg8::UnitG&, int r) const { return (unsigned)r; }
};
struct EpiRglru {
  static constexpr bool PERM = true, FP8 = false;
  const bf16_t* XCR; const float* ba; const float* bx; const float* C8; float* RA; bf16_t* RBo;
  __device__ __forceinline__ void operator()(const f32x4 (&acc)[2][2][4][2], const pg8::UnitG& u, int wr, int wc, int fr, int fq) const {
    const int row0 = u.pm * 256 + wr * 64 + fr;
#pragma unroll
    for (int n = 0; n < 2; ++n) {
      const int ch = 256 * u.e + 128 * u.pn + 32 * wc + 8 * fq + 4 * n;
      const f32x4 vba = *(const f32x4*)(ba + ch), vbx = *(const f32x4*)(bx + ch), c8 = *(const f32x4*)(C8 + ch);
#pragma unroll
      for (int ai = 0; ai < 2; ++ai)
#pragma unroll
        for (int m = 0; m < 4; ++m) {
          const size_t off = (size_t)(row0 + ai * 128 + m * 16) * RW + ch;
          const u32x2 xw = *(const u32x2*)(XCR + off);
          const float xc[4] = {bflo(xw.x), bfhi(xw.x), bflo(xw.y), bfhi(xw.y)};
          f32x4 av; float bv[4];
#pragma unroll
          for (int j = 0; j < 4; ++j) {
            const float r = __builtin_amdgcn_rcpf(1.0f + __expf(-(acc[ai][0][m][n][j] + vba[j])));
            const float ig = __builtin_amdgcn_rcpf(1.0f + __expf(-(acc[ai][1][m][n][j] + vbx[j])));
            const float la = c8[j] * r;
            const float a = __expf(la);
            const float x2 = 2.0f * la;
            const float poly = -x2 * (1.0f + x2 * 0.5f * (1.0f + x2 * (1.0f / 3.0f) * (1.0f + x2 * 0.25f * (1.0f + x2 * 0.2f))));
            const float om = (x2 > -0.25f) ? poly : (1.0f - a * a);
            av[j] = a;
            bv[j] = sqrtf(fmaxf(om, 0.f)) * (ig * xc[j]);
          }
          *(f32x4*)(RA + off) = av;
          u32x2 w; w.x = pk2(bv[0], bv[1]); w.y = pk2(bv[2], bv[3]); *(u32x2*)(RBo + off) = w;
          asm volatile("" ::: "memory");
        }
    }
  }
};

struct SchedMerge {
  const char* YM; const char* YR; const char* WPM; const char* WPR; int G, c;
  __device__ __forceinline__ bool next(int i, pg8::UnitG& u) const {
    int pm, pn; if (!pg8::dense_order(i >> 1, G, c, NTOK / 256, DM / 256, pm, pn)) return false;
    const int seg = i & 1;
    u.pm = pm; u.pn = pn; u.e = seg; u.cnt = 0; u.mt = 0; u.row0 = pm * 256; u.nt = seg ? RW / 64 : MW / 64; u.keep = seg ? 0 : 1;
    u.A = (seg ? YR : YM) + (size_t)pm * 256 * RW * 2; u.B = (seg ? WPR : WPM) + (size_t)pn * 256 * RW * 2; return true;
  }
  __device__ __forceinline__ unsigned arow(const pg8::UnitG&, int r) const { return (unsigned)r; }
};
struct EpiMergeF {
  static constexpr bool PERM = true, FP8 = false;
  const bf16_t* PROJ; const float* bgate; bf16_t* MRG;
  __device__ __forceinline__ void operator()(f32x4 (&acc)[2][2][4][2], const pg8::UnitG& u, int wr, int wc, int fr, int fq) const {
    const int row0 = u.pm * 256 + wr * 64 + fr, col0 = u.pn * 256 + wc * 32 + 8 * fq;
#pragma unroll
    for (int bj = 0; bj < 2; ++bj) {
      const int col = col0 + bj * 128;
      const f32x4 b00 = *(const f32x4*)(bgate + col), b01 = *(const f32x4*)(bgate + col + 4), b10 = *(const f32x4*)(bgate + DM + col), b11 = *(const f32x4*)(bgate + DM + col + 4);
#pragma unroll
      for (int ai = 0; ai < 2; ++ai)
#pragma unroll
        for (int m = 0; m < 4; ++m) {
          const size_t row = (size_t)(row0 + ai * 128 + m * 16);
          const u32x4 g1w = *(const u32x4*)(PROJ + row * INC + O_G1 + col);
          const float g1p[8] = {bflo(g1w.x), bfhi(g1w.x), bflo(g1w.y), bfhi(g1w.y), bflo(g1w.z), bfhi(g1w.z), bflo(g1w.w), bfhi(g1w.w)};
          if (u.e == 0) {
            const u32x4 g0w = *(const u32x4*)(PROJ + row * INC + O_G0 + col);
            const float g0p[8] = {bflo(g0w.x), bfhi(g0w.x), bflo(g0w.y), bfhi(g0w.y), bflo(g0w.z), bfhi(g0w.z), bflo(g0w.w), bfhi(g0w.w)};
#pragma unroll
            for (int j = 0; j < 4; ++j) {
              acc[ai][bj][m][0][j] *= (1.0f + __expf(-(g1p[j] + b10[j]))) * __builtin_amdgcn_rcpf(1.0f + __expf(-(g0p[j] + b00[j])));
              acc[ai][bj][m][1][j] *= (1.0f + __expf(-(g1p[4 + j] + b11[j]))) * __builtin_amdgcn_rcpf(1.0f + __expf(-(g0p[4 + j] + b01[j])));
            }
          } else {
            f32x4 v0, v1;
#pragma unroll
            for (int j = 0; j < 4; ++j) { v0[j] = acc[ai][bj][m][0][j] * __builtin_amdgcn_rcpf(1.0f + __expf(-(g1p[j] + b10[j]))); v1[j] = acc[ai][bj][m][1][j] * __builtin_amdgcn_rcpf(1.0f + __expf(-(g1p[4 + j] + b11[j]))); }
            u32x4 w; w.x = pk2(v0[0], v0[1]); w.y = pk2(v0[2], v0[3]); w.z = pk2(v1[0], v1[1]); w.w = pk2(v1[2], v1[3]); *(u32x4*)(MRG + row * DM + col) = w;
          }
        }
    }
  }
};

struct EpiWo {
  static constexpr bool PERM = false, FP8 = false;
  const float* X; float* O;
  __device__ __forceinline__ void operator()(const f32x4 (&acc)[2][2][4][2], const pg8::UnitG& u, int wr, int wc, int fr, int fq) const {
    const int row0 = u.pm * 256 + wr * 64 + fr, col0 = u.pn * 256 + wc * 32 + 4 * fq;
#pragma unroll
    for (int ai = 0; ai < 2; ++ai)
#pragma unroll
      for (int m = 0; m < 4; ++m) { const size_t off = (size_t)(row0 + ai * 128 + m * 16) * DM + col0;
#pragma unroll
        for (int bj = 0; bj < 2; ++bj)
#pragma unroll
          for (int n = 0; n < 2; ++n) { const f32x4 x = *(const f32x4*)(X + off + bj * 128 + n * 16); *(f32x4*)(O + off + bj * 128 + n * 16) = x * ALPHA + acc[ai][bj][m][n]; } }
  }
};

struct MoeTab { const LAS int* tp; const LAS int* cp; const LAS int* cnt; int n_rt; };
template <int NT  , int STAGE  >
struct SchedMoe {
  MoeTab T; const int* LIST; const char* Abase; const char* Wr; const char* Ws; int G, c, ntv;
  __device__ __forceinline__ bool next(int i, pg8::UnitG& u) const {
    const int L = i * G + c; const int total = NT * (T.n_rt + 32); if (L >= total) return false;
    const int rt = L / NT, pn = L % NT; u.pn = pn; u.nt = ntv; u.keep = 0;
    constexpr int KK = (STAGE == 1) ? DM / 2 : DE / 2;
    constexpr int NN = NT * 256;
    if (rt < T.n_rt) {
      const int e = __builtin_amdgcn_readfirstlane(T.tp[256 + rt]);
      const int mt = rt - __builtin_amdgcn_readfirstlane(T.tp[e]);
      u.e = e; u.mt = mt; u.cnt = __builtin_amdgcn_readfirstlane(T.cnt[e]); u.pm = rt; u.row0 = rt * 256;
      u.B = Wr + ((size_t)e * NN + (size_t)pn * 256) * KK * 2;
    } else {
      u.e = NE; u.mt = rt - T.n_rt; u.cnt = NTOK; u.pm = rt; u.row0 = rt * 256;
      u.B = Ws + (size_t)pn * 256 * KK * 2;
    }
    if (STAGE == 2) u.pm = __builtin_amdgcn_readfirstlane(T.cp[u.e]);
    if (STAGE == 1) u.A = Abase;
    else u.A = Abase + (size_t)rt * 256 * DE;
    return true;
  }
  __device__ __forceinline__ unsigned arow(const pg8::UnitG& u, int r) const {
    if (u.e < NE) { int slot = u.mt * 256 + r; if (slot >= u.cnt) slot = 0; return (unsigned)LIST[u.e * NTOK + slot]; }
    return (unsigned)(u.mt * 256 + r);
  }
};
struct EpiMoe1 {
  static constexpr bool PERM = true, FP8 = true;
  unsigned char* H;
  __device__ __forceinline__ void operator()(const f32x4 (&acc)[2][2][4][2], const pg8::UnitG& u, int wr, int wc, int fr, int fq) const {
    const int row0 = u.row0 + wr * 64 + fr, col0 = u.pn * 128 + wc * 32 + 8 * fq;
#pragma unroll
    for (int ai = 0; ai < 2; ++ai)
#pragma unroll
      for (int m = 0; m < 4; ++m) { unsigned char* rowp = H + (size_t)(row0 + ai * 128 + m * 16) * DE + col0;
        float v[8];
#pragma unroll
        for (int n = 0; n < 2; ++n) { const f32x4 g = acc[ai][0][m][n], up = acc[ai][1][m][n];
#pragma unroll
          for (int j = 0; j < 4; ++j) { const float gg = g[j] * 0.015625f; v[4 * n + j] = gg * __builtin_amdgcn_rcpf(1.0f + __expf(-gg)) * (up[j] * 0.015625f); } }
        int q0 = 0, q1 = 0; q0 = __builtin_amdgcn_cvt_pk_fp8_f32(v[0], v[1], q0, false); q0 = __builtin_amdgcn_cvt_pk_fp8_f32(v[2], v[3], q0, true); q1 = __builtin_amdgcn_cvt_pk_fp8_f32(v[4], v[5], q1, false); q1 = __builtin_amdgcn_cvt_pk_fp8_f32(v[6], v[7], q1, true);
        u32x2 w; w.x = (unsigned)q0; w.y = (unsigned)q1; *(u32x2*)rowp = w; }
  }
};
struct EpiMoe2 {
  static constexpr bool PERM = true, FP8 = true;
  bf16_t* YRM; const float* LISTW; bf16_t* DUMMY;
  __device__ __forceinline__ void operator()(const f32x4 (&acc)[2][2][4][2], const pg8::UnitG& u, int wr, int wc, int fr, int fq) const {
    const int slot0 = u.mt * 256 + wr * 64 + fr;
    bf16_t* base = YRM + (size_t)(u.pm + slot0) * DM + u.pn * 256 + wc * 32 + 8 * fq;
    bf16_t* sink = DUMMY + (size_t)blockIdx.x * 8192 + ((wr * 4 + wc) * 64 + fq * 16 + fr) * 8;
    const float* lw = LISTW + u.e * NTOK + slot0;
    float wv[8];
#pragma unroll
    for (int i = 0; i < 8; ++i) wv[i] = lw[(i >> 2) * 128 + (i & 3) * 16];
#pragma unroll
    for (int ai = 0; ai < 2; ++ai)
#pragma unroll
      for (int m = 0; m < 4; ++m) { const int ds = ai * 128 + m * 16;
        const float w = wv[ai * 4 + m] * 0.03125f;
        bf16_t* rowp = (slot0 + ds < u.cnt) ? base + (size_t)ds * DM : sink;
#pragma unroll
        for (int bj = 0; bj < 2; ++bj) { const f32x4 v0 = acc[ai][bj][m][0] * w, v1 = acc[ai][bj][m][1] * w; u32x4 q; q.x = pk2(v0[0], v0[1]); q.y = pk2(v0[2], v0[3]); q.z = pk2(v1[0], v1[1]); q.w = pk2(v1[2], v1[3]); *(u32x4*)(rowp + bj * 128) = q; } }
  }
};


#define XB_TMO      128
#define XB_XCNT(j)  (256  + 64 * (j))
#define XB_XSUB(j)  (1280 + 64 * (j))
#define XB_XGEN(j)  (2304 + 64 * (j))
#define XB_TOP      3328
#define XB_TOPGEN   3392
#define XCD_BAR_WORDS 3456
#define XB_SPIN_CAP (1u << 18)
__device__ __forceinline__ unsigned xb_ld(unsigned* p)              { return __hip_atomic_load(p, __ATOMIC_RELAXED, __HIP_MEMORY_SCOPE_AGENT); }
__device__ __forceinline__ unsigned xb_add(unsigned* p, unsigned v) { return __hip_atomic_fetch_add(p, v, __ATOMIC_RELAXED, __HIP_MEMORY_SCOPE_AGENT); }
__device__ __forceinline__ unsigned xb_xcc_id() { return (unsigned)__builtin_amdgcn_s_getreg((3 << 11) | 20) & 0xFu; }
#define XB_SPIN(cond, bar) do { unsigned _sp = 0; while (cond) { __builtin_amdgcn_s_sleep(1); \
    if ((++_sp & 255u) == 0u) { if (xb_ld(&(bar)[XB_TMO])) break; if (_sp > XB_SPIN_CAP) { atomicAdd(&(bar)[XB_TMO], 1u); break; } } } } while (0)
struct XcdBarrier { unsigned* bar; unsigned x; volatile LAS unsigned* st; };
__device__ __forceinline__ XcdBarrier xcd_barrier_post(unsigned* bar, volatile LAS unsigned* st) {
    XcdBarrier b; b.bar = bar; b.x = xb_xcc_id(); b.st = st;
    if (threadIdx.x == 0) (void)xb_add(&bar[XB_XCNT(b.x)], 1u);
    return b;
}
__device__ __forceinline__ void xcd_barrier_complete(unsigned* bar, unsigned x, unsigned& nloc, unsigned& nx) {
    const unsigned G = gridDim.x * gridDim.y * gridDim.z;
    unsigned sum, cnt, mine, sp = 0u;
    for (;;) {
        sum = 0u; cnt = 0u; mine = 0u;
#pragma unroll
        for (unsigned j = 0; j < 16; ++j) { const unsigned c = xb_ld(&bar[XB_XCNT(j)]); sum += c; cnt += (c > 0u) ? 1u : 0u; mine = (j == x) ? c : mine; }
        if (sum == G) break;
        __builtin_amdgcn_s_sleep(1);
        if ((++sp & 255u) == 0u) { if (xb_ld(&bar[XB_TMO])) break; if (sp > XB_SPIN_CAP) { atomicAdd(&bar[XB_TMO], 1u); break; } }
    }
    nloc = mine > 0u ? mine : 1u; nx = cnt > 0u ? cnt : 1u;
}
__device__ __forceinline__ void xcd_barrier(const XcdBarrier& b) {
    asm volatile("s_waitcnt vmcnt(0)" ::: "memory");
    __syncthreads();
    if (threadIdx.x == 0) {
        unsigned* bar = b.bar;
        __builtin_amdgcn_s_waitcnt(0);
        unsigned nloc = b.st[0], nx = b.st[1];
        if (nloc == 0u) { xcd_barrier_complete(bar, b.x, nloc, nx); b.st[0] = nloc; b.st[1] = nx; }
        const unsigned old = xb_add(&bar[XB_XSUB(b.x)], 1u);
        const unsigned gen = old / nloc;
        if (old + 1u == (gen + 1u) * nloc) {
            __builtin_amdgcn_fence(__ATOMIC_RELEASE, "agent");
            asm volatile("s_waitcnt vmcnt(0)" ::: "memory");
            const unsigned og = xb_add(&bar[XB_TOP], 1u);
            const unsigned tg = og / nx;
            if (og + 1u == (tg + 1u) * nx) xb_add(&bar[XB_TOPGEN], 1u);
            else XB_SPIN(xb_ld(&bar[XB_TOPGEN]) == tg, bar);
            __builtin_amdgcn_fence(__ATOMIC_ACQUIRE, "agent");
            xb_add(&bar[XB_XGEN(b.x)], 1u);
            asm volatile("s_waitcnt vmcnt(0)" ::: "memory");
        } else {
            XB_SPIN(xb_ld(&bar[XB_XGEN(b.x)]) == gen, bar);
            __builtin_amdgcn_fence(__ATOMIC_ACQUIRE, "agent");
            asm volatile("s_waitcnt vmcnt(0)" ::: "memory");
        }
    }
    __syncthreads();
}

template <class T> __device__ __forceinline__ T* as_global(T* p) { const unsigned long long v = (unsigned long long)p; return (T*)(__attribute__((address_space(1))) T*)v; }
template <class T> __device__ __forceinline__ T* opaque_global(T* p) { unsigned long long v = (unsigned long long)p; asm volatile("" : "+s"(v)); return (T*)(__attribute__((address_space(1))) T*)v; }
struct InPtrs { const float* const* p; __device__ __forceinline__ const float* operator[](int k) const { return as_global(p[k]); } };
struct Frame {
  LAS unsigned char* lds; int tid, lane, wave, G, bid; unsigned char* ws; InPtrs in; float* out;
};

struct TJob { const float* W; unsigned char* WT; int N, ldtB, k0, n0, up, mode; float sc; };
__device__ __forceinline__ int gu_row(int n, int up) { return 256 * (n >> 7) + (n & 127) + up * 128; }
constexpr int TR0 = 32 * 52, TR1 = 32 * 8, TR2 = 40 * 8, TR3 = 32 * 8, TR4 = 2 * 10 * 4, TR5 = 2 * 32 * 2, TR6 = 8 * 8, TR7 = 2 * 64 * 32 * 2, TR8 = 64 * 8 * 8;
constexpr int T_NITEMS = TR0 + TR1 + TR2 + TR3 + TR4 + TR5 + TR6 + TR7 + TR8;
__device__ __forceinline__ TJob tj_decode(const Frame& F, int it) {
  unsigned char* ws = F.ws; int r = it;
  if (r < TR0) { const int kb = r / 52, nb = r % 52; return TJob{F.in[1], ws + WS_WIN, INC, DM * 2, 64 * kb, 256 * nb, 0, 0, 1.f}; } r -= TR0;
  if (r < TR1) { const int kb = r / 8, nb = r % 8; return TJob{F.in[19], ws + WS_WPM, DM, RW * 2, 64 * kb, 256 * nb, 0, 0, 1.f}; } r -= TR1;
  if (r < TR2) { const int kb = r / 8, nb = r % 8; return TJob{F.in[20], ws + WS_WPR, DM, RW * 2, 64 * kb, 256 * nb, 0, 0, 1.f}; } r -= TR2;
  if (r < TR3) { const int kb = r / 8, nb = r % 8; return TJob{F.in[21], ws + WS_WO, DM, DM * 2, 64 * kb, 256 * nb, 0, 0, 1.f}; } r -= TR3;
  if (r < TR4) { const int which = r / 40, rr = r % 40, blk = rr / 4, kb = rr % 4; return TJob{F.in[which ? 16 : 14] + (size_t)blk * 65536, ws + WS_WRAX + (size_t)blk * 512 * 256 * 2, 256, 256 * 2, 64 * kb, 0, which, 1, 1.f}; } r -= TR4;
  if (r < TR5) { const int which = r / 64, q = r % 64, kb = q / 2, nb = q % 2; return TJob{F.in[which ? 30 : 29], ws + WS_WSGU, DE, DM, 64 * kb, 256 * nb, which, 3, 64.f}; } r -= TR5;
  if (r < TR6) { const int kb = r / 8, nb = r % 8; return TJob{F.in[31], ws + WS_WSD, DM, DE, 64 * kb, 256 * nb, 0, 2, 32.f}; } r -= TR6;
  if (r < TR7) { const int which = r / 4096, rr = r % 4096, e = rr / 64, q = rr % 64, kb = q / 2, nb = q % 2; return TJob{F.in[which ? 27 : 26] + (size_t)e * DM * DE, ws + WS_WEGU + (size_t)e * 1024 * DM, DE, DM, 64 * kb, 256 * nb, which, 3, 64.f}; } r -= TR7;
  { const int e = r / 64, q = r % 64, kb = q / 8, nb = q % 8; return TJob{F.in[28] + (size_t)e * DE * DM, ws + WS_WED + (size_t)e * DM * DE, DM, DE, 64 * kb, 256 * nb, 0, 2, 32.f}; }
}
__device__ __forceinline__ void tj_load(const TJob& j, f32x4 (&v)[8], int wave, int lane) {
  const float* p = j.W + (size_t)(j.k0 + 8 * wave) * j.N + j.n0 + 4 * lane;
#pragma unroll
  for (int i = 0; i < 8; ++i) v[i] = *(const f32x4*)(p + (size_t)i * j.N);
}
__device__ __forceinline__ void tj_store(const TJob& j, const f32x4 (&v)[8], LAS float* scr, int wave, int lane, int tid) {
#pragma unroll
  for (int i = 0; i < 8; ++i) { LAS float* d = scr + (8 * wave + i) * 257 + 4 * lane; d[0] = v[i][0]; d[1] = v[i][1]; d[2] = v[i][2]; d[3] = v[i][3]; }
  LBAR();
  if (j.mode < 2) {
#pragma unroll
    for (int it = 0; it < 4; ++it) { const int idx = it * 512 + tid, n = idx >> 3, c = idx & 7; const LAS float* s = scr + (8 * c) * 257 + n;
      u32x4 o; o.x = pk2(s[0 * 257], s[1 * 257]); o.y = pk2(s[2 * 257], s[3 * 257]); o.z = pk2(s[4 * 257], s[5 * 257]); o.w = pk2(s[6 * 257], s[7 * 257]);
      const int nn = j.n0 + n; const int row = j.mode ? gu_row(nn, j.up) : nn;
      *(u32x4*)(j.WT + (size_t)row * j.ldtB + (j.k0 + 8 * c) * 2) = o; }
  } else {
#pragma unroll
    for (int it = 0; it < 2; ++it) { const int idx = it * 512 + tid, n = idx >> 2, c = idx & 3; const LAS float* s = scr + (16 * c) * 257 + n;
      int w[4];
#pragma unroll
      for (int q = 0; q < 4; ++q) { int t = 0; t = __builtin_amdgcn_cvt_pk_fp8_f32(s[(4 * q) * 257] * j.sc, s[(4 * q + 1) * 257] * j.sc, t, false); t = __builtin_amdgcn_cvt_pk_fp8_f32(s[(4 * q + 2) * 257] * j.sc, s[(4 * q + 3) * 257] * j.sc, t, true); w[q] = t; }
      u32x4 o; o.x = (unsigned)w[0]; o.y = (unsigned)w[1]; o.z = (unsigned)w[2]; o.w = (unsigned)w[3];
      const int nn = j.n0 + n; const int row = (j.mode == 3) ? gu_row(nn, j.up) : nn;
      *(u32x4*)(j.WT + (size_t)row * j.ldtB + j.k0 + 16 * c) = o; }
  }
  LBAR();
}

__device__ __forceinline__ void phase_prologue(const Frame& F) {
  LAS float* scr = (LAS float*)F.lds;
  unsigned char* ws = F.ws;
  {
    f32x4 vA[8], vB[8]; TJob jA, jB;
    int it = F.bid;
    if (it < T_NITEMS) { jA = tj_decode(F, it); tj_load(jA, vA, F.wave, F.lane); }
    while (it < T_NITEMS) {
      { const int itn = it + F.G; jB = tj_decode(F, itn < T_NITEMS ? itn : T_NITEMS - 1); tj_load(jB, vB, F.wave, F.lane); }
      tj_store(jA, vA, scr, F.wave, F.lane, F.tid);
      it += F.G; if (it >= T_NITEMS) break;
      { const int itn = it + F.G; jA = tj_decode(F, itn < T_NITEMS ? itn : T_NITEMS - 1); tj_load(jA, vA, F.wave, F.lane); }
      tj_store(jB, vB, scr, F.wave, F.lane, F.tid);
      it += F.G;
    }
  }
  const int gt = F.bid * 512 + F.tid, NGT = F.G * 512;
  { const float* x = F.in[0]; bf16_t* xb = (bf16_t*)(ws + WS_XB);
    for (int i = gt; i < NTOK * DM / 8; i += NGT) { const f32x4 a = *(const f32x4*)(x + (size_t)i * 8), b = *(const f32x4*)(x + (size_t)i * 8 + 4);
      u32x4 o; o.x = pk2(a[0], a[1]); o.y = pk2(a[2], a[3]); o.z = pk2(b[0], b[1]); o.w = pk2(b[2], b[3]); *(u32x4*)(xb + (size_t)i * 8) = o; } }
  { const float* wif = F.in[8]; bf16_t* wt = (bf16_t*)(ws + WS_SMALL + SM_WIFT);
    for (int i = gt; i < 16 * 6144; i += NGT) { const int n = i / 6144, k = i % 6144; float v = wif[k * 16 + n]; if (k >= 2048 && k < 4096) v *= 16.0f; wt[i] = (bf16_t)f2bf(v); } }
  { const float* lam = F.in[18]; float* c8 = (float*)(ws + WS_SMALL + SM_C8); for (int i = gt; i < RW; i += NGT) c8[i] = -8.0f * log1pf(expf(-lam[i])); }
  { const float* rwt = F.in[24]; bf16_t* rh = (bf16_t*)(ws + WS_SMALL + SM_RWH); bf16_t* rl = (bf16_t*)(ws + WS_SMALL + SM_RWL);
    for (int i = gt; i < NE * DM; i += NGT) { const int n = i / DM, k = i % DM; const float v = rwt[k * NE + n]; const unsigned h = f2bf(v); rh[i] = (bf16_t)h; rl[i] = (bf16_t)f2bf(v - __uint_as_float(h << 16)); } }
  { float* lw64 = (float*)(ws + WS_LISTW) + (size_t)NE * NTOK; for (int i = gt; i < NTOK; i += NGT) lw64[i] = 1.0f; }
  { int* ctl = (int*)(ws + WS_CTL); for (int i = gt; i < 4096; i += NGT) ctl[i] = 0; }
}

__device__ __forceinline__ void phase_mprep(const Frame& F) {
  unsigned char* ws = F.ws;
  const bf16_t* PROJ = (const bf16_t*)(ws + WS_PROJ);
  bf16_t* Q = (bf16_t*)(ws + WS_Q); bf16_t* Kb = (bf16_t*)(ws + WS_K); bf16_t* V = (bf16_t*)(ws + WS_V); bf16_t* XCM = (bf16_t*)(ws + WS_XCM);
  const bf16_t* WIFT = (const bf16_t*)(ws + WS_SMALL + SM_WIFT);
  float* IG = (float*)(ws + WS_SMALL + SM_IG); float* LF = (float*)(ws + WS_SMALL + SM_LF);
  const int g = F.tid;
  f32x4 cw[4]; for (int j = 0; j < 4; ++j) cw[j] = *(const f32x4*)(F.in[3] + j * MW + 4 * g);
  const f32x4 cb = *(const f32x4*)(F.in[4] + 4 * g);
  f32x4 wq[4], wk[4], wv[4];
  for (int i = 0; i < 4; ++i) { wq[i] = *(const f32x4*)(F.in[5] + g * 16 + 4 * i); wk[i] = *(const f32x4*)(F.in[6] + g * 16 + 4 * i); wv[i] = *(const f32x4*)(F.in[7] + g * 16 + 4 * i); }
  LAS unsigned char* AIMG = F.lds; LAS float* red = (LAS float*)(F.lds + 98432);
  const int r = F.lane & 15, gq = F.lane >> 4;
  for (int tile = F.bid; tile < NTOK / 8; tile += F.G) {
    const int t0 = tile * 8, s0 = t0 & (SEQ - 1);
    u32x2 rw[11];
#pragma unroll
    for (int j = 0; j < 11; ++j) { const int pos = s0 - 3 + j; rw[j] = (pos >= 0) ? *(const u32x2*)(PROJ + (size_t)(t0 - 3 + j) * INC + 4 * g) : (u32x2){0u, 0u}; }
#pragma unroll
    for (int tt = 0; tt < 8; ++tt) {
      const int t = t0 + tt;
      f32x4 xw[4];
#pragma unroll
      for (int j = 0; j < 4; ++j) xw[j] = (f32x4){bflo(rw[tt + j].x), bfhi(rw[tt + j].x), bflo(rw[tt + j].y), bfhi(rw[tt + j].y)};
      const f32x4 cv = cb + cw[0] * xw[0] + cw[1] * xw[1] + cw[2] * xw[2] + cw[3] * xw[3];
      f32x4 xc; for (int i = 0; i < 4; ++i) xc[i] = cv[i] * __builtin_amdgcn_rcpf(1.0f + __expf(-cv[i]));
      const f32x4 q = xc[0] * wq[0] + xc[1] * wq[1] + xc[2] * wq[2] + xc[3] * wq[3];
      f32x4 k = xc[0] * wk[0] + xc[1] * wk[1] + xc[2] * wk[2] + xc[3] * wk[3];
      const f32x4 v = xw[3][0] * wv[0] + xw[3][1] * wv[1] + xw[3][2] * wv[2] + xw[3][3] * wv[3];
      k = k * 0.0625f;
      const size_t o = (size_t)t * MW + 4 * g;
      u32x2 wqv, wkv, wvv, wxc;
      wqv.x = pk2(q[0], q[1]); wqv.y = pk2(q[2], q[3]); *(u32x2*)(Q + o) = wqv;
      wkv.x = pk2(k[0], k[1]); wkv.y = pk2(k[2], k[3]); *(u32x2*)(Kb + o) = wkv;
      wvv.x = pk2(v[0], v[1]); wvv.y = pk2(v[2], v[3]); *(u32x2*)(V + o) = wvv;
      wxc.x = pk2(xc[0], xc[1]); wxc.y = pk2(xc[2], xc[3]); *(u32x2*)(XCM + o) = wxc;
      LAS unsigned char* ar = AIMG + tt * 12304 + 8 * g;
      *(LAS u32x2*)(ar) = wqv; *(LAS u32x2*)(ar + 4096) = wkv; *(LAS u32x2*)(ar + 8192) = wvv;
    }
    LBAR();
    {
      f32x4 acc = (f32x4){0.f, 0.f, 0.f, 0.f};
#pragma unroll
      for (int ib = 0; ib < 3; ++ib) {
        bf16x8 bfr[8];
#pragma unroll
        for (int i = 0; i < 8; ++i) { const int ks = F.wave * 24 + ib * 8 + i; bfr[i] = *(const bf16x8*)(WIFT + (size_t)r * 6144 + ks * 32 + 8 * gq); }
#pragma unroll
        for (int i = 0; i < 8; ++i) { const int ks = F.wave * 24 + ib * 8 + i;
          const bf16x8 a = *(const LAS bf16x8*)(AIMG + (r & 7) * 12304 + (ks * 32 + 8 * gq) * 2);
          acc = __builtin_amdgcn_mfma_f32_16x16x32_bf16(a, bfr[i], acc, 0, 0, 0); }
      }
#pragma unroll
      for (int j = 0; j < 4; ++j) red[F.wave * 256 + (4 * gq + j) * 16 + r] = acc[j];
    }
    LBAR();
    if (F.tid < 128) {
      const int row = F.tid >> 4, n = F.tid & 15;
      float s = F.in[9][n];
#pragma unroll
      for (int w = 0; w < 8; ++w) s += red[w * 256 + F.tid];
      const int t = t0 + row, b = t >> 12, sp = t & (SEQ - 1);
      if (n < 8) IG[(size_t)(b * 8 + n) * SEQ + sp] = s;
      else LF[(size_t)(b * 8 + (n - 8)) * SEQ + sp] = fminf(s, 0.f) - log1pf(__expf(-fabsf(s)));
    }
    LBAR();
  }
}

__device__ __forceinline__ void phase_rconv(const Frame& F) {
  unsigned char* ws = F.ws;
  const bf16_t* PROJ = (const bf16_t*)(ws + WS_PROJ); bf16_t* XCR = (bf16_t*)(ws + WS_XCR);
  const int gt = F.bid * 512 + F.tid, NGT = F.G * 512;
  for (int it = gt; it < (NTOK / 16) * 640; it += NGT) {
    const int tile = it / 640, g = it % 640, t0 = tile * 16, s0 = t0 & (SEQ - 1);
    f32x4 cw[4]; for (int j = 0; j < 4; ++j) cw[j] = *(const f32x4*)(F.in[12] + j * RW + 4 * g);
    const f32x4 cb = *(const f32x4*)(F.in[13] + 4 * g);
    u32x2 rw[19];
#pragma unroll
    for (int j = 0; j < 19; ++j) { const int pos = s0 - 3 + j; rw[j] = (pos >= 0) ? *(const u32x2*)(PROJ + (size_t)(t0 - 3 + j) * INC + O_XR + 4 * g) : (u32x2){0u, 0u}; }
#pragma unroll
    for (int tt = 0; tt < 16; ++tt) {
      f32x4 cv = cb;
#pragma unroll
      for (int j = 0; j < 4; ++j) cv = cv + cw[j] * (f32x4){bflo(rw[tt + j].x), bfhi(rw[tt + j].x), bflo(rw[tt + j].y), bfhi(rw[tt + j].y)};
      u32x2 w; w.x = pk2(cv[0], cv[1]); w.y = pk2(cv[2], cv[3]); *(u32x2*)(XCR + (size_t)(t0 + tt) * RW + 4 * g) = w;
    }
  }
}

__device__ __forceinline__ float chunk_m(const float* IG, const float* LF, int bh, int c, int lane, int wave, LAS float* CS) {
  for (int cc = wave; cc < c; cc += 8) {
    const float lf = LF[(size_t)bh * SEQ + 64 * cc + lane], ig = IG[(size_t)bh * SEQ + 64 * cc + lane];
    const float b = wave_scan_sum(lf, lane), gmax = wave_max(ig - b);
    if (lane == 63) { CS[cc] = b; CS[64 + cc] = b + gmax; }
  }
  __syncthreads();
  float A = 0.f, B = -INFINITY;
  if (lane < c) { A = CS[lane]; B = CS[64 + lane]; }
#pragma unroll
  for (int o = 1; o < 64; o <<= 1) { const float pA = __shfl_up(A, o), pB = __shfl_up(B, o); if (lane >= o) { B = fmaxf(pB + A, B); A = pA + A; } }
  const float mafter = fmaxf(A, B);
  const float mc = __shfl(mafter, c > 0 ? c - 1 : 0);
  return c > 0 ? mc : 0.f;
}

__device__ __forceinline__ void phase_m1(const Frame& F, const int bid2, const int G2) {
  unsigned char* ws = F.ws;
  const bf16_t* Q = (const bf16_t*)(ws + WS_Q); const bf16_t* Kb = (const bf16_t*)(ws + WS_K); const bf16_t* V = (const bf16_t*)(ws + WS_V);
  const float* IG = (const float*)(ws + WS_SMALL + SM_IG); const float* LF = (const float*)(ws + WS_SMALL + SM_LF);
  float* INTER = (float*)(ws + WS_SMALL + SM_INTER); float* EMR = (float*)(ws + WS_SMALL + SM_EMR); float* DENI = (float*)(ws + WS_SMALL + SM_DENI);
  bf16_t* HNI = (bf16_t*)(ws + WS_HNI);
  LAS unsigned char* QS = F.lds; LAS unsigned char* KS = F.lds + 33792; LAS unsigned char* VT = F.lds + 67584; LAS unsigned char* PS = F.lds + 104448;
  LAS float* SCg = (LAS float*)(F.lds + 113664); LAS float* SCM = SCg + 64;
  const int r = F.lane & 15, gq = F.lane >> 4, w = F.wave;
  for (int item = bid2; item < 16 * NCH; item += G2) {
    const int bh = item / NCH, c = item % NCH, b = bh >> 3, h = bh & 7, tok0 = b * SEQ + 64 * c;
    const float m = chunk_m(IG, LF, bh, c, F.lane, w, (LAS float*)(F.lds + 114176));
    const float lf_c = LF[(size_t)bh * SEQ + 64 * c + F.lane], ig_c = IG[(size_t)bh * SEQ + 64 * c + F.lane];
    const float b_l = wave_scan_sum(lf_c, F.lane), g_l = ig_c - b_l;
    const float M_l = fmaxf(m, wave_scan_max(g_l, F.lane));
    if (w == 0) { SCg[F.lane] = g_l; SCM[F.lane] = M_l; INTER[(size_t)(tok0 + F.lane) * 8 + h] = __expf(m - M_l); EMR[(size_t)(tok0 + F.lane) * 8 + h] = __expf(-(b_l + M_l)); }
#pragma unroll
    for (int i = 0; i < 4; ++i) {
      const int idx = i * 512 + F.tid, row = idx >> 5, c16 = idx & 31;
      const size_t go = (size_t)(tok0 + row) * MW + 256 * h + 8 * c16;
      *(LAS u32x4*)(QS + row * 528 + c16 * 16) = *(const u32x4*)(Q + go);
      *(LAS u32x4*)(KS + row * 528 + c16 * 16) = *(const u32x4*)(Kb + go);
    }
    {
      const int sp = F.tid & 31, cq = F.tid >> 5;
#pragma unroll
      for (int i = 0; i < 2; ++i) {
        const size_t go = (size_t)(tok0 + 2 * sp) * MW + 256 * h + 8 * (cq + 16 * i);
        const u32x4 v0 = *(const u32x4*)(V + go), v1 = *(const u32x4*)(V + go + MW);
        const unsigned a0[4] = {v0.x, v0.y, v0.z, v0.w}, a1[4] = {v1.x, v1.y, v1.z, v1.w};
#pragma unroll
        for (int e = 0; e < 4; ++e) { const int dv = 8 * (cq + 16 * i) + 2 * e;
          *(LAS unsigned*)(VT + dv * 144 + sp * 4) = (a0[e] & 0xffffu) | (a1[e] << 16);
          *(LAS unsigned*)(VT + (dv + 1) * 144 + sp * 4) = (a0[e] >> 16) | (a1[e] & 0xffff0000u); }
      }
    }
    __syncthreads();
    {
      const int mi = w & 3;
#pragma unroll
      for (int nn = 0; nn < 2; ++nn) {
        const int ni = 2 * (w >> 2) + nn;
        f32x4 acc = (f32x4){0.f, 0.f, 0.f, 0.f};
        if (ni <= mi) {
#pragma unroll
          for (int ks = 0; ks < 8; ++ks) {
            const bf16x8 a = *(const LAS bf16x8*)(QS + (16 * mi + r) * 528 + (32 * ks + 8 * gq) * 2);
            const bf16x8 bb = *(const LAS bf16x8*)(KS + (16 * ni + r) * 528 + (32 * ks + 8 * gq) * 2);
            acc = __builtin_amdgcn_mfma_f32_16x16x32_bf16(a, bb, acc, 0, 0, 0);
          }
        }
        const int s = 16 * ni + r; const float gs = SCg[s];
#pragma unroll
        for (int j = 0; j < 4; ++j) { const int l = 16 * mi + 4 * gq + j; const float p = (s <= l) ? acc[j] * __expf(gs - SCM[l]) : 0.f; *(LAS bf16_t*)(PS + l * 144 + s * 2) = (bf16_t)f2bf(p); }
      }
    }
    __syncthreads();
    if (F.tid < 64) { float s = 0.f; for (int k = 0; k < 64; ++k) s += bf1(*(const LAS bf16_t*)(PS + F.tid * 144 + k * 2)); DENI[(size_t)(tok0 + F.tid) * 8 + h] = s; }
#pragma unroll
    for (int nn = 0; nn < 2; ++nn) {
      const int ni = 2 * w + nn;
#pragma unroll
      for (int mi = 0; mi < 4; ++mi) {
        f32x4 acc = (f32x4){0.f, 0.f, 0.f, 0.f};
#pragma unroll
        for (int ks = 0; ks < 2; ++ks) {
          const bf16x8 a = *(const LAS bf16x8*)(PS + (16 * mi + r) * 144 + (32 * ks + 8 * gq) * 2);
          const bf16x8 bb = *(const LAS bf16x8*)(VT + (16 * ni + r) * 144 + (32 * ks + 8 * gq) * 2);
          acc = __builtin_amdgcn_mfma_f32_16x16x32_bf16(a, bb, acc, 0, 0, 0);
        }
#pragma unroll
        for (int j = 0; j < 4; ++j) HNI[(size_t)(tok0 + 16 * mi + 4 * gq + j) * MW + 256 * h + 16 * ni + r] = (bf16_t)f2bf(acc[j]);
      }
    }
    __syncthreads();
  }
}

__device__ __forceinline__ void phase_m2(const Frame& F, const int nblk) {
  unsigned char* ws = F.ws;
  const bf16_t* Q = (const bf16_t*)(ws + WS_Q); const bf16_t* Kb = (const bf16_t*)(ws + WS_K); const bf16_t* V = (const bf16_t*)(ws + WS_V);
  const float* IG = (const float*)(ws + WS_SMALL + SM_IG); const float* LF = (const float*)(ws + WS_SMALL + SM_LF);
  float* QN = (float*)(ws + WS_SMALL + SM_QN);
  bf16_t* HNE = (bf16_t*)(ws + WS_HNE);
  LAS unsigned char* QS = F.lds; LAS unsigned char* KT = F.lds + 33792; LAS unsigned char* WVT = F.lds + 70656; LAS unsigned char* CT = F.lds + 77568;
  LAS float* TD = (LAS float*)(F.lds + 111360); LAS float* CS = (LAS float*)(F.lds + 111616);
  float* DUMMY = (float*)(ws + WS_M2TAB + 4 * MiB);
  const int w = F.wave;
  for (int item = F.bid; item < 128; item += nblk) {
    const int bh = item >> 3, sl = item & 7, b = bh >> 3, h = bh & 7, dv0 = 32 * sl;
    float* TI = (float*)(ws + WS_M2TAB) + (size_t)item * 8192; float* TW = TI + 4096;
    const int lane = F.lane;
    for (int i = F.tid; i < (6912 + 33792) / 4; i += 512) *(LAS unsigned*)(WVT + 4 * i) = 0u;
    float gk[8], pk[8];
#pragma unroll
    for (int i = 0; i < 8; ++i) {
      const int cc = w + 8 * i;
      const float lf = LF[(size_t)bh * SEQ + 64 * cc + lane], ig = IG[(size_t)bh * SEQ + 64 * cc + lane];
      const float bl = wave_scan_sum(lf, lane), g = ig - bl;
      const float gmax = wave_max(g), pm = wave_scan_max(g, lane);
      gk[i] = g; pk[i] = pm;
      if (lane == 63) { CS[cc] = bl; CS[64 + cc] = bl + gmax; }
    }
    __syncthreads();
    {
      float A = CS[lane], B = CS[64 + lane]; const float gmx = B - A;
#pragma unroll
      for (int o = 1; o < 64; o <<= 1) { const float pA = __shfl_up(A, o), pB = __shfl_up(B, o); if (lane >= o) { B = fmaxf(pB + A, B); A = pA + A; } }
      const float mafter = fmaxf(A, B);
      float mstart = __shfl_up(mafter, 1); if (lane == 0) mstart = 0.f;
      const float M63 = fmaxf(mstart, gmx);
      if (w == 0) TD[lane] = __expf(mstart - M63);
#pragma unroll
      for (int i = 0; i < 8; ++i) {
        const int cc = w + 8 * i;
        const float ms = __shfl(mstart, cc), m6 = __shfl(M63, cc);
        TI[cc * 64 + lane] = __expf(ms - fmaxf(ms, pk[i])); TW[cc * 64 + lane] = __expf(gk[i] - m6);
      }
    }
    __threadfence(); __syncthreads();
    f32x4 acc[2][3];
#pragma unroll
    for (int a = 0; a < 2; ++a)
#pragma unroll
      for (int n = 0; n < 3; ++n) acc[a][n] = (f32x4){0.f, 0.f, 0.f, 0.f};
    u32x4 qrA[4], krA[2][2], vrA = (u32x4){0u, 0u, 0u, 0u}, qrB[4], krB[2][2], vrB = (u32x4){0u, 0u, 0u, 0u};
    float wsA = 0.f, wsB = 0.f; f32x4 ivA = (f32x4){0.f, 0.f, 0.f, 0.f}, ivB = ivA;
#define M2_LOAD(qreg, kreg, vreg, wsr, ivr, c) do { const int tk_ = b * SEQ + 64 * (c); \
      _Pragma("unroll") for (int i = 0; i < 4; ++i) { const int idx = i * 512 + tdx, row = idx >> 5, c16 = idx & 31; qreg[i] = *(const u32x4*)(Q + (size_t)(tk_ + row) * MW + 256 * h + 8 * c16); } \
      _Pragma("unroll") for (int i = 0; i < 2; ++i) { const size_t go = (size_t)(tk_ + 2 * sp) * MW + 256 * h + 8 * (cq + 16 * i); kreg[i][0] = *(const u32x4*)(Kb + go); kreg[i][1] = *(const u32x4*)(Kb + go + MW); } \
      vreg = *(const u32x4*)(V + (size_t)(tk_ + lane) * MW + 256 * h + dv0 + 8 * (w & 3)); \
      wsr = TW[(c) * 64 + lane]; \
      ivr = *(const f32x4*)(TI + (c) * 64 + 16 * (w & 3) + 4 * gq); } while (0)
#define M2_AMMA(mi, nt) \
        f32x4 a2 = (f32x4){0.f, 0.f, 0.f, 0.f}; \
        _Pragma("unroll") for (int ks = 0; ks < 8; ++ks) { \
          const bf16x8 a = *(const LAS bf16x8*)(QS + (16 * (mi) + r) * 528 + (32 * ks + 8 * gq) * 2); \
          const bf16x8 bb = *(const LAS bf16x8*)(CT + (16 * (nt) + r) * 528 + (32 * ks + 8 * gq) * 2); \
          a2 = __builtin_amdgcn_mfma_f32_16x16x32_bf16(a, bb, a2, 0, 0, 0); }
#define M2_ATILE_H(mi, nt, tok0, ivr) do { M2_AMMA(mi, nt) \
        _Pragma("unroll") for (int j = 0; j < 4; ++j) { const int l = 16 * (mi) + 4 * gq + j; \
          HNE[(size_t)((tok0) + l) * MW + 256 * h + dv0 + 16 * (nt) + r] = (bf16_t)f2bf(a2[j] * ivr[j]); } } while (0)
#define M2_ATILE_Q(mi, nt, tok0, ivr) do { M2_AMMA(mi, nt) \
        _Pragma("unroll") for (int j = 0; j < 4; ++j) { const int l = 16 * (mi) + 4 * gq + j; \
          float* qp = ((nt) == 2 && r == 0) ? (QN + (size_t)((tok0) + l) * 8 + h) : (DUMMY + tdx * 4 + j); *qp = a2[j] * ivr[j]; } } while (0)
#define M2_BODY(c, qreg, kreg, vreg, wsr, ivr) do { \
      int tdx = (int)threadIdx.x; asm volatile("" : "+v"(tdx)); \
      const int lane = tdx & 63, r = lane & 15, gq = lane >> 4, sp = tdx & 31, cq = tdx >> 5; \
      const int tok0 = b * SEQ + 64 * (c); \
      _Pragma("unroll") for (int i = 0; i < 4; ++i) { const int idx = i * 512 + tdx, row = idx >> 5, c16 = idx & 31; *(LAS u32x4*)(QS + row * 528 + c16 * 16) = qreg[i]; } \
      _Pragma("unroll") for (int i = 0; i < 2; ++i) { \
        const unsigned k0[4] = {kreg[i][0].x, kreg[i][0].y, kreg[i][0].z, kreg[i][0].w}, k1[4] = {kreg[i][1].x, kreg[i][1].y, kreg[i][1].z, kreg[i][1].w}; \
        _Pragma("unroll") for (int e = 0; e < 4; ++e) { const int dk = 8 * (cq + 16 * i) + 2 * e; \
          *(LAS unsigned*)(KT + dk * 144 + sp * 4) = (k0[e] & 0xffffu) | (k1[e] << 16); \
          *(LAS unsigned*)(KT + (dk + 1) * 144 + sp * 4) = (k0[e] >> 16) | (k1[e] & 0xffff0000u); } } \
      if (w < 4) { const unsigned vw[4] = {vreg.x, vreg.y, vreg.z, vreg.w}; \
        _Pragma("unroll") for (int e = 0; e < 4; ++e) { *(LAS bf16_t*)(WVT + (8 * w + 2 * e) * 144 + lane * 2) = (bf16_t)f2bf(bflo(vw[e]) * wsr); *(LAS bf16_t*)(WVT + (8 * w + 2 * e + 1) * 144 + lane * 2) = (bf16_t)f2bf(bfhi(vw[e]) * wsr); } \
      } else if (w == 4) { *(LAS bf16_t*)(WVT + 32 * 144 + lane * 2) = (bf16_t)f2bf(wsr); } \
      const f32x4 ivc = ivr; \
      { const int cn_ = ((c) + 2 < NCH) ? (c) + 2 : NCH - 1; M2_LOAD(qreg, kreg, vreg, wsr, ivr, cn_); } \
      LBAR(); \
      M2_ATILE_H(w & 3, w >> 2, tok0, ivc); \
      M2_ATILE_Q(w & 3, 2 + (w >> 2), tok0, ivc); \
      const float decay = TD[(c)]; \
      _Pragma("unroll") for (int mt = 0; mt < 2; ++mt) \
        _Pragma("unroll") for (int n2 = 0; n2 < 3; ++n2) { \
          f32x4 cacc = acc[mt][n2] * decay; \
          _Pragma("unroll") for (int ks = 0; ks < 2; ++ks) { \
            const bf16x8 a = *(const LAS bf16x8*)(KT + (32 * w + 16 * mt + r) * 144 + (32 * ks + 8 * gq) * 2); \
            const bf16x8 bb = *(const LAS bf16x8*)(WVT + (16 * n2 + r) * 144 + (32 * ks + 8 * gq) * 2); \
            cacc = __builtin_amdgcn_mfma_f32_16x16x32_bf16(a, bb, cacc, 0, 0, 0); } \
          acc[mt][n2] = cacc; } \
      LBAR(); \
      _Pragma("unroll") for (int mt = 0; mt < 2; ++mt) \
        _Pragma("unroll") for (int n2 = 0; n2 < 3; ++n2) { u32x2 q; q.x = pk2(acc[mt][n2][0], acc[mt][n2][1]); q.y = pk2(acc[mt][n2][2], acc[mt][n2][3]); \
          *(LAS u32x2*)(CT + (16 * n2 + r) * 528 + (32 * w + 16 * mt + 4 * gq) * 2) = q; } \
    } while (0)
    { const int tdx = F.tid, sp = tdx & 31, cq = tdx >> 5, gq = (tdx & 63) >> 4;
      M2_LOAD(qrA, krA, vrA, wsA, ivA, 0);
      M2_LOAD(qrB, krB, vrB, wsB, ivB, 1); }
    __syncthreads();
#pragma unroll 1
    for (int c = 0; c < NCH; c += 2) {
      M2_BODY(c, qrA, krA, vrA, wsA, ivA);
      M2_BODY(c + 1, qrB, krB, vrB, wsB, ivB);
    }
#undef M2_BODY
#undef M2_ATILE_H
#undef M2_ATILE_Q
#undef M2_AMMA
#undef M2_LOAD
    __syncthreads();
  }
}

__device__ __forceinline__ void phase_ragg(const Frame& F) {
  unsigned char* ws = F.ws;
  const float* RA = (const float*)(ws + WS_RA); const bf16_t* RBb = (const bf16_t*)(ws + WS_RB);
  float* AGGA = (float*)(ws + WS_SMALL + SM_AGGA); float* AGGB = (float*)(ws + WS_SMALL + SM_AGGB);
  const int gt = F.bid * 512 + F.tid, NGT = F.G * 512;
#pragma unroll 1
  for (int it = gt; it < 2 * NCH * RW; it += NGT) {
    const int bc = it / RW, ch = it - bc * RW;
    const float* pa = RA + (size_t)bc * 64 * RW + ch; const bf16_t* pb = RBb + (size_t)bc * 64 * RW + ch;
    float A = 1.f, B = 0.f;
#pragma unroll 1
    for (int tb = 0; tb < 8; ++tb) {
      float a[8]; float bb[8];
#pragma unroll
      for (int t = 0; t < 8; ++t) { a[t] = pa[(size_t)(tb * 8 + t) * RW]; bb[t] = bf1(pb[(size_t)(tb * 8 + t) * RW]); }
#pragma unroll
      for (int t = 0; t < 8; ++t) { A *= a[t]; B = a[t] * B + bb[t]; }
    }
    AGGA[it] = A; AGGB[it] = B;
  }
}
__device__ __forceinline__ void phase_rscan(const Frame& F) {
  unsigned char* ws = F.ws;
  const float* RA = (const float*)(ws + WS_RA); const bf16_t* RBb = (const bf16_t*)(ws + WS_RB);
  const float* AGGA = (const float*)(ws + WS_SMALL + SM_AGGA); const float* AGGB = (const float*)(ws + WS_SMALL + SM_AGGB);
  const bf16_t* PROJ = (const bf16_t*)(ws + WS_PROJ); bf16_t* YR = (bf16_t*)(ws + WS_YR);
  const int gt = F.bid * 512 + F.tid, NGT = F.G * 512;
  for (int it = gt; it < 2 * NCH * RW; it += NGT) {
    const int bc = it / RW, ch = it % RW, t0 = bc * 64, b = bc / NCH, cidx = bc % NCH;
    float hcar = 0.f;
    for (int c0 = 0; c0 < cidx; c0 += 16) {
      float ca[16], cb[16];
#pragma unroll
      for (int k = 0; k < 16; ++k) { const int cc = c0 + k; const int j = (b * NCH + (cc < cidx ? cc : 0)) * RW + ch; ca[k] = AGGA[j]; cb[k] = AGGB[j]; }
#pragma unroll
      for (int k = 0; k < 16; ++k) { if (c0 + k < cidx) hcar = ca[k] * hcar + cb[k]; }
    }
#pragma unroll
    for (int tb = 0; tb < 4; ++tb) {
      float a[16]; bf16_t bb[16], xg[16];
#pragma unroll
      for (int t = 0; t < 16; ++t) { const size_t o = (size_t)(t0 + tb * 16 + t) * RW + ch; a[t] = RA[o]; bb[t] = RBb[o]; xg[t] = PROJ[(size_t)(t0 + tb * 16 + t) * INC + O_XG + ch]; }
#pragma unroll
      for (int t = 0; t < 16; ++t) { hcar = a[t] * hcar + bf1(bb[t]); YR[(size_t)(t0 + tb * 16 + t) * RW + ch] = (bf16_t)f2bf(hcar * gelu_tanh(bf1(xg[t]))); }
    }
  }
}

__device__ __forceinline__ void phase_ym(const Frame& F) {
  unsigned char* ws = F.ws;
  const bf16_t* HNI = (const bf16_t*)(ws + WS_HNI); const bf16_t* HNE = (const bf16_t*)(ws + WS_HNE);
  const float* EMR = (const float*)(ws + WS_SMALL + SM_EMR); const float* DENI = (const float*)(ws + WS_SMALL + SM_DENI); const float* QN = (const float*)(ws + WS_SMALL + SM_QN);
  const bf16_t* XCM = (const bf16_t*)(ws + WS_XCM); const bf16_t* PROJ = (const bf16_t*)(ws + WS_PROJ); bf16_t* YM = (bf16_t*)(ws + WS_YM);
  const float* normw = F.in[10]; const float* skip = F.in[11];
  const int gw = F.bid * 8 + F.wave, NGW = F.G * 8, lane = F.lane;
  for (int t = gw; t < NTOK; t += NGW) {
    u32x2 a[8], e[8], xcw[8], zw[8]; float den[8], emr[8];
#pragma unroll
    for (int h = 0; h < 8; ++h) {
      const size_t o = (size_t)t * MW + 256 * h + 4 * lane;
      a[h] = *(const u32x2*)(HNI + o); e[h] = *(const u32x2*)(HNE + o); xcw[h] = *(const u32x2*)(XCM + o); zw[h] = *(const u32x2*)(PROJ + (size_t)t * INC + O_Z + 256 * h + 4 * lane);
      den[h] = DENI[t * 8 + h] + QN[t * 8 + h]; emr[h] = EMR[t * 8 + h];
    }
#pragma unroll
    for (int h = 0; h < 8; ++h) {
      const int col = 256 * h + 4 * lane;
      const float inv = 1.0f / fmaxf(fabsf(den[h]), emr[h]);
      const float hv[4] = {(bflo(a[h].x) + bflo(e[h].x)) * inv, (bfhi(a[h].x) + bfhi(e[h].x)) * inv, (bflo(a[h].y) + bflo(e[h].y)) * inv, (bfhi(a[h].y) + bfhi(e[h].y)) * inv};
      const float mean = wave_sum((hv[0] + hv[1]) + (hv[2] + hv[3])) * (1.0f / 256.0f);
      float d[4]; float s2 = 0.f;
#pragma unroll
      for (int j = 0; j < 4; ++j) { d[j] = hv[j] - mean; s2 += d[j] * d[j]; }
      const float rstd = rsqrtf(wave_sum(s2) * (1.0f / 256.0f) + LN_EPS);
      const f32x4 nw = *(const f32x4*)(normw + col), sk = *(const f32x4*)(skip + col);
      const float xc[4] = {bflo(xcw[h].x), bfhi(xcw[h].x), bflo(xcw[h].y), bfhi(xcw[h].y)}, z[4] = {bflo(zw[h].x), bfhi(zw[h].x), bflo(zw[h].y), bfhi(zw[h].y)};
      float y[4];
#pragma unroll
      for (int j = 0; j < 4; ++j) y[j] = (d[j] * rstd * nw[j] + sk[j] * xc[j]) * siluf_(z[j]);
      u32x2 w; w.x = pk2(y[0], y[1]); w.y = pk2(y[2], y[3]); *(u32x2*)(YM + (size_t)t * RW + col) = w;
    }
  }
}

__device__ __forceinline__ void phase_ln_router(const Frame& F) {
  unsigned char* ws = F.ws;
  float* X1 = (float*)(ws + WS_X1); unsigned char* X1Q = ws + WS_X1B;
  int* CNT = (int*)(ws + WS_CTL); int* LIST = (int*)(ws + WS_LIST); float* LISTW = (float*)(ws + WS_LISTW); int* TOKES = (int*)(ws + WS_TOKES);
  const float* g1 = F.in[22]; const float* b1 = F.in[23]; const float* rw = F.in[24]; const float* rbias = F.in[25];
  LAS unsigned char* XH = F.lds; LAS unsigned char* XL = F.lds + 65792;
  const bf16_t* RWH = (const bf16_t*)(ws + WS_SMALL + SM_RWH); const bf16_t* RWL = (const bf16_t*)(ws + WS_SMALL + SM_RWL);
  const int w = F.wave;
  for (int tile = F.bid; tile < NTOK / 16; tile += F.G) {
    const int t0 = tile * 16;
    int lane = F.lane; asm volatile("" : "+v"(lane));
    const int r16 = lane & 15, gq = lane >> 4;
#pragma unroll 1
    for (int q = 0; q < 2; ++q) {
      const int tl = 2 * w + q, t = t0 + tl;
      float* xr = X1 + (size_t)t * DM;
      f32x4 v[8]; float s = 0.f;
#pragma unroll
      for (int j = 0; j < 8; ++j) { v[j] = *(const f32x4*)(xr + 4 * lane + 256 * j); s += (v[j][0] + v[j][1]) + (v[j][2] + v[j][3]); }
      const float mean = wave_sum(s) * (1.0f / DM); float s2 = 0.f;
#pragma unroll
      for (int j = 0; j < 8; ++j) { v[j] = v[j] - mean; s2 += (v[j][0] * v[j][0] + v[j][1] * v[j][1]) + (v[j][2] * v[j][2] + v[j][3] * v[j][3]); }
      const float rstd = rsqrtf(wave_sum(s2) * (1.0f / DM) + LN_EPS);
#pragma unroll
      for (int j = 0; j < 8; ++j) {
        const int col = 4 * lane + 256 * j;
        const f32x4 gg = *(const f32x4*)(g1 + col), bb = *(const f32x4*)(b1 + col);
        const f32x4 o = v[j] * rstd * gg + bb;
        *(f32x4*)(xr + col) = o;
        u32x2 pw; pw.x = pk2(o[0], o[1]); pw.y = pk2(o[2], o[3]);
        { int q8 = 0; q8 = __builtin_amdgcn_cvt_pk_fp8_f32(o[0], o[1], q8, false); q8 = __builtin_amdgcn_cvt_pk_fp8_f32(o[2], o[3], q8, true); *(int*)(X1Q + (size_t)t * DM + col) = q8; }
        { float lo[4];
#pragma unroll
          for (int e = 0; e < 4; ++e) lo[e] = o[e] - __uint_as_float(f2bf(o[e]) << 16);
          *(LAS u32x2*)(XH + tl * 4112 + col * 2) = pw; u32x2 lw; lw.x = pk2(lo[0], lo[1]); lw.y = pk2(lo[2], lo[3]); *(LAS u32x2*)(XL + tl * 4112 + col * 2) = lw; }
      }
    }
    __syncthreads();
    f32x4 lacc[4];
    {
      const bf16_t* rh = RWH + (size_t)r16 * DM + 256 * w + 8 * gq; const bf16_t* rl = RWL + (size_t)r16 * DM + 256 * w + 8 * gq;
      const LAS unsigned char* xh = XH + r16 * 4112 + (256 * w + 8 * gq) * 2; const LAS unsigned char* xl = XL + r16 * 4112 + (256 * w + 8 * gq) * 2;
#pragma unroll
      for (int nt = 0; nt < 4; ++nt) {
        f32x4 a4 = (f32x4){0.f, 0.f, 0.f, 0.f};
#pragma unroll
        for (int kh = 0; kh < 2; ++kh) {
          bf16x8 bh[4], bl[4];
#pragma unroll
          for (int k2 = 0; k2 < 4; ++k2) { bh[k2] = *(const bf16x8*)(rh + (size_t)(16 * nt) * DM + 32 * (4 * kh + k2)); bl[k2] = *(const bf16x8*)(rl + (size_t)(16 * nt) * DM + 32 * (4 * kh + k2)); }
#pragma unroll
          for (int k2 = 0; k2 < 4; ++k2) {
            const bf16x8 ah = *(const LAS bf16x8*)(xh + 64 * (4 * kh + k2));
            const bf16x8 al = *(const LAS bf16x8*)(xl + 64 * (4 * kh + k2));
            a4 = __builtin_amdgcn_mfma_f32_16x16x32_bf16(ah, bh[k2], a4, 0, 0, 0);
            a4 = __builtin_amdgcn_mfma_f32_16x16x32_bf16(al, bh[k2], a4, 0, 0, 0);
            a4 = __builtin_amdgcn_mfma_f32_16x16x32_bf16(ah, bl[k2], a4, 0, 0, 0);
          }
          asm volatile("" ::: "memory");
        }
        lacc[nt] = a4;
      }
    }
    __syncthreads();
    LAS float* PART = (LAS float*)F.lds;
#pragma unroll
    for (int nt = 0; nt < 4; ++nt)
#pragma unroll
      for (int j = 0; j < 4; ++j) PART[(w * 16 + 4 * gq + j) * 64 + 16 * nt + r16] = lacc[nt][j];
    __syncthreads();
    LAS int* lcnt = (LAS int*)(F.lds + 40960); LAS int* lbase = lcnt + 64;
    if (F.tid < 64) lcnt[F.tid] = 0;
    __syncthreads();
    int lslot[2], rnk[2]; float wg[2];
#pragma unroll
    for (int q = 0; q < 2; ++q) {
      const int tl = 2 * w + q;
      float logit = 0.f;
#pragma unroll
      for (int ww = 0; ww < 8; ++ww) logit += PART[(ww * 16 + tl) * 64 + lane];
      const float score = 1.0f / (1.0f + expf(-logit));
      const float biased = score + rbias[lane];
      int cnt = 0;
#pragma unroll
      for (int d = 1; d < 8; ++d) { const int other = (lane & ~7) | ((lane + d) & 7); const float ov = __shfl(biased, other); cnt += (ov > biased || (ov == biased && other < lane)) ? 1 : 0; }
      float gs = cnt < 2 ? biased : 0.f;
      gs += __shfl_xor(gs, 1); gs += __shfl_xor(gs, 2); gs += __shfl_xor(gs, 4);
      const int gi = lane >> 3; int grank = 0;
#pragma unroll
      for (int gg = 0; gg < 8; ++gg) { const float og = __shfl(gs, 8 * gg); grank += (og > gs || (og == gs && gg < gi)) ? 1 : 0; }
      const float val = grank < 4 ? biased : -INFINITY;
      int erank = 0;
      for (int e2 = 0; e2 < 64; ++e2) { const float ov = __shfl(val, e2); erank += (ov > val || (ov == val && e2 < lane)) ? 1 : 0; }
      const bool chosen = erank < 8;
      const float wsum = wave_sum(chosen ? score : 0.f);
      rnk[q] = erank; wg[q] = score / wsum * 2.5f; lslot[q] = -1;
      if (chosen) lslot[q] = atomicAdd((int*)(lcnt + lane), 1);
    }
    __syncthreads();
    if (F.tid < 64) { const int c = lcnt[F.tid]; lbase[F.tid] = c ? atomicAdd(&CNT[F.tid * 64], c) : 0; }
    __syncthreads();
#pragma unroll
    for (int q = 0; q < 2; ++q) {
      if (lslot[q] >= 0) { const int t = t0 + 2 * w + q; const int slot = lbase[lane] + lslot[q];
        LIST[lane * NTOK + slot] = t; LISTW[lane * NTOK + slot] = wg[q]; TOKES[t * 8 + rnk[q]] = (lane << 16) | slot; }
    }
    __syncthreads();
  }
}

__device__ __forceinline__ MoeTab build_moe_tab(const Frame& F) {
  LAS int* tp = (LAS int*)(F.lds + LDS_X); LAS int* cp = tp + 68; LAS int* cn = tp + 136;
  const int* CNT = (const int*)(F.ws + WS_CTL);
  if (F.tid == 0) { int a = 0, b = 0; for (int e = 0; e < NE; ++e) { const int c = CNT[e * 64]; tp[e] = a; cp[e] = b; cn[e] = c; a += (c + 255) >> 8; b += c; } tp[NE] = a; cp[NE] = b; }
  __syncthreads();
  { LAS int* rt = tp + 256; if (F.tid < 384) { int e = 0; for (int k = 0; k < NE; ++k) { if (tp[k + 1] <= F.tid) e = k + 1; } rt[F.tid] = e < NE ? e : NE - 1; } }
  __syncthreads();
  MoeTab T; T.tp = tp; T.cp = cp; T.cnt = cn; T.n_rt = __builtin_amdgcn_readfirstlane(tp[NE]);
  return T;
}

__device__ __forceinline__ void phase_final(const Frame& F, const MoeTab& T) {
  unsigned char* ws = F.ws;
  const bf16_t* YRM = (const bf16_t*)(ws + WS_YRM); const int* TOKES = (const int*)(ws + WS_TOKES);
  const float* g2 = F.in[32]; const float* b2 = F.in[33];
  const int gw = F.bid * 8 + F.wave, NGW = F.G * 8, lane = F.lane;
  for (int t = gw; t < NTOK; t += NGW) {
    float* orow = F.out + (size_t)t * DM;
    f32x4 v[8];
    { const float* xrow = (const float*)(ws + WS_X1) + (size_t)t * DM; const bf16_t* ys = YRM + (size_t)(NTOK * 8 + t) * DM;
#pragma unroll
      for (int j = 0; j < 8; ++j) { const u32x2 wv = *(const u32x2*)(ys + 4 * lane + 256 * j); v[j] = *(const f32x4*)(xrow + 4 * lane + 256 * j) * ALPHA; v[j][0] += bflo(wv.x); v[j][1] += bfhi(wv.x); v[j][2] += bflo(wv.y); v[j][3] += bfhi(wv.y); } }
    const int esl = TOKES[t * 8 + (lane & 7)];
#pragma unroll
    for (int kb = 0; kb < 2; ++kb) {
      u32x2 yv[4][8];
#pragma unroll
      for (int k = 0; k < 4; ++k) {
        const int es = __shfl(esl, kb * 4 + k); const int e = es >> 16, slot = es & 0xffff;
        const bf16_t* yr = YRM + (size_t)(T.cp[e] + slot) * DM;
#pragma unroll
        for (int j = 0; j < 8; ++j) yv[k][j] = *(const u32x2*)(yr + 4 * lane + 256 * j);
      }
#pragma unroll
      for (int k = 0; k < 4; ++k)
#pragma unroll
        for (int j = 0; j < 8; ++j) { v[j][0] += bflo(yv[k][j].x); v[j][1] += bfhi(yv[k][j].x); v[j][2] += bflo(yv[k][j].y); v[j][3] += bfhi(yv[k][j].y); }
    }
    float s = 0.f;
#pragma unroll
    for (int j = 0; j < 8; ++j) s += (v[j][0] + v[j][1]) + (v[j][2] + v[j][3]);
    const float mean = wave_sum(s) * (1.0f / DM); float s2 = 0.f;
#pragma unroll
    for (int j = 0; j < 8; ++j) { v[j] = v[j] - mean; s2 += (v[j][0] * v[j][0] + v[j][1] * v[j][1]) + (v[j][2] * v[j][2] + v[j][3] * v[j][3]); }
    const float rstd = rsqrtf(wave_sum(s2) * (1.0f / DM) + LN_EPS);
#pragma unroll
    for (int j = 0; j < 8; ++j) { const int col = 4 * lane + 256 * j; const f32x4 gg = *(const f32x4*)(g2 + col), bb = *(const f32x4*)(b2 + col); *(f32x4*)(orow + col) = v[j] * rstd * gg + bb; }
  }
}

__global__ void __launch_bounds__(512, 2) fwd_megakernel(Params p, int ph_lo, int ph_hi) {
  extern __shared__ __attribute__((aligned(16))) unsigned char lds_raw[];
  Frame F;
  F.lds = (LAS unsigned char*)lds_raw; F.tid = threadIdx.x; F.lane = F.tid & 63; F.wave = __builtin_amdgcn_readfirstlane(F.tid >> 6);
  F.G = gridDim.x; F.bid = blockIdx.x; F.ws = as_global(p.ws); F.in = InPtrs{p.in}; F.out = as_global(p.out);
  unsigned char* ws = as_global(p.ws);
#ifndef PHMASK
#define PHMASK 0xFFF
#endif
#define IN(k) (((PHMASK >> (k)) & 1) && ph_lo <= (k) && (k) < ph_hi)
#ifndef RPTMASK
#define RPTMASK 0
#endif
#define RPT(k) for (int _rp = 0; _rp < 1 + ((RPTMASK >> (k)) & 1); ++_rp)
#define FRESH() do { unsigned char* w2_ = opaque_global(p.ws); ws = w2_; F.ws = w2_; int l2_ = (int)__builtin_amdgcn_mbcnt_hi(~0u, __builtin_amdgcn_mbcnt_lo(~0u, 0u)); asm volatile("" : "+v"(l2_)); F.lane = l2_; F.tid = F.wave * 64 + l2_; } while (0)
#define SYNC(k) do { if (IN(k) && IN((k) + 1)) { xcd_barrier(xbar); } } while (0)
  { volatile LAS unsigned* st = (volatile LAS unsigned*)(F.lds + LDS_X + 4096); if (F.tid < 4) st[F.tid] = 0u; }
  __syncthreads();
  const XcdBarrier xbar = xcd_barrier_post((unsigned*)(ws + WS_CTL + 16384), (volatile LAS unsigned*)(F.lds + LDS_X + 4096));

  FRESH();
  if (IN(0)) RPT(0) { if (_rp) xcd_barrier(xbar); phase_prologue(F); }
  SYNC(0);
  FRESH();
  if (IN(1)) RPT(1) { if (_rp) xcd_barrier(xbar);
    SchedDense S{(const char*)(ws + WS_XB), (const char*)(ws + WS_WIN), NTOK / 256, INC / 256, F.G, F.bid, DM, DM, DM / 64};
    EpiStoreBf16 E{(bf16_t*)(ws + WS_PROJ), INC};
    pg8::gemm_phase<EpiStoreBf16, SchedDense, false>(F.lds, DM, DM, S, E);
  }
  SYNC(1);
  FRESH();
  if (IN(2)) RPT(2) { if (_rp) xcd_barrier(xbar); phase_mprep(F); phase_rconv(F); }
  SYNC(2);
  FRESH();
  if (IN(3)) RPT(3) { if (_rp) xcd_barrier(xbar);
    const int nm2 = F.G >> 1;
    if (F.bid < nm2) phase_m2(F, nm2);
    else {
      const int bid2 = F.bid - nm2, G2 = F.G - nm2;
      phase_m1(F, bid2, G2);
      int Kr = 4; asm volatile("" : "+s"(Kr));
      SchedRglru S{(const char*)(ws + WS_XCR), (const char*)(ws + WS_WRAX), G2, bid2, Kr};
      EpiRglru E{(const bf16_t*)(ws + WS_XCR), p.in[15], p.in[17], (const float*)(ws + WS_SMALL + SM_C8), (float*)(ws + WS_RA), (bf16_t*)(ws + WS_RB)};
      pg8::gemm_phase<EpiRglru, SchedRglru, false>(F.lds, RW, 256, S, E);
    }
  }
  SYNC(3);
  FRESH();
  if (IN(4)) RPT(4) { if (_rp) xcd_barrier(xbar); phase_ragg(F); phase_ym(F); }
  SYNC(4);
  FRESH();
  if (IN(5)) RPT(5) { if (_rp) xcd_barrier(xbar); phase_rscan(F); }
  SYNC(5);
  FRESH();
  if (IN(6)) RPT(6) { if (_rp) xcd_barrier(xbar);
    SchedMerge S{(const char*)(ws + WS_YM), (const char*)(ws + WS_YR), (const char*)(ws + WS_WPM), (const char*)(ws + WS_WPR), F.G, F.bid};
    EpiMergeF E{(const bf16_t*)(ws + WS_PROJ), p.in[2], (bf16_t*)(ws + WS_MERGED)};
    pg8::gemm_phase<EpiMergeF, SchedMerge, false>(F.lds, RW, RW, S, E);
  }
  SYNC(6);
  FRESH();
  if (IN(7)) RPT(7) { if (_rp) xcd_barrier(xbar);
    SchedDense S{(const char*)(ws + WS_MERGED), (const char*)(ws + WS_WO), NTOK / 256, DM / 256, F.G, F.bid, DM, DM, DM / 64};
    EpiWo E{p.in[0], (float*)(ws + WS_X1)};
    pg8::gemm_phase<EpiWo, SchedDense, false>(F.lds, DM, DM, S, E);
  }
  SYNC(7);
  FRESH();
  if (IN(8)) phase_ln_router(F);
  SYNC(8);
  FRESH();
  if (IN(9)) RPT(9) { if (_rp) xcd_barrier(xbar);
    const MoeTab T = build_moe_tab(F);
    SchedMoe<4, 1> S{T, (const int*)(ws + WS_LIST), (const char*)(ws + WS_X1B), (const char*)(ws + WS_WEGU), (const char*)(ws + WS_WSGU), F.G, F.bid, DM / 128};
    EpiMoe1 E{ws + WS_HMOE};
    pg8::gemm_phase<EpiMoe1, SchedMoe<4, 1>, true>(F.lds, DM / 2, DM / 2, S, E);
  }
  SYNC(9);
  FRESH();
  if (IN(10)) RPT(10) { if (_rp) xcd_barrier(xbar);
    const MoeTab T = build_moe_tab(F);
    int nt2 = DE / 128; asm volatile("" : "+s"(nt2));
    SchedMoe<8, 2> S{T, (const int*)(ws + WS_LIST), (const char*)(ws + WS_HMOE), (const char*)(ws + WS_WED), (const char*)(ws + WS_WSD), F.G, F.bid, nt2};
    EpiMoe2 E{(bf16_t*)(ws + WS_YRM), (const float*)(ws + WS_LISTW), (bf16_t*)(ws + WS_WIN)};
    pg8::gemm_phase<EpiMoe2, SchedMoe<8, 2>, false>(F.lds, DE / 2, DE / 2, S, E);
  }
  SYNC(10);
  FRESH();
  if (IN(11)) { const MoeTab T = build_moe_tab(F); phase_final(F, T); }
#undef IN
#undef SYNC
}

#ifndef N_LAUNCH_SPLIT
#define N_LAUNCH_SPLIT 0
#endif
extern "C" void kernel_launch(void* const* d_in, const int* in_sizes, int n_in, void* d_out, int out_size, void* d_ws, size_t ws_size, hipStream_t stream) {
  static int grid_blocks = 0;
  if (grid_blocks == 0) {
    int dev = 0, cus = 0, per_cu = 0;
    (void)hipGetDevice(&dev);
    (void)hipDeviceGetAttribute(&cus, hipDeviceAttributeMultiprocessorCount, dev);
    (void)hipFuncSetAttribute((const void*)fwd_megakernel, hipFuncAttributeMaxDynamicSharedMemorySize, LDS_BYTES);
    (void)hipOccupancyMaxActiveBlocksPerMultiprocessor(&per_cu, fwd_megakernel, 512, LDS_BYTES);
    if (per_cu < 1) { fprintf(stderr, "kernel_launch: occupancy query says %d blocks per CU\n", per_cu); per_cu = 1; }
    grid_blocks = cus * per_cu;
    fprintf(stderr, "kernel_launch: cus %d per_cu %d grid %d ws_size %zu (need %zu) n_in %d\n", cus, per_cu, grid_blocks, ws_size, (size_t)WS_END, n_in);
    if (ws_size < WS_END || n_in != 34) { fprintf(stderr, "kernel_launch: workspace too small or unexpected inputs; nothing launched\n"); grid_blocks = -1; }
  }
  if (grid_blocks < 0) return;
  (void)hipMemsetAsync((char*)d_ws + WS_CTL, 0, 65536, stream);
  Params p{};
  for (int i = 0; i < 34; ++i) p.in[i] = (const float*)d_in[i];
  p.out = (float*)d_out; p.ws = (unsigned char*)d_ws;
#if N_LAUNCH_SPLIT
  for (int ph = 0; ph < 12; ++ph) { hipLaunchKernelGGL(fwd_megakernel, dim3(grid_blocks), dim3(512), LDS_BYTES, stream, p, ph, ph + 1); }
#else
  int lo = 0, hi = 12;
  void* args[] = {&p, &lo, &hi};
  hipError_t e = hipLaunchCooperativeKernel((void*)fwd_megakernel, dim3(grid_blocks), dim3(512), args, LDS_BYTES, stream);
  if (e != hipSuccess) fprintf(stderr, "cooperative launch failed: %s (grid %d)\n", hipGetErrorString(e), grid_blocks);
#endif
}
```

```cpp
#include <hip/hip_runtime.h>
#include <hip/hip_cooperative_groups.h>
#include <cstdio>
#include <cstdint>
namespace cg = cooperative_groups;

#define LAS __attribute__((address_space(3)))
typedef unsigned short bf16_t;
typedef short bf16x8 __attribute__((ext_vector_type(8)));
typedef float f32x4 __attribute__((ext_vector_type(4)));
typedef float f32x2 __attribute__((ext_vector_type(2)));
typedef unsigned u32x4 __attribute__((ext_vector_type(4)));
typedef unsigned u32x2 __attribute__((ext_vector_type(2)));
typedef int i32x8 __attribute__((ext_vector_type(8)));
typedef int i32x4 __attribute__((ext_vector_type(4)));

constexpr int NTOK = 8192, DM = 2048, SEQ = 4096, MW = 2048, RW = 2560, INC = 13312, NH = 8, HD = 256, NE = 64, DE = 512;
constexpr int O_Z = 2048, O_XR = 4096, O_XG = 6656, O_G0 = 9216, O_G1 = 11264;
constexpr float LN_EPS = 1e-5f;
constexpr float ALPHA = 1.189207115002721f;
constexpr int NCH = 64;

constexpr size_t MiB = 1u << 20;
constexpr size_t WS_CTL = 0;
constexpr size_t WS_WIN = 1 * MiB, WS_RB = 1 * MiB, WS_M2TAB = 41 * MiB;
constexpr size_t WS_WPM = 53 * MiB  , WS_WPR = 63 * MiB, WS_WO = 73 * MiB, WS_WRAX = 81 * MiB, WS_WSGU = 84 * MiB, WS_WSD = 1014 * MiB;
constexpr size_t WS_WEGU = 88 * MiB, WS_WED = 344 * MiB;
constexpr size_t WS_XB = 472 * MiB, WS_HNI = 472 * MiB, WS_HMOE = 472 * MiB;
constexpr size_t WS_PROJ = 504 * MiB;
constexpr size_t WS_YRM = 560 * MiB;
constexpr size_t WS_Q = 712 * MiB, WS_K = 744 * MiB, WS_V = 776 * MiB, WS_YM = 712 * MiB  , WS_YR = 752 * MiB;
constexpr size_t WS_XCM = 808 * MiB, WS_MERGED = 808 * MiB;
constexpr size_t WS_XCR = 840 * MiB;
constexpr size_t WS_SMALL = 880 * MiB;
constexpr size_t WS_RA = 886 * MiB, WS_T1 = 886 * MiB, WS_X1B = 886 * MiB  ;
constexpr size_t WS_LIST = 918 * MiB, WS_LISTW = 920 * MiB  , WS_TOKES = 923 * MiB;
constexpr size_t WS_X1 = 950 * MiB;
constexpr size_t WS_HNE = 966 * MiB;
constexpr size_t WS_END = 1016 * MiB;
constexpr size_t SM_IG = 0, SM_LF = 256 * 1024, SM_INTER = 512 * 1024, SM_EMR = 768 * 1024, SM_DENI = 1024 * 1024, SM_QN = 1280 * 1024;
constexpr size_t SM_WIFT = 1536 * 1024;
constexpr size_t SM_C8 = 1792 * 1024;
constexpr size_t SM_RWH = 4608 * 1024, SM_RWL = 4864 * 1024;
constexpr size_t SM_AGGA = 2 * MiB, SM_AGGB = 2 * MiB + 1310720;

constexpr int LDS_BYTES = 147456;
constexpr int LDS_X = 131072;

struct Params {
  const float* in[34];
  float* out;
  unsigned char* ws;
};

typedef __bf16 hbf2_t __attribute__((ext_vector_type(2)));
typedef float hf2_t __attribute__((ext_vector_type(2)));
__device__ __forceinline__ unsigned pk2(float lo, float hi) { const hf2_t f = {lo, hi}; return __builtin_bit_cast(unsigned, __builtin_convertvector(f, hbf2_t)); }
__device__ __forceinline__ unsigned f2bf(float f) { return pk2(f, 0.f) & 0xffffu; }
__device__ __forceinline__ float bflo(unsigned w) { return __uint_as_float(w << 16); }
__device__ __forceinline__ float bfhi(unsigned w) { return __uint_as_float(w & 0xffff0000u); }
__device__ __forceinline__ float bf1(bf16_t b) { return __uint_as_float(((unsigned)b) << 16); }
__device__ __forceinline__ float sigmoidf_(float x) { return 1.0f / (1.0f + __expf(-x)); }
__device__ __forceinline__ float siluf_(float x) { return x / (1.0f + __expf(-x)); }
__device__ __forceinline__ float gelu_tanh(float x) { const float u = 0.7978845608028654f * (x + 0.044715f * x * x * x); return 0.5f * x * (1.0f + tanhf(u)); }
__device__ __forceinline__ float wave_sum(float v) {
#pragma unroll
  for (int o = 1; o < 64; o <<= 1) v += __shfl_xor(v, o);
  return v;
}
__device__ __forceinline__ float wave_max(float v) {
#pragma unroll
  for (int o = 1; o < 64; o <<= 1) v = fmaxf(v, __shfl_xor(v, o));
  return v;
}
__device__ __forceinline__ float wave_scan_sum(float v, int lane) {
#pragma unroll
  for (int o = 1; o < 64; o <<= 1) { const float t = __shfl_up(v, o); if (lane >= o) v += t; }
  return v;
}
__device__ __forceinline__ float wave_scan_max(float v, int lane) {
#pragma unroll
  for (int o = 1; o < 64; o <<= 1) { const float t = __shfl_up(v, o); if (lane >= o) v = fmaxf(v, t); }
  return v;
}
#define LDS_WAIT() asm volatile("s_waitcnt lgkmcnt(0)" ::: "memory")
#define LBAR() do { asm volatile("s_waitcnt lgkmcnt(0)" ::: "memory"); __builtin_amdgcn_s_barrier(); asm volatile("" ::: "memory"); } while (0)

namespace pg8 {
constexpr int BM = 256, BK = 64, HALF = 128, HTB = HALF * BK * 2, NXCD = 8, WGM = 8;
__device__ __forceinline__ int lds_byte(int r, int c) { const int st = (r >> 4) * 2 + (c >> 5), rr = r & 15, cc = c & 31, ob = rr * 64 + cc * 2; return st * 1024 + (ob ^ (((ob >> 9) & 1) << 5)); }
__device__ __forceinline__ void stage_rc(int b, int& R, int& C) { const int st = b / 1024, sb = b % 1024, swz = sb ^ (((sb >> 9) & 1) << 5); R = (st >> 1) * 16 + swz / 64; C = (st & 1) * 32 + (swz % 64) / 2; }

__device__ __forceinline__ int perm32(int rho) { const int n = rho >> 4, i = rho & 15; return 8 * (i >> 2) + 4 * n + (i & 3); }
struct UnitG { const char* A; const char* B; int pm, pn, e, cnt, mt, row0, nt, keep; };

__device__ __forceinline__ bool dense_order(int i, int G, int c, int nM, int nN, int& pm, int& pn) {
  const int nwg = nM * nN; const long L = (long)i * G + c; if (L >= nwg) return false;
  int wgid = (int)L; { const int q = nwg / NXCD, r = nwg % NXCD, xcd = wgid % NXCD, off = wgid / NXCD; wgid = (xcd < r ? xcd * (q + 1) : r * (q + 1) + (xcd - r) * q) + off; }
  const int nig = WGM * nN, gid = wgid / nig, fm = gid * WGM, gsz = (nM - fm) < WGM ? (nM - fm) : WGM;
  pm = fm + ((wgid % nig) % gsz); pn = (wgid % nig) / gsz; return true;
}

template <class Epi, class Sched, bool GATHER>
__device__ __forceinline__ void gemm_phase(LAS unsigned char* lds, const int lda, const int ldb, const Sched& S, const Epi& E) {
  const int tid = threadIdx.x, wid = __builtin_amdgcn_readfirstlane(tid >> 6), lane = tid & 63, wr = wid >> 2, wc = wid & 3, fr = lane & 15, fq = lane >> 4;
  int Rr[2], Cc[2];
  unsigned voffB[2];
  unsigned vA[2][2];
  unsigned nvA[2][2];
#pragma unroll
  for (int i = 0; i < 2; ++i) { stage_rc(tid * 16 + i * 8192, Rr[i], Cc[i]); const int Rb = Epi::PERM ? ((Rr[i] & ~31) + perm32(Rr[i] & 31)) : Rr[i]; voffB[i] = (unsigned)(Rb * ldb + Cc[i]) * 2u; }
  const size_t kstep = (size_t)(BK * 2);
  const size_t hstepA = (size_t)HALF * lda * 2, hstepB = (size_t)HALF * ldb * 2;
  const unsigned ldsw = (unsigned)wid * 1024u;
  const int aoff = lds_byte(wr * 64 + fr, fq * 8), boff = lds_byte(wc * 32 + fr, fq * 8);
#define PG8_SA(b, h) (((b) * 2 + (h)) * HTB)
#define PG8_SB(b, h) ((4 + (b) * 2 + (h)) * HTB)
#define PG8_STAGE_B(bufoff, gbase) do { _Pragma("unroll") for (int _i = 0; _i < 2; ++_i) \
    __builtin_amdgcn_global_load_lds((const unsigned*)((const char*)(gbase) + voffB[_i]), (LAS unsigned*)(lds + (bufoff) + ldsw + _i * 8192), 16, 0, 0); } while (0)
#define PG8_STAGE_A(bufoff, gbase, h) do { _Pragma("unroll") for (int _i = 0; _i < 2; ++_i) { \
    const char* _p = GATHER ? ((const char*)(gbase) + vA[h][_i]) : ((const char*)(gbase) + (h) * hstepA + vA[0][_i]); \
    __builtin_amdgcn_global_load_lds((const unsigned*)_p, (LAS unsigned*)(lds + (bufoff) + ldsw + _i * 8192), 16, 0, 0); } } while (0)
#define PG8_LD8(p) __builtin_shufflevector(*(const LAS i32x4*)(p), *(const LAS i32x4*)((p) + 1024), 0, 1, 2, 3, 4, 5, 6, 7)
#define PG8_LO(x) __builtin_bit_cast(bf16x8, __builtin_shufflevector(x, x, 0, 1, 2, 3))
#define PG8_HI(x) __builtin_bit_cast(bf16x8, __builtin_shufflevector(x, x, 4, 5, 6, 7))
#define PG8_LDA(dst, b, h) do { _Pragma("unroll") for (int m = 0; m < 4; ++m) dst[m] = PG8_LD8(lds + PG8_SA(b, h) + aoff + m * 2048); } while (0)
#define PG8_LDB(dst, b, h) do { _Pragma("unroll") for (int n = 0; n < 2; ++n) dst[n] = PG8_LD8(lds + PG8_SB(b, h) + boff + n * 2048); } while (0)
#define PG8_MMA(ai, bj, At, Bt) do { __builtin_amdgcn_s_setprio(1); _Pragma("unroll") for (int m = 0; m < 4; ++m) _Pragma("unroll") for (int n = 0; n < 2; ++n) { \
    acc[ai][bj][m][n] = __builtin_amdgcn_mfma_f32_16x16x32_bf16(PG8_LO(Bt[n]), PG8_LO(At[m]), acc[ai][bj][m][n], 0, 0, 0); \
    acc[ai][bj][m][n] = __builtin_amdgcn_mfma_f32_16x16x32_bf16(PG8_HI(Bt[n]), PG8_HI(At[m]), acc[ai][bj][m][n], 0, 0, 0); } __builtin_amdgcn_s_setprio(0); } while (0)
#define PG8_MMA8(ai, bj, At, Bt) do { __builtin_amdgcn_s_setprio(1); _Pragma("unroll") for (int m = 0; m < 4; ++m) _Pragma("unroll") for (int n = 0; n < 2; ++n) \
    acc[ai][bj][m][n] = __builtin_amdgcn_mfma_scale_f32_16x16x128_f8f6f4(Bt[n], At[m], acc[ai][bj][m][n], 0, 0, 0, 0x7F7F7F7F, 0, 0x7F7F7F7F); __builtin_amdgcn_s_setprio(0); } while (0)
#define PG8_MM(ai, bj, At, Bt) do { if (Epi::FP8) PG8_MMA8(ai, bj, At, Bt); else PG8_MMA(ai, bj, At, Bt); } while (0)
#define PG8_WAIT_V(n) asm volatile("s_waitcnt vmcnt(" #n ")" ::: "memory")
#define PG8_WAIT_L(n) asm volatile("s_waitcnt lgkmcnt(" #n ")" ::: "memory")
#define PG8_BAR __builtin_amdgcn_s_barrier()
#define PG8_SCHED __builtin_amdgcn_sched_barrier(0)
  UnitG cur, nxt; int ui = 0;
  if (!S.next(0, cur)) return;
#pragma unroll
  for (int h = 0; h < 2; ++h)
#pragma unroll
    for (int i = 0; i < 2; ++i) {
      if (GATHER) vA[h][i] = (unsigned)(S.arow(cur, h * HALF + Rr[i]) * lda + Cc[i]) * 2u;
      else vA[h][i] = (unsigned)(Rr[i] * lda + Cc[i]) * 2u;
      nvA[h][i] = vA[h][i];
    }
  f32x4 acc[2][2][4][2];
#pragma unroll
  for (int a = 0; a < 2; ++a)
#pragma unroll
    for (int b = 0; b < 2; ++b)
#pragma unroll
      for (int m = 0; m < 4; ++m)
#pragma unroll
        for (int n = 0; n < 2; ++n) acc[a][b][m][n] = (f32x4){0.f, 0.f, 0.f, 0.f};
  i32x8 At[4], B0[2], B1[2];
  const char* cA = cur.A; const char* cB = cur.B;
  { const char* pB0 = cB; const char* pB1 = cB + hstepB; const char* pA0 = cA; const char* pB2 = cB + kstep; const char* pA1 = cA + kstep; const char* pB3 = cB + hstepB + kstep;
    asm volatile("" : "+s"(pB0), "+s"(pB1), "+s"(pA0), "+s"(pB2), "+s"(pA1), "+s"(pB3));
  PG8_STAGE_B(PG8_SB(0, 0), pB0); PG8_STAGE_B(PG8_SB(0, 1), pB1); PG8_STAGE_A(PG8_SA(0, 0), pA0, 0); PG8_STAGE_A(PG8_SA(0, 1), pA0, 1);
  if (wr == 1) PG8_BAR;
  PG8_WAIT_V(2); PG8_BAR;
  PG8_STAGE_B(PG8_SB(1, 0), pB2); PG8_STAGE_A(PG8_SA(1, 0), pA1, 0); PG8_STAGE_B(PG8_SB(1, 1), pB3); }
  PG8_WAIT_V(6); PG8_BAR;
  for (;;) {
    const bool has_next = S.next(ui + 1, nxt);
    const char* nA = has_next ? nxt.A : cA; const char* nB = has_next ? nxt.B : cB;
    if (GATHER) {
      if (has_next) {
#pragma unroll
        for (int h = 0; h < 2; ++h)
#pragma unroll
          for (int i = 0; i < 2; ++i) nvA[h][i] = (unsigned)(S.arow(nxt, h * HALF + Rr[i]) * lda + Cc[i]) * 2u;
      }
    }
    const int nt = cur.nt;
#pragma unroll 1
    for (int t = 0; t < nt; t += 2) {
      const bool last = (t == nt - 2);
      const char* a1 = cA + (size_t)(t + 1) * kstep;
      const char* a2 = last ? nA : cA + (size_t)(t + 2) * kstep; const char* b2 = last ? nB : cB + (size_t)(t + 2) * kstep;
      const char* a3 = a2 + kstep; const char* b3 = b2 + kstep;
      asm volatile("" : "+s"(a1), "+s"(a2), "+s"(a3), "+s"(b2), "+s"(b3));
      PG8_LDB(B0, 0, 0); PG8_LDB(B1, 0, 1); PG8_SCHED; PG8_LDA(At, 0, 0); PG8_STAGE_A(PG8_SA(1, 1), a1, 1);
      if (GATHER) { if (last) {
#pragma unroll
        for (int h = 0; h < 2; ++h)
#pragma unroll
          for (int i = 0; i < 2; ++i) vA[h][i] = nvA[h][i]; } }
      PG8_WAIT_V(8); PG8_WAIT_L(0); PG8_BAR; PG8_MM(0, 0, At, B0); PG8_MM(0, 1, At, B1); PG8_BAR; PG8_SCHED;
      PG8_LDA(At, 0, 1); PG8_STAGE_B(PG8_SB(0, 0), b2); PG8_STAGE_B(PG8_SB(0, 1), b2 + hstepB); PG8_STAGE_A(PG8_SA(0, 0), a2, 0);
      PG8_WAIT_V(8); PG8_WAIT_L(0); PG8_BAR; PG8_MM(1, 0, At, B0); PG8_MM(1, 1, At, B1); PG8_BAR; PG8_SCHED;
      PG8_LDB(B0, 1, 0); PG8_LDB(B1, 1, 1); PG8_SCHED; PG8_LDA(At, 1, 0); PG8_STAGE_A(PG8_SA(0, 1), a2, 1);
      PG8_WAIT_V(8); PG8_WAIT_L(0); PG8_BAR; PG8_MM(0, 0, At, B0); PG8_MM(0, 1, At, B1); PG8_BAR; PG8_SCHED;
      PG8_LDA(At, 1, 1); PG8_STAGE_B(PG8_SB(1, 0), b3); PG8_STAGE_B(PG8_SB(1, 1), b3 + hstepB); PG8_STAGE_A(PG8_SA(1, 0), a3, 0);
      PG8_WAIT_V(8); PG8_WAIT_L(0); PG8_BAR; PG8_MM(1, 0, At, B0); PG8_MM(1, 1, At, B1); PG8_BAR; PG8_SCHED;
    }
    if (wr == 0) PG8_BAR;
    { int l2 = (int)__builtin_amdgcn_mbcnt_hi(~0u, __builtin_amdgcn_mbcnt_lo(~0u, 0u)); asm volatile("" : "+v"(l2));
      E(acc, cur, wr, wc, l2 & 15, l2 >> 4); }
    if (!has_next) break;
    if (!cur.keep) {
#pragma unroll
      for (int a = 0; a < 2; ++a)
#pragma unroll
        for (int b = 0; b < 2; ++b)
#pragma unroll
          for (int m = 0; m < 4; ++m)
#pragma unroll
            for (int n = 0; n < 2; ++n) acc[a][b][m][n] = (f32x4){0.f, 0.f, 0.f, 0.f};
    }
    cur = nxt; cA = nA; cB = nB; ++ui;
    if (wr == 1) PG8_BAR;
  }
  PG8_WAIT_V(0);
  PG8_BAR;
#undef PG8_SA
#undef PG8_SB
#undef PG8_STAGE_A
#undef PG8_STAGE_B
#undef PG8_LDA
#undef PG8_LDB
#undef PG8_MMA
#undef PG8_MMA8
#undef PG8_MM
#undef PG8_LD8
#undef PG8_LO
#undef PG8_HI
#undef PG8_WAIT_V
#undef PG8_WAIT_L
#undef PG8_BAR
#undef PG8_SCHED
}
}

__device__ __forceinline__ const char* uni_ptr(const char* p) {
  const unsigned long long v = (unsigned long long)p;
  const unsigned lo = __builtin_amdgcn_readfirstlane((unsigned)v), hi = __builtin_amdgcn_readfirstlane((unsigned)(v >> 32));
  return (const char*)(((unsigned long long)hi << 32) | lo);
}

struct SchedDense {
  const char* A; const char* B; int nM, nN, G, c, lda, ldb, nt;
  __device__ __forceinline__ bool next(int i, pg8::UnitG& u) const {
    int pm, pn; if (!pg8::dense_order(i, G, c, nM, nN, pm, pn)) return false;
    u.pm = pm; u.pn = pn; u.e = 0; u.cnt = 0; u.mt = 0; u.row0 = pm * 256; u.nt = nt; u.keep = 0;
    u.A = A + (size_t)pm * 256 * lda * 2; u.B = B + (size_t)pn * 256 * ldb * 2; return true;
  }
  __device__ __forceinline__ unsigned arow(const pg8::UnitG&, int r) const { return (unsigned)r; }
};

struct EpiStoreBf16 {
  static constexpr bool PERM = true, FP8 = false;
  bf16_t* O; int ldc;
  __device__ __forceinline__ void operator()(const f32x4 (&acc)[2][2][4][2], const pg8::UnitG& u, int wr, int wc, int fr, int fq) const {
    const int row0 = u.pm * 256 + wr * 64 + fr, col0 = u.pn * 256 + wc * 32 + 8 * fq;
#pragma unroll
    for (int ai = 0; ai < 2; ++ai)
#pragma unroll
      for (int m = 0; m < 4; ++m) { bf16_t* rowp = O + (size_t)(row0 + ai * 128 + m * 16) * ldc + col0;
#pragma unroll
        for (int bj = 0; bj < 2; ++bj) { const f32x4 v0 = acc[ai][bj][m][0], v1 = acc[ai][bj][m][1]; u32x4 w; w.x = pk2(v0[0], v0[1]); w.y = pk2(v0[2], v0[3]); w.z = pk2(v1[0], v1[1]); w.w = pk2(v1[2], v1[3]); *(u32x4*)(rowp + bj * 128) = w; } }
  }
};

struct SchedRglru {
  const char* XCR; const char* W; int G, c, nt4;
  __device__ __forceinline__ bool next(int i, pg8::UnitG& u) const {
    const int L = i * G + c; if (L >= 640) return false;
    const int blk = L >> 6, rem = L & 63; u.e = blk; u.pm = rem >> 1; u.pn = rem & 1; u.cnt = 0; u.mt = 0; u.row0 = u.pm * 256; u.nt = nt4; u.keep = 0;
    u.A = XCR + ((size_t)u.pm * 256 * RW + 256 * blk) * 2; u.B = W + ((size_t)(blk * 512 + u.pn * 256) * 256) * 2; return true;
  }
  __device__ __forceinline__ unsigned arow(const pg8::UnitG&, int r) const { return (unsigned)r; }
};
struct EpiRglru {
  static constexpr bool PERM = true, FP8 = false;
  const bf16_t* XCR; const float* ba; const float* bx; const float* C8; float* RA; bf16_t* RBo;
  __device__ __forceinline__ void operator()(const f32x4 (&acc)[2][2][4][2], const pg8::UnitG& u, int wr, int wc, int fr, int fq) const {
    const int row0 = u.pm * 256 + wr * 64 + fr;
#pragma unroll
    for (int n = 0; n < 2; ++n) {
      const int ch = 256 * u.e + 128 * u.pn + 32 * wc + 8 * fq + 4 * n;
      const f32x4 vba = *(const f32x4*)(ba + ch), vbx = *(const f32x4*)(bx + ch), c8 = *(const f32x4*)(C8 + ch);
#pragma unroll
      for (int ai = 0; ai < 2; ++ai)
#pragma unroll
        for (int m = 0; m < 4; ++m) {
          const size_t off = (size_t)(row0 + ai * 128 + m * 16) * RW + ch;
          const u32x2 xw = *(const u32x2*)(XCR + off);
          const float xc[4] = {bflo(xw.x), bfhi(xw.x), bflo(xw.y), bfhi(xw.y)};
          f32x4 av; float bv[4];
#pragma unroll
          for (int j = 0; j < 4; ++j) {
            const float r = __builtin_amdgcn_rcpf(1.0f + __expf(-(acc[ai][0][m][n][j] + vba[j])));
            const float ig = __builtin_amdgcn_rcpf(1.0f + __expf(-(acc[ai][1][m][n][j] + vbx[j])));
            const float la = c8[j] * r;
            const float a = __expf(la);
            const float x2 = 2.0f * la;
            const float poly = -x2 * (1.0f + x2 * 0.5f * (1.0f + x2 * (1.0f / 3.0f) * (1.0f + x2 * 0.25f * (1.0f + x2 * 0.2f))));
            const float om = (x2 > -0.25f) ? poly : (1.0f - a * a);
            av[j] = a;
            bv[j] = sqrtf(fmaxf(om, 0.f)) * (ig * xc[j]);
          }
          *(f32x4*)(RA + off) = av;
          u32x2 w; w.x = pk2(bv[0], bv[1]); w.y = pk2(bv[2], bv[3]); *(u32x2*)(RBo + off) = w;
          asm volatile("" ::: "memory");
        }
    }
  }
};

struct SchedMerge {
  const char* YM; const char* YR; const char* WPM; const char* WPR; int G, c;
  __device__ __forceinline__ bool next(int i, pg8::UnitG& u) const {
    int pm, pn; if (!pg8::dense_order(i >> 1, G, c, NTOK / 256, DM / 256, pm, pn)) return false;
    const int seg = i & 1;
    u.pm = pm; u.pn = pn; u.e = seg; u.cnt = 0; u.mt = 0; u.row0 = pm * 256; u.nt = seg ? RW / 64 : MW / 64; u.keep = seg ? 0 : 1;
    u.A = (seg ? YR : YM) + (size_t)pm * 256 * RW * 2; u.B = (seg ? WPR : WPM) + (size_t)pn * 256 * RW * 2; return true;
  }
  __device__ __forceinline__ unsigned arow(const pg8::UnitG&, int r) const { return (unsigned)r; }
};
struct EpiMergeF {
  static constexpr bool PERM = true, FP8 = false;
  const bf16_t* PROJ; const float* bgate; bf16_t* MRG;
  __device__ __forceinline__ void operator()(f32x4 (&acc)[2][2][4][2], const pg8::UnitG& u, int wr, int wc, int fr, int fq) const {
    const int row0 = u.pm * 256 + wr * 64 + fr, col0 = u.pn * 256 + wc * 32 + 8 * fq;
#pragma unroll
    for (int bj = 0; bj < 2; ++bj) {
      const int col = col0 + bj * 128;
      const f32x4 b00 = *(const f32x4*)(bgate + col), b01 = *(const f32x4*)(bgate + col + 4), b10 = *(const f32x4*)(bgate + DM + col), b11 = *(const f32x4*)(bgate + DM + col + 4);
#pragma unroll
      for (int ai = 0; ai < 2; ++ai)
#pragma unroll
        for (int m = 0; m < 4; ++m) {
          const size_t row = (size_t)(row0 + ai * 128 + m * 16);
          const u32x4 g1w = *(const u32x4*)(PROJ + row * INC + O_G1 + col);
          const float g1p[8] = {bflo(g1w.x), bfhi(g1w.x), bflo(g1w.y), bfhi(g1w.y), bflo(g1w.z), bfhi(g1w.z), bflo(g1w.w), bfhi(g1w.w)};
          if (u.e == 0) {
            const u32x4 g0w = *(const u32x4*)(PROJ + row * INC + O_G0 + col);
            const float g0p[8] = {bflo(g0w.x), bfhi(g0w.x), bflo(g0w.y), bfhi(g0w.y), bflo(g0w.z), bfhi(g0w.z), bflo(g0w.w), bfhi(g0w.w)};
#pragma unroll
            for (int j = 0; j < 4; ++j) {
              acc[ai][bj][m][0][j] *= (1.0f + __expf(-(g1p[j] + b10[j]))) * __builtin_amdgcn_rcpf(1.0f + __expf(-(g0p[j] + b00[j])));
              acc[ai][bj][m][1][j] *= (1.0f + __expf(-(g1p[4 + j] + b11[j]))) * __builtin_amdgcn_rcpf(1.0f + __expf(-(g0p[4 + j] + b01[j])));
            }
          } else {
            f32x4 v0, v1;
#pragma unroll
            for (int j = 0; j < 4; ++j) { v0[j] = acc[ai][bj][m][0][j] * __builtin_amdgcn_rcpf(1.0f + __expf(-(g1p[j] + b10[j]))); v1[j] = acc[ai][bj][m][1][j] * __builtin_amdgcn_rcpf(1.0f + __expf(-(g1p[4 + j] + b11[j]))); }
            u32x4 w; w.x = pk2(v0[0], v0[1]); w.y = pk2(v0[2], v0[3]); w.z = pk2(v1[0], v1[1]); w.w = pk2(v1[2], v1[3]); *(u32x4*)(MRG + row * DM + col) = w;
          }
        }
    }
  }
};

struct EpiWo {
  static constexpr bool PERM = false, FP8 = false;
  const float* X; float* O;
  __device__ __forceinline__ void operator()(const f32x4 (&acc)[2][2][4][2], const pg8::UnitG& u, int wr, int wc, int fr, int fq) const {
    const int row0 = u.pm * 256 + wr * 64 + fr, col0 = u.pn * 256 + wc * 32 + 4 * fq;
#pragma unroll
    for (int ai = 0; ai < 2; ++ai)
#pragma unroll
      for (int m = 0; m < 4; ++m) { const size_t off = (size_t)(row0 + ai * 128 + m * 16) * DM + col0;
#pragma unroll
        for (int bj = 0; bj < 2; ++bj)
#pragma unroll
          for (int n = 0; n < 2; ++n) { const f32x4 x = *(const f32x4*)(X + off + bj * 128 + n * 16); *(f32x4*)(O + off + bj * 128 + n * 16) = x * ALPHA + acc[ai][bj][m][n]; } }
  }
};

struct MoeTab { const LAS int* tp; const LAS int* cp; const LAS int* cnt; int n_rt; };
template <int NT  , int STAGE  >
struct SchedMoe {
  MoeTab T; const int* LIST; const char* Abase; const char* Wr; const char* Ws; int G, c, ntv;
  __device__ __forceinline__ bool next(int i, pg8::UnitG& u) const {
    const int L = i * G + c; const int total = NT * (T.n_rt + 32); if (L >= total) return false;
    const int rt = L / NT, pn = L % NT; u.pn = pn; u.nt = ntv; u.keep = 0;
    constexpr int KK = (STAGE == 1) ? DM / 2 : DE / 2;
    constexpr int NN = NT * 256;
    if (rt < T.n_rt) {
      const int e = __builtin_amdgcn_readfirstlane(T.tp[256 + rt]);
      const int mt = rt - __builtin_amdgcn_readfirstlane(T.tp[e]);
      u.e = e; u.mt = mt; u.cnt = __builtin_amdgcn_readfirstlane(T.cnt[e]); u.pm = rt; u.row0 = rt * 256;
      u.B = Wr + ((size_t)e * NN + (size_t)pn * 256) * KK * 2;
    } else {
      u.e = NE; u.mt = rt - T.n_rt; u.cnt = NTOK; u.pm = rt; u.row0 = rt * 256;
      u.B = Ws + (size_t)pn * 256 * KK * 2;
    }
    if (STAGE == 2) u.pm = __builtin_amdgcn_readfirstlane(T.cp[u.e]);
    if (STAGE == 1) u.A = Abase;
    else u.A = Abase + (size_t)rt * 256 * DE;
    return true;
  }
  __device__ __forceinline__ unsigned arow(const pg8::UnitG& u, int r) const {
    if (u.e < NE) { int slot = u.mt * 256 + r; if (slot >= u.cnt) slot = 0; return (unsigned)LIST[u.e * NTOK + slot]; }
    return (unsigned)(u.mt * 256 + r);
  }
};
struct EpiMoe1 {
  static constexpr bool PERM = true, FP8 = true;
  unsigned char* H;
  __device__ __forceinline__ void operator()(const f32x4 (&acc)[2][2][4][2], const pg8::UnitG& u, int wr, int wc, int fr, int fq) const {
    const int row0 = u.row0 + wr * 64 + fr, col0 = u.pn * 128 + wc * 32 + 8 * fq;
#pragma unroll
    for (int ai = 0; ai < 2; ++ai)
#pragma unroll
      for (int m = 0; m < 4; ++m) { unsigned char* rowp = H + (size_t)(row0 + ai * 128 + m * 16) * DE + col0;
        float v[8];
#pragma unroll
        for (int n = 0; n < 2; ++n) { const f32x4 g = acc[ai][0][m][n], up = acc[ai][1][m][n];
#pragma unroll
          for (int j = 0; j < 4; ++j) { const float gg = g[j] * 0.015625f; v[4 * n + j] = gg * __builtin_amdgcn_rcpf(1.0f + __expf(-gg)) * (up[j] * 0.015625f); } }
        int q0 = 0, q1 = 0; q0 = __builtin_amdgcn_cvt_pk_fp8_f32(v[0], v[1], q0, false); q0 = __builtin_amdgcn_cvt_pk_fp8_f32(v[2], v[3], q0, true); q1 = __builtin_amdgcn_cvt_pk_fp8_f32(v[4], v[5], q1, false); q1 = __builtin_amdgcn_cvt_pk_fp8_f32(v[6], v[7], q1, true);
        u32x2 w; w.x = (unsigned)q0; w.y = (unsigned)q1; *(u32x2*)rowp = w; }
  }
};
struct EpiMoe2 {
  static constexpr bool PERM = true, FP8 = true;
  bf16_t* YRM; const float* LISTW; bf16_t* DUMMY;
  __device__ __forceinline__ void operator()(const f32x4 (&acc)[2][2][4][2], const pg8::UnitG& u, int wr, int wc, int fr, int fq) const {
    const int slot0 = u.mt * 256 + wr * 64 + fr;
    bf16_t* base = YRM + (size_t)(u.pm + slot0) * DM + u.pn * 256 + wc * 32 + 8 * fq;
    bf16_t* sink = DUMMY + (size_t)blockIdx.x * 8192 + ((wr * 4 + wc) * 64 + fq * 16 + fr) * 8;
    const float* lw = LISTW + u.e * NTOK + slot0;
    float wv[8];
#pragma unroll
    for (int i = 0; i < 8; ++i) wv[i] = lw[(i >> 2) * 128 + (i & 3) * 16];
#pragma unroll
    for (int ai = 0; ai < 2; ++ai)
#pragma unroll
      for (int m = 0; m < 4; ++m) { const int ds = ai * 128 + m * 16;
        const float w = wv[ai * 4 + m] * 0.03125f;
        bf16_t* rowp = (slot0 + ds < u.cnt) ? base + (size_t)ds * DM : sink;
#pragma unroll
        for (int bj = 0; bj < 2; ++bj) { const f32x4 v0 = acc[ai][bj][m][0] * w, v1 = acc[ai][bj][m][1] * w; u32x4 q; q.x = pk2(v0[0], v0[1]); q.y = pk2(v0[2], v0[3]); q.z = pk2(v1[0], v1[1]); q.w = pk2(v1[2], v1[3]); *(u32x4*)(rowp + bj * 128) = q; } }
  }
};


#define XB_TMO      128
#define XB_XCNT(j)  (256  + 64 * (j))
#define XB_XSUB(j)  (1280 + 64 * (j))
#define XB_XGEN(j)  (2304 + 64 * (j))
#define XB_TOP      3328
#define XB_TOPGEN   3392
#define XCD_BAR_WORDS 3456
#define XB_SPIN_CAP (1u << 18)
__device__ __forceinline__ unsigned xb_ld(unsigned* p)              { return __hip_atomic_load(p, __ATOMIC_RELAXED, __HIP_MEMORY_SCOPE_AGENT); }
__device__ __forceinline__ unsigned xb_add(unsigned* p, unsigned v) { return __hip_atomic_fetch_add(p, v, __ATOMIC_RELAXED, __HIP_MEMORY_SCOPE_AGENT); }
__device__ __forceinline__ unsigned xb_xcc_id() { return (unsigned)__builtin_amdgcn_s_getreg((3 << 11) | 20) & 0xFu; }
#define XB_SPIN(cond, bar) do { unsigned _sp = 0; while (cond) { __builtin_amdgcn_s_sleep(1); \
    if ((++_sp & 255u) == 0u) { if (xb_ld(&(bar)[XB_TMO])) break; if (_sp > XB_SPIN_CAP) { atomicAdd(&(bar)[XB_TMO], 1u); break; } } } } while (0)
struct XcdBarrier { unsigned* bar; unsigned x; volatile LAS unsigned* st; };
__device__ __forceinline__ XcdBarrier xcd_barrier_post(unsigned* bar, volatile LAS unsigned* st) {
    XcdBarrier b; b.bar = bar; b.x = xb_xcc_id(); b.st = st;
    if (threadIdx.x == 0) (void)xb_add(&bar[XB_XCNT(b.x)], 1u);
    return b;
}
__device__ __forceinline__ void xcd_barrier_complete(unsigned* bar, unsigned x, unsigned& nloc, unsigned& nx) {
    const unsigned G = gridDim.x * gridDim.y * gridDim.z;
    unsigned sum, cnt, mine, sp = 0u;
    for (;;) {
        sum = 0u; cnt = 0u; mine = 0u;
#pragma unroll
        for (unsigned j = 0; j < 16; ++j) { const unsigned c = xb_ld(&bar[XB_XCNT(j)]); sum += c; cnt += (c > 0u) ? 1u : 0u; mine = (j == x) ? c : mine; }
        if (sum == G) break;
        __builtin_amdgcn_s_sleep(1);
        if ((++sp & 255u) == 0u) { if (xb_ld(&bar[XB_TMO])) break; if (sp > XB_SPIN_CAP) { atomicAdd(&bar[XB_TMO], 1u); break; } }
    }
    nloc = mine > 0u ? mine : 1u; nx = cnt > 0u ? cnt : 1u;
}
__device__ __forceinline__ void xcd_barrier(const XcdBarrier& b) {
    asm volatile("s_waitcnt vmcnt(0)" ::: "memory");
    __syncthreads();
    if (threadIdx.x == 0) {
        unsigned* bar = b.bar;
        __builtin_amdgcn_s_waitcnt(0);
        unsigned nloc = b.st[0], nx = b.st[1];
        if (nloc == 0u) { xcd_barrier_complete(bar, b.x, nloc, nx); b.st[0] = nloc; b.st[1] = nx; }
        const unsigned old = xb_add(&bar[XB_XSUB(b.x)], 1u);
        const unsigned gen = old / nloc;
        if (old + 1u == (gen + 1u) * nloc) {
            __builtin_amdgcn_fence(__ATOMIC_RELEASE, "agent");
            asm volatile("s_waitcnt vmcnt(0)" ::: "memory");
            const unsigned og = xb_add(&bar[XB_TOP], 1u);
            const unsigned tg = og / nx;
            if (og + 1u == (tg + 1u) * nx) xb_add(&bar[XB_TOPGEN], 1u);
            else XB_SPIN(xb_ld(&bar[XB_TOPGEN]) == tg, bar);
            __builtin_amdgcn_fence(__ATOMIC_ACQUIRE, "agent");
            xb_add(&bar[XB_XGEN(b.x)], 1u);
            asm volatile("s_waitcnt vmcnt(0)" ::: "memory");
        } else {
            XB_SPIN(xb_ld(&bar[XB_XGEN(b.x)]) == gen, bar);
            __builtin_amdgcn_fence(__ATOMIC_ACQUIRE, "agent");
            asm volatile("s_waitcnt vmcnt(0)" ::: "memory");
        }
    }
    __syncthreads();
}

template <class T> __device__ __forceinline__ T* as_global(T* p) { const unsigned long long v = (unsigned long long)p; return (T*)(__attribute__((address_space(1))) T*)v; }
template <class T> __device__ __forceinline__ T* opaque_global(T* p) { unsigned long long v = (unsigned long long)p; asm volatile("" : "+s"(v)); return (T*)(__attribute__((address_space(1))) T*)v; }
struct InPtrs { const float* const* p; __device__ __forceinline__ const float* operator[](int k) const { return as_global(p[k]); } };
struct Frame {
  LAS unsigned char* lds; int tid, lane, wave, G, bid; unsigned char* ws; InPtrs in; float* out;
};

struct TJob { const float* W; unsigned char* WT; int N, ldtB, k0, n0, up, mode; float sc; };
__device__ __forceinline__ int gu_row(int n, int up) { return 256 * (n >> 7) + (n & 127) + up * 128; }
constexpr int TR0 = 16 * 104, TR1 = 16 * 16, TR2 = 20 * 16, TR3 = 16 * 16, TR4 = 2 * 10 * 4, TR5 = 2 * 16 * 4, TR6 = 4 * 16, TR7 = 2 * 64 * 16 * 4, TR8 = 64 * 4 * 16;
constexpr int T_NITEMS = TR0 + TR1 + TR2 + TR3 + TR4 + TR5 + TR6 + TR7 + TR8;
__device__ __forceinline__ TJob tj_decode(const Frame& F, int it) {
  unsigned char* ws = F.ws; int r = it;
  if (r < TR0) { const int kb = r / 104, nb = r % 104; return TJob{F.in[1], ws + WS_WIN, INC, DM * 2, 128 * kb, 128 * nb, 0, 0, 1.f}; } r -= TR0;
  if (r < TR1) { const int kb = r / 16, nb = r % 16; return TJob{F.in[19], ws + WS_WPM, DM, RW * 2, 128 * kb, 128 * nb, 0, 0, 1.f}; } r -= TR1;
  if (r < TR2) { const int kb = r / 16, nb = r % 16; return TJob{F.in[20], ws + WS_WPR, DM, RW * 2, 128 * kb, 128 * nb, 0, 0, 1.f}; } r -= TR2;
  if (r < TR3) { const int kb = r / 16, nb = r % 16; return TJob{F.in[21], ws + WS_WO, DM, DM * 2, 128 * kb, 128 * nb, 0, 0, 1.f}; } r -= TR3;
  if (r < TR4) { const int which = r / 40, rr = r % 40, blk = rr / 4, q = rr % 4; return TJob{F.in[which ? 16 : 14] + (size_t)blk * 65536, ws + WS_WRAX + (size_t)blk * 512 * 256 * 2, 256, 256 * 2, 128 * (q >> 1), 128 * (q & 1), which, 1, 1.f}; } r -= TR4;
  if (r < TR5) { const int which = r / 64, q = r % 64, kb = q / 4, nb = q % 4; return TJob{F.in[which ? 30 : 29], ws + WS_WSGU, DE, DM, 128 * kb, 128 * nb, which, 3, 64.f}; } r -= TR5;
  if (r < TR6) { const int kb = r / 16, nb = r % 16; return TJob{F.in[31], ws + WS_WSD, DM, DE, 128 * kb, 128 * nb, 0, 2, 32.f}; } r -= TR6;
  if (r < TR7) { const int which = r / 4096, rr = r % 4096, e = rr / 64, q = rr % 64, kb = q / 4, nb = q % 4; return TJob{F.in[which ? 27 : 26] + (size_t)e * DM * DE, ws + WS_WEGU + (size_t)e * 1024 * DM, DE, DM, 128 * kb, 128 * nb, which, 3, 64.f}; } r -= TR7;
  { const int e = r / 64, q = r % 64, kb = q / 16, nb = q % 16; return TJob{F.in[28] + (size_t)e * DE * DM, ws + WS_WED + (size_t)e * DM * DE, DM, DE, 128 * kb, 128 * nb, 0, 2, 32.f}; }
}
__device__ __forceinline__ void tj_load(const TJob& j, f32x4 (&v)[8], int wave, int lane) {
  const float* p = j.W + (size_t)(j.k0 + 16 * wave + (lane >> 5)) * j.N + j.n0 + 4 * (lane & 31);
#pragma unroll
  for (int i = 0; i < 8; ++i) v[i] = *(const f32x4*)(p + (size_t)(2 * i) * j.N);
}
__device__ __forceinline__ void tj_store(const TJob& j, const f32x4 (&v)[8], LAS float* scr, int wave, int lane, int tid) {
#pragma unroll
  for (int i = 0; i < 8; ++i) { LAS float* d = scr + (16 * wave + 2 * i + (lane >> 5)) * 129 + 4 * (lane & 31); d[0] = v[i][0]; d[1] = v[i][1]; d[2] = v[i][2]; d[3] = v[i][3]; }
  LBAR();
  if (j.mode < 2) {
#pragma unroll
    for (int it = 0; it < 4; ++it) { const int idx = it * 512 + tid, n = idx >> 4, c = idx & 15; const LAS float* s = scr + (8 * c) * 129 + n;
      u32x4 o; o.x = pk2(s[0 * 129], s[1 * 129]); o.y = pk2(s[2 * 129], s[3 * 129]); o.z = pk2(s[4 * 129], s[5 * 129]); o.w = pk2(s[6 * 129], s[7 * 129]);
      const int nn = j.n0 + n; const int row = j.mode ? gu_row(nn, j.up) : nn;
      *(u32x4*)(j.WT + (size_t)row * j.ldtB + (j.k0 + 8 * c) * 2) = o; }
  } else {
#pragma unroll
    for (int it = 0; it < 2; ++it) { const int idx = it * 512 + tid, n = idx >> 3, c = idx & 7; const LAS float* s = scr + (16 * c) * 129 + n;
      int w[4];
#pragma unroll
      for (int q = 0; q < 4; ++q) { int t = 0; t = __builtin_amdgcn_cvt_pk_fp8_f32(s[(4 * q) * 129] * j.sc, s[(4 * q + 1) * 129] * j.sc, t, false); t = __builtin_amdgcn_cvt_pk_fp8_f32(s[(4 * q + 2) * 129] * j.sc, s[(4 * q + 3) * 129] * j.sc, t, true); w[q] = t; }
      u32x4 o; o.x = (unsigned)w[0]; o.y = (unsigned)w[1]; o.z = (unsigned)w[2]; o.w = (unsigned)w[3];
      const int nn = j.n0 + n; const int row = (j.mode == 3) ? gu_row(nn, j.up) : nn;
      *(u32x4*)(j.WT + (size_t)row * j.ldtB + j.k0 + 16 * c) = o; }
  }
  LBAR();
}

__device__ __forceinline__ void phase_prologue(const Frame& F) {
  LAS float* scr = (LAS float*)F.lds;
  unsigned char* ws = F.ws;
  {
    f32x4 vA[8], vB[8]; TJob jA, jB;
    int it = F.bid;
    if (it < T_NITEMS) { jA = tj_decode(F, it); tj_load(jA, vA, F.wave, F.lane); }
    while (it < T_NITEMS) {
      { const int itn = it + F.G; jB = tj_decode(F, itn < T_NITEMS ? itn : T_NITEMS - 1); tj_load(jB, vB, F.wave, F.lane); }
      tj_store(jA, vA, scr, F.wave, F.lane, F.tid);
      it += F.G; if (it >= T_NITEMS) break;
      { const int itn = it + F.G; jA = tj_decode(F, itn < T_NITEMS ? itn : T_NITEMS - 1); tj_load(jA, vA, F.wave, F.lane); }
      tj_store(jB, vB, scr, F.wave, F.lane, F.tid);
      it += F.G;
    }
  }
  const int gt = F.bid * 512 + F.tid, NGT = F.G * 512;
  { const float* x = F.in[0]; bf16_t* xb = (bf16_t*)(ws + WS_XB);
    for (int i = gt; i < NTOK * DM / 8; i += NGT) { const f32x4 a = *(const f32x4*)(x + (size_t)i * 8), b = *(const f32x4*)(x + (size_t)i * 8 + 4);
      u32x4 o; o.x = pk2(a[0], a[1]); o.y = pk2(a[2], a[3]); o.z = pk2(b[0], b[1]); o.w = pk2(b[2], b[3]); *(u32x4*)(xb + (size_t)i * 8) = o; } }
  { const float* wif = F.in[8]; bf16_t* wt = (bf16_t*)(ws + WS_SMALL + SM_WIFT);
    for (int i = gt; i < 16 * 6144; i += NGT) { const int n = i / 6144, k = i % 6144; float v = wif[k * 16 + n]; if (k >= 2048 && k < 4096) v *= 16.0f; wt[i] = (bf16_t)f2bf(v); } }
  { const float* lam = F.in[18]; float* c8 = (float*)(ws + WS_SMALL + SM_C8); for (int i = gt; i < RW; i += NGT) c8[i] = -8.0f * log1pf(expf(-lam[i])); }
  { const float* rwt = F.in[24]; bf16_t* rh = (bf16_t*)(ws + WS_SMALL + SM_RWH); bf16_t* rl = (bf16_t*)(ws + WS_SMALL + SM_RWL);
    for (int i = gt; i < NE * DM; i += NGT) { const int n = i / DM, k = i % DM; const float v = rwt[k * NE + n]; const unsigned h = f2bf(v); rh[i] = (bf16_t)h; rl[i] = (bf16_t)f2bf(v - __uint_as_float(h << 16)); } }
  { float* lw64 = (float*)(ws + WS_LISTW) + (size_t)NE * NTOK; for (int i = gt; i < NTOK; i += NGT) lw64[i] = 1.0f; }
  { int* ctl = (int*)(ws + WS_CTL); for (int i = gt; i < 4096; i += NGT) ctl[i] = 0; }
}

__device__ __forceinline__ void phase_mprep(const Frame& F) {
  unsigned char* ws = F.ws;
  const bf16_t* PROJ = (const bf16_t*)(ws + WS_PROJ);
  bf16_t* Q = (bf16_t*)(ws + WS_Q); bf16_t* Kb = (bf16_t*)(ws + WS_K); bf16_t* V = (bf16_t*)(ws + WS_V); bf16_t* XCM = (bf16_t*)(ws + WS_XCM);
  const bf16_t* WIFT = (const bf16_t*)(ws + WS_SMALL + SM_WIFT);
  float* IG = (float*)(ws + WS_SMALL + SM_IG); float* LF = (float*)(ws + WS_SMALL + SM_LF);
  const int g = F.tid;
  f32x4 cw[4]; for (int j = 0; j < 4; ++j) cw[j] = *(const f32x4*)(F.in[3] + j * MW + 4 * g);
  const f32x4 cb = *(const f32x4*)(F.in[4] + 4 * g);
  f32x4 wq[4], wk[4], wv[4];
  for (int i = 0; i < 4; ++i) { wq[i] = *(const f32x4*)(F.in[5] + g * 16 + 4 * i); wk[i] = *(const f32x4*)(F.in[6] + g * 16 + 4 * i); wv[i] = *(const f32x4*)(F.in[7] + g * 16 + 4 * i); }
  LAS unsigned char* AIMG = F.lds; LAS float* red = (LAS float*)(F.lds + 98432);
  const int r = F.lane & 15, gq = F.lane >> 4;
  for (int tile = F.bid; tile < NTOK / 8; tile += F.G) {
    const int t0 = tile * 8, s0 = t0 & (SEQ - 1);
    u32x2 rw[11];
#pragma unroll
    for (int j = 0; j < 11; ++j) { const int pos = s0 - 3 + j; rw[j] = (pos >= 0) ? *(const u32x2*)(PROJ + (size_t)(t0 - 3 + j) * INC + 4 * g) : (u32x2){0u, 0u}; }
#pragma unroll
    for (int tt = 0; tt < 8; ++tt) {
      const int t = t0 + tt;
      f32x4 xw[4];
#pragma unroll
      for (int j = 0; j < 4; ++j) xw[j] = (f32x4){bflo(rw[tt + j].x), bfhi(rw[tt + j].x), bflo(rw[tt + j].y), bfhi(rw[tt + j].y)};
      const f32x4 cv = cb + cw[0] * xw[0] + cw[1] * xw[1] + cw[2] * xw[2] + cw[3] * xw[3];
      f32x4 xc; for (int i = 0; i < 4; ++i) xc[i] = cv[i] * __builtin_amdgcn_rcpf(1.0f + __expf(-cv[i]));
      const f32x4 q = xc[0] * wq[0] + xc[1] * wq[1] + xc[2] * wq[2] + xc[3] * wq[3];
      f32x4 k = xc[0] * wk[0] + xc[1] * wk[1] + xc[2] * wk[2] + xc[3] * wk[3];
      const f32x4 v = xw[3][0] * wv[0] + xw[3][1] * wv[1] + xw[3][2] * wv[2] + xw[3][3] * wv[3];
      k = k * 0.0625f;
      const size_t o = (size_t)t * MW + 4 * g;
      u32x2 wqv, wkv, wvv, wxc;
      wqv.x = pk2(q[0], q[1]); wqv.y = pk2(q[2], q[3]); *(u32x2*)(Q + o) = wqv;
      wkv.x = pk2(k[0], k[1]); wkv.y = pk2(k[2], k[3]); *(u32x2*)(Kb + o) = wkv;
      wvv.x = pk2(v[0], v[1]); wvv.y = pk2(v[2], v[3]); *(u32x2*)(V + o) = wvv;
      wxc.x = pk2(xc[0], xc[1]); wxc.y = pk2(xc[2], xc[3]); *(u32x2*)(XCM + o) = wxc;
      LAS unsigned char* ar = AIMG + tt * 12304 + 8 * g;
      *(LAS u32x2*)(ar) = wqv; *(LAS u32x2*)(ar + 4096) = wkv; *(LAS u32x2*)(ar + 8192) = wvv;
    }
    LBAR();
    {
      f32x4 acc = (f32x4){0.f, 0.f, 0.f, 0.f};
#pragma unroll
      for (int ib = 0; ib < 3; ++ib) {
        bf16x8 bfr[8];
#pragma unroll
        for (int i = 0; i < 8; ++i) { const int ks = F.wave * 24 + ib * 8 + i; bfr[i] = *(const bf16x8*)(WIFT + (size_t)r * 6144 + ks * 32 + 8 * gq); }
#pragma unroll
        for (int i = 0; i < 8; ++i) { const int ks = F.wave * 24 + ib * 8 + i;
          const bf16x8 a = *(const LAS bf16x8*)(AIMG + (r & 7) * 12304 + (ks * 32 + 8 * gq) * 2);
          acc = __builtin_amdgcn_mfma_f32_16x16x32_bf16(a, bfr[i], acc, 0, 0, 0); }
      }
#pragma unroll
      for (int j = 0; j < 4; ++j) red[F.wave * 256 + (4 * gq + j) * 16 + r] = acc[j];
    }
    LBAR();
    if (F.tid < 128) {
      const int row = F.tid >> 4, n = F.tid & 15;
      float s = F.in[9][n];
#pragma unroll
      for (int w = 0; w < 8; ++w) s += red[w * 256 + F.tid];
      const int t = t0 + row, b = t >> 12, sp = t & (SEQ - 1);
      if (n < 8) IG[(size_t)(b * 8 + n) * SEQ + sp] = s;
      else LF[(size_t)(b * 8 + (n - 8)) * SEQ + sp] = fminf(s, 0.f) - log1pf(__expf(-fabsf(s)));
    }
    LBAR();
  }
}

__device__ __forceinline__ void phase_rconv(const Frame& F) {
  unsigned char* ws = F.ws;
  const bf16_t* PROJ = (const bf16_t*)(ws + WS_PROJ); bf16_t* XCR = (bf16_t*)(ws + WS_XCR);
  const int gt = F.bid * 512 + F.tid, NGT = F.G * 512;
  for (int it = gt; it < (NTOK / 16) * 640; it += NGT) {
    const int tile = it / 640, g = it % 640, t0 = tile * 16, s0 = t0 & (SEQ - 1);
    f32x4 cw[4]; for (int j = 0; j < 4; ++j) cw[j] = *(const f32x4*)(F.in[12] + j * RW + 4 * g);
    const f32x4 cb = *(const f32x4*)(F.in[13] + 4 * g);
    u32x2 rw[19];
#pragma unroll
    for (int j = 0; j < 19; ++j) { const int pos = s0 - 3 + j; rw[j] = (pos >= 0) ? *(const u32x2*)(PROJ + (size_t)(t0 - 3 + j) * INC + O_XR + 4 * g) : (u32x2){0u, 0u}; }
#pragma unroll
    for (int tt = 0; tt < 16; ++tt) {
      f32x4 cv = cb;
#pragma unroll
      for (int j = 0; j < 4; ++j) cv = cv + cw[j] * (f32x4){bflo(rw[tt + j].x), bfhi(rw[tt + j].x), bflo(rw[tt + j].y), bfhi(rw[tt + j].y)};
      u32x2 w; w.x = pk2(cv[0], cv[1]); w.y = pk2(cv[2], cv[3]); *(u32x2*)(XCR + (size_t)(t0 + tt) * RW + 4 * g) = w;
    }
  }
}

__device__ __forceinline__ float chunk_m(const float* IG, const float* LF, int bh, int c, int lane, int wave, LAS float* CS) {
  for (int cc = wave; cc < c; cc += 8) {
    const float lf = LF[(size_t)bh * SEQ + 64 * cc + lane], ig = IG[(size_t)bh * SEQ + 64 * cc + lane];
    const float b = wave_scan_sum(lf, lane), gmax = wave_max(ig - b);
    if (lane == 63) { CS[cc] = b; CS[64 + cc] = b + gmax; }
  }
  __syncthreads();
  float A = 0.f, B = -INFINITY;
  if (lane < c) { A = CS[lane]; B = CS[64 + lane]; }
#pragma unroll
  for (int o = 1; o < 64; o <<= 1) { const float pA = __shfl_up(A, o), pB = __shfl_up(B, o); if (lane >= o) { B = fmaxf(pB + A, B); A = pA + A; } }
  const float mafter = fmaxf(A, B);
  const float mc = __shfl(mafter, c > 0 ? c - 1 : 0);
  return c > 0 ? mc : 0.f;
}

__device__ __forceinline__ void phase_m1(const Frame& F, const int bid2, const int G2) {
  unsigned char* ws = F.ws;
  const bf16_t* Q = (const bf16_t*)(ws + WS_Q); const bf16_t* Kb = (const bf16_t*)(ws + WS_K); const bf16_t* V = (const bf16_t*)(ws + WS_V);
  const float* IG = (const float*)(ws + WS_SMALL + SM_IG); const float* LF = (const float*)(ws + WS_SMALL + SM_LF);
  float* INTER = (float*)(ws + WS_SMALL + SM_INTER); float* EMR = (float*)(ws + WS_SMALL + SM_EMR); float* DENI = (float*)(ws + WS_SMALL + SM_DENI);
  bf16_t* HNI = (bf16_t*)(ws + WS_HNI);
  LAS unsigned char* QS = F.lds; LAS unsigned char* KS = F.lds + 33792; LAS unsigned char* VT = F.lds + 67584; LAS unsigned char* PS = F.lds + 104448;
  LAS float* SCg = (LAS float*)(F.lds + 113664); LAS float* SCM = SCg + 64;
  const int r = F.lane & 15, gq = F.lane >> 4, w = F.wave;
  for (int item = bid2; item < 16 * NCH; item += G2) {
    const int bh = item / NCH, c = item % NCH, b = bh >> 3, h = bh & 7, tok0 = b * SEQ + 64 * c;
    const float m = chunk_m(IG, LF, bh, c, F.lane, w, (LAS float*)(F.lds + 114176));
    const float lf_c = LF[(size_t)bh * SEQ + 64 * c + F.lane], ig_c = IG[(size_t)bh * SEQ + 64 * c + F.lane];
    const float b_l = wave_scan_sum(lf_c, F.lane), g_l = ig_c - b_l;
    const float M_l = fmaxf(m, wave_scan_max(g_l, F.lane));
    if (w == 0) { SCg[F.lane] = g_l; SCM[F.lane] = M_l; INTER[(size_t)(tok0 + F.lane) * 8 + h] = __expf(m - M_l); EMR[(size_t)(tok0 + F.lane) * 8 + h] = __expf(-(b_l + M_l)); }
#pragma unroll
    for (int i = 0; i < 4; ++i) {
      const int idx = i * 512 + F.tid, row = idx >> 5, c16 = idx & 31;
      const size_t go = (size_t)(tok0 + row) * MW + 256 * h + 8 * c16;
      *(LAS u32x4*)(QS + row * 528 + c16 * 16) = *(const u32x4*)(Q + go);
      *(LAS u32x4*)(KS + row * 528 + c16 * 16) = *(const u32x4*)(Kb + go);
    }
    {
      const int sp = F.tid & 31, cq = F.tid >> 5;
#pragma unroll
      for (int i = 0; i < 2; ++i) {
        const size_t go = (size_t)(tok0 + 2 * sp) * MW + 256 * h + 8 * (cq + 16 * i);
        const u32x4 v0 = *(const u32x4*)(V + go), v1 = *(const u32x4*)(V + go + MW);
        const unsigned a0[4] = {v0.x, v0.y, v0.z, v0.w}, a1[4] = {v1.x, v1.y, v1.z, v1.w};
#pragma unroll
        for (int e = 0; e < 4; ++e) { const int dv = 8 * (cq + 16 * i) + 2 * e;
          *(LAS unsigned*)(VT + dv * 144 + sp * 4) = (a0[e] & 0xffffu) | (a1[e] << 16);
          *(LAS unsigned*)(VT + (dv + 1) * 144 + sp * 4) = (a0[e] >> 16) | (a1[e] & 0xffff0000u); }
      }
    }
    __syncthreads();
    {
      const int mi = w & 3;
#pragma unroll
      for (int nn = 0; nn < 2; ++nn) {
        const int ni = 2 * (w >> 2) + nn;
        f32x4 acc = (f32x4){0.f, 0.f, 0.f, 0.f};
        if (ni <= mi) {
#pragma unroll
          for (int ks = 0; ks < 8; ++ks) {
            const bf16x8 a = *(const LAS bf16x8*)(QS + (16 * mi + r) * 528 + (32 * ks + 8 * gq) * 2);
            const bf16x8 bb = *(const LAS bf16x8*)(KS + (16 * ni + r) * 528 + (32 * ks + 8 * gq) * 2);
            acc = __builtin_amdgcn_mfma_f32_16x16x32_bf16(a, bb, acc, 0, 0, 0);
          }
        }
        const int s = 16 * ni + r; const float gs = SCg[s];
#pragma unroll
        for (int j = 0; j < 4; ++j) { const int l = 16 * mi + 4 * gq + j; const float p = (s <= l) ? acc[j] * __expf(gs - SCM[l]) : 0.f; *(LAS bf16_t*)(PS + l * 144 + s * 2) = (bf16_t)f2bf(p); }
      }
    }
    __syncthreads();
    if (F.tid < 64) { float s = 0.f; for (int k = 0; k < 64; ++k) s += bf1(*(const LAS bf16_t*)(PS + F.tid * 144 + k * 2)); DENI[(size_t)(tok0 + F.tid) * 8 + h] = s; }
#pragma unroll
    for (int nn = 0; nn < 2; ++nn) {
      const int ni = 2 * w + nn;
#pragma unroll
      for (int mi = 0; mi < 4; ++mi) {
        f32x4 acc = (f32x4){0.f, 0.f, 0.f, 0.f};
#pragma unroll
        for (int ks = 0; ks < 2; ++ks) {
          const bf16x8 a = *(const LAS bf16x8*)(PS + (16 * mi + r) * 144 + (32 * ks + 8 * gq) * 2);
          const bf16x8 bb = *(const LAS bf16x8*)(VT + (16 * ni + r) * 144 + (32 * ks + 8 * gq) * 2);
          acc = __builtin_amdgcn_mfma_f32_16x16x32_bf16(a, bb, acc, 0, 0, 0);
        }
#pragma unroll
        for (int j = 0; j < 4; ++j) HNI[(size_t)(tok0 + 16 * mi + 4 * gq + j) * MW + 256 * h + 16 * ni + r] = (bf16_t)f2bf(acc[j]);
      }
    }
    __syncthreads();
  }
}

__device__ __forceinline__ void phase_m2(const Frame& F, const int nblk) {
  unsigned char* ws = F.ws;
  const bf16_t* Q = (const bf16_t*)(ws + WS_Q); const bf16_t* Kb = (const bf16_t*)(ws + WS_K); const bf16_t* V = (const bf16_t*)(ws + WS_V);
  const float* IG = (const float*)(ws + WS_SMALL + SM_IG); const float* LF = (const float*)(ws + WS_SMALL + SM_LF);
  float* QN = (float*)(ws + WS_SMALL + SM_QN);
  bf16_t* HNE = (bf16_t*)(ws + WS_HNE);
  LAS unsigned char* QS = F.lds; LAS unsigned char* KT = F.lds + 33792; LAS unsigned char* WVT = F.lds + 70656; LAS unsigned char* CT = F.lds + 77568;
  LAS float* TD = (LAS float*)(F.lds + 111360); LAS float* CS = (LAS float*)(F.lds + 111616);
  float* DUMMY = (float*)(ws + WS_M2TAB + 4 * MiB);
  const int w = F.wave;
  for (int item = F.bid; item < 128; item += nblk) {
    const int bh = item >> 3, sl = item & 7, b = bh >> 3, h = bh & 7, dv0 = 32 * sl;
    float* TI = (float*)(ws + WS_M2TAB) + (size_t)item * 8192; float* TW = TI + 4096;
    const int lane = F.lane;
    for (int i = F.tid; i < (6912 + 33792) / 4; i += 512) *(LAS unsigned*)(WVT + 4 * i) = 0u;
    float gk[8], pk[8];
#pragma unroll
    for (int i = 0; i < 8; ++i) {
      const int cc = w + 8 * i;
      const float lf = LF[(size_t)bh * SEQ + 64 * cc + lane], ig = IG[(size_t)bh * SEQ + 64 * cc + lane];
      const float bl = wave_scan_sum(lf, lane), g = ig - bl;
      const float gmax = wave_max(g), pm = wave_scan_max(g, lane);
      gk[i] = g; pk[i] = pm;
      if (lane == 63) { CS[cc] = bl; CS[64 + cc] = bl + gmax; }
    }
    __syncthreads();
    {
      float A = CS[lane], B = CS[64 + lane]; const float gmx = B - A;
#pragma unroll
      for (int o = 1; o < 64; o <<= 1) { const float pA = __shfl_up(A, o), pB = __shfl_up(B, o); if (lane >= o) { B = fmaxf(pB + A, B); A = pA + A; } }
      const float mafter = fmaxf(A, B);
      float mstart = __shfl_up(mafter, 1); if (lane == 0) mstart = 0.f;
      const float M63 = fmaxf(mstart, gmx);
      if (w == 0) TD[lane] = __expf(mstart - M63);
#pragma unroll
      for (int i = 0; i < 8; ++i) {
        const int cc = w + 8 * i;
        const float ms = __shfl(mstart, cc), m6 = __shfl(M63, cc);
        TI[cc * 64 + lane] = __expf(ms - fmaxf(ms, pk[i])); TW[cc * 64 + lane] = __expf(gk[i] - m6);
      }
    }
    __threadfence(); __syncthreads();
    f32x4 acc[2][3];
#pragma unroll
    for (int a = 0; a < 2; ++a)
#pragma unroll
      for (int n = 0; n < 3; ++n) acc[a][n] = (f32x4){0.f, 0.f, 0.f, 0.f};
    u32x4 qrA[4], krA[2][2], vrA = (u32x4){0u, 0u, 0u, 0u}, qrB[4], krB[2][2], vrB = (u32x4){0u, 0u, 0u, 0u};
    float wsA = 0.f, wsB = 0.f; f32x4 ivA = (f32x4){0.f, 0.f, 0.f, 0.f}, ivB = ivA;
#define M2_LOAD(qreg, kreg, vreg, wsr, ivr, c) do { const int tk_ = b * SEQ + 64 * (c); \
      _Pragma("unroll") for (int i = 0; i < 4; ++i) { const int idx = i * 512 + tdx, row = idx >> 5, c16 = idx & 31; qreg[i] = *(const u32x4*)(Q + (size_t)(tk_ + row) * MW + 256 * h + 8 * c16); } \
      _Pragma("unroll") for (int i = 0; i < 2; ++i) { const size_t go = (size_t)(tk_ + 2 * sp) * MW + 256 * h + 8 * (cq + 16 * i); kreg[i][0] = *(const u32x4*)(Kb + go); kreg[i][1] = *(const u32x4*)(Kb + go + MW); } \
      vreg = *(const u32x4*)(V + (size_t)(tk_ + lane) * MW + 256 * h + dv0 + 8 * (w & 3)); \
      wsr = TW[(c) * 64 + lane]; \
      ivr = *(const f32x4*)(TI + (c) * 64 + 16 * (w & 3) + 4 * gq); } while (0)
#define M2_AMMA(mi, nt) \
        f32x4 a2 = (f32x4){0.f, 0.f, 0.f, 0.f}; \
        _Pragma("unroll") for (int ks = 0; ks < 8; ++ks) { \
          const bf16x8 a = *(const LAS bf16x8*)(QS + (16 * (mi) + r) * 528 + (32 * ks + 8 * gq) * 2); \
          const bf16x8 bb = *(const LAS bf16x8*)(CT + (16 * (nt) + r) * 528 + (32 * ks + 8 * gq) * 2); \
          a2 = __builtin_amdgcn_mfma_f32_16x16x32_bf16(a, bb, a2, 0, 0, 0); }
#define M2_ATILE_H(mi, nt, tok0, ivr) do { M2_AMMA(mi, nt) \
        _Pragma("unroll") for (int j = 0; j < 4; ++j) { const int l = 16 * (mi) + 4 * gq + j; \
          HNE[(size_t)((tok0) + l) * MW + 256 * h + dv0 + 16 * (nt) + r] = (bf16_t)f2bf(a2[j] * ivr[j]); } } while (0)
#define M2_ATILE_Q(mi, nt, tok0, ivr) do { M2_AMMA(mi, nt) \
        _Pragma("unroll") for (int j = 0; j < 4; ++j) { const int l = 16 * (mi) + 4 * gq + j; \
          float* qp = ((nt) == 2 && r == 0) ? (QN + (size_t)((tok0) + l) * 8 + h) : (DUMMY + tdx * 4 + j); *qp = a2[j] * ivr[j]; } } while (0)
#define M2_BODY(c, qreg, kreg, vreg, wsr, ivr) do { \
      int tdx = (int)threadIdx.x; asm volatile("" : "+v"(tdx)); \
      const int lane = tdx & 63, r = lane & 15, gq = lane >> 4, sp = tdx & 31, cq = tdx >> 5; \
      const int tok0 = b * SEQ + 64 * (c); \
      _Pragma("unroll") for (int i = 0; i < 4; ++i) { const int idx = i * 512 + tdx, row = idx >> 5, c16 = idx & 31; *(LAS u32x4*)(QS + row * 528 + c16 * 16) = qreg[i]; } \
      _Pragma("unroll") for (int i = 0; i < 2; ++i) { \
        const unsigned k0[4] = {kreg[i][0].x, kreg[i][0].y, kreg[i][0].z, kreg[i][0].w}, k1[4] = {kreg[i][1].x, kreg[i][1].y, kreg[i][1].z, kreg[i][1].w}; \
        _Pragma("unroll") for (int e = 0; e < 4; ++e) { const int dk = 8 * (cq + 16 * i) + 2 * e; \
          *(LAS unsigned*)(KT + dk * 144 + sp * 4) = (k0[e] & 0xffffu) | (k1[e] << 16); \
          *(LAS unsigned*)(KT + (dk + 1) * 144 + sp * 4) = (k0[e] >> 16) | (k1[e] & 0xffff0000u); } } \
      if (w < 4) { const unsigned vw[4] = {vreg.x, vreg.y, vreg.z, vreg.w}; \
        _Pragma("unroll") for (int e = 0; e < 4; ++e) { *(LAS bf16_t*)(WVT + (8 * w + 2 * e) * 144 + lane * 2) = (bf16_t)f2bf(bflo(vw[e]) * wsr); *(LAS bf16_t*)(WVT + (8 * w + 2 * e + 1) * 144 + lane * 2) = (bf16_t)f2bf(bfhi(vw[e]) * wsr); } \
      } else if (w == 4) { *(LAS bf16_t*)(WVT + 32 * 144 + lane * 2) = (bf16_t)f2bf(wsr); } \
      const f32x4 ivc = ivr; \
      { const int cn_ = ((c) + 2 < NCH) ? (c) + 2 : NCH - 1; M2_LOAD(qreg, kreg, vreg, wsr, ivr, cn_); } \
      LBAR(); \
      M2_ATILE_H(w & 3, w >> 2, tok0, ivc); \
      M2_ATILE_Q(w & 3, 2 + (w >> 2), tok0, ivc); \
      const float decay = TD[(c)]; \
      _Pragma("unroll") for (int mt = 0; mt < 2; ++mt) \
        _Pragma("unroll") for (int n2 = 0; n2 < 3; ++n2) { \
          f32x4 cacc = acc[mt][n2] * decay; \
          _Pragma("unroll") for (int ks = 0; ks < 2; ++ks) { \
            const bf16x8 a = *(const LAS bf16x8*)(KT + (32 * w + 16 * mt + r) * 144 + (32 * ks + 8 * gq) * 2); \
            const bf16x8 bb = *(const LAS bf16x8*)(WVT + (16 * n2 + r) * 144 + (32 * ks + 8 * gq) * 2); \
            cacc = __builtin_amdgcn_mfma_f32_16x16x32_bf16(a, bb, cacc, 0, 0, 0); } \
          acc[mt][n2] = cacc; } \
      LBAR(); \
      _Pragma("unroll") for (int mt = 0; mt < 2; ++mt) \
        _Pragma("unroll") for (int n2 = 0; n2 < 3; ++n2) { u32x2 q; q.x = pk2(acc[mt][n2][0], acc[mt][n2][1]); q.y = pk2(acc[mt][n2][2], acc[mt][n2][3]); \
          *(LAS u32x2*)(CT + (16 * n2 + r) * 528 + (32 * w + 16 * mt + 4 * gq) * 2) = q; } \
    } while (0)
    { const int tdx = F.tid, sp = tdx & 31, cq = tdx >> 5, gq = (tdx & 63) >> 4;
      M2_LOAD(qrA, krA, vrA, wsA, ivA, 0);
      M2_LOAD(qrB, krB, vrB, wsB, ivB, 1); }
    __syncthreads();
#pragma unroll 1
    for (int c = 0; c < NCH; c += 2) {
      M2_BODY(c, qrA, krA, vrA, wsA, ivA);
      M2_BODY(c + 1, qrB, krB, vrB, wsB, ivB);
    }
#undef M2_BODY
#undef M2_ATILE_H
#undef M2_ATILE_Q
#undef M2_AMMA
#undef M2_LOAD
    __syncthreads();
  }
}

__device__ __forceinline__ void phase_ragg(const Frame& F) {
  unsigned char* ws = F.ws;
  const float* RA = (const float*)(ws + WS_RA); const bf16_t* RBb = (const bf16_t*)(ws + WS_RB);
  float* AGGA = (float*)(ws + WS_SMALL + SM_AGGA); float* AGGB = (float*)(ws + WS_SMALL + SM_AGGB);
  const int gt = F.bid * 512 + F.tid, NGT = F.G * 512;
#pragma unroll 1
  for (int it = gt; it < 2 * NCH * RW; it += NGT) {
    const int bc = it / RW, ch = it - bc * RW;
    const float* pa = RA + (size_t)bc * 64 * RW + ch; const bf16_t* pb = RBb + (size_t)bc * 64 * RW + ch;
    float A = 1.f, B = 0.f;
#pragma unroll 1
    for (int tb = 0; tb < 8; ++tb) {
      float a[8]; float bb[8];
#pragma unroll
      for (int t = 0; t < 8; ++t) { a[t] = pa[(size_t)(tb * 8 + t) * RW]; bb[t] = bf1(pb[(size_t)(tb * 8 + t) * RW]); }
#pragma unroll
      for (int t = 0; t < 8; ++t) { A *= a[t]; B = a[t] * B + bb[t]; }
    }
    AGGA[it] = A; AGGB[it] = B;
  }
}
__device__ __forceinline__ void phase_rscan(const Frame& F) {
  unsigned char* ws = F.ws;
  const float* RA = (const float*)(ws + WS_RA); const bf16_t* RBb = (const bf16_t*)(ws + WS_RB);
  const float* AGGA = (const float*)(ws + WS_SMALL + SM_AGGA); const float* AGGB = (const float*)(ws + WS_SMALL + SM_AGGB);
  const bf16_t* PROJ = (const bf16_t*)(ws + WS_PROJ); bf16_t* YR = (bf16_t*)(ws + WS_YR);
  const int gt = F.bid * 512 + F.tid, NGT = F.G * 512;
  for (int it = gt; it < 2 * NCH * RW; it += NGT) {
    const int bc = it / RW, ch = it % RW, t0 = bc * 64, b = bc / NCH, cidx = bc % NCH;
    float hcar = 0.f;
    for (int c0 = 0; c0 < cidx; c0 += 16) {
      float ca[16], cb[16];
#pragma unroll
      for (int k = 0; k < 16; ++k) { const int cc = c0 + k; const int j = (b * NCH + (cc < cidx ? cc : 0)) * RW + ch; ca[k] = AGGA[j]; cb[k] = AGGB[j]; }
#pragma unroll
      for (int k = 0; k < 16; ++k) { if (c0 + k < cidx) hcar = ca[k] * hcar + cb[k]; }
    }
#pragma unroll
    for (int tb = 0; tb < 4; ++tb) {
      float a[16]; bf16_t bb[16], xg[16];
#pragma unroll
      for (int t = 0; t < 16; ++t) { const size_t o = (size_t)(t0 + tb * 16 + t) * RW + ch; a[t] = RA[o]; bb[t] = RBb[o]; xg[t] = PROJ[(size_t)(t0 + tb * 16 + t) * INC + O_XG + ch]; }
#pragma unroll
      for (int t = 0; t < 16; ++t) { hcar = a[t] * hcar + bf1(bb[t]); YR[(size_t)(t0 + tb * 16 + t) * RW + ch] = (bf16_t)f2bf(hcar * gelu_tanh(bf1(xg[t]))); }
    }
  }
}

__device__ __forceinline__ void phase_ym(const Frame& F) {
  unsigned char* ws = F.ws;
  const bf16_t* HNI = (const bf16_t*)(ws + WS_HNI); const bf16_t* HNE = (const bf16_t*)(ws + WS_HNE);
  const float* EMR = (const float*)(ws + WS_SMALL + SM_EMR); const float* DENI = (const float*)(ws + WS_SMALL + SM_DENI); const float* QN = (const float*)(ws + WS_SMALL + SM_QN);
  const bf16_t* XCM = (const bf16_t*)(ws + WS_XCM); const bf16_t* PROJ = (const bf16_t*)(ws + WS_PROJ); bf16_t* YM = (bf16_t*)(ws + WS_YM);
  const float* normw = F.in[10]; const float* skip = F.in[11];
  const int gw = F.bid * 8 + F.wave, NGW = F.G * 8, lane = F.lane;
  for (int t = gw; t < NTOK; t += NGW) {
    u32x2 a[8], e[8], xcw[8], zw[8]; float den[8], emr[8];
#pragma unroll
    for (int h = 0; h < 8; ++h) {
      const size_t o = (size_t)t * MW + 256 * h + 4 * lane;
      a[h] = *(const u32x2*)(HNI + o); e[h] = *(const u32x2*)(HNE + o); xcw[h] = *(const u32x2*)(XCM + o); zw[h] = *(const u32x2*)(PROJ + (size_t)t * INC + O_Z + 256 * h + 4 * lane);
      den[h] = DENI[t * 8 + h] + QN[t * 8 + h]; emr[h] = EMR[t * 8 + h];
    }
#pragma unroll
    for (int h = 0; h < 8; ++h) {
      const int col = 256 * h + 4 * lane;
      const float inv = 1.0f / fmaxf(fabsf(den[h]), emr[h]);
      const float hv[4] = {(bflo(a[h].x) + bflo(e[h].x)) * inv, (bfhi(a[h].x) + bfhi(e[h].x)) * inv, (bflo(a[h].y) + bflo(e[h].y)) * inv, (bfhi(a[h].y) + bfhi(e[h].y)) * inv};
      const float mean = wave_sum((hv[0] + hv[1]) + (hv[2] + hv[3])) * (1.0f / 256.0f);
      float d[4]; float s2 = 0.f;
#pragma unroll
      for (int j = 0; j < 4; ++j) { d[j] = hv[j] - mean; s2 += d[j] * d[j]; }
      const float rstd = rsqrtf(wave_sum(s2) * (1.0f / 256.0f) + LN_EPS);
      const f32x4 nw = *(const f32x4*)(normw + col), sk = *(const f32x4*)(skip + col);
      const float xc[4] = {bflo(xcw[h].x), bfhi(xcw[h].x), bflo(xcw[h].y), bfhi(xcw[h].y)}, z[4] = {bflo(zw[h].x), bfhi(zw[h].x), bflo(zw[h].y), bfhi(zw[h].y)};
      float y[4];
#pragma unroll
      for (int j = 0; j < 4; ++j) y[j] = (d[j] * rstd * nw[j] + sk[j] * xc[j]) * siluf_(z[j]);
      u32x2 w; w.x = pk2(y[0], y[1]); w.y = pk2(y[2], y[3]); *(u32x2*)(YM + (size_t)t * RW + col) = w;
    }
  }
}

__device__ __forceinline__ void phase_ln_router(const Frame& F) {
  unsigned char* ws = F.ws;
  float* X1 = (float*)(ws + WS_X1); unsigned char* X1Q = ws + WS_X1B;
  int* CNT = (int*)(ws + WS_CTL); int* LIST = (int*)(ws + WS_LIST); float* LISTW = (float*)(ws + WS_LISTW); int* TOKES = (int*)(ws + WS_TOKES);
  const float* g1 = F.in[22]; const float* b1 = F.in[23]; const float* rw = F.in[24]; const float* rbias = F.in[25];
  LAS unsigned char* XH = F.lds; LAS unsigned char* XL = F.lds + 65792;
  const bf16_t* RWH = (const bf16_t*)(ws + WS_SMALL + SM_RWH); const bf16_t* RWL = (const bf16_t*)(ws + WS_SMALL + SM_RWL);
  const int w = F.wave;
  for (int tile = F.bid; tile < NTOK / 16; tile += F.G) {
    const int t0 = tile * 16;
    int lane = F.lane; asm volatile("" : "+v"(lane));
    const int r16 = lane & 15, gq = lane >> 4;
#pragma unroll 1
    for (int q = 0; q < 2; ++q) {
      const int tl = 2 * w + q, t = t0 + tl;
      float* xr = X1 + (size_t)t * DM;
      f32x4 v[8]; float s = 0.f;
#pragma unroll
      for (int j = 0; j < 8; ++j) { v[j] = *(const f32x4*)(xr + 4 * lane + 256 * j); s += (v[j][0] + v[j][1]) + (v[j][2] + v[j][3]); }
      const float mean = wave_sum(s) * (1.0f / DM); float s2 = 0.f;
#pragma unroll
      for (int j = 0; j < 8; ++j) { v[j] = v[j] - mean; s2 += (v[j][0] * v[j][0] + v[j][1] * v[j][1]) + (v[j][2] * v[j][2] + v[j][3] * v[j][3]); }
      const float rstd = rsqrtf(wave_sum(s2) * (1.0f / DM) + LN_EPS);
#pragma unroll
      for (int j = 0; j < 8; ++j) {
        const int col = 4 * lane + 256 * j;
        const f32x4 gg = *(const f32x4*)(g1 + col), bb = *(const f32x4*)(b1 + col);
        const f32x4 o = v[j] * rstd * gg + bb;
        *(f32x4*)(xr + col) = o;
        u32x2 pw; pw.x = pk2(o[0], o[1]); pw.y = pk2(o[2], o[3]);
        { int q8 = 0; q8 = __builtin_amdgcn_cvt_pk_fp8_f32(o[0], o[1], q8, false); q8 = __builtin_amdgcn_cvt_pk_fp8_f32(o[2], o[3], q8, true); *(int*)(X1Q + (size_t)t * DM + col) = q8; }
        { float lo[4];
#pragma unroll
          for (int e = 0; e < 4; ++e) lo[e] = o[e] - __uint_as_float(f2bf(o[e]) << 16);
          *(LAS u32x2*)(XH + tl * 4112 + col * 2) = pw; u32x2 lw; lw.x = pk2(lo[0], lo[1]); lw.y = pk2(lo[2], lo[3]); *(LAS u32x2*)(XL + tl * 4112 + col * 2) = lw; }
      }
    }
    __syncthreads();
    f32x4 lacc[4];
    {
      const bf16_t* rh = RWH + (size_t)r16 * DM + 256 * w + 8 * gq; const bf16_t* rl = RWL + (size_t)r16 * DM + 256 * w + 8 * gq;
      const LAS unsigned char* xh = XH + r16 * 4112 + (256 * w + 8 * gq) * 2; const LAS unsigned char* xl = XL + r16 * 4112 + (256 * w + 8 * gq) * 2;
#pragma unroll
      for (int nt = 0; nt < 4; ++nt) {
        f32x4 a4 = (f32x4){0.f, 0.f, 0.f, 0.f};
#pragma unroll
        for (int kh = 0; kh < 2; ++kh) {
          bf16x8 bh[4], bl[4];
#pragma unroll
          for (int k2 = 0; k2 < 4; ++k2) { bh[k2] = *(const bf16x8*)(rh + (size_t)(16 * nt) * DM + 32 * (4 * kh + k2)); bl[k2] = *(const bf16x8*)(rl + (size_t)(16 * nt) * DM + 32 * (4 * kh + k2)); }
#pragma unroll
          for (int k2 = 0; k2 < 4; ++k2) {
            const bf16x8 ah = *(const LAS bf16x8*)(xh + 64 * (4 * kh + k2));
            const bf16x8 al = *(const LAS bf16x8*)(xl + 64 * (4 * kh + k2));
            a4 = __builtin_amdgcn_mfma_f32_16x16x32_bf16(ah, bh[k2], a4, 0, 0, 0);
            a4 = __builtin_amdgcn_mfma_f32_16x16x32_bf16(al, bh[k2], a4, 0, 0, 0);
            a4 = __builtin_amdgcn_mfma_f32_16x16x32_bf16(ah, bl[k2], a4, 0, 0, 0);
          }
          asm volatile("" ::: "memory");
        }
        lacc[nt] = a4;
      }
    }
    __syncthreads();
    LAS float* PART = (LAS float*)F.lds;
#pragma unroll
    for (int nt = 0; nt < 4; ++nt)
#pragma unroll
      for (int j = 0; j < 4; ++j) PART[(w * 16 + 4 * gq + j) * 64 + 16 * nt + r16] = lacc[nt][j];
    __syncthreads();
    LAS int* lcnt = (LAS int*)(F.lds + 40960); LAS int* lbase = lcnt + 64;
    if (F.tid < 64) lcnt[F.tid] = 0;
    __syncthreads();
    int lslot[2], rnk[2]; float wg[2];
#pragma unroll
    for (int q = 0; q < 2; ++q) {
      const int tl = 2 * w + q;
      float logit = 0.f;
#pragma unroll
      for (int ww = 0; ww < 8; ++ww) logit += PART[(ww * 16 + tl) * 64 + lane];
      const float score = 1.0f / (1.0f + expf(-logit));
      const float biased = score + rbias[lane];
      int cnt = 0;
#pragma unroll
      for (int d = 1; d < 8; ++d) { const int other = (lane & ~7) | ((lane + d) & 7); const float ov = __shfl(biased, other); cnt += (ov > biased || (ov == biased && other < lane)) ? 1 : 0; }
      float gs = cnt < 2 ? biased : 0.f;
      gs += __shfl_xor(gs, 1); gs += __shfl_xor(gs, 2); gs += __shfl_xor(gs, 4);
      const int gi = lane >> 3; int grank = 0;
#pragma unroll
      for (int gg = 0; gg < 8; ++gg) { const float og = __shfl(gs, 8 * gg); grank += (og > gs || (og == gs && gg < gi)) ? 1 : 0; }
      const float val = grank < 4 ? biased : -INFINITY;
      int erank = 0;
      for (int e2 = 0; e2 < 64; ++e2) { const float ov = __shfl(val, e2); erank += (ov > val || (ov == val && e2 < lane)) ? 1 : 0; }
      const bool chosen = erank < 8;
      const float wsum = wave_sum(chosen ? score : 0.f);
      rnk[q] = erank; wg[q] = score / wsum * 2.5f; lslot[q] = -1;
      if (chosen) lslot[q] = atomicAdd((int*)(lcnt + lane), 1);
    }
    __syncthreads();
    if (F.tid < 64) { const int c = lcnt[F.tid]; lbase[F.tid] = c ? atomicAdd(&CNT[F.tid * 64], c) : 0; }
    __syncthreads();
#pragma unroll
    for (int q = 0; q < 2; ++q) {
      if (lslot[q] >= 0) { const int t = t0 + 2 * w + q; const int slot = lbase[lane] + lslot[q];
        LIST[lane * NTOK + slot] = t; LISTW[lane * NTOK + slot] = wg[q]; TOKES[t * 8 + rnk[q]] = (lane << 16) | slot; }
    }
    __syncthreads();
  }
}

__device__ __forceinline__ MoeTab build_moe_tab(const Frame& F) {
  LAS int* tp = (LAS int*)(F.lds + LDS_X); LAS int* cp = tp + 68; LAS int* cn = tp + 136;
  const int* CNT = (const int*)(F.ws + WS_CTL);
  if (F.tid == 0) { int a = 0, b = 0; for (int e = 0; e < NE; ++e) { const int c = CNT[e * 64]; tp[e] = a; cp[e] = b; cn[e] = c; a += (c + 255) >> 8; b += c; } tp[NE] = a; cp[NE] = b; }
  __syncthreads();
  { LAS int* rt = tp + 256; if (F.tid < 384) { int e = 0; for (int k = 0; k < NE; ++k) { if (tp[k + 1] <= F.tid) e = k + 1; } rt[F.tid] = e < NE ? e : NE - 1; } }
  __syncthreads();
  MoeTab T; T.tp = tp; T.cp = cp; T.cnt = cn; T.n_rt = __builtin_amdgcn_readfirstlane(tp[NE]);
  return T;
}

__device__ __forceinline__ void phase_final(const Frame& F, const MoeTab& T) {
  unsigned char* ws = F.ws;
  const bf16_t* YRM = (const bf16_t*)(ws + WS_YRM); const int* TOKES = (const int*)(ws + WS_TOKES);
  const float* g2 = F.in[32]; const float* b2 = F.in[33];
  const int gw = F.bid * 8 + F.wave, NGW = F.G * 8, lane = F.lane;
  for (int t = gw; t < NTOK; t += NGW) {
    float* orow = F.out + (size_t)t * DM;
    f32x4 v[8];
    { const float* xrow = (const float*)(ws + WS_X1) + (size_t)t * DM; const bf16_t* ys = YRM + (size_t)(NTOK * 8 + t) * DM;
#pragma unroll
      for (int j = 0; j < 8; ++j) { const u32x2 wv = *(const u32x2*)(ys + 4 * lane + 256 * j); v[j] = *(const f32x4*)(xrow + 4 * lane + 256 * j) * ALPHA; v[j][0] += bflo(wv.x); v[j][1] += bfhi(wv.x); v[j][2] += bflo(wv.y); v[j][3] += bfhi(wv.y); } }
    const int esl = TOKES[t * 8 + (lane & 7)];
#pragma unroll
    for (int kb = 0; kb < 2; ++kb) {
      u32x2 yv[4][8];
#pragma unroll
      for (int k = 0; k < 4; ++k) {
        const int es = __shfl(esl, kb * 4 + k); const int e = es >> 16, slot = es & 0xffff;
        const bf16_t* yr = YRM + (size_t)(T.cp[e] + slot) * DM;
#pragma unroll
        for (int j = 0; j < 8; ++j) yv[k][j] = *(const u32x2*)(yr + 4 * lane + 256 * j);
      }
#pragma unroll
      for (int k = 0; k < 4; ++k)
#pragma unroll
        for (int j = 0; j < 8; ++j) { v[j][0] += bflo(yv[k][j].x); v[j][1] += bfhi(yv[k][j].x); v[j][2] += bflo(yv[k][j].y); v[j][3] += bfhi(yv[k][j].y); }
    }
    float s = 0.f;
#pragma unroll
    for (int j = 0; j < 8; ++j) s += (v[j][0] + v[j][1]) + (v[j][2] + v[j][3]);
    const float mean = wave_sum(s) * (1.0f / DM); float s2 = 0.f;
#pragma unroll
    for (int j = 0; j < 8; ++j) { v[j] = v[j] - mean; s2 += (v[j][0] * v[j][0] + v[j][1] * v[j][1]) + (v[j][2] * v[j][2] + v[j][3] * v[j][3]); }
    const float rstd = rsqrtf(wave_sum(s2) * (1.0f / DM) + LN_EPS);
#pragma unroll
    for (int j = 0; j < 8; ++j) { const int col = 4 * lane + 256 * j; const f32x4 gg = *(const f32x4*)(g2 + col), bb = *(const f32x4*)(b2 + col); *(f32x4*)(orow + col) = v[j] * rstd * gg + bb; }
  }
}

__global__ void __launch_bounds__(512, 2) fwd_megakernel(Params p, int ph_lo, int ph_hi) {
  extern __shared__ __attribute__((aligned(16))) unsigned char lds_raw[];
  Frame F;
  F.lds = (LAS unsigned char*)lds_raw; F.tid = threadIdx.x; F.lane = F.tid & 63; F.wave = __builtin_amdgcn_readfirstlane(F.tid >> 6);
  F.G = gridDim.x; F.bid = blockIdx.x; F.ws = as_global(p.ws); F.in = InPtrs{p.in}; F.out = as_global(p.out);
  unsigned char* ws = as_global(p.ws);
#ifndef PHMASK
#define PHMASK 0xFFF
#endif
#define IN(k) (((PHMASK >> (k)) & 1) && ph_lo <= (k) && (k) < ph_hi)
#ifndef RPTMASK
#define RPTMASK 0
#endif
#define RPT(k) for (int _rp = 0; _rp < 1 + ((RPTMASK >> (k)) & 1); ++_rp)
#define FRESH() do { unsigned char* w2_ = opaque_global(p.ws); ws = w2_; F.ws = w2_; int l2_ = (int)__builtin_amdgcn_mbcnt_hi(~0u, __builtin_amdgcn_mbcnt_lo(~0u, 0u)); asm volatile("" : "+v"(l2_)); F.lane = l2_; F.tid = F.wave * 64 + l2_; } while (0)
#define SYNC(k) do { if (IN(k) && IN((k) + 1)) { xcd_barrier(xbar); } } while (0)
  { volatile LAS unsigned* st = (volatile LAS unsigned*)(F.lds + LDS_X + 4096); if (F.tid < 4) st[F.tid] = 0u; }
  __syncthreads();
  const XcdBarrier xbar = xcd_barrier_post((unsigned*)(ws + WS_CTL + 16384), (volatile LAS unsigned*)(F.lds + LDS_X + 4096));

  FRESH();
  if (IN(0)) RPT(0) { if (_rp) xcd_barrier(xbar); phase_prologue(F); }
  SYNC(0);
  FRESH();
  if (IN(1)) RPT(1) { if (_rp) xcd_barrier(xbar);
    SchedDense S{(const char*)(ws + WS_XB), (const char*)(ws + WS_WIN), NTOK / 256, INC / 256, F.G, F.bid, DM, DM, DM / 64};
    EpiStoreBf16 E{(bf16_t*)(ws + WS_PROJ), INC};
    pg8::gemm_phase<EpiStoreBf16, SchedDense, false>(F.lds, DM, DM, S, E);
  }
  SYNC(1);
  FRESH();
  if (IN(2)) RPT(2) { if (_rp) xcd_barrier(xbar); phase_mprep(F); phase_rconv(F); }
  SYNC(2);
  FRESH();
  if (IN(3)) RPT(3) { if (_rp) xcd_barrier(xbar);
    const int nm2 = F.G >> 1;
    if (F.bid < nm2) phase_m2(F, nm2);
    else {
      const int bid2 = F.bid - nm2, G2 = F.G - nm2;
      phase_m1(F, bid2, G2);
      int Kr = 4; asm volatile("" : "+s"(Kr));
      SchedRglru S{(const char*)(ws + WS_XCR), (const char*)(ws + WS_WRAX), G2, bid2, Kr};
      EpiRglru E{(const bf16_t*)(ws + WS_XCR), p.in[15], p.in[17], (const float*)(ws + WS_SMALL + SM_C8), (float*)(ws + WS_RA), (bf16_t*)(ws + WS_RB)};
      pg8::gemm_phase<EpiRglru, SchedRglru, false>(F.lds, RW, 256, S, E);
    }
  }
  SYNC(3);
  FRESH();
  if (IN(4)) RPT(4) { if (_rp) xcd_barrier(xbar); phase_ragg(F); phase_ym(F); }
  SYNC(4);
  FRESH();
  if (IN(5)) RPT(5) { if (_rp) xcd_barrier(xbar); phase_rscan(F); }
  SYNC(5);
  FRESH();
  if (IN(6)) RPT(6) { if (_rp) xcd_barrier(xbar);
    SchedMerge S{(const char*)(ws + WS_YM), (const char*)(ws + WS_YR), (const char*)(ws + WS_WPM), (const char*)(ws + WS_WPR), F.G, F.bid};
    EpiMergeF E{(const bf16_t*)(ws + WS_PROJ), p.in[2], (bf16_t*)(ws + WS_MERGED)};
    pg8::gemm_phase<EpiMergeF, SchedMerge, false>(F.lds, RW, RW, S, E);
  }
  SYNC(6);
  FRESH();
  if (IN(7)) RPT(7) { if (_rp) xcd_barrier(xbar);
    SchedDense S{(const char*)(ws + WS_MERGED), (const char*)(ws + WS_WO), NTOK / 256, DM / 256, F.G, F.bid, DM, DM, DM / 64};
    EpiWo E{p.in[0], (float*)(ws + WS_X1)};
    pg8::gemm_phase<EpiWo, SchedDense, false>(F.lds, DM, DM, S, E);
  }
  SYNC(7);
  FRESH();
  if (IN(8)) phase_ln_router(F);
  SYNC(8);
  FRESH();
  if (IN(9)) RPT(9) { if (_rp) xcd_barrier(xbar);
    const MoeTab T = build_moe_tab(F);
    SchedMoe<4, 1> S{T, (const int*)(ws + WS_LIST), (const char*)(ws + WS_X1B), (const char*)(ws + WS_WEGU), (const char*)(ws + WS_WSGU), F.G, F.bid, DM / 128};
    EpiMoe1 E{ws + WS_HMOE};
    pg8::gemm_phase<EpiMoe1, SchedMoe<4, 1>, true>(F.lds, DM / 2, DM / 2, S, E);
  }
  SYNC(9);
  FRESH();
  if (IN(10)) RPT(10) { if (_rp) xcd_barrier(xbar);
    const MoeTab T = build_moe_tab(F);
    int nt2 = DE / 128; asm volatile("" : "+s"(nt2));
    SchedMoe<8, 2> S{T, (const int*)(ws + WS_LIST), (const char*)(ws + WS_HMOE), (const char*)(ws + WS_WED), (const char*)(ws + WS_WSD), F.G, F.bid, nt2};
    EpiMoe2 E{(bf16_t*)(ws + WS_YRM), (const float*)(ws + WS_LISTW), (bf16_t*)(ws + WS_WIN)};
    pg8::gemm_phase<EpiMoe2, SchedMoe<8, 2>, false>(F.lds, DE / 2, DE / 2, S, E);
  }
  SYNC(10);
  FRESH();
  if (IN(11)) { const MoeTab T = build_moe_tab(F); phase_final(F, T); }
#undef IN
#undef SYNC
}

#ifndef N_LAUNCH_SPLIT
#define N_LAUNCH_SPLIT 0
#endif
extern "C" void kernel_launch(void* const* d_in, const int* in_sizes, int n_in, void* d_out, int out_size, void* d_ws, size_t ws_size, hipStream_t stream) {
  static int grid_blocks = 0;
  if (grid_blocks == 0) {
    int dev = 0, cus = 0, per_cu = 0;
    (void)hipGetDevice(&dev);
    (void)hipDeviceGetAttribute(&cus, hipDeviceAttributeMultiprocessorCount, dev);
    (void)hipFuncSetAttribute((const void*)fwd_megakernel, hipFuncAttributeMaxDynamicSharedMemorySize, LDS_BYTES);
    (void)hipOccupancyMaxActiveBlocksPerMultiprocessor(&per_cu, fwd_megakernel, 512, LDS_BYTES);
    if (per_cu < 1) { fprintf(stderr, "kernel_launch: occupancy query says %d blocks per CU\n", per_cu); per_cu = 1; }
    grid_blocks = cus * per_cu;
    fprintf(stderr, "kernel_launch: cus %d per_cu %d grid %d ws_size %zu (need %zu) n_in %d\n", cus, per_cu, grid_blocks, ws_size, (size_t)WS_END, n_in);
    if (ws_size < WS_END || n_in != 34) { fprintf(stderr, "kernel_launch: workspace too small or unexpected inputs; nothing launched\n"); grid_blocks = -1; }
  }
  if (grid_blocks < 0) return;
  (void)hipMemsetAsync((char*)d_ws + WS_CTL, 0, 65536, stream);
  Params p{};
  for (int i = 0; i < 34; ++i) p.in[i] = (const float*)d_in[i];
  p.out = (float*)d_out; p.ws = (unsigned char*)d_ws;
#if N_LAUNCH_SPLIT
  for (int ph = 0; ph < 12; ++ph) { hipLaunchKernelGGL(fwd_megakernel, dim3(grid_blocks), dim3(512), LDS_BYTES, stream, p, ph, ph + 1); }
#else
  int lo = 0, hi = 12;
  void* args[] = {&p, &lo, &hi};
  hipError_t e = hipLaunchCooperativeKernel((void*)fwd_megakernel, dim3(grid_blocks), dim3(512), args, LDS_BYTES, stream);
  if (e != hipSuccess) fprintf(stderr, "cooperative launch failed: %s (grid %d)\n", hipGetErrorString(e), grid_blocks);
#endif
}
```

```cpp
#include <hip/hip_runtime.h>
#include <hip/hip_cooperative_groups.h>
#include <cstdio>
#include <cstdint>
namespace cg = cooperative_groups;

#define LAS __attribute__((address_space(3)))
typedef unsigned short bf16_t;
typedef short bf16x8 __attribute__((ext_vector_type(8)));
typedef float f32x4 __attribute__((ext_vector_type(4)));
typedef float f32x2 __attribute__((ext_vector_type(2)));
typedef unsigned u32x4 __attribute__((ext_vector_type(4)));
typedef unsigned u32x2 __attribute__((ext_vector_type(2)));
typedef int i32x8 __attribute__((ext_vector_type(8)));
typedef int i32x4 __attribute__((ext_vector_type(4)));

constexpr int NTOK = 8192, DM = 2048, SEQ = 4096, MW = 2048, RW = 2560, INC = 13312, NH = 8, HD = 256, NE = 64, DE = 512;
constexpr int O_Z = 2048, O_XR = 4096, O_XG = 6656, O_G0 = 9216, O_G1 = 11264;
constexpr float LN_EPS = 1e-5f;
constexpr float ALPHA = 1.189207115002721f;
constexpr int NCH = 64;

constexpr size_t MiB = 1u << 20;
constexpr size_t WS_CTL = 0;
constexpr size_t WS_WIN = 1 * MiB, WS_RB = 1 * MiB, WS_M2TAB = 41 * MiB;
constexpr size_t WS_WPM = 53 * MiB  , WS_WPR = 63 * MiB, WS_WO = 73 * MiB, WS_WRAX = 81 * MiB, WS_WSGU = 84 * MiB, WS_WSD = 1014 * MiB;
constexpr size_t WS_WEGU = 88 * MiB, WS_WED = 344 * MiB;
constexpr size_t WS_XB = 472 * MiB, WS_HNI = 472 * MiB, WS_HMOE = 472 * MiB;
constexpr size_t WS_PROJ = 504 * MiB;
constexpr size_t WS_YRM = 560 * MiB;
constexpr size_t WS_Q = 712 * MiB, WS_K = 744 * MiB, WS_V = 776 * MiB, WS_YM = 712 * MiB  , WS_YR = 752 * MiB;
constexpr size_t WS_XCM = 808 * MiB, WS_MERGED = 808 * MiB;
constexpr size_t WS_XCR = 840 * MiB;
constexpr size_t WS_SMALL = 880 * MiB;
constexpr size_t WS_RA = 886 * MiB, WS_T1 = 886 * MiB, WS_X1B = 886 * MiB  ;
constexpr size_t WS_LIST = 918 * MiB, WS_LISTW = 920 * MiB  , WS_TOKES = 923 * MiB;
constexpr size_t WS_X1 = 950 * MiB;
constexpr size_t WS_HNE = 966 * MiB;
constexpr size_t WS_END = 1016 * MiB;
constexpr size_t SM_IG = 0, SM_LF = 256 * 1024, SM_INTER = 512 * 1024, SM_EMR = 768 * 1024, SM_DENI = 1024 * 1024, SM_QN = 1280 * 1024;
constexpr size_t SM_WIFT = 1536 * 1024;
constexpr size_t SM_C8 = 1792 * 1024;
constexpr size_t SM_RWH = 4608 * 1024, SM_RWL = 4864 * 1024;
constexpr size_t SM_AGGA = 2 * MiB, SM_AGGB = 2 * MiB + 1310720;

constexpr int LDS_BYTES = 147456;
constexpr int LDS_X = 131072;

struct Params {
  const float* in[34];
  float* out;
  unsigned char* ws;
};

typedef __bf16 hbf2_t __attribute__((ext_vector_type(2)));
typedef float hf2_t __attribute__((ext_vector_type(2)));
__device__ __forceinline__ unsigned pk2(float lo, float hi) { const hf2_t f = {lo, hi}; return __builtin_bit_cast(unsigned, __builtin_convertvector(f, hbf2_t)); }
__device__ __forceinline__ unsigned f2bf(float f) { return pk2(f, 0.f) & 0xffffu; }
__device__ __forceinline__ float bflo(unsigned w) { return __uint_as_float(w << 16); }
__device__ __forceinline__ float bfhi(unsigned w) { return __uint_as_float(w & 0xffff0000u); }
__device__ __forceinline__ float bf1(bf16_t b) { return __uint_as_float(((unsigned)b) << 16); }
__device__ __forceinline__ float sigmoidf_(float x) { return 1.0f / (1.0f + __expf(-x)); }
__device__ __forceinline__ float siluf_(float x) { return x / (1.0f + __expf(-x)); }
__device__ __forceinline__ float gelu_tanh(float x) { const float u = 0.7978845608028654f * (x + 0.044715f * x * x * x); return 0.5f * x * (1.0f + tanhf(u)); }
__device__ __forceinline__ float wave_sum(float v) {
#pragma unroll
  for (int o = 1; o < 64; o <<= 1) v += __shfl_xor(v, o);
  return v;
}
__device__ __forceinline__ float wave_max(float v) {
#pragma unroll
  for (int o = 1; o < 64; o <<= 1) v = fmaxf(v, __shfl_xor(v, o));
  return v;
}
__device__ __forceinline__ float wave_scan_sum(float v, int lane) {
#pragma unroll
  for (int o = 1; o < 64; o <<= 1) { const float t = __shfl_up(v, o); if (lane >= o) v += t; }
  return v;
}
__device__ __forceinline__ float wave_scan_max(float v, int lane) {
#pragma unroll
  for (int o = 1; o < 64; o <<= 1) { const float t = __shfl_up(v, o); if (lane >= o) v = fmaxf(v, t); }
  return v;
}
#define LDS_WAIT() asm volatile("s_waitcnt lgkmcnt(0)" ::: "memory")
#define LBAR() do { asm volatile("s_waitcnt lgkmcnt(0)" ::: "memory"); __builtin_amdgcn_s_barrier(); asm volatile("" ::: "memory"); } while (0)

namespace pg8 {
constexpr int BM = 256, BK = 64, HALF = 128, HTB = HALF * BK * 2, NXCD = 8, WGM = 8;
__device__ __forceinline__ int lds_byte(int r, int c) { const int st = (r >> 4) * 2 + (c >> 5), rr = r & 15, cc = c & 31, ob = rr * 64 + cc * 2; return st * 1024 + (ob ^ (((ob >> 9) & 1) << 5)); }
__device__ __forceinline__ void stage_rc(int b, int& R, int& C) { const int st = b / 1024, sb = b % 1024, swz = sb ^ (((sb >> 9) & 1) << 5); R = (st >> 1) * 16 + swz / 64; C = (st & 1) * 32 + (swz % 64) / 2; }

__device__ __forceinline__ int perm32(int rho) { const int n = rho >> 4, i = rho & 15; return 8 * (i >> 2) + 4 * n + (i & 3); }
struct UnitG { const char* A; const char* B; int pm, pn, e, cnt, mt, row0, nt, keep; };

__device__ __forceinline__ bool dense_order(int i, int G, int c, int nM, int nN, int& pm, int& pn) {
  const int nwg = nM * nN; const long L = (long)i * G + c; if (L >= nwg) return false;
  int wgid = (int)L; { const int q = nwg / NXCD, r = nwg % NXCD, xcd = wgid % NXCD, off = wgid / NXCD; wgid = (xcd < r ? xcd * (q + 1) : r * (q + 1) + (xcd - r) * q) + off; }
  const int nig = WGM * nN, gid = wgid / nig, fm = gid * WGM, gsz = (nM - fm) < WGM ? (nM - fm) : WGM;
  pm = fm + ((wgid % nig) % gsz); pn = (wgid % nig) / gsz; return true;
}

template <class Epi, class Sched, bool GATHER>
__device__ __forceinline__ void gemm_phase(LAS unsigned char* lds, const int lda, const int ldb, const Sched& S, const Epi& E) {
  const int tid = threadIdx.x, wid = __builtin_amdgcn_readfirstlane(tid >> 6), lane = tid & 63, wr = wid >> 2, wc = wid & 3, fr = lane & 15, fq = lane >> 4;
  int Rr[2], Cc[2];
  unsigned voffB[2];
  unsigned vA[2][2];
  unsigned nvA[2][2];
#pragma unroll
  for (int i = 0; i < 2; ++i) { stage_rc(tid * 16 + i * 8192, Rr[i], Cc[i]); const int Rb = Epi::PERM ? ((Rr[i] & ~31) + perm32(Rr[i] & 31)) : Rr[i]; voffB[i] = (unsigned)(Rb * ldb + Cc[i]) * 2u; }
  const size_t kstep = (size_t)(BK * 2);
  const size_t hstepA = (size_t)HALF * lda * 2, hstepB = (size_t)HALF * ldb * 2;
  const unsigned ldsw = (unsigned)wid * 1024u;
  const int aoff = lds_byte(wr * 64 + fr, fq * 8), boff = lds_byte(wc * 32 + fr, fq * 8);
#define PG8_SA(b, h) (((b) * 2 + (h)) * HTB)
#define PG8_SB(b, h) ((4 + (b) * 2 + (h)) * HTB)
#define PG8_STAGE_B(bufoff, gbase) do { _Pragma("unroll") for (int _i = 0; _i < 2; ++_i) \
    __builtin_amdgcn_global_load_lds((const unsigned*)((const char*)(gbase) + voffB[_i]), (LAS unsigned*)(lds + (bufoff) + ldsw + _i * 8192), 16, 0, 0); } while (0)
#define PG8_STAGE_A(bufoff, gbase, h) do { _Pragma("unroll") for (int _i = 0; _i < 2; ++_i) { \
    const char* _p = GATHER ? ((const char*)(gbase) + vA[h][_i]) : ((const char*)(gbase) + (h) * hstepA + vA[0][_i]); \
    __builtin_amdgcn_global_load_lds((const unsigned*)_p, (LAS unsigned*)(lds + (bufoff) + ldsw + _i * 8192), 16, 0, 0); } } while (0)
#define PG8_LD8(p) __builtin_shufflevector(*(const LAS i32x4*)(p), *(const LAS i32x4*)((p) + 1024), 0, 1, 2, 3, 4, 5, 6, 7)
#define PG8_LO(x) __builtin_bit_cast(bf16x8, __builtin_shufflevector(x, x, 0, 1, 2, 3))
#define PG8_HI(x) __builtin_bit_cast(bf16x8, __builtin_shufflevector(x, x, 4, 5, 6, 7))
#define PG8_LDA(dst, b, h) do { _Pragma("unroll") for (int m = 0; m < 4; ++m) dst[m] = PG8_LD8(lds + PG8_SA(b, h) + aoff + m * 2048); } while (0)
#define PG8_LDB(dst, b, h) do { _Pragma("unroll") for (int n = 0; n < 2; ++n) dst[n] = PG8_LD8(lds + PG8_SB(b, h) + boff + n * 2048); } while (0)
#define PG8_MMA(ai, bj, At, Bt) do { __builtin_amdgcn_s_setprio(1); _Pragma("unroll") for (int m = 0; m < 4; ++m) _Pragma("unroll") for (int n = 0; n < 2; ++n) { \
    acc[ai][bj][m][n] = __builtin_amdgcn_mfma_f32_16x16x32_bf16(PG8_LO(Bt[n]), PG8_LO(At[m]), acc[ai][bj][m][n], 0, 0, 0); \
    acc[ai][bj][m][n] = __builtin_amdgcn_mfma_f32_16x16x32_bf16(PG8_HI(Bt[n]), PG8_HI(At[m]), acc[ai][bj][m][n], 0, 0, 0); } __builtin_amdgcn_s_setprio(0); } while (0)
#define PG8_MMA8(ai, bj, At, Bt) do { __builtin_amdgcn_s_setprio(1); _Pragma("unroll") for (int m = 0; m < 4; ++m) _Pragma("unroll") for (int n = 0; n < 2; ++n) \
    acc[ai][bj][m][n] = __builtin_amdgcn_mfma_scale_f32_16x16x128_f8f6f4(Bt[n], At[m], acc[ai][bj][m][n], 0, 0, 0, 0x7F7F7F7F, 0, 0x7F7F7F7F); __builtin_amdgcn_s_setprio(0); } while (0)
#define PG8_MM(ai, bj, At, Bt) do { if (Epi::FP8) PG8_MMA8(ai, bj, At, Bt); else PG8_MMA(ai, bj, At, Bt); } while (0)
#define PG8_WAIT_V(n) asm volatile("s_waitcnt vmcnt(" #n ")" ::: "memory")
#define PG8_WAIT_L(n) asm volatile("s_waitcnt lgkmcnt(" #n ")" ::: "memory")
#define PG8_BAR __builtin_amdgcn_s_barrier()
#define PG8_SCHED __builtin_amdgcn_sched_barrier(0)
  UnitG cur, nxt; int ui = 0;
  if (!S.next(0, cur)) return;
#pragma unroll
  for (int h = 0; h < 2; ++h)
#pragma unroll
    for (int i = 0; i < 2; ++i) {
      if (GATHER) vA[h][i] = (unsigned)(S.arow(cur, h * HALF + Rr[i]) * lda + Cc[i]) * 2u;
      else vA[h][i] = (unsigned)(Rr[i] * lda + Cc[i]) * 2u;
      nvA[h][i] = vA[h][i];
    }
  f32x4 acc[2][2][4][2];
#pragma unroll
  for (int a = 0; a < 2; ++a)
#pragma unroll
    for (int b = 0; b < 2; ++b)
#pragma unroll
      for (int m = 0; m < 4; ++m)
#pragma unroll
        for (int n = 0; n < 2; ++n) acc[a][b][m][n] = (f32x4){0.f, 0.f, 0.f, 0.f};
  i32x8 At[4], B0[2], B1[2];
  const char* cA = cur.A; const char* cB = cur.B;
  { const char* pB0 = cB; const char* pB1 = cB + hstepB; const char* pA0 = cA; const char* pB2 = cB + kstep; const char* pA1 = cA + kstep; const char* pB3 = cB + hstepB + kstep;
    asm volatile("" : "+s"(pB0), "+s"(pB1), "+s"(pA0), "+s"(pB2), "+s"(pA1), "+s"(pB3));
  PG8_STAGE_B(PG8_SB(0, 0), pB0); PG8_STAGE_B(PG8_SB(0, 1), pB1); PG8_STAGE_A(PG8_SA(0, 0), pA0, 0); PG8_STAGE_A(PG8_SA(0, 1), pA0, 1);
  if (wr == 1) PG8_BAR;
  PG8_WAIT_V(2); PG8_BAR;
  PG8_STAGE_B(PG8_SB(1, 0), pB2); PG8_STAGE_A(PG8_SA(1, 0), pA1, 0); PG8_STAGE_B(PG8_SB(1, 1), pB3); }
  PG8_WAIT_V(6); PG8_BAR;
  for (;;) {
    const bool has_next = S.next(ui + 1, nxt);
    const char* nA = has_next ? nxt.A : cA; const char* nB = has_next ? nxt.B : cB;
    if (GATHER) {
      if (has_next) {
#pragma unroll
        for (int h = 0; h < 2; ++h)
#pragma unroll
          for (int i = 0; i < 2; ++i) nvA[h][i] = (unsigned)(S.arow(nxt, h * HALF + Rr[i]) * lda + Cc[i]) * 2u;
      }
    }
    const int nt = cur.nt;
#pragma unroll 1
    for (int t = 0; t < nt; t += 2) {
      const bool last = (t == nt - 2);
      const char* a1 = cA + (size_t)(t + 1) * kstep;
      const char* a2 = last ? nA : cA + (size_t)(t + 2) * kstep; const char* b2 = last ? nB : cB + (size_t)(t + 2) * kstep;
      const char* a3 = a2 + kstep; const char* b3 = b2 + kstep;
      asm volatile("" : "+s"(a1), "+s"(a2), "+s"(a3), "+s"(b2), "+s"(b3));
      PG8_LDB(B0, 0, 0); PG8_LDB(B1, 0, 1); PG8_SCHED; PG8_LDA(At, 0, 0); PG8_STAGE_A(PG8_SA(1, 1), a1, 1);
      if (GATHER) { if (last) {
#pragma unroll
        for (int h = 0; h < 2; ++h)
#pragma unroll
          for (int i = 0; i < 2; ++i) vA[h][i] = nvA[h][i]; } }
      PG8_WAIT_V(8); PG8_WAIT_L(0); PG8_BAR; PG8_MM(0, 0, At, B0); PG8_MM(0, 1, At, B1); PG8_BAR; PG8_SCHED;
      PG8_LDA(At, 0, 1); PG8_STAGE_B(PG8_SB(0, 0), b2); PG8_STAGE_B(PG8_SB(0, 1), b2 + hstepB); PG8_STAGE_A(PG8_SA(0, 0), a2, 0);
      PG8_WAIT_V(8); PG8_WAIT_L(0); PG8_BAR; PG8_MM(1, 0, At, B0); PG8_MM(1, 1, At, B1); PG8_BAR; PG8_SCHED;
      PG8_LDB(B0, 1, 0); PG8_LDB(B1, 1, 1); PG8_SCHED; PG8_LDA(At, 1, 0); PG8_STAGE_A(PG8_SA(0, 1), a2, 1);
      PG8_WAIT_V(8); PG8_WAIT_L(0); PG8_BAR; PG8_MM(0, 0, At, B0); PG8_MM(0, 1, At, B1); PG8_BAR; PG8_SCHED;
      PG8_LDA(At, 1, 1); PG8_STAGE_B(PG8_SB(1, 0), b3); PG8_STAGE_B(PG8_SB(1, 1), b3 + hstepB); PG8_STAGE_A(PG8_SA(1, 0), a3, 0);
      PG8_WAIT_V(8); PG8_WAIT_L(0); PG8_BAR; PG8_MM(1, 0, At, B0); PG8_MM(1, 1, At, B1); PG8_BAR; PG8_SCHED;
    }
    if (wr == 0) PG8_BAR;
    { int l2 = (int)__builtin_amdgcn_mbcnt_hi(~0u, __builtin_amdgcn_mbcnt_lo(~0u, 0u)); asm volatile("" : "+v"(l2));
      E(acc, cur, wr, wc, l2 & 15, l2 >> 4); }
    if (!has_next) break;
    if (!cur.keep) {
#pragma unroll
      for (int a = 0; a < 2; ++a)
#pragma unroll
        for (int b = 0; b < 2; ++b)
#pragma unroll
          for (int m = 0; m < 4; ++m)
#pragma unroll
            for (int n = 0; n < 2; ++n) acc[a][b][m][n] = (f32x4){0.f, 0.f, 0.f, 0.f};
    }
    cur = nxt; cA = nA; cB = nB; ++ui;
    if (wr == 1) PG8_BAR;
  }
  PG8_WAIT_V(0);
  PG8_BAR;
#undef PG8_SA
#undef PG8_SB
#undef PG8_STAGE_A
#undef PG8_STAGE_B
#undef PG8_LDA
#undef PG8_LDB
#undef PG8_MMA
#undef PG8_MMA8
#undef PG8_MM
#undef PG8_LD8
#undef PG8_LO
#undef PG8_HI
#undef PG8_WAIT_V
#undef PG8_WAIT_L
#undef PG8_BAR
#undef PG8_SCHED
}
}

__device__ __forceinline__ const char* uni_ptr(const char* p) {
  const unsigned long long v = (unsigned long long)p;
  const unsigned lo = __builtin_amdgcn_readfirstlane((unsigned)v), hi = __builtin_amdgcn_readfirstlane((unsigned)(v >> 32));
  return (const char*)(((unsigned long long)hi << 32) | lo);
}

struct SchedDense {
  const char* A; const char* B; int nM, nN, G, c, lda, ldb, nt;
  __device__ __forceinline__ bool next(int i, pg8::UnitG& u) const {
    int pm, pn; if (!pg8::dense_order(i, G, c, nM, nN, pm, pn)) return false;
    u.pm = pm; u.pn = pn; u.e = 0; u.cnt = 0; u.mt = 0; u.row0 = pm * 256; u.nt = nt; u.keep = 0;
    u.A = A + (size_t)pm * 256 * lda * 2; u.B = B + (size_t)pn * 256 * ldb * 2; return true;
  }
  __device__ __forceinline__ unsigned arow(const pg8::UnitG&, int r) const { return (unsigned)r; }
};

struct EpiStoreBf16 {
  static constexpr bool PERM = true, FP8 = false;
  bf16_t* O; int ldc;
  __device__ __forceinline__ void operator()(const f32x4 (&acc)[2][2][4][2], const pg8::UnitG& u, int wr, int wc, int fr, int fq) const {
    const int row0 = u.pm * 256 + wr * 64 + fr, col0 = u.pn * 256 + wc * 32 + 8 * fq;
#pragma unroll
    for (int ai = 0; ai < 2; ++ai)
#pragma unroll
      for (int m = 0; m < 4; ++m) { bf16_t* rowp = O + (size_t)(row0 + ai * 128 + m * 16) * ldc + col0;
#pragma unroll
        for (int bj = 0; bj < 2; ++bj) { const f32x4 v0 = acc[ai][bj][m][0], v1 = acc[ai][bj][m][1]; u32x4 w; w.x = pk2(v0[0], v0[1]); w.y = pk2(v0[2], v0[3]); w.z = pk2(v1[0], v1[1]); w.w = pk2(v1[2], v1[3]); *(u32x4*)(rowp + bj * 128) = w; } }
  }
};

struct SchedRglru {
  const char* XCR; const char* W; int G, c, nt4;
  __device__ __forceinline__ bool next(int i, pg8::UnitG& u) const {
    const int L = i * G + c; if (L >= 640) return false;
    const int blk = L >> 6, rem = L & 63; u.e = blk; u.pm = rem >> 1; u.pn = rem & 1; u.cnt = 0; u.mt = 0; u.row0 = u.pm * 256; u.nt = nt4; u.keep = 0;
    u.A = XCR + ((size_t)u.pm * 256 * RW + 256 * blk) * 2; u.B = W + ((size_t)(blk * 512 + u.pn * 256) * 256) * 2; return true;
  }
  __device__ __forceinline__ unsigned arow(const pg8::UnitG&, int r) const { return (unsigned)r; }
};
struct EpiRglru {
  static constexpr bool PERM = true, FP8 = false;
  const bf16_t* XCR; const float* ba; const float* bx; const float* C8; float* RA; bf16_t* RBo;
  __device__ __forceinline__ void operator()(const f32x4 (&acc)[2][2][4][2], const pg8::UnitG& u, int wr, int wc, int fr, int fq) const {
    const int row0 = u.pm * 256 + wr * 64 + fr;
#pragma unroll
    for (int n = 0; n < 2; ++n) {
      const int ch = 256 * u.e + 128 * u.pn + 32 * wc + 8 * fq + 4 * n;
      const f32x4 vba = *(const f32x4*)(ba + ch), vbx = *(const f32x4*)(bx + ch), c8 = *(const f32x4*)(C8 + ch);
#pragma unroll
      for (int ai = 0; ai < 2; ++ai)
#pragma unroll
        for (int m = 0; m < 4; ++m) {
          const size_t off = (size_t)(row0 + ai * 128 + m * 16) * RW + ch;
          const u32x2 xw = *(const u32x2*)(XCR + off);
          const float xc[4] = {bflo(xw.x), bfhi(xw.x), bflo(xw.y), bfhi(xw.y)};
          f32x4 av; float bv[4];
#pragma unroll
          for (int j = 0; j < 4; ++j) {
            const float r = __builtin_amdgcn_rcpf(1.0f + __expf(-(acc[ai][0][m][n][j] + vba[j])));
            const float ig = __builtin_amdgcn_rcpf(1.0f + __expf(-(acc[ai][1][m][n][j] + vbx[j])));
            const float la = c8[j] * r;
            const float a = __expf(la);
            const float x2 = 2.0f * la;
            const float poly = -x2 * (1.0f + x2 * 0.5f * (1.0f + x2 * (1.0f / 3.0f) * (1.0f + x2 * 0.25f * (1.0f + x2 * 0.2f))));
            const float om = (x2 > -0.25f) ? poly : (1.0f - a * a);
            av[j] = a;
            bv[j] = sqrtf(fmaxf(om, 0.f)) * (ig * xc[j]);
          }
          *(f32x4*)(RA + off) = av;
          u32x2 w; w.x = pk2(bv[0], bv[1]); w.y = pk2(bv[2], bv[3]); *(u32x2*)(RBo + off) = w;
          asm volatile("" ::: "memory");
        }
    }
  }
};

struct SchedMerge {
  const char* YM; const char* YR; const char* WPM; const char* WPR; int G, c;
  __device__ __forceinline__ bool next(int i, pg8::UnitG& u) const {
    int pm, pn; if (!pg8::dense_order(i >> 1, G, c, NTOK / 256, DM / 256, pm, pn)) return false;
    const int seg = i & 1;
    u.pm = pm; u.pn = pn; u.e = seg; u.cnt = 0; u.mt = 0; u.row0 = pm * 256; u.nt = seg ? RW / 64 : MW / 64; u.keep = seg ? 0 : 1;
    u.A = (seg ? YR : YM) + (size_t)pm * 256 * RW * 2; u.B = (seg ? WPR : WPM) + (size_t)pn * 256 * RW * 2; return true;
  }
  __device__ __forceinline__ unsigned arow(const pg8::UnitG&, int r) const { return (unsigned)r; }
};
struct EpiMergeF {
  static constexpr bool PERM = true, FP8 = false;
  const bf16_t* PROJ; const float* bgate; bf16_t* MRG;
  __device__ __forceinline__ void operator()(f32x4 (&acc)[2][2][4][2], const pg8::UnitG& u, int wr, int wc, int fr, int fq) const {
    const int row0 = u.pm * 256 + wr * 64 + fr, col0 = u.pn * 256 + wc * 32 + 8 * fq;
#pragma unroll
    for (int bj = 0; bj < 2; ++bj) {
      const int col = col0 + bj * 128;
      const f32x4 b00 = *(const f32x4*)(bgate + col), b01 = *(const f32x4*)(bgate + col + 4), b10 = *(const f32x4*)(bgate + DM + col), b11 = *(const f32x4*)(bgate + DM + col + 4);
#pragma unroll
      for (int ai = 0; ai < 2; ++ai)
#pragma unroll
        for (int m = 0; m < 4; ++m) {
          const size_t row = (size_t)(row0 + ai * 128 + m * 16);
          const u32x4 g1w = *(const u32x4*)(PROJ + row * INC + O_G1 + col);
          const float g1p[8] = {bflo(g1w.x), bfhi(g1w.x), bflo(g1w.y), bfhi(g1w.y), bflo(g1w.z), bfhi(g1w.z), bflo(g1w.w), bfhi(g1w.w)};
          if (u.e == 0) {
            const u32x4 g0w = *(const u32x4*)(PROJ + row * INC + O_G0 + col);
            const float g0p[8] = {bflo(g0w.x), bfhi(g0w.x), bflo(g0w.y), bfhi(g0w.y), bflo(g0w.z), bfhi(g0w.z), bflo(g0w.w), bfhi(g0w.w)};
#pragma unroll
            for (int j = 0; j < 4; ++j) {
              acc[ai][bj][m][0][j] *= (1.0f + __expf(-(g1p[j] + b10[j]))) * __builtin_amdgcn_rcpf(1.0f + __expf(-(g0p[j] + b00[j])));
              acc[ai][bj][m][1][j] *= (1.0f + __expf(-(g1p[4 + j] + b11[j]))) * __builtin_amdgcn_rcpf(1.0f + __expf(-(g0p[4 + j] + b01[j])));
            }
          } else {
            f32x4 v0, v1;
#pragma unroll
            for (int j = 0; j < 4; ++j) { v0[j] = acc[ai][bj][m][0][j] * __builtin_amdgcn_rcpf(1.0f + __expf(-(g1p[j] + b10[j]))); v1[j] = acc[ai][bj][m][1][j] * __builtin_amdgcn_rcpf(1.0f + __expf(-(g1p[4 + j] + b11[j]))); }
            u32x4 w; w.x = pk2(v0[0], v0[1]); w.y = pk2(v0[2], v0[3]); w.z = pk2(v1[0], v1[1]); w.w = pk2(v1[2], v1[3]); *(u32x4*)(MRG + row * DM + col) = w;
          }
        }
    }
  }
};

struct EpiWo {
  static constexpr bool PERM = false, FP8 = false;
  const float* X; float* O;
  __device__ __forceinline__ void operator()(const f32x4 (&acc)[2][2][4][2], const pg8::UnitG& u, int wr, int wc, int fr, int fq) const {
    const int row0 = u.pm * 256 + wr * 64 + fr, col0 = u.pn * 256 + wc * 32 + 4 * fq;
#pragma unroll
    for (int ai = 0; ai < 2; ++ai)
#pragma unroll
      for (int m = 0; m < 4; ++m) { const size_t off = (size_t)(row0 + ai * 128 + m * 16) * DM + col0;
#pragma unroll
        for (int bj = 0; bj < 2; ++bj)
#pragma unroll
          for (int n = 0; n < 2; ++n) { const f32x4 x = *(const f32x4*)(X + off + bj * 128 + n * 16); *(f32x4*)(O + off + bj * 128 + n * 16) = x * ALPHA + acc[ai][bj][m][n]; } }
  }
};

struct MoeTab { const LAS int* tp; const LAS int* cp; const LAS int* cnt; int n_rt; };
template <int NT  , int STAGE  >
struct SchedMoe {
  MoeTab T; const int* LIST; const char* Abase; const char* Wr; const char* Ws; int G, c, ntv;
  __device__ __forceinline__ bool next(int i, pg8::UnitG& u) const {
    const int L = i * G + c; const int total = NT * (T.n_rt + 32); if (L >= total) return false;
    const int rt = L / NT, pn = L % NT; u.pn = pn; u.nt = ntv; u.keep = 0;
    constexpr int KK = (STAGE == 1) ? DM / 2 : DE / 2;
    constexpr int NN = NT * 256;
    if (rt < T.n_rt) {
      const int e = __builtin_amdgcn_readfirstlane(T.tp[256 + rt]);
      const int mt = rt - __builtin_amdgcn_readfirstlane(T.tp[e]);
      u.e = e; u.mt = mt; u.cnt = __builtin_amdgcn_readfirstlane(T.cnt[e]); u.pm = rt; u.row0 = rt * 256;
      u.B = Wr + ((size_t)e * NN + (size_t)pn * 256) * KK * 2;
    } else {
      u.e = NE; u.mt = rt - T.n_rt; u.cnt = NTOK; u.pm = rt; u.row0 = rt * 256;
      u.B = Ws + (size_t)pn * 256 * KK * 2;
    }
    if (STAGE == 2) u.pm = __builtin_amdgcn_readfirstlane(T.cp[u.e]);
    if (STAGE == 1) u.A = Abase;
    else u.A = Abase + (size_t)rt * 256 * DE;
    return true;
  }
  __device__ __forceinline__ unsigned arow(const pg8::UnitG& u, int r) const {
    if (u.e < NE) { int slot = u.mt * 256 + r; if (slot >= u.cnt) slot = 0; return (unsigned)LIST[u.e * NTOK + slot]; }
    return (unsigned)(u.mt * 256 + r);
  }
};
struct EpiMoe1 {
  static constexpr bool PERM = true, FP8 = true;
  unsigned char* H;
  __device__ __forceinline__ void operator()(const f32x4 (&acc)[2][2][4][2], const pg8::UnitG& u, int wr, int wc, int fr, int fq) const {
    const int row0 = u.row0 + wr * 64 + fr, col0 = u.pn * 128 + wc * 32 + 8 * fq;
#pragma unroll
    for (int ai = 0; ai < 2; ++ai)
#pragma unroll
      for (int m = 0; m < 4; ++m) { unsigned char* rowp = H + (size_t)(row0 + ai * 128 + m * 16) * DE + col0;
        float v[8];
#pragma unroll
        for (int n = 0; n < 2; ++n) { const f32x4 g = acc[ai][0][m][n], up = acc[ai][1][m][n];
#pragma unroll
          for (int j = 0; j < 4; ++j) { const float gg = g[j] * 0.015625f; v[4 * n + j] = gg * __builtin_amdgcn_rcpf(1.0f + __expf(-gg)) * (up[j] * 0.015625f); } }
        int q0 = 0, q1 = 0; q0 = __builtin_amdgcn_cvt_pk_fp8_f32(v[0], v[1], q0, false); q0 = __builtin_amdgcn_cvt_pk_fp8_f32(v[2], v[3], q0, true); q1 = __builtin_amdgcn_cvt_pk_fp8_f32(v[4], v[5], q1, false); q1 = __builtin_amdgcn_cvt_pk_fp8_f32(v[6], v[7], q1, true);
        u32x2 w; w.x = (unsigned)q0; w.y = (unsigned)q1; *(u32x2*)rowp = w; }
  }
};
struct EpiMoe2 {
  static constexpr bool PERM = true, FP8 = true;
  bf16_t* YRM; const float* LISTW; bf16_t* DUMMY;
  __device__ __forceinline__ void operator()(const f32x4 (&acc)[2][2][4][2], const pg8::UnitG& u, int wr, int wc, int fr, int fq) const {
    const int slot0 = u.mt * 256 + wr * 64 + fr;
    bf16_t* base = YRM + (size_t)(u.pm + slot0) * DM + u.pn * 256 + wc * 32 + 8 * fq;
    bf16_t* sink = DUMMY + (size_t)blockIdx.x * 8192 + ((wr * 4 + wc) * 64 + fq * 16 + fr) * 8;
    const float* lw = LISTW + u.e * NTOK + slot0;
    float wv[8];
#pragma unroll
    for (int i = 0; i < 8; ++i) wv[i] = lw[(i >> 2) * 128 + (i & 3) * 16];
#pragma unroll
    for (int ai = 0; ai < 2; ++ai)
#pragma unroll
      for (int m = 0; m < 4; ++m) { const int ds = ai * 128 + m * 16;
        const float w = wv[ai * 4 + m] * 0.03125f;
        bf16_t* rowp = (slot0 + ds < u.cnt) ? base + (size_t)ds * DM : sink;
#pragma unroll
        for (int bj = 0; bj < 2; ++bj) { const f32x4 v0 = acc[ai][bj][m][0] * w, v1 = acc[ai][bj][m][1] * w; u32x4 q; q.x = pk2(v0[0], v0[1]); q.y = pk2(v0[2], v0[3]); q.z = pk2(v1[0], v1[1]); q.w = pk2(v1[2], v1[3]); *(u32x4*)(rowp + bj * 128) = q; } }
  }
};


#define XB_TMO      128
#define XB_XCNT(j)  (256  + 64 * (j))
#define XB_XSUB(j)  (1280 + 64 * (j))
#define XB_XGEN(j)  (2304 + 64 * (j))
#define XB_TOP      3328
#define XB_TOPGEN   3392
#define XCD_BAR_WORDS 3456
#define XB_SPIN_CAP (1u << 18)
__device__ __forceinline__ unsigned xb_ld(unsigned* p)              { return __hip_atomic_load(p, __ATOMIC_RELAXED, __HIP_MEMORY_SCOPE_AGENT); }
__device__ __forceinline__ unsigned xb_add(unsigned* p, unsigned v) { return __hip_atomic_fetch_add(p, v, __ATOMIC_RELAXED, __HIP_MEMORY_SCOPE_AGENT); }
__device__ __forceinline__ unsigned xb_xcc_id() { return (unsigned)__builtin_amdgcn_s_getreg((3 << 11) | 20) & 0xFu; }
#define XB_SPIN(cond, bar) do { unsigned _sp = 0; while (cond) { __builtin_amdgcn_s_sleep(1); \
    if ((++_sp & 255u) == 0u) { if (xb_ld(&(bar)[XB_TMO])) break; if (_sp > XB_SPIN_CAP) { atomicAdd(&(bar)[XB_TMO], 1u); break; } } } } while (0)
struct XcdBarrier { unsigned* bar; unsigned x; volatile LAS unsigned* st; };
__device__ __forceinline__ XcdBarrier xcd_barrier_post(unsigned* bar, volatile LAS unsigned* st) {
    XcdBarrier b; b.bar = bar; b.x = xb_xcc_id(); b.st = st;
    if (threadIdx.x == 0) (void)xb_add(&bar[XB_XCNT(b.x)], 1u);
    return b;
}
__device__ __forceinline__ void xcd_barrier_complete(unsigned* bar, unsigned x, unsigned& nloc, unsigned& nx) {
    const unsigned G = gridDim.x * gridDim.y * gridDim.z;
    unsigned sum, cnt, mine, sp = 0u;
    for (;;) {
        sum = 0u; cnt = 0u; mine = 0u;
#pragma unroll
        for (unsigned j = 0; j < 16; ++j) { const unsigned c = xb_ld(&bar[XB_XCNT(j)]); sum += c; cnt += (c > 0u) ? 1u : 0u; mine = (j == x) ? c : mine; }
        if (sum == G) break;
        __builtin_amdgcn_s_sleep(1);
        if ((++sp & 255u) == 0u) { if (xb_ld(&bar[XB_TMO])) break; if (sp > XB_SPIN_CAP) { atomicAdd(&bar[XB_TMO], 1u); break; } }
    }
    nloc = mine > 0u ? mine : 1u; nx = cnt > 0u ? cnt : 1u;
}
__device__ __forceinline__ void xcd_barrier(const XcdBarrier& b) {
    asm volatile("s_waitcnt vmcnt(0)" ::: "memory");
    __syncthreads();
    if (threadIdx.x == 0) {
        unsigned* bar = b.bar;
        __builtin_amdgcn_s_waitcnt(0);
        unsigned nloc = b.st[0], nx = b.st[1];
        if (nloc == 0u) { xcd_barrier_complete(bar, b.x, nloc, nx); b.st[0] = nloc; b.st[1] = nx; }
        const unsigned old = xb_add(&bar[XB_XSUB(b.x)], 1u);
        const unsigned gen = old / nloc;
        if (old + 1u == (gen + 1u) * nloc) {
            __builtin_amdgcn_fence(__ATOMIC_RELEASE, "agent");
            asm volatile("s_waitcnt vmcnt(0)" ::: "memory");
            const unsigned og = xb_add(&bar[XB_TOP], 1u);
            const unsigned tg = og / nx;
            if (og + 1u == (tg + 1u) * nx) xb_add(&bar[XB_TOPGEN], 1u);
            else XB_SPIN(xb_ld(&bar[XB_TOPGEN]) == tg, bar);
            __builtin_amdgcn_fence(__ATOMIC_ACQUIRE, "agent");
            xb_add(&bar[XB_XGEN(b.x)], 1u);
            asm volatile("s_waitcnt vmcnt(0)" ::: "memory");
        } else {
            XB_SPIN(xb_ld(&bar[XB_XGEN(b.x)]) == gen, bar);
            __builtin_amdgcn_fence(__ATOMIC_ACQUIRE, "agent");
            asm volatile("s_waitcnt vmcnt(0)" ::: "memory");
        }
    }
    __syncthreads();
}

template <class T> __device__ __forceinline__ T* as_global(T* p) { const unsigned long long v = (unsigned long long)p; return (T*)(__attribute__((address_space(1))) T*)v; }
template <class T> __device__ __forceinline__ T* opaque_global(T* p) { unsigned long long v = (unsigned long long)p; asm volatile("" : "+s"(v)); return (T*)(__attribute__((address_space(1))) T*)v; }
struct InPtrs { const float* const* p; __device__ __forceinline__ const float* operator[](int k) const { return as_global(p[k]); } };
struct Frame {
  LAS unsigned char* lds; int tid, lane, wave, G, bid; unsigned char* ws; InPtrs in; float* out;
};

struct TJob { const float* W; unsigned char* WT; int N, ldtB, k0, n0, up, mode; float sc; };
__device__ __forceinline__ int gu_row(int n, int up) { return 256 * (n >> 7) + (n & 127) + up * 128; }
constexpr int TR0 = 16 * 104, TR1 = 16 * 16, TR2 = 20 * 16, TR3 = 16 * 16, TR4 = 2 * 10 * 4, TR5 = 2 * 16 * 4, TR6 = 4 * 16, TR7 = 2 * 64 * 16 * 4, TR8 = 64 * 4 * 16;
constexpr int T_NITEMS = TR0 + TR1 + TR2 + TR3 + TR4 + TR5 + TR6 + TR7 + TR8;
__device__ __forceinline__ TJob tj_decode(const Frame& F, int it) {
  unsigned char* ws = F.ws; int r = it;
  if (r < TR0) { const int kb = r / 104, nb = r % 104; return TJob{F.in[1], ws + WS_WIN, INC, DM * 2, 128 * kb, 128 * nb, 0, 0, 1.f}; } r -= TR0;
  if (r < TR1) { const int kb = r / 16, nb = r % 16; return TJob{F.in[19], ws + WS_WPM, DM, RW * 2, 128 * kb, 128 * nb, 0, 0, 1.f}; } r -= TR1;
  if (r < TR2) { const int kb = r / 16, nb = r % 16; return TJob{F.in[20], ws + WS_WPR, DM, RW * 2, 128 * kb, 128 * nb, 0, 0, 1.f}; } r -= TR2;
  if (r < TR3) { const int kb = r / 16, nb = r % 16; return TJob{F.in[21], ws + WS_WO, DM, DM * 2, 128 * kb, 128 * nb, 0, 0, 1.f}; } r -= TR3;
  if (r < TR4) { const int which = r / 40, rr = r % 40, blk = rr / 4, q = rr % 4; return TJob{F.in[which ? 16 : 14] + (size_t)blk * 65536, ws + WS_WRAX + (size_t)blk * 512 * 256 * 2, 256, 256 * 2, 128 * (q >> 1), 128 * (q & 1), which, 1, 1.f}; } r -= TR4;
  if (r < TR5) { const int which = r / 64, q = r % 64, kb = q / 4, nb = q % 4; return TJob{F.in[which ? 30 : 29], ws + WS_WSGU, DE, DM, 128 * kb, 128 * nb, which, 3, 64.f}; } r -= TR5;
  if (r < TR6) { const int kb = r / 16, nb = r % 16; return TJob{F.in[31], ws + WS_WSD, DM, DE, 128 * kb, 128 * nb, 0, 2, 32.f}; } r -= TR6;
  if (r < TR7) { const int which = r / 4096, rr = r % 4096, e = rr / 64, q = rr % 64, kb = q / 4, nb = q % 4; return TJob{F.in[which ? 27 : 26] + (size_t)e * DM * DE, ws + WS_WEGU + (size_t)e * 1024 * DM, DE, DM, 128 * kb, 128 * nb, which, 3, 64.f}; } r -= TR7;
  { const int e = r / 64, q = r % 64, kb = q / 16, nb = q % 16; return TJob{F.in[28] + (size_t)e * DE * DM, ws + WS_WED + (size_t)e * DM * DE, DM, DE, 128 * kb, 128 * nb, 0, 2, 32.f}; }
}
__device__ __forceinline__ void tj_load(const TJob& j, f32x4 (&v)[8], int wave, int lane) {
  const float* p = j.W + (size_t)(j.k0 + 16 * wave + (lane >> 5)) * j.N + j.n0 + 4 * (lane & 31);
#pragma unroll
  for (int i = 0; i < 8; ++i) v[i] = __builtin_nontemporal_load((const f32x4*)(p + (size_t)(2 * i) * j.N));
}
__device__ __forceinline__ void tj_store(const TJob& j, const f32x4 (&v)[8], LAS float* scr, int wave, int lane, int tid) {
#pragma unroll
  for (int i = 0; i < 8; ++i) { LAS float* d = scr + (16 * wave + 2 * i + (lane >> 5)) * 129 + 4 * (lane & 31); d[0] = v[i][0]; d[1] = v[i][1]; d[2] = v[i][2]; d[3] = v[i][3]; }
  LBAR();
  if (j.mode < 2) {
#pragma unroll
    for (int it = 0; it < 4; ++it) { const int idx = it * 512 + tid, n = idx >> 4, c = idx & 15; const LAS float* s = scr + (8 * c) * 129 + n;
      u32x4 o; o.x = pk2(s[0 * 129], s[1 * 129]); o.y = pk2(s[2 * 129], s[3 * 129]); o.z = pk2(s[4 * 129], s[5 * 129]); o.w = pk2(s[6 * 129], s[7 * 129]);
      const int nn = j.n0 + n; const int row = j.mode ? gu_row(nn, j.up) : nn;
      *(u32x4*)(j.WT + (size_t)row * j.ldtB + (j.k0 + 8 * c) * 2) = o; }
  } else {
#pragma unroll
    for (int it = 0; it < 2; ++it) { const int idx = it * 512 + tid, n = idx >> 3, c = idx & 7; const LAS float* s = scr + (16 * c) * 129 + n;
      int w[4];
#pragma unroll
      for (int q = 0; q < 4; ++q) { int t = 0; t = __builtin_amdgcn_cvt_pk_fp8_f32(s[(4 * q) * 129] * j.sc, s[(4 * q + 1) * 129] * j.sc, t, false); t = __builtin_amdgcn_cvt_pk_fp8_f32(s[(4 * q + 2) * 129] * j.sc, s[(4 * q + 3) * 129] * j.sc, t, true); w[q] = t; }
      u32x4 o; o.x = (unsigned)w[0]; o.y = (unsigned)w[1]; o.z = (unsigned)w[2]; o.w = (unsigned)w[3];
      const int nn = j.n0 + n; const int row = (j.mode == 3) ? gu_row(nn, j.up) : nn;
      *(u32x4*)(j.WT + (size_t)row * j.ldtB + j.k0 + 16 * c) = o; }
  }
  LBAR();
}

__device__ __forceinline__ void phase_prologue(const Frame& F) {
  LAS float* scr = (LAS float*)F.lds;
  unsigned char* ws = F.ws;
  {
    f32x4 vA[8], vB[8]; TJob jA, jB;
    int it = F.bid;
    if (it < T_NITEMS) { jA = tj_decode(F, it); tj_load(jA, vA, F.wave, F.lane); }
    while (it < T_NITEMS) {
      { const int itn = it + F.G; jB = tj_decode(F, itn < T_NITEMS ? itn : T_NITEMS - 1); tj_load(jB, vB, F.wave, F.lane); }
      tj_store(jA, vA, scr, F.wave, F.lane, F.tid);
      it += F.G; if (it >= T_NITEMS) break;
      { const int itn = it + F.G; jA = tj_decode(F, itn < T_NITEMS ? itn : T_NITEMS - 1); tj_load(jA, vA, F.wave, F.lane); }
      tj_store(jB, vB, scr, F.wave, F.lane, F.tid);
      it += F.G;
    }
  }
  const int gt = F.bid * 512 + F.tid, NGT = F.G * 512;
  { const float* x = F.in[0]; bf16_t* xb = (bf16_t*)(ws + WS_XB);
    for (int i = gt; i < NTOK * DM / 8; i += NGT) { const f32x4 a = *(const f32x4*)(x + (size_t)i * 8), b = *(const f32x4*)(x + (size_t)i * 8 + 4);
      u32x4 o; o.x = pk2(a[0], a[1]); o.y = pk2(a[2], a[3]); o.z = pk2(b[0], b[1]); o.w = pk2(b[2], b[3]); *(u32x4*)(xb + (size_t)i * 8) = o; } }
  { const float* wif = F.in[8]; bf16_t* wt = (bf16_t*)(ws + WS_SMALL + SM_WIFT);
    for (int i = gt; i < 16 * 6144; i += NGT) { const int n = i / 6144, k = i % 6144; float v = wif[k * 16 + n]; if (k >= 2048 && k < 4096) v *= 16.0f; wt[i] = (bf16_t)f2bf(v); } }
  { const float* lam = F.in[18]; float* c8 = (float*)(ws + WS_SMALL + SM_C8); for (int i = gt; i < RW; i += NGT) c8[i] = -8.0f * log1pf(expf(-lam[i])); }
  { const float* rwt = F.in[24]; bf16_t* rh = (bf16_t*)(ws + WS_SMALL + SM_RWH); bf16_t* rl = (bf16_t*)(ws + WS_SMALL + SM_RWL);
    for (int i = gt; i < NE * DM; i += NGT) { const int n = i / DM, k = i % DM; const float v = rwt[k * NE + n]; const unsigned h = f2bf(v); rh[i] = (bf16_t)h; rl[i] = (bf16_t)f2bf(v - __uint_as_float(h << 16)); } }
  { float* lw64 = (float*)(ws + WS_LISTW) + (size_t)NE * NTOK; for (int i = gt; i < NTOK; i += NGT) lw64[i] = 1.0f; }
  { int* ctl = (int*)(ws + WS_CTL); for (int i = gt; i < 4096; i += NGT) ctl[i] = 0; }
}

__device__ __forceinline__ void phase_mprep(const Frame& F) {
  unsigned char* ws = F.ws;
  const bf16_t* PROJ = (const bf16_t*)(ws + WS_PROJ);
  bf16_t* Q = (bf16_t*)(ws + WS_Q); bf16_t* Kb = (bf16_t*)(ws + WS_K); bf16_t* V = (bf16_t*)(ws + WS_V); bf16_t* XCM = (bf16_t*)(ws + WS_XCM);
  const bf16_t* WIFT = (const bf16_t*)(ws + WS_SMALL + SM_WIFT);
  float* IG = (float*)(ws + WS_SMALL + SM_IG); float* LF = (float*)(ws + WS_SMALL + SM_LF);
  const int g = F.tid;
  f32x4 cw[4]; for (int j = 0; j < 4; ++j) cw[j] = *(const f32x4*)(F.in[3] + j * MW + 4 * g);
  const f32x4 cb = *(const f32x4*)(F.in[4] + 4 * g);
  f32x4 wq[4], wk[4], wv[4];
  for (int i = 0; i < 4; ++i) { wq[i] = *(const f32x4*)(F.in[5] + g * 16 + 4 * i); wk[i] = *(const f32x4*)(F.in[6] + g * 16 + 4 * i); wv[i] = *(const f32x4*)(F.in[7] + g * 16 + 4 * i); }
  LAS unsigned char* AIMG = F.lds; LAS float* red = (LAS float*)(F.lds + 98432);
  const int r = F.lane & 15, gq = F.lane >> 4;
  for (int tile = F.bid; tile < NTOK / 8; tile += F.G) {
    const int t0 = tile * 8, s0 = t0 & (SEQ - 1);
    u32x2 rw[11];
#pragma unroll
    for (int j = 0; j < 11; ++j) { const int pos = s0 - 3 + j; rw[j] = (pos >= 0) ? *(const u32x2*)(PROJ + (size_t)(t0 - 3 + j) * INC + 4 * g) : (u32x2){0u, 0u}; }
#pragma unroll
    for (int tt = 0; tt < 8; ++tt) {
      const int t = t0 + tt;
      f32x4 xw[4];
#pragma unroll
      for (int j = 0; j < 4; ++j) xw[j] = (f32x4){bflo(rw[tt + j].x), bfhi(rw[tt + j].x), bflo(rw[tt + j].y), bfhi(rw[tt + j].y)};
      const f32x4 cv = cb + cw[0] * xw[0] + cw[1] * xw[1] + cw[2] * xw[2] + cw[3] * xw[3];
      f32x4 xc; for (int i = 0; i < 4; ++i) xc[i] = cv[i] * __builtin_amdgcn_rcpf(1.0f + __expf(-cv[i]));
      const f32x4 q = xc[0] * wq[0] + xc[1] * wq[1] + xc[2] * wq[2] + xc[3] * wq[3];
      f32x4 k = xc[0] * wk[0] + xc[1] * wk[1] + xc[2] * wk[2] + xc[3] * wk[3];
      const f32x4 v = xw[3][0] * wv[0] + xw[3][1] * wv[1] + xw[3][2] * wv[2] + xw[3][3] * wv[3];
      k = k * 0.0625f;
      const size_t o = (size_t)t * MW + 4 * g;
      u32x2 wqv, wkv, wvv, wxc;
      wqv.x = pk2(q[0], q[1]); wqv.y = pk2(q[2], q[3]); *(u32x2*)(Q + o) = wqv;
      wkv.x = pk2(k[0], k[1]); wkv.y = pk2(k[2], k[3]); *(u32x2*)(Kb + o) = wkv;
      wvv.x = pk2(v[0], v[1]); wvv.y = pk2(v[2], v[3]); *(u32x2*)(V + o) = wvv;
      wxc.x = pk2(xc[0], xc[1]); wxc.y = pk2(xc[2], xc[3]); *(u32x2*)(XCM + o) = wxc;
      LAS unsigned char* ar = AIMG + tt * 12304 + 8 * g;
      *(LAS u32x2*)(ar) = wqv; *(LAS u32x2*)(ar + 4096) = wkv; *(LAS u32x2*)(ar + 8192) = wvv;
    }
    LBAR();
    {
      f32x4 acc = (f32x4){0.f, 0.f, 0.f, 0.f};
#pragma unroll
      for (int ib = 0; ib < 3; ++ib) {
        bf16x8 bfr[8];
#pragma unroll
        for (int i = 0; i < 8; ++i) { const int ks = F.wave * 24 + ib * 8 + i; bfr[i] = *(const bf16x8*)(WIFT + (size_t)r * 6144 + ks * 32 + 8 * gq); }
#pragma unroll
        for (int i = 0; i < 8; ++i) { const int ks = F.wave * 24 + ib * 8 + i;
          const bf16x8 a = *(const LAS bf16x8*)(AIMG + (r & 7) * 12304 + (ks * 32 + 8 * gq) * 2);
          acc = __builtin_amdgcn_mfma_f32_16x16x32_bf16(a, bfr[i], acc, 0, 0, 0); }
      }
#pragma unroll
      for (int j = 0; j < 4; ++j) red[F.wave * 256 + (4 * gq + j) * 16 + r] = acc[j];
    }
    LBAR();
    if (F.tid < 128) {
      const int row = F.tid >> 4, n = F.tid & 15;
      float s = F.in[9][n];
#pragma unroll
      for (int w = 0; w < 8; ++w) s += red[w * 256 + F.tid];
      const int t = t0 + row, b = t >> 12, sp = t & (SEQ - 1);
      if (n < 8) IG[(size_t)(b * 8 + n) * SEQ + sp] = s;
      else LF[(size_t)(b * 8 + (n - 8)) * SEQ + sp] = fminf(s, 0.f) - log1pf(__expf(-fabsf(s)));
    }
    LBAR();
  }
}

__device__ __forceinline__ void phase_rconv(const Frame& F) {
  unsigned char* ws = F.ws;
  const bf16_t* PROJ = (const bf16_t*)(ws + WS_PROJ); bf16_t* XCR = (bf16_t*)(ws + WS_XCR);
  const int gt = F.bid * 512 + F.tid, NGT = F.G * 512;
  for (int it = gt; it < (NTOK / 16) * 640; it += NGT) {
    const int tile = it / 640, g = it % 640, t0 = tile * 16, s0 = t0 & (SEQ - 1);
    f32x4 cw[4]; for (int j = 0; j < 4; ++j) cw[j] = *(const f32x4*)(F.in[12] + j * RW + 4 * g);
    const f32x4 cb = *(const f32x4*)(F.in[13] + 4 * g);
    u32x2 rw[19];
#pragma unroll
    for (int j = 0; j < 19; ++j) { const int pos = s0 - 3 + j; rw[j] = (pos >= 0) ? *(const u32x2*)(PROJ + (size_t)(t0 - 3 + j) * INC + O_XR + 4 * g) : (u32x2){0u, 0u}; }
#pragma unroll
    for (int tt = 0; tt < 16; ++tt) {
      f32x4 cv = cb;
#pragma unroll
      for (int j = 0; j < 4; ++j) cv = cv + cw[j] * (f32x4){bflo(rw[tt + j].x), bfhi(rw[tt + j].x), bflo(rw[tt + j].y), bfhi(rw[tt + j].y)};
      u32x2 w; w.x = pk2(cv[0], cv[1]); w.y = pk2(cv[2], cv[3]); *(u32x2*)(XCR + (size_t)(t0 + tt) * RW + 4 * g) = w;
    }
  }
}

__device__ __forceinline__ float chunk_m(const float* IG, const float* LF, int bh, int c, int lane, int wave, LAS float* CS) {
  for (int cc = wave; cc < c; cc += 8) {
    const float lf = LF[(size_t)bh * SEQ + 64 * cc + lane], ig = IG[(size_t)bh * SEQ + 64 * cc + lane];
    const float b = wave_scan_sum(lf, lane), gmax = wave_max(ig - b);
    if (lane == 63) { CS[cc] = b; CS[64 + cc] = b + gmax; }
  }
  __syncthreads();
  float A = 0.f, B = -INFINITY;
  if (lane < c) { A = CS[lane]; B = CS[64 + lane]; }
#pragma unroll
  for (int o = 1; o < 64; o <<= 1) { const float pA = __shfl_up(A, o), pB = __shfl_up(B, o); if (lane >= o) { B = fmaxf(pB + A, B); A = pA + A; } }
  const float mafter = fmaxf(A, B);
  const float mc = __shfl(mafter, c > 0 ? c - 1 : 0);
  return c > 0 ? mc : 0.f;
}

__device__ __forceinline__ void phase_m1(const Frame& F, const int bid2, const int G2) {
  unsigned char* ws = F.ws;
  const bf16_t* Q = (const bf16_t*)(ws + WS_Q); const bf16_t* Kb = (const bf16_t*)(ws + WS_K); const bf16_t* V = (const bf16_t*)(ws + WS_V);
  const float* IG = (const float*)(ws + WS_SMALL + SM_IG); const float* LF = (const float*)(ws + WS_SMALL + SM_LF);
  float* INTER = (float*)(ws + WS_SMALL + SM_INTER); float* EMR = (float*)(ws + WS_SMALL + SM_EMR); float* DENI = (float*)(ws + WS_SMALL + SM_DENI);
  bf16_t* HNI = (bf16_t*)(ws + WS_HNI);
  LAS unsigned char* QS = F.lds; LAS unsigned char* KS = F.lds + 33792; LAS unsigned char* VT = F.lds + 67584; LAS unsigned char* PS = F.lds + 104448;
  LAS float* SCg = (LAS float*)(F.lds + 113664); LAS float* SCM = SCg + 64;
  const int r = F.lane & 15, gq = F.lane >> 4, w = F.wave;
  for (int item = bid2; item < 16 * NCH; item += G2) {
    const int bh = item / NCH, c = item % NCH, b = bh >> 3, h = bh & 7, tok0 = b * SEQ + 64 * c;
    const float m = chunk_m(IG, LF, bh, c, F.lane, w, (LAS float*)(F.lds + 114176));
    const float lf_c = LF[(size_t)bh * SEQ + 64 * c + F.lane], ig_c = IG[(size_t)bh * SEQ + 64 * c + F.lane];
    const float b_l = wave_scan_sum(lf_c, F.lane), g_l = ig_c - b_l;
    const float M_l = fmaxf(m, wave_scan_max(g_l, F.lane));
    if (w == 0) { SCg[F.lane] = g_l; SCM[F.lane] = M_l; INTER[(size_t)(tok0 + F.lane) * 8 + h] = __expf(m - M_l); EMR[(size_t)(tok0 + F.lane) * 8 + h] = __expf(-(b_l + M_l)); }
#pragma unroll
    for (int i = 0; i < 4; ++i) {
      const int idx = i * 512 + F.tid, row = idx >> 5, c16 = idx & 31;
      const size_t go = (size_t)(tok0 + row) * MW + 256 * h + 8 * c16;
      *(LAS u32x4*)(QS + row * 528 + c16 * 16) = *(const u32x4*)(Q + go);
      *(LAS u32x4*)(KS + row * 528 + c16 * 16) = *(const u32x4*)(Kb + go);
    }
    {
      const int sp = F.tid & 31, cq = F.tid >> 5;
#pragma unroll
      for (int i = 0; i < 2; ++i) {
        const size_t go = (size_t)(tok0 + 2 * sp) * MW + 256 * h + 8 * (cq + 16 * i);
        const u32x4 v0 = *(const u32x4*)(V + go), v1 = *(const u32x4*)(V + go + MW);
        const unsigned a0[4] = {v0.x, v0.y, v0.z, v0.w}, a1[4] = {v1.x, v1.y, v1.z, v1.w};
#pragma unroll
        for (int e = 0; e < 4; ++e) { const int dv = 8 * (cq + 16 * i) + 2 * e;
          *(LAS unsigned*)(VT + dv * 144 + sp * 4) = (a0[e] & 0xffffu) | (a1[e] << 16);
          *(LAS unsigned*)(VT + (dv + 1) * 144 + sp * 4) = (a0[e] >> 16) | (a1[e] & 0xffff0000u); }
      }
    }
    __syncthreads();
    {
      const int mi = w & 3;
#pragma unroll
      for (int nn = 0; nn < 2; ++nn) {
        const int ni = 2 * (w >> 2) + nn;
        f32x4 acc = (f32x4){0.f, 0.f, 0.f, 0.f};
        if (ni <= mi) {
#pragma unroll
          for (int ks = 0; ks < 8; ++ks) {
            const bf16x8 a = *(const LAS bf16x8*)(QS + (16 * mi + r) * 528 + (32 * ks + 8 * gq) * 2);
            const bf16x8 bb = *(const LAS bf16x8*)(KS + (16 * ni + r) * 528 + (32 * ks + 8 * gq) * 2);
            acc = __builtin_amdgcn_mfma_f32_16x16x32_bf16(a, bb, acc, 0, 0, 0);
          }
        }
        const int s = 16 * ni + r; const float gs = SCg[s];
#pragma unroll
        for (int j = 0; j < 4; ++j) { const int l = 16 * mi + 4 * gq + j; const float p = (s <= l) ? acc[j] * __expf(gs - SCM[l]) : 0.f; *(LAS bf16_t*)(PS + l * 144 + s * 2) = (bf16_t)f2bf(p); }
      }
    }
    __syncthreads();
    if (F.tid < 64) { float s = 0.f; for (int k = 0; k < 64; ++k) s += bf1(*(const LAS bf16_t*)(PS + F.tid * 144 + k * 2)); DENI[(size_t)(tok0 + F.tid) * 8 + h] = s; }
#pragma unroll
    for (int nn = 0; nn < 2; ++nn) {
      const int ni = 2 * w + nn;
#pragma unroll
      for (int mi = 0; mi < 4; ++mi) {
        f32x4 acc = (f32x4){0.f, 0.f, 0.f, 0.f};
#pragma unroll
        for (int ks = 0; ks < 2; ++ks) {
          const bf16x8 a = *(const LAS bf16x8*)(PS + (16 * mi + r) * 144 + (32 * ks + 8 * gq) * 2);
          const bf16x8 bb = *(const LAS bf16x8*)(VT + (16 * ni + r) * 144 + (32 * ks + 8 * gq) * 2);
          acc = __builtin_amdgcn_mfma_f32_16x16x32_bf16(a, bb, acc, 0, 0, 0);
        }
#pragma unroll
        for (int j = 0; j < 4; ++j) HNI[(size_t)(tok0 + 16 * mi + 4 * gq + j) * MW + 256 * h + 16 * ni + r] = (bf16_t)f2bf(acc[j]);
      }
    }
    __syncthreads();
  }
}

__device__ __forceinline__ void phase_m2(const Frame& F, const int nblk) {
  unsigned char* ws = F.ws;
  const bf16_t* Q = (const bf16_t*)(ws + WS_Q); const bf16_t* Kb = (const bf16_t*)(ws + WS_K); const bf16_t* V = (const bf16_t*)(ws + WS_V);
  const float* IG = (const float*)(ws + WS_SMALL + SM_IG); const float* LF = (const float*)(ws + WS_SMALL + SM_LF);
  float* QN = (float*)(ws + WS_SMALL + SM_QN);
  bf16_t* HNE = (bf16_t*)(ws + WS_HNE);
  LAS unsigned char* QS = F.lds; LAS unsigned char* KT = F.lds + 33792; LAS unsigned char* WVT = F.lds + 70656; LAS unsigned char* CT = F.lds + 77568;
  LAS float* TD = (LAS float*)(F.lds + 111360); LAS float* CS = (LAS float*)(F.lds + 111616);
  float* DUMMY = (float*)(ws + WS_M2TAB + 4 * MiB);
  const int w = F.wave;
  for (int item = F.bid; item < 128; item += nblk) {
    const int bh = item >> 3, sl = item & 7, b = bh >> 3, h = bh & 7, dv0 = 32 * sl;
    float* TI = (float*)(ws + WS_M2TAB) + (size_t)item * 8192; float* TW = TI + 4096;
    const int lane = F.lane;
    for (int i = F.tid; i < (6912 + 33792) / 4; i += 512) *(LAS unsigned*)(WVT + 4 * i) = 0u;
    float gk[8], pk[8];
#pragma unroll
    for (int i = 0; i < 8; ++i) {
      const int cc = w + 8 * i;
      const float lf = LF[(size_t)bh * SEQ + 64 * cc + lane], ig = IG[(size_t)bh * SEQ + 64 * cc + lane];
      const float bl = wave_scan_sum(lf, lane), g = ig - bl;
      const float gmax = wave_max(g), pm = wave_scan_max(g, lane);
      gk[i] = g; pk[i] = pm;
      if (lane == 63) { CS[cc] = bl; CS[64 + cc] = bl + gmax; }
    }
    __syncthreads();
    {
      float A = CS[lane], B = CS[64 + lane]; const float gmx = B - A;
#pragma unroll
      for (int o = 1; o < 64; o <<= 1) { const float pA = __shfl_up(A, o), pB = __shfl_up(B, o); if (lane >= o) { B = fmaxf(pB + A, B); A = pA + A; } }
      const float mafter = fmaxf(A, B);
      float mstart = __shfl_up(mafter, 1); if (lane == 0) mstart = 0.f;
      const float M63 = fmaxf(mstart, gmx);
      if (w == 0) TD[lane] = __expf(mstart - M63);
#pragma unroll
      for (int i = 0; i < 8; ++i) {
        const int cc = w + 8 * i;
        const float ms = __shfl(mstart, cc), m6 = __shfl(M63, cc);
        TI[cc * 64 + lane] = __expf(ms - fmaxf(ms, pk[i])); TW[cc * 64 + lane] = __expf(gk[i] - m6);
      }
    }
    __threadfence(); __syncthreads();
    f32x4 acc[2][3];
#pragma unroll
    for (int a = 0; a < 2; ++a)
#pragma unroll
      for (int n = 0; n < 3; ++n) acc[a][n] = (f32x4){0.f, 0.f, 0.f, 0.f};
    u32x4 qrA[4], krA[2][2], vrA = (u32x4){0u, 0u, 0u, 0u}, qrB[4], krB[2][2], vrB = (u32x4){0u, 0u, 0u, 0u};
    float wsA = 0.f, wsB = 0.f; f32x4 ivA = (f32x4){0.f, 0.f, 0.f, 0.f}, ivB = ivA;
#define M2_LOAD(qreg, kreg, vreg, wsr, ivr, c) do { const int tk_ = b * SEQ + 64 * (c); \
      _Pragma("unroll") for (int i = 0; i < 4; ++i) { const int idx = i * 512 + tdx, row = idx >> 5, c16 = idx & 31; qreg[i] = *(const u32x4*)(Q + (size_t)(tk_ + row) * MW + 256 * h + 8 * c16); } \
      _Pragma("unroll") for (int i = 0; i < 2; ++i) { const size_t go = (size_t)(tk_ + 2 * sp) * MW + 256 * h + 8 * (cq + 16 * i); kreg[i][0] = *(const u32x4*)(Kb + go); kreg[i][1] = *(const u32x4*)(Kb + go + MW); } \
      vreg = *(const u32x4*)(V + (size_t)(tk_ + lane) * MW + 256 * h + dv0 + 8 * (w & 3)); \
      wsr = TW[(c) * 64 + lane]; \
      ivr = *(const f32x4*)(TI + (c) * 64 + 16 * (w & 3) + 4 * gq); } while (0)
#define M2_AMMA(mi, nt) \
        f32x4 a2 = (f32x4){0.f, 0.f, 0.f, 0.f}; \
        _Pragma("unroll") for (int ks = 0; ks < 8; ++ks) { \
          const bf16x8 a = *(const LAS bf16x8*)(QS + (16 * (mi) + r) * 528 + (32 * ks + 8 * gq) * 2); \
          const bf16x8 bb = *(const LAS bf16x8*)(CT + (16 * (nt) + r) * 528 + (32 * ks + 8 * gq) * 2); \
          a2 = __builtin_amdgcn_mfma_f32_16x16x32_bf16(a, bb, a2, 0, 0, 0); }
#define M2_ATILE_H(mi, nt, tok0, ivr) do { M2_AMMA(mi, nt) \
        _Pragma("unroll") for (int j = 0; j < 4; ++j) { const int l = 16 * (mi) + 4 * gq + j; \
          HNE[(size_t)((tok0) + l) * MW + 256 * h + dv0 + 16 * (nt) + r] = (bf16_t)f2bf(a2[j] * ivr[j]); } } while (0)
#define M2_ATILE_Q(mi, nt, tok0, ivr) do { M2_AMMA(mi, nt) \
        _Pragma("unroll") for (int j = 0; j < 4; ++j) { const int l = 16 * (mi) + 4 * gq + j; \
          float* qp = ((nt) == 2 && r == 0) ? (QN + (size_t)((tok0) + l) * 8 + h) : (DUMMY + tdx * 4 + j); *qp = a2[j] * ivr[j]; } } while (0)
#define M2_BODY(c, qreg, kreg, vreg, wsr, ivr) do { \
      int tdx = (int)threadIdx.x; asm volatile("" : "+v"(tdx)); \
      const int lane = tdx & 63, r = lane & 15, gq = lane >> 4, sp = tdx & 31, cq = tdx >> 5; \
      const int tok0 = b * SEQ + 64 * (c); \
      _Pragma("unroll") for (int i = 0; i < 4; ++i) { const int idx = i * 512 + tdx, row = idx >> 5, c16 = idx & 31; *(LAS u32x4*)(QS + row * 528 + c16 * 16) = qreg[i]; } \
      _Pragma("unroll") for (int i = 0; i < 2; ++i) { \
        const unsigned k0[4] = {kreg[i][0].x, kreg[i][0].y, kreg[i][0].z, kreg[i][0].w}, k1[4] = {kreg[i][1].x, kreg[i][1].y, kreg[i][1].z, kreg[i][1].w}; \
        _Pragma("unroll") for (int e = 0; e < 4; ++e) { const int dk = 8 * (cq + 16 * i) + 2 * e; \
          *(LAS unsigned*)(KT + dk * 144 + sp * 4) = (k0[e] & 0xffffu) | (k1[e] << 16); \
          *(LAS unsigned*)(KT + (dk + 1) * 144 + sp * 4) = (k0[e] >> 16) | (k1[e] & 0xffff0000u); } } \
      if (w < 4) { const unsigned vw[4] = {vreg.x, vreg.y, vreg.z, vreg.w}; \
        _Pragma("unroll") for (int e = 0; e < 4; ++e) { *(LAS bf16_t*)(WVT + (8 * w + 2 * e) * 144 + lane * 2) = (bf16_t)f2bf(bflo(vw[e]) * wsr); *(LAS bf16_t*)(WVT + (8 * w + 2 * e + 1) * 144 + lane * 2) = (bf16_t)f2bf(bfhi(vw[e]) * wsr); } \
      } else if (w == 4) { *(LAS bf16_t*)(WVT + 32 * 144 + lane * 2) = (bf16_t)f2bf(wsr); } \
      const f32x4 ivc = ivr; \
      { const int cn_ = ((c) + 2 < NCH) ? (c) + 2 : NCH - 1; M2_LOAD(qreg, kreg, vreg, wsr, ivr, cn_); } \
      LBAR(); \
      M2_ATILE_H(w & 3, w >> 2, tok0, ivc); \
      M2_ATILE_Q(w & 3, 2 + (w >> 2), tok0, ivc); \
      const float decay = TD[(c)]; \
      _Pragma("unroll") for (int mt = 0; mt < 2; ++mt) \
        _Pragma("unroll") for (int n2 = 0; n2 < 3; ++n2) { \
          f32x4 cacc = acc[mt][n2] * decay; \
          _Pragma("unroll") for (int ks = 0; ks < 2; ++ks) { \
            const bf16x8 a = *(const LAS bf16x8*)(KT + (32 * w + 16 * mt + r) * 144 + (32 * ks + 8 * gq) * 2); \
            const bf16x8 bb = *(const LAS bf16x8*)(WVT + (16 * n2 + r) * 144 + (32 * ks + 8 * gq) * 2); \
            cacc = __builtin_amdgcn_mfma_f32_16x16x32_bf16(a, bb, cacc, 0, 0, 0); } \
          acc[mt][n2] = cacc; } \
      LBAR(); \
      _Pragma("unroll") for (int mt = 0; mt < 2; ++mt) \
        _Pragma("unroll") for (int n2 = 0; n2 < 3; ++n2) { u32x2 q; q.x = pk2(acc[mt][n2][0], acc[mt][n2][1]); q.y = pk2(acc[mt][n2][2], acc[mt][n2][3]); \
          *(LAS u32x2*)(CT + (16 * n2 + r) * 528 + (32 * w + 16 * mt + 4 * gq) * 2) = q; } \
    } while (0)
    { const int tdx = F.tid, sp = tdx & 31, cq = tdx >> 5, gq = (tdx & 63) >> 4;
      M2_LOAD(qrA, krA, vrA, wsA, ivA, 0);
      M2_LOAD(qrB, krB, vrB, wsB, ivB, 1); }
    __syncthreads();
#pragma unroll 1
    for (int c = 0; c < NCH; c += 2) {
      M2_BODY(c, qrA, krA, vrA, wsA, ivA);
      M2_BODY(c + 1, qrB, krB, vrB, wsB, ivB);
    }
#undef M2_BODY
#undef M2_ATILE_H
#undef M2_ATILE_Q
#undef M2_AMMA
#undef M2_LOAD
    __syncthreads();
  }
}

__device__ __forceinline__ void phase_ragg(const Frame& F) {
  unsigned char* ws = F.ws;
  const float* RA = (const float*)(ws + WS_RA); const bf16_t* RBb = (const bf16_t*)(ws + WS_RB);
  float* AGGA = (float*)(ws + WS_SMALL + SM_AGGA); float* AGGB = (float*)(ws + WS_SMALL + SM_AGGB);
  const int gt = F.bid * 512 + F.tid, NGT = F.G * 512;
#pragma unroll 1
  for (int it = gt; it < 2 * NCH * RW; it += NGT) {
    const int bc = it / RW, ch = it - bc * RW;
    const float* pa = RA + (size_t)bc * 64 * RW + ch; const bf16_t* pb = RBb + (size_t)bc * 64 * RW + ch;
    float A = 1.f, B = 0.f;
#pragma unroll 1
    for (int tb = 0; tb < 8; ++tb) {
      float a[8]; float bb[8];
#pragma unroll
      for (int t = 0; t < 8; ++t) { a[t] = pa[(size_t)(tb * 8 + t) * RW]; bb[t] = bf1(pb[(size_t)(tb * 8 + t) * RW]); }
#pragma unroll
      for (int t = 0; t < 8; ++t) { A *= a[t]; B = a[t] * B + bb[t]; }
    }
    AGGA[it] = A; AGGB[it] = B;
  }
}
__device__ __forceinline__ void phase_rscan(const Frame& F) {
  unsigned char* ws = F.ws;
  const float* RA = (const float*)(ws + WS_RA); const bf16_t* RBb = (const bf16_t*)(ws + WS_RB);
  const float* AGGA = (const float*)(ws + WS_SMALL + SM_AGGA); const float* AGGB = (const float*)(ws + WS_SMALL + SM_AGGB);
  const bf16_t* PROJ = (const bf16_t*)(ws + WS_PROJ); bf16_t* YR = (bf16_t*)(ws + WS_YR);
  const int gt = F.bid * 512 + F.tid, NGT = F.G * 512;
  for (int it = gt; it < 2 * NCH * RW; it += NGT) {
    const int bc = it / RW, ch = it % RW, t0 = bc * 64, b = bc / NCH, cidx = bc % NCH;
    float hcar = 0.f;
    for (int c0 = 0; c0 < cidx; c0 += 16) {
      float ca[16], cb[16];
#pragma unroll
      for (int k = 0; k < 16; ++k) { const int cc = c0 + k; const int j = (b * NCH + (cc < cidx ? cc : 0)) * RW + ch; ca[k] = AGGA[j]; cb[k] = AGGB[j]; }
#pragma unroll
      for (int k = 0; k < 16; ++k) { if (c0 + k < cidx) hcar = ca[k] * hcar + cb[k]; }
    }
#pragma unroll
    for (int tb = 0; tb < 4; ++tb) {
      float a[16]; bf16_t bb[16], xg[16];
#pragma unroll
      for (int t = 0; t < 16; ++t) { const size_t o = (size_t)(t0 + tb * 16 + t) * RW + ch; a[t] = RA[o]; bb[t] = RBb[o]; xg[t] = PROJ[(size_t)(t0 + tb * 16 + t) * INC + O_XG + ch]; }
#pragma unroll
      for (int t = 0; t < 16; ++t) { hcar = a[t] * hcar + bf1(bb[t]); YR[(size_t)(t0 + tb * 16 + t) * RW + ch] = (bf16_t)f2bf(hcar * gelu_tanh(bf1(xg[t]))); }
    }
  }
}

__device__ __forceinline__ void phase_ym(const Frame& F) {
  unsigned char* ws = F.ws;
  const bf16_t* HNI = (const bf16_t*)(ws + WS_HNI); const bf16_t* HNE = (const bf16_t*)(ws + WS_HNE);
  const float* EMR = (const float*)(ws + WS_SMALL + SM_EMR); const float* DENI = (const float*)(ws + WS_SMALL + SM_DENI); const float* QN = (const float*)(ws + WS_SMALL + SM_QN);
  const bf16_t* XCM = (const bf16_t*)(ws + WS_XCM); const bf16_t* PROJ = (const bf16_t*)(ws + WS_PROJ); bf16_t* YM = (bf16_t*)(ws + WS_YM);
  const float* normw = F.in[10]; const float* skip = F.in[11];
  const int gw = F.bid * 8 + F.wave, NGW = F.G * 8, lane = F.lane;
  for (int t = gw; t < NTOK; t += NGW) {
    u32x2 a[8], e[8], xcw[8], zw[8]; float den[8], emr[8];
#pragma unroll
    for (int h = 0; h < 8; ++h) {
      const size_t o = (size_t)t * MW + 256 * h + 4 * lane;
      a[h] = *(const u32x2*)(HNI + o); e[h] = *(const u32x2*)(HNE + o); xcw[h] = *(const u32x2*)(XCM + o); zw[h] = *(const u32x2*)(PROJ + (size_t)t * INC + O_Z + 256 * h + 4 * lane);
      den[h] = DENI[t * 8 + h] + QN[t * 8 + h]; emr[h] = EMR[t * 8 + h];
    }
#pragma unroll
    for (int h = 0; h < 8; ++h) {
      const int col = 256 * h + 4 * lane;
      const float inv = 1.0f / fmaxf(fabsf(den[h]), emr[h]);
      const float hv[4] = {(bflo(a[h].x) + bflo(e[h].x)) * inv, (bfhi(a[h].x) + bfhi(e[h].x)) * inv, (bflo(a[h].y) + bflo(e[h].y)) * inv, (bfhi(a[h].y) + bfhi(e[h].y)) * inv};
      const float mean = wave_sum((hv[0] + hv[1]) + (hv[2] + hv[3])) * (1.0f / 256.0f);
      float d[4]; float s2 = 0.f;
#pragma unroll
      for (int j = 0; j < 4; ++j) { d[j] = hv[j] - mean; s2 += d[j] * d[j]; }
      const float rstd = rsqrtf(wave_sum(s2) * (1.0f / 256.0f) + LN_EPS);
      const f32x4 nw = *(const f32x4*)(normw + col), sk = *(const f32x4*)(skip + col);
      const float xc[4] = {bflo(xcw[h].x), bfhi(xcw[h].x), bflo(xcw[h].y), bfhi(xcw[h].y)}, z[4] = {bflo(zw[h].x), bfhi(zw[h].x), bflo(zw[h].y), bfhi(zw[h].y)};
      float y[4];
#pragma unroll
      for (int j = 0; j < 4; ++j) y[j] = (d[j] * rstd * nw[j] + sk[j] * xc[j]) * siluf_(z[j]);
      u32x2 w; w.x = pk2(y[0], y[1]); w.y = pk2(y[2], y[3]); *(u32x2*)(YM + (size_t)t * RW + col) = w;
    }
  }
}

__device__ __forceinline__ void phase_ln_router(const Frame& F) {
  unsigned char* ws = F.ws;
  float* X1 = (float*)(ws + WS_X1); unsigned char* X1Q = ws + WS_X1B;
  int* CNT = (int*)(ws + WS_CTL); int* LIST = (int*)(ws + WS_LIST); float* LISTW = (float*)(ws + WS_LISTW); int* TOKES = (int*)(ws + WS_TOKES);
  const float* g1 = F.in[22]; const float* b1 = F.in[23]; const float* rw = F.in[24]; const float* rbias = F.in[25];
  LAS unsigned char* XH = F.lds; LAS unsigned char* XL = F.lds + 65792;
  const bf16_t* RWH = (const bf16_t*)(ws + WS_SMALL + SM_RWH); const bf16_t* RWL = (const bf16_t*)(ws + WS_SMALL + SM_RWL);
  const int w = F.wave;
  for (int tile = F.bid; tile < NTOK / 16; tile += F.G) {
    const int t0 = tile * 16;
    int lane = F.lane; asm volatile("" : "+v"(lane));
    const int r16 = lane & 15, gq = lane >> 4;
#pragma unroll 1
    for (int q = 0; q < 2; ++q) {
      const int tl = 2 * w + q, t = t0 + tl;
      float* xr = X1 + (size_t)t * DM;
      f32x4 v[8]; float s = 0.f;
#pragma unroll
      for (int j = 0; j < 8; ++j) { v[j] = *(const f32x4*)(xr + 4 * lane + 256 * j); s += (v[j][0] + v[j][1]) + (v[j][2] + v[j][3]); }
      const float mean = wave_sum(s) * (1.0f / DM); float s2 = 0.f;
#pragma unroll
      for (int j = 0; j < 8; ++j) { v[j] = v[j] - mean; s2 += (v[j][0] * v[j][0] + v[j][1] * v[j][1]) + (v[j][2] * v[j][2] + v[j][3] * v[j][3]); }
      const float rstd = rsqrtf(wave_sum(s2) * (1.0f / DM) + LN_EPS);
#pragma unroll
      for (int j = 0; j < 8; ++j) {
        const int col = 4 * lane + 256 * j;
        const f32x4 gg = *(const f32x4*)(g1 + col), bb = *(const f32x4*)(b1 + col);
        const f32x4 o = v[j] * rstd * gg + bb;
        *(f32x4*)(xr + col) = o;
        u32x2 pw; pw.x = pk2(o[0], o[1]); pw.y = pk2(o[2], o[3]);
        { int q8 = 0; q8 = __builtin_amdgcn_cvt_pk_fp8_f32(o[0], o[1], q8, false); q8 = __builtin_amdgcn_cvt_pk_fp8_f32(o[2], o[3], q8, true); *(int*)(X1Q + (size_t)t * DM + col) = q8; }
        { float lo[4];
#pragma unroll
          for (int e = 0; e < 4; ++e) lo[e] = o[e] - __uint_as_float(f2bf(o[e]) << 16);
          *(LAS u32x2*)(XH + tl * 4112 + col * 2) = pw; u32x2 lw; lw.x = pk2(lo[0], lo[1]); lw.y = pk2(lo[2], lo[3]); *(LAS u32x2*)(XL + tl * 4112 + col * 2) = lw; }
      }
    }
    __syncthreads();
    f32x4 lacc[4];
    {
      const bf16_t* rh = RWH + (size_t)r16 * DM + 256 * w + 8 * gq; const bf16_t* rl = RWL + (size_t)r16 * DM + 256 * w + 8 * gq;
      const LAS unsigned char* xh = XH + r16 * 4112 + (256 * w + 8 * gq) * 2; const LAS unsigned char* xl = XL + r16 * 4112 + (256 * w + 8 * gq) * 2;
#pragma unroll
      for (int nt = 0; nt < 4; ++nt) {
        f32x4 a4 = (f32x4){0.f, 0.f, 0.f, 0.f};
#pragma unroll
        for (int kh = 0; kh < 2; ++kh) {
          bf16x8 bh[4], bl[4];
#pragma unroll
          for (int k2 = 0; k2 < 4; ++k2) { bh[k2] = *(const bf16x8*)(rh + (size_t)(16 * nt) * DM + 32 * (4 * kh + k2)); bl[k2] = *(const bf16x8*)(rl + (size_t)(16 * nt) * DM + 32 * (4 * kh + k2)); }
#pragma unroll
          for (int k2 = 0; k2 < 4; ++k2) {
            const bf16x8 ah = *(const LAS bf16x8*)(xh + 64 * (4 * kh + k2));
            const bf16x8 al = *(const LAS bf16x8*)(xl + 64 * (4 * kh + k2));
            a4 = __builtin_amdgcn_mfma_f32_16x16x32_bf16(ah, bh[k2], a4, 0, 0, 0);
            a4 = __builtin_amdgcn_mfma_f32_16x16x32_bf16(al, bh[k2], a4, 0, 0, 0);
            a4 = __builtin_amdgcn_mfma_f32_16x16x32_bf16(ah, bl[k2], a4, 0, 0, 0);
          }
          asm volatile("" ::: "memory");
        }
        lacc[nt] = a4;
      }
    }
    __syncthreads();
    LAS float* PART = (LAS float*)F.lds;
#pragma unroll
    for (int nt = 0; nt < 4; ++nt)
#pragma unroll
      for (int j = 0; j < 4; ++j) PART[(w * 16 + 4 * gq + j) * 64 + 16 * nt + r16] = lacc[nt][j];
    __syncthreads();
    LAS int* lcnt = (LAS int*)(F.lds + 40960); LAS int* lbase = lcnt + 64;
    if (F.tid < 64) lcnt[F.tid] = 0;
    __syncthreads();
    int lslot[2], rnk[2]; float wg[2];
#pragma unroll
    for (int q = 0; q < 2; ++q) {
      const int tl = 2 * w + q;
      float logit = 0.f;
#pragma unroll
      for (int ww = 0; ww < 8; ++ww) logit += PART[(ww * 16 + tl) * 64 + lane];
      const float score = 1.0f / (1.0f + expf(-logit));
      const float biased = score + rbias[lane];
      int cnt = 0;
#pragma unroll
      for (int d = 1; d < 8; ++d) { const int other = (lane & ~7) | ((lane + d) & 7); const float ov = __shfl(biased, other); cnt += (ov > biased || (ov == biased && other < lane)) ? 1 : 0; }
      float gs = cnt < 2 ? biased : 0.f;
      gs += __shfl_xor(gs, 1); gs += __shfl_xor(gs, 2); gs += __shfl_xor(gs, 4);
      const int gi = lane >> 3; int grank = 0;
#pragma unroll
      for (int gg = 0; gg < 8; ++gg) { const float og = __shfl(gs, 8 * gg); grank += (og > gs || (og == gs && gg < gi)) ? 1 : 0; }
      const float val = grank < 4 ? biased : -INFINITY;
      int erank = 0;
      for (int e2 = 0; e2 < 64; ++e2) { const float ov = __shfl(val, e2); erank += (ov > val || (ov == val && e2 < lane)) ? 1 : 0; }
      const bool chosen = erank < 8;
      const float wsum = wave_sum(chosen ? score : 0.f);
      rnk[q] = erank; wg[q] = score / wsum * 2.5f; lslot[q] = -1;
      if (chosen) lslot[q] = atomicAdd((int*)(lcnt + lane), 1);
    }
    __syncthreads();
    if (F.tid < 64) { const int c = lcnt[F.tid]; lbase[F.tid] = c ? atomicAdd(&CNT[F.tid * 64], c) : 0; }
    __syncthreads();
#pragma unroll
    for (int q = 0; q < 2; ++q) {
      if (lslot[q] >= 0) { const int t = t0 + 2 * w + q; const int slot = lbase[lane] + lslot[q];
        LIST[lane * NTOK + slot] = t; LISTW[lane * NTOK + slot] = wg[q]; TOKES[t * 8 + rnk[q]] = (lane << 16) | slot; }
    }
    __syncthreads();
  }
}

__device__ __forceinline__ MoeTab build_moe_tab(const Frame& F) {
  LAS int* tp = (LAS int*)(F.lds + LDS_X); LAS int* cp = tp + 68; LAS int* cn = tp + 136;
  const int* CNT = (const int*)(F.ws + WS_CTL);
  if (F.tid == 0) { int a = 0, b = 0; for (int e = 0; e < NE; ++e) { const int c = CNT[e * 64]; tp[e] = a; cp[e] = b; cn[e] = c; a += (c + 255) >> 8; b += c; } tp[NE] = a; cp[NE] = b; }
  __syncthreads();
  { LAS int* rt = tp + 256; if (F.tid < 384) { int e = 0; for (int k = 0; k < NE; ++k) { if (tp[k + 1] <= F.tid) e = k + 1; } rt[F.tid] = e < NE ? e : NE - 1; } }
  __syncthreads();
  MoeTab T; T.tp = tp; T.cp = cp; T.cnt = cn; T.n_rt = __builtin_amdgcn_readfirstlane(tp[NE]);
  return T;
}

__device__ __forceinline__ void phase_final(const Frame& F, const MoeTab& T) {
  unsigned char* ws = F.ws;
  const bf16_t* YRM = (const bf16_t*)(ws + WS_YRM); const int* TOKES = (const int*)(ws + WS_TOKES);
  const float* g2 = F.in[32]; const float* b2 = F.in[33];
  const int gw = F.bid * 8 + F.wave, NGW = F.G * 8, lane = F.lane;
  for (int t = gw; t < NTOK; t += NGW) {
    float* orow = F.out + (size_t)t * DM;
    f32x4 v[8];
    { const float* xrow = (const float*)(ws + WS_X1) + (size_t)t * DM; const bf16_t* ys = YRM + (size_t)(NTOK * 8 + t) * DM;
#pragma unroll
      for (int j = 0; j < 8; ++j) { const u32x2 wv = *(const u32x2*)(ys + 4 * lane + 256 * j); v[j] = *(const f32x4*)(xrow + 4 * lane + 256 * j) * ALPHA; v[j][0] += bflo(wv.x); v[j][1] += bfhi(wv.x); v[j][2] += bflo(wv.y); v[j][3] += bfhi(wv.y); } }
    const int esl = TOKES[t * 8 + (lane & 7)];
#pragma unroll
    for (int kb = 0; kb < 2; ++kb) {
      u32x2 yv[4][8];
#pragma unroll
      for (int k = 0; k < 4; ++k) {
        const int es = __shfl(esl, kb * 4 + k); const int e = es >> 16, slot = es & 0xffff;
        const bf16_t* yr = YRM + (size_t)(T.cp[e] + slot) * DM;
#pragma unroll
        for (int j = 0; j < 8; ++j) yv[k][j] = *(const u32x2*)(yr + 4 * lane + 256 * j);
      }
#pragma unroll
      for (int k = 0; k < 4; ++k)
#pragma unroll
        for (int j = 0; j < 8; ++j) { v[j][0] += bflo(yv[k][j].x); v[j][1] += bfhi(yv[k][j].x); v[j][2] += bflo(yv[k][j].y); v[j][3] += bfhi(yv[k][j].y); }
    }
    float s = 0.f;
#pragma unroll
    for (int j = 0; j < 8; ++j) s += (v[j][0] + v[j][1]) + (v[j][2] + v[j][3]);
    const float mean = wave_sum(s) * (1.0f / DM); float s2 = 0.f;
#pragma unroll
    for (int j = 0; j < 8; ++j) { v[j] = v[j] - mean; s2 += (v[j][0] * v[j][0] + v[j][1] * v[j][1]) + (v[j][2] * v[j][2] + v[j][3] * v[j][3]); }
    const float rstd = rsqrtf(wave_sum(s2) * (1.0f / DM) + LN_EPS);
#pragma unroll
    for (int j = 0; j < 8; ++j) { const int col = 4 * lane + 256 * j; const f32x4 gg = *(const f32x4*)(g2 + col), bb = *(const f32x4*)(b2 + col); *(f32x4*)(orow + col) = v[j] * rstd * gg + bb; }
  }
}

__global__ void __launch_bounds__(512, 2) fwd_megakernel(Params p, int ph_lo, int ph_hi) {
  extern __shared__ __attribute__((aligned(16))) unsigned char lds_raw[];
  Frame F;
  F.lds = (LAS unsigned char*)lds_raw; F.tid = threadIdx.x; F.lane = F.tid & 63; F.wave = __builtin_amdgcn_readfirstlane(F.tid >> 6);
  F.G = gridDim.x; F.bid = blockIdx.x; F.ws = as_global(p.ws); F.in = InPtrs{p.in}; F.out = as_global(p.out);
  unsigned char* ws = as_global(p.ws);
#ifndef PHMASK
#define PHMASK 0xFFF
#endif
#define IN(k) (((PHMASK >> (k)) & 1) && ph_lo <= (k) && (k) < ph_hi)
#ifndef RPTMASK
#define RPTMASK 0
#endif
#define RPT(k) for (int _rp = 0; _rp < 1 + ((RPTMASK >> (k)) & 1); ++_rp)
#define FRESH() do { unsigned char* w2_ = opaque_global(p.ws); ws = w2_; F.ws = w2_; int l2_ = (int)__builtin_amdgcn_mbcnt_hi(~0u, __builtin_amdgcn_mbcnt_lo(~0u, 0u)); asm volatile("" : "+v"(l2_)); F.lane = l2_; F.tid = F.wave * 64 + l2_; } while (0)
#define SYNC(k) do { if (IN(k) && IN((k) + 1)) { xcd_barrier(xbar); } } while (0)
  { volatile LAS unsigned* st = (volatile LAS unsigned*)(F.lds + LDS_X + 4096); if (F.tid < 4) st[F.tid] = 0u; }
  __syncthreads();
  const XcdBarrier xbar = xcd_barrier_post((unsigned*)(ws + WS_CTL + 16384), (volatile LAS unsigned*)(F.lds + LDS_X + 4096));

  FRESH();
  if (IN(0)) RPT(0) { if (_rp) xcd_barrier(xbar); phase_prologue(F); }
  SYNC(0);
  FRESH();
  if (IN(1)) RPT(1) { if (_rp) xcd_barrier(xbar);
    SchedDense S{(const char*)(ws + WS_XB), (const char*)(ws + WS_WIN), NTOK / 256, INC / 256, F.G, F.bid, DM, DM, DM / 64};
    EpiStoreBf16 E{(bf16_t*)(ws + WS_PROJ), INC};
    pg8::gemm_phase<EpiStoreBf16, SchedDense, false>(F.lds, DM, DM, S, E);
  }
  SYNC(1);
  FRESH();
  if (IN(2)) RPT(2) { if (_rp) xcd_barrier(xbar); phase_mprep(F); phase_rconv(F); }
  SYNC(2);
  FRESH();
  if (IN(3)) RPT(3) { if (_rp) xcd_barrier(xbar);
    const int nm2 = F.G >> 1;
    if (F.bid < nm2) phase_m2(F, nm2);
    else {
      const int bid2 = F.bid - nm2, G2 = F.G - nm2;
      phase_m1(F, bid2, G2);
      int Kr = 4; asm volatile("" : "+s"(Kr));
      SchedRglru S{(const char*)(ws + WS_XCR), (const char*)(ws + WS_WRAX), G2, bid2, Kr};
      EpiRglru E{(const bf16_t*)(ws + WS_XCR), p.in[15], p.in[17], (const float*)(ws + WS_SMALL + SM_C8), (float*)(ws + WS_RA), (bf16_t*)(ws + WS_RB)};
      pg8::gemm_phase<EpiRglru, SchedRglru, false>(F.lds, RW, 256, S, E);
    }
  }
  SYNC(3);
  FRESH();
  if (IN(4)) RPT(4) { if (_rp) xcd_barrier(xbar); phase_ragg(F); phase_ym(F); }
  SYNC(4);
  FRESH();
  if (IN(5)) RPT(5) { if (_rp) xcd_barrier(xbar); phase_rscan(F); }
  SYNC(5);
  FRESH();
  if (IN(6)) RPT(6) { if (_rp) xcd_barrier(xbar);
    SchedMerge S{(const char*)(ws + WS_YM), (const char*)(ws + WS_YR), (const char*)(ws + WS_WPM), (const char*)(ws + WS_WPR), F.G, F.bid};
    EpiMergeF E{(const bf16_t*)(ws + WS_PROJ), p.in[2], (bf16_t*)(ws + WS_MERGED)};
    pg8::gemm_phase<EpiMergeF, SchedMerge, false>(F.lds, RW, RW, S, E);
  }
  SYNC(6);
  FRESH();
  if (IN(7)) RPT(7) { if (_rp) xcd_barrier(xbar);
    SchedDense S{(const char*)(ws + WS_MERGED), (const char*)(ws + WS_WO), NTOK / 256, DM / 256, F.G, F.bid, DM, DM, DM / 64};
    EpiWo E{p.in[0], (float*)(ws + WS_X1)};
    pg8::gemm_phase<EpiWo, SchedDense, false>(F.lds, DM, DM, S, E);
  }
  SYNC(7);
  FRESH();
  if (IN(8)) phase_ln_router(F);
  SYNC(8);
  FRESH();
  if (IN(9)) RPT(9) { if (_rp) xcd_barrier(xbar);
    const MoeTab T = build_moe_tab(F);
    SchedMoe<4, 1> S{T, (const int*)(ws + WS_LIST), (const char*)(ws + WS_X1B), (const char*)(ws + WS_WEGU), (const char*)(ws + WS_WSGU), F.G, F.bid, DM / 128};
    EpiMoe1 E{ws + WS_HMOE};
    pg8::gemm_phase<EpiMoe1, SchedMoe<4, 1>, true>(F.lds, DM / 2, DM / 2, S, E);
  }
  SYNC(9);
  FRESH();
  if (IN(10)) RPT(10) { if (_rp) xcd_barrier(xbar);
    const MoeTab T = build_moe_tab(F);
    int nt2 = DE / 128; asm volatile("" : "+s"(nt2));
    SchedMoe<8, 2> S{T, (const int*)(ws + WS_LIST), (const char*)(ws + WS_HMOE), (const char*)(ws + WS_WED), (const char*)(ws + WS_WSD), F.G, F.bid, nt2};
    EpiMoe2 E{(bf16_t*)(ws + WS_YRM), (const float*)(ws + WS_LISTW), (bf16_t*)(ws + WS_WIN)};
    pg8::gemm_phase<EpiMoe2, SchedMoe<8, 2>, false>(F.lds, DE / 2, DE / 2, S, E);
  }
  SYNC(10);
  FRESH();
  if (IN(11)) { const MoeTab T = build_moe_tab(F); phase_final(F, T); }
#undef IN
#undef SYNC
}

#ifndef N_LAUNCH_SPLIT
#define N_LAUNCH_SPLIT 0
#endif
extern "C" void kernel_launch(void* const* d_in, const int* in_sizes, int n_in, void* d_out, int out_size, void* d_ws, size_t ws_size, hipStream_t stream) {
  static int grid_blocks = 0;
  if (grid_blocks == 0) {
    int dev = 0, cus = 0, per_cu = 0;
    (void)hipGetDevice(&dev);
    (void)hipDeviceGetAttribute(&cus, hipDeviceAttributeMultiprocessorCount, dev);
    (void)hipFuncSetAttribute((const void*)fwd_megakernel, hipFuncAttributeMaxDynamicSharedMemorySize, LDS_BYTES);
    (void)hipOccupancyMaxActiveBlocksPerMultiprocessor(&per_cu, fwd_megakernel, 512, LDS_BYTES);
    if (per_cu < 1) { fprintf(stderr, "kernel_launch: occupancy query says %d blocks per CU\n", per_cu); per_cu = 1; }
    grid_blocks = cus * per_cu;
    fprintf(stderr, "kernel_launch: cus %d per_cu %d grid %d ws_size %zu (need %zu) n_in %d\n", cus, per_cu, grid_blocks, ws_size, (size_t)WS_END, n_in);
    if (ws_size < WS_END || n_in != 34) { fprintf(stderr, "kernel_launch: workspace too small or unexpected inputs; nothing launched\n"); grid_blocks = -1; }
  }
  if (grid_blocks < 0) return;
  (void)hipMemsetAsync((char*)d_ws + WS_CTL, 0, 65536, stream);
  Params p{};
  for (int i = 0; i < 34; ++i) p.in[i] = (const float*)d_in[i];
  p.out = (float*)d_out; p.ws = (unsigned char*)d_ws;
#if N_LAUNCH_SPLIT
  for (int ph = 0; ph < 12; ++ph) { hipLaunchKernelGGL(fwd_megakernel, dim3(grid_blocks), dim3(512), LDS_BYTES, stream, p, ph, ph + 1); }
#else
  int lo = 0, hi = 12;
  void* args[] = {&p, &lo, &hi};
  hipError_t e = hipLaunchCooperativeKernel((void*)fwd_megakernel, dim3(grid_blocks), dim3(512), args, LDS_BYTES, stream);
  if (e != hipSuccess) fprintf(stderr, "cooperative launch failed: %s (grid %d)\n", hipGetErrorString(e), grid_blocks);
#endif
}
```

```cpp
#include <hip/hip_runtime.h>
#include <hip/hip_cooperative_groups.h>
#include <cstdio>
#include <cstdint>
namespace cg = cooperative_groups;

#define LAS __attribute__((address_space(3)))
typedef unsigned short bf16_t;
typedef short bf16x8 __attribute__((ext_vector_type(8)));
typedef float f32x4 __attribute__((ext_vector_type(4)));
typedef float f32x2 __attribute__((ext_vector_type(2)));
typedef unsigned u32x4 __attribute__((ext_vector_type(4)));
typedef unsigned u32x2 __attribute__((ext_vector_type(2)));
typedef int i32x8 __attribute__((ext_vector_type(8)));
typedef int i32x4 __attribute__((ext_vector_type(4)));

constexpr int NTOK = 8192, DM = 2048, SEQ = 4096, MW = 2048, RW = 2560, INC = 13312, NH = 8, HD = 256, NE = 64, DE = 512;
constexpr int O_Z = 2048, O_XR = 4096, O_XG = 6656, O_G0 = 9216, O_G1 = 11264;
constexpr float LN_EPS = 1e-5f;
constexpr float ALPHA = 1.189207115002721f;
constexpr int NCH = 64;

constexpr size_t MiB = 1u << 20;
constexpr size_t WS_CTL = 0;
constexpr size_t WS_WIN = 1 * MiB, WS_RB = 1 * MiB, WS_M2TAB = 41 * MiB;
constexpr size_t WS_WPM = 53 * MiB  , WS_WPR = 63 * MiB, WS_WO = 73 * MiB, WS_WRAX = 81 * MiB, WS_WSGU = 84 * MiB, WS_WSD = 1014 * MiB;
constexpr size_t WS_WEGU = 88 * MiB, WS_WED = 344 * MiB;
constexpr size_t WS_XB = 472 * MiB, WS_HNI = 472 * MiB, WS_HMOE = 472 * MiB;
constexpr size_t WS_PROJ = 504 * MiB;
constexpr size_t WS_YRM = 560 * MiB;
constexpr size_t WS_Q = 712 * MiB, WS_K = 744 * MiB, WS_V = 776 * MiB, WS_YM = 712 * MiB  , WS_YR = 752 * MiB;
constexpr size_t WS_XCM = 808 * MiB, WS_MERGED = 808 * MiB;
constexpr size_t WS_XCR = 840 * MiB;
constexpr size_t WS_SMALL = 880 * MiB;
constexpr size_t WS_RA = 886 * MiB, WS_T1 = 886 * MiB, WS_X1B = 886 * MiB  ;
constexpr size_t WS_LIST = 918 * MiB, WS_LISTW = 920 * MiB  , WS_TOKES = 923 * MiB;
constexpr size_t WS_X1 = 950 * MiB;
constexpr size_t WS_HNE = 966 * MiB;
constexpr size_t WS_END = 1016 * MiB;
constexpr size_t SM_IG = 0, SM_LF = 256 * 1024, SM_INTER = 512 * 1024, SM_EMR = 768 * 1024, SM_DENI = 1024 * 1024, SM_QN = 1280 * 1024;
constexpr size_t SM_WIFT = 1536 * 1024;
constexpr size_t SM_C8 = 1792 * 1024;
constexpr size_t SM_RWH = 4608 * 1024, SM_RWL = 4864 * 1024;
constexpr size_t SM_AGGA = 2 * MiB, SM_AGGB = 2 * MiB + 1310720;

constexpr int LDS_BYTES = 147456;
constexpr int LDS_X = 131072;

struct Params {
  const float* in[34];
  float* out;
  unsigned char* ws;
};

typedef __bf16 hbf2_t __attribute__((ext_vector_type(2)));
typedef float hf2_t __attribute__((ext_vector_type(2)));
__device__ __forceinline__ unsigned pk2(float lo, float hi) { const hf2_t f = {lo, hi}; return __builtin_bit_cast(unsigned, __builtin_convertvector(f, hbf2_t)); }
__device__ __forceinline__ unsigned f2bf(float f) { return pk2(f, 0.f) & 0xffffu; }
__device__ __forceinline__ float bflo(unsigned w) { return __uint_as_float(w << 16); }
__device__ __forceinline__ float bfhi(unsigned w) { return __uint_as_float(w & 0xffff0000u); }
__device__ __forceinline__ float bf1(bf16_t b) { return __uint_as_float(((unsigned)b) << 16); }
__device__ __forceinline__ float sigmoidf_(float x) { return 1.0f / (1.0f + __expf(-x)); }
__device__ __forceinline__ float siluf_(float x) { return x / (1.0f + __expf(-x)); }
__device__ __forceinline__ float gelu_tanh(float x) { const float u = 0.7978845608028654f * (x + 0.044715f * x * x * x); return 0.5f * x * (1.0f + tanhf(u)); }
__device__ __forceinline__ float wave_sum(float v) {
#pragma unroll
  for (int o = 1; o < 64; o <<= 1) v += __shfl_xor(v, o);
  return v;
}
__device__ __forceinline__ float wave_max(float v) {
#pragma unroll
  for (int o = 1; o < 64; o <<= 1) v = fmaxf(v, __shfl_xor(v, o));
  return v;
}
__device__ __forceinline__ float wave_scan_sum(float v, int lane) {
#pragma unroll
  for (int o = 1; o < 64; o <<= 1) { const float t = __shfl_up(v, o); if (lane >= o) v += t; }
  return v;
}
__device__ __forceinline__ float wave_scan_max(float v, int lane) {
#pragma unroll
  for (int o = 1; o < 64; o <<= 1) { const float t = __shfl_up(v, o); if (lane >= o) v = fmaxf(v, t); }
  return v;
}
#define LDS_WAIT() asm volatile("s_waitcnt lgkmcnt(0)" ::: "memory")
#define LBAR() do { asm volatile("s_waitcnt lgkmcnt(0)" ::: "memory"); __builtin_amdgcn_s_barrier(); asm volatile("" ::: "memory"); } while (0)

namespace pg8 {
constexpr int BM = 256, BK = 64, HALF = 128, HTB = HALF * BK * 2, NXCD = 8, WGM = 8;
__device__ __forceinline__ int lds_byte(int r, int c) { const int st = (r >> 4) * 2 + (c >> 5), rr = r & 15, cc = c & 31, ob = rr * 64 + cc * 2; return st * 1024 + (ob ^ (((ob >> 9) & 1) << 5)); }
__device__ __forceinline__ void stage_rc(int b, int& R, int& C) { const int st = b / 1024, sb = b % 1024, swz = sb ^ (((sb >> 9) & 1) << 5); R = (st >> 1) * 16 + swz / 64; C = (st & 1) * 32 + (swz % 64) / 2; }

__device__ __forceinline__ int perm32(int rho) { const int n = rho >> 4, i = rho & 15; return 8 * (i >> 2) + 4 * n + (i & 3); }
struct UnitG { const char* A; const char* B; int pm, pn, e, cnt, mt, row0, nt, keep; };

__device__ __forceinline__ bool dense_order(int i, int G, int c, int nM, int nN, int& pm, int& pn) {
  const int nwg = nM * nN; const long L = (long)i * G + c; if (L >= nwg) return false;
  int wgid = (int)L; { const int q = nwg / NXCD, r = nwg % NXCD, xcd = wgid % NXCD, off = wgid / NXCD; wgid = (xcd < r ? xcd * (q + 1) : r * (q + 1) + (xcd - r) * q) + off; }
  const int nig = WGM * nN, gid = wgid / nig, fm = gid * WGM, gsz = (nM - fm) < WGM ? (nM - fm) : WGM;
  pm = fm + ((wgid % nig) % gsz); pn = (wgid % nig) / gsz; return true;
}

template <class Epi, class Sched, bool GATHER>
__device__ __forceinline__ void gemm_phase(LAS unsigned char* lds, const int lda, const int ldb, const Sched& S, const Epi& E) {
  const int tid = threadIdx.x, wid = __builtin_amdgcn_readfirstlane(tid >> 6), lane = tid & 63, wr = wid >> 2, wc = wid & 3, fr = lane & 15, fq = lane >> 4;
  int Rr[2], Cc[2];
  unsigned voffB[2];
  unsigned vA[2][2];
  unsigned nvA[2][2];
#pragma unroll
  for (int i = 0; i < 2; ++i) { stage_rc(tid * 16 + i * 8192, Rr[i], Cc[i]); const int Rb = Epi::PERM ? ((Rr[i] & ~31) + perm32(Rr[i] & 31)) : Rr[i]; voffB[i] = (unsigned)(Rb * ldb + Cc[i]) * 2u; }
  const size_t kstep = (size_t)(BK * 2);
  const size_t hstepA = (size_t)HALF * lda * 2, hstepB = (size_t)HALF * ldb * 2;
  const unsigned ldsw = (unsigned)wid * 1024u;
  const int aoff = lds_byte(wr * 64 + fr, fq * 8), boff = lds_byte(wc * 32 + fr, fq * 8);
#define PG8_SA(b, h) (((b) * 2 + (h)) * HTB)
#define PG8_SB(b, h) ((4 + (b) * 2 + (h)) * HTB)
#define PG8_STAGE_B(bufoff, gbase) do { _Pragma("unroll") for (int _i = 0; _i < 2; ++_i) \
    __builtin_amdgcn_global_load_lds((const unsigned*)((const char*)(gbase) + voffB[_i]), (LAS unsigned*)(lds + (bufoff) + ldsw + _i * 8192), 16, 0, 0); } while (0)
#define PG8_STAGE_A(bufoff, gbase, h) do { _Pragma("unroll") for (int _i = 0; _i < 2; ++_i) { \
    const char* _p = GATHER ? ((const char*)(gbase) + vA[h][_i]) : ((const char*)(gbase) + (h) * hstepA + vA[0][_i]); \
    __builtin_amdgcn_global_load_lds((const unsigned*)_p, (LAS unsigned*)(lds + (bufoff) + ldsw + _i * 8192), 16, 0, 0); } } while (0)
#define PG8_LD8(p) __builtin_shufflevector(*(const LAS i32x4*)(p), *(const LAS i32x4*)((p) + 1024), 0, 1, 2, 3, 4, 5, 6, 7)
#define PG8_LO(x) __builtin_bit_cast(bf16x8, __builtin_shufflevector(x, x, 0, 1, 2, 3))
#define PG8_HI(x) __builtin_bit_cast(bf16x8, __builtin_shufflevector(x, x, 4, 5, 6, 7))
#define PG8_LDA(dst, b, h) do { _Pragma("unroll") for (int m = 0; m < 4; ++m) dst[m] = PG8_LD8(lds + PG8_SA(b, h) + aoff + m * 2048); } while (0)
#define PG8_LDB(dst, b, h) do { _Pragma("unroll") for (int n = 0; n < 2; ++n) dst[n] = PG8_LD8(lds + PG8_SB(b, h) + boff + n * 2048); } while (0)
#define PG8_MMA(ai, bj, At, Bt) do { __builtin_amdgcn_s_setprio(1); _Pragma("unroll") for (int m = 0; m < 4; ++m) _Pragma("unroll") for (int n = 0; n < 2; ++n) { \
    acc[ai][bj][m][n] = __builtin_amdgcn_mfma_f32_16x16x32_bf16(PG8_LO(Bt[n]), PG8_LO(At[m]), acc[ai][bj][m][n], 0, 0, 0); \
    acc[ai][bj][m][n] = __builtin_amdgcn_mfma_f32_16x16x32_bf16(PG8_HI(Bt[n]), PG8_HI(At[m]), acc[ai][bj][m][n], 0, 0, 0); } __builtin_amdgcn_s_setprio(0); } while (0)
#define PG8_MMA8(ai, bj, At, Bt) do { __builtin_amdgcn_s_setprio(1); _Pragma("unroll") for (int m = 0; m < 4; ++m) _Pragma("unroll") for (int n = 0; n < 2; ++n) \
    acc[ai][bj][m][n] = __builtin_amdgcn_mfma_scale_f32_16x16x128_f8f6f4(Bt[n], At[m], acc[ai][bj][m][n], 0, 0, 0, 0x7F7F7F7F, 0, 0x7F7F7F7F); __builtin_amdgcn_s_setprio(0); } while (0)
#define PG8_MM(ai, bj, At, Bt) do { if (Epi::FP8) PG8_MMA8(ai, bj, At, Bt); else PG8_MMA(ai, bj, At, Bt); } while (0)
#define PG8_WAIT_V(n) asm volatile("s_waitcnt vmcnt(" #n ")" ::: "memory")
#define PG8_WAIT_L(n) asm volatile("s_waitcnt lgkmcnt(" #n ")" ::: "memory")
#define PG8_BAR __builtin_amdgcn_s_barrier()
#define PG8_SCHED __builtin_amdgcn_sched_barrier(0)
  UnitG cur, nxt; int ui = 0;
  if (!S.next(0, cur)) return;
#pragma unroll
  for (int h = 0; h < 2; ++h)
#pragma unroll
    for (int i = 0; i < 2; ++i) {
      if (GATHER) vA[h][i] = (unsigned)(S.arow(cur, h * HALF + Rr[i]) * lda + Cc[i]) * 2u;
      else vA[h][i] = (unsigned)(Rr[i] * lda + Cc[i]) * 2u;
      nvA[h][i] = vA[h][i];
    }
  f32x4 acc[2][2][4][2];
#pragma unroll
  for (int a = 0; a < 2; ++a)
#pragma unroll
    for (int b = 0; b < 2; ++b)
#pragma unroll
      for (int m = 0; m < 4; ++m)
#pragma unroll
        for (int n = 0; n < 2; ++n) acc[a][b][m][n] = (f32x4){0.f, 0.f, 0.f, 0.f};
  i32x8 At[4], B0[2], B1[2];
  const char* cA = cur.A; const char* cB = cur.B;
  { const char* pB0 = cB; const char* pB1 = cB + hstepB; const char* pA0 = cA; const char* pB2 = cB + kstep; const char* pA1 = cA + kstep; const char* pB3 = cB + hstepB + kstep;
    asm volatile("" : "+s"(pB0), "+s"(pB1), "+s"(pA0), "+s"(pB2), "+s"(pA1), "+s"(pB3));
  PG8_STAGE_B(PG8_SB(0, 0), pB0); PG8_STAGE_B(PG8_SB(0, 1), pB1); PG8_STAGE_A(PG8_SA(0, 0), pA0, 0); PG8_STAGE_A(PG8_SA(0, 1), pA0, 1);
  if (wr == 1) PG8_BAR;
  PG8_WAIT_V(2); PG8_BAR;
  PG8_STAGE_B(PG8_SB(1, 0), pB2); PG8_STAGE_A(PG8_SA(1, 0), pA1, 0); PG8_STAGE_B(PG8_SB(1, 1), pB3); }
  PG8_WAIT_V(6); PG8_BAR;
  for (;;) {
    const bool has_next = S.next(ui + 1, nxt);
    const char* nA = has_next ? nxt.A : cA; const char* nB = has_next ? nxt.B : cB;
    if (GATHER) {
      if (has_next) {
#pragma unroll
        for (int h = 0; h < 2; ++h)
#pragma unroll
          for (int i = 0; i < 2; ++i) nvA[h][i] = (unsigned)(S.arow(nxt, h * HALF + Rr[i]) * lda + Cc[i]) * 2u;
      }
    }
    const int nt = cur.nt;
#pragma unroll 1
    for (int t = 0; t < nt; t += 2) {
      const bool last = (t == nt - 2);
      const char* a1 = cA + (size_t)(t + 1) * kstep;
      const char* a2 = last ? nA : cA + (size_t)(t + 2) * kstep; const char* b2 = last ? nB : cB + (size_t)(t + 2) * kstep;
      const char* a3 = a2 + kstep; const char* b3 = b2 + kstep;
      asm volatile("" : "+s"(a1), "+s"(a2), "+s"(a3), "+s"(b2), "+s"(b3));
      PG8_LDB(B0, 0, 0); PG8_LDB(B1, 0, 1); PG8_SCHED; PG8_LDA(At, 0, 0); PG8_STAGE_A(PG8_SA(1, 1), a1, 1);
      if (GATHER) { if (last) {
#pragma unroll
        for (int h = 0; h < 2; ++h)
#pragma unroll
          for (int i = 0; i < 2; ++i) vA[h][i] = nvA[h][i]; } }
      PG8_WAIT_V(8); PG8_WAIT_L(0); PG8_BAR; PG8_MM(0, 0, At, B0); PG8_MM(0, 1, At, B1); PG8_BAR; PG8_SCHED;
      PG8_LDA(At, 0, 1); PG8_STAGE_B(PG8_SB(0, 0), b2); PG8_STAGE_B(PG8_SB(0, 1), b2 + hstepB); PG8_STAGE_A(PG8_SA(0, 0), a2, 0);
      PG8_WAIT_V(8); PG8_WAIT_L(0); PG8_BAR; PG8_MM(1, 0, At, B0); PG8_MM(1, 1, At, B1); PG8_BAR; PG8_SCHED;
      PG8_LDB(B0, 1, 0); PG8_LDB(B1, 1, 1); PG8_SCHED; PG8_LDA(At, 1, 0); PG8_STAGE_A(PG8_SA(0, 1), a2, 1);
      PG8_WAIT_V(8); PG8_WAIT_L(0); PG8_BAR; PG8_MM(0, 0, At, B0); PG8_MM(0, 1, At, B1); PG8_BAR; PG8_SCHED;
      PG8_LDA(At, 1, 1); PG8_STAGE_B(PG8_SB(1, 0), b3); PG8_STAGE_B(PG8_SB(1, 1), b3 + hstepB); PG8_STAGE_A(PG8_SA(1, 0), a3, 0);
      PG8_WAIT_V(8); PG8_WAIT_L(0); PG8_BAR; PG8_MM(1, 0, At, B0); PG8_MM(1, 1, At, B1); PG8_BAR; PG8_SCHED;
    }
    if (wr == 0) PG8_BAR;
    { int l2 = (int)__builtin_amdgcn_mbcnt_hi(~0u, __builtin_amdgcn_mbcnt_lo(~0u, 0u)); asm volatile("" : "+v"(l2));
      E(acc, cur, wr, wc, l2 & 15, l2 >> 4); }
    if (!has_next) break;
    if (!cur.keep) {
#pragma unroll
      for (int a = 0; a < 2; ++a)
#pragma unroll
        for (int b = 0; b < 2; ++b)
#pragma unroll
          for (int m = 0; m < 4; ++m)
#pragma unroll
            for (int n = 0; n < 2; ++n) acc[a][b][m][n] = (f32x4){0.f, 0.f, 0.f, 0.f};
    }
    cur = nxt; cA = nA; cB = nB; ++ui;
    if (wr == 1) PG8_BAR;
  }
  PG8_WAIT_V(0);
  PG8_BAR;
#undef PG8_SA
#undef PG8_SB
#undef PG8_STAGE_A
#undef PG8_STAGE_B
#undef PG8_LDA
#undef PG8_LDB
#undef PG8_MMA
#undef PG8_MMA8
#undef PG8_MM
#undef PG8_LD8
#undef PG8_LO
#undef PG8_HI
#undef PG8_WAIT_V
#undef PG8_WAIT_L
#undef PG8_BAR
#undef PG8_SCHED
}
}

__device__ __forceinline__ const char* uni_ptr(const char* p) {
  const unsigned long long v = (unsigned long long)p;
  const unsigned lo = __builtin_amdgcn_readfirstlane((unsigned)v), hi = __builtin_amdgcn_readfirstlane((unsigned)(v >> 32));
  return (const char*)(((unsigned long long)hi << 32) | lo);
}

struct SchedDense {
  const char* A; const char* B; int nM, nN, G, c, lda, ldb, nt;
  __device__ __forceinline__ bool next(int i, pg8::UnitG& u) const {
    int pm, pn; if (!pg8::dense_order(i, G, c, nM, nN, pm, pn)) return false;
    u.pm = pm; u.pn = pn; u.e = 0; u.cnt = 0; u.mt = 0; u.row0 = pm * 256; u.nt = nt; u.keep = 0;
    u.A = A + (size_t)pm * 256 * lda * 2; u.B = B + (size_t)pn * 256 * ldb * 2; return true;
  }
  __device__ __forceinline__ unsigned arow(const pg8::UnitG&, int r) const { return (unsigned)r; }
};

struct EpiStoreBf16 {
  static constexpr bool PERM = true, FP8 = false;
  bf16_t* O; int ldc;
  __device__ __forceinline__ void operator()(const f32x4 (&acc)[2][2][4][2], const pg8::UnitG& u, int wr, int wc, int fr, int fq) const {
    const int row0 = u.pm * 256 + wr * 64 + fr, col0 = u.pn * 256 + wc * 32 + 8 * fq;
#pragma unroll
    for (int ai = 0; ai < 2; ++ai)
#pragma unroll
      for (int m = 0; m < 4; ++m) { bf16_t* rowp = O + (size_t)(row0 + ai * 128 + m * 16) * ldc + col0;
#pragma unroll
        for (int bj = 0; bj < 2; ++bj) { const f32x4 v0 = acc[ai][bj][m][0], v1 = acc[ai][bj][m][1]; u32x4 w; w.x = pk2(v0[0], v0[1]); w.y = pk2(v0[2], v0[3]); w.z = pk2(v1[0], v1[1]); w.w = pk2(v1[2], v1[3]); *(u32x4*)(rowp + bj * 128) = w; } }
  }
};

struct SchedRglru {
  const char* XCR; const char* W; int G, c, nt4;
  __device__ __forceinline__ bool next(int i, pg8::UnitG& u) const {
    const int L = i * G + c; if (L >= 640) return false;
    const int blk = L >> 6, rem = L & 63; u.e = blk; u.pm = rem >> 1; u.pn = rem & 1; u.cnt = 0; u.mt = 0; u.row0 = u.pm * 256; u.nt = nt4; u.keep = 0;
    u.A = XCR + ((size_t)u.pm * 256 * RW + 256 * blk) * 2; u.B = W + ((size_t)(blk * 512 + u.pn * 256) * 256) * 2; return true;
  }
  __device__ __forceinline__ unsigned arow(const pg8::UnitG&, int r) const { return (unsigned)r; }
};
struct EpiRglru {
  static constexpr bool PERM = true, FP8 = false;
  const bf16_t* XCR; const float* ba; const float* bx; const float* C8; float* RA; bf16_t* RBo;
  __device__ __forceinline__ void operator()(const f32x4 (&acc)[2][2][4][2], const pg8::UnitG& u, int wr, int wc, int fr, int fq) const {
    const int row0 = u.pm * 256 + wr * 64 + fr;
#pragma unroll
    for (int n = 0; n < 2; ++n) {
      const int ch = 256 * u.e + 128 * u.pn + 32 * wc + 8 * fq + 4 * n;
      const f32x4 vba = *(const f32x4*)(ba + ch), vbx = *(const f32x4*)(bx + ch), c8 = *(const f32x4*)(C8 + ch);
#pragma unroll
      for (int ai = 0; ai < 2; ++ai)
#pragma unroll
        for (int m = 0; m < 4; ++m) {
          const size_t off = (size_t)(row0 + ai * 128 + m * 16) * RW + ch;
          const u32x2 xw = *(const u32x2*)(XCR + off);
          const float xc[4] = {bflo(xw.x), bfhi(xw.x), bflo(xw.y), bfhi(xw.y)};
          f32x4 av; float bv[4];
#pragma unroll
          for (int j = 0; j < 4; ++j) {
            const float r = __builtin_amdgcn_rcpf(1.0f + __expf(-(acc[ai][0][m][n][j] + vba[j])));
            const float ig = __builtin_amdgcn_rcpf(1.0f + __expf(-(acc[ai][1][m][n][j] + vbx[j])));
            const float la = c8[j] * r;
            const float a = __expf(la);
            const float x2 = 2.0f * la;
            const float poly = -x2 * (1.0f + x2 * 0.5f * (1.0f + x2 * (1.0f / 3.0f) * (1.0f + x2 * 0.25f * (1.0f + x2 * 0.2f))));
            const float om = (x2 > -0.25f) ? poly : (1.0f - a * a);
            av[j] = a;
            bv[j] = sqrtf(fmaxf(om, 0.f)) * (ig * xc[j]);
          }
          *(f32x4*)(RA + off) = av;
          u32x2 w; w.x = pk2(bv[0], bv[1]); w.y = pk2(bv[2], bv[3]); *(u32x2*)(RBo + off) = w;
          asm volatile("" ::: "memory");
        }
    }
  }
};

struct SchedMerge {
  const char* YM; const char* YR; const char* WPM; const char* WPR; int G, c;
  __device__ __forceinline__ bool next(int i, pg8::UnitG& u) const {
    int pm, pn; if (!pg8::dense_order(i >> 1, G, c, NTOK / 256, DM / 256, pm, pn)) return false;
    const int seg = i & 1;
    u.pm = pm; u.pn = pn; u.e = seg; u.cnt = 0; u.mt = 0; u.row0 = pm * 256; u.nt = seg ? RW / 64 : MW / 64; u.keep = seg ? 0 : 1;
    u.A = (seg ? YR : YM) + (size_t)pm * 256 * RW * 2; u.B = (seg ? WPR : WPM) + (size_t)pn * 256 * RW * 2; return true;
  }
  __device__ __forceinline__ unsigned arow(const pg8::UnitG&, int r) const { return (unsigned)r; }
};
struct EpiMergeF {
  static constexpr bool PERM = true, FP8 = false;
  const bf16_t* PROJ; const float* bgate; bf16_t* MRG;
  __device__ __forceinline__ void operator()(f32x4 (&acc)[2][2][4][2], const pg8::UnitG& u, int wr, int wc, int fr, int fq) const {
    const int row0 = u.pm * 256 + wr * 64 + fr, col0 = u.pn * 256 + wc * 32 + 8 * fq;
#pragma unroll
    for (int bj = 0; bj < 2; ++bj) {
      const int col = col0 + bj * 128;
      const f32x4 b00 = *(const f32x4*)(bgate + col), b01 = *(const f32x4*)(bgate + col + 4), b10 = *(const f32x4*)(bgate + DM + col), b11 = *(const f32x4*)(bgate + DM + col + 4);
#pragma unroll
      for (int ai = 0; ai < 2; ++ai)
#pragma unroll
        for (int m = 0; m < 4; ++m) {
          const size_t row = (size_t)(row0 + ai * 128 + m * 16);
          const u32x4 g1w = *(const u32x4*)(PROJ + row * INC + O_G1 + col);
          const float g1p[8] = {bflo(g1w.x), bfhi(g1w.x), bflo(g1w.y), bfhi(g1w.y), bflo(g1w.z), bfhi(g1w.z), bflo(g1w.w), bfhi(g1w.w)};
          if (u.e == 0) {
            const u32x4 g0w = *(const u32x4*)(PROJ + row * INC + O_G0 + col);
            const float g0p[8] = {bflo(g0w.x), bfhi(g0w.x), bflo(g0w.y), bfhi(g0w.y), bflo(g0w.z), bfhi(g0w.z), bflo(g0w.w), bfhi(g0w.w)};
#pragma unroll
            for (int j = 0; j < 4; ++j) {
              acc[ai][bj][m][0][j] *= (1.0f + __expf(-(g1p[j] + b10[j]))) * __builtin_amdgcn_rcpf(1.0f + __expf(-(g0p[j] + b00[j])));
              acc[ai][bj][m][1][j] *= (1.0f + __expf(-(g1p[4 + j] + b11[j]))) * __builtin_amdgcn_rcpf(1.0f + __expf(-(g0p[4 + j] + b01[j])));
            }
          } else {
            f32x4 v0, v1;
#pragma unroll
            for (int j = 0; j < 4; ++j) { v0[j] = acc[ai][bj][m][0][j] * __builtin_amdgcn_rcpf(1.0f + __expf(-(g1p[j] + b10[j]))); v1[j] = acc[ai][bj][m][1][j] * __builtin_amdgcn_rcpf(1.0f + __expf(-(g1p[4 + j] + b11[j]))); }
            u32x4 w; w.x = pk2(v0[0], v0[1]); w.y = pk2(v0[2], v0[3]); w.z = pk2(v1[0], v1[1]); w.w = pk2(v1[2], v1[3]); *(u32x4*)(MRG + row * DM + col) = w;
          }
        }
    }
  }
};

struct EpiWo {
  static constexpr bool PERM = false, FP8 = false;
  const float* X; float* O;
  __device__ __forceinline__ void operator()(const f32x4 (&acc)[2][2][4][2], const pg8::UnitG& u, int wr, int wc, int fr, int fq) const {
    const int row0 = u.pm * 256 + wr * 64 + fr, col0 = u.pn * 256 + wc * 32 + 4 * fq;
#pragma unroll
    for (int ai = 0; ai < 2; ++ai)
#pragma unroll
      for (int m = 0; m < 4; ++m) { const size_t off = (size_t)(row0 + ai * 128 + m * 16) * DM + col0;
#pragma unroll
        for (int bj = 0; bj < 2; ++bj)
#pragma unroll
          for (int n = 0; n < 2; ++n) { const f32x4 x = *(const f32x4*)(X + off + bj * 128 + n * 16); *(f32x4*)(O + off + bj * 128 + n * 16) = x * ALPHA + acc[ai][bj][m][n]; } }
  }
};

struct MoeTab { const LAS int* tp; const LAS int* cp; const LAS int* cnt; int n_rt; };
template <int NT  , int STAGE  >
struct SchedMoe {
  MoeTab T; const int* LIST; const char* Abase; const char* Wr; const char* Ws; int G, c, ntv;
  __device__ __forceinline__ bool next(int i, pg8::UnitG& u) const {
    const int L = i * G + c; const int total = NT * (T.n_rt + 32); if (L >= total) return false;
    const int rt = L / NT, pn = L % NT; u.pn = pn; u.nt = ntv; u.keep = 0;
    constexpr int KK = (STAGE == 1) ? DM / 2 : DE / 2;
    constexpr int NN = NT * 256;
    if (rt < T.n_rt) {
      const int e = __builtin_amdgcn_readfirstlane(T.tp[256 + rt]);
      const int mt = rt - __builtin_amdgcn_readfirstlane(T.tp[e]);
      u.e = e; u.mt = mt; u.cnt = __builtin_amdgcn_readfirstlane(T.cnt[e]); u.pm = rt; u.row0 = rt * 256;
      u.B = Wr + ((size_t)e * NN + (size_t)pn * 256) * KK * 2;
    } else {
      u.e = NE; u.mt = rt - T.n_rt; u.cnt = NTOK; u.pm = rt; u.row0 = rt * 256;
      u.B = Ws + (size_t)pn * 256 * KK * 2;
    }
    if (STAGE == 2) u.pm = __builtin_amdgcn_readfirstlane(T.cp[u.e]);
    if (STAGE == 1) u.A = Abase;
    else u.A = Abase + (size_t)rt * 256 * DE;
    return true;
  }
  __device__ __forceinline__ unsigned arow(const pg8::UnitG& u, int r) const {
    if (u.e < NE) { int slot = u.mt * 256 + r; if (slot >= u.cnt) slot = 0; return (unsigned)LIST[u.e * NTOK + slot]; }
    return (unsigned)(u.mt * 256 + r);
  }
};
struct EpiMoe1 {
  static constexpr bool PERM = true, FP8 = true;
  unsigned char* H;
  __device__ __forceinline__ void operator()(const f32x4 (&acc)[2][2][4][2], const pg8::UnitG& u, int wr, int wc, int fr, int fq) const {
    const int row0 = u.row0 + wr * 64 + fr, col0 = u.pn * 128 + wc * 32 + 8 * fq;
#pragma unroll
    for (int ai = 0; ai < 2; ++ai)
#pragma unroll
      for (int m = 0; m < 4; ++m) { unsigned char* rowp = H + (size_t)(row0 + ai * 128 + m * 16) * DE + col0;
        float v[8];
#pragma unroll
        for (int n = 0; n < 2; ++n) { const f32x4 g = acc[ai][0][m][n], up = acc[ai][1][m][n];
#pragma unroll
          for (int j = 0; j < 4; ++j) { const float gg = g[j] * 0.015625f; v[4 * n + j] = gg * __builtin_amdgcn_rcpf(1.0f + __expf(-gg)) * (up[j] * 0.015625f); } }
        int q0 = 0, q1 = 0; q0 = __builtin_amdgcn_cvt_pk_fp8_f32(v[0], v[1], q0, false); q0 = __builtin_amdgcn_cvt_pk_fp8_f32(v[2], v[3], q0, true); q1 = __builtin_amdgcn_cvt_pk_fp8_f32(v[4], v[5], q1, false); q1 = __builtin_amdgcn_cvt_pk_fp8_f32(v[6], v[7], q1, true);
        u32x2 w; w.x = (unsigned)q0; w.y = (unsigned)q1; *(u32x2*)rowp = w; }
  }
};
struct EpiMoe2 {
  static constexpr bool PERM = true, FP8 = true;
  bf16_t* YRM; const float* LISTW; bf16_t* DUMMY;
  __device__ __forceinline__ void operator()(const f32x4 (&acc)[2][2][4][2], const pg8::UnitG& u, int wr, int wc, int fr, int fq) const {
    const int slot0 = u.mt * 256 + wr * 64 + fr;
    bf16_t* base = YRM + (size_t)(u.pm + slot0) * DM + u.pn * 256 + wc * 32 + 8 * fq;
    bf16_t* sink = DUMMY + (size_t)blockIdx.x * 8192 + ((wr * 4 + wc) * 64 + fq * 16 + fr) * 8;
    const float* lw = LISTW + u.e * NTOK + slot0;
    float wv[8];
#pragma unroll
    for (int i = 0; i < 8; ++i) wv[i] = lw[(i >> 2) * 128 + (i & 3) * 16];
#pragma unroll
    for (int ai = 0; ai < 2; ++ai)
#pragma unroll
      for (int m = 0; m < 4; ++m) { const int ds = ai * 128 + m * 16;
        const float w = wv[ai * 4 + m] * 0.03125f;
        bf16_t* rowp = (slot0 + ds < u.cnt) ? base + (size_t)ds * DM : sink;
#pragma unroll
        for (int bj = 0; bj < 2; ++bj) { const f32x4 v0 = acc[ai][bj][m][0] * w, v1 = acc[ai][bj][m][1] * w; u32x4 q; q.x = pk2(v0[0], v0[1]); q.y = pk2(v0[2], v0[3]); q.z = pk2(v1[0], v1[1]); q.w = pk2(v1[2], v1[3]); *(u32x4*)(rowp + bj * 128) = q; } }
  }
};


#define XB_TMO      128
#define XB_XCNT(j)  (256  + 64 * (j))
#define XB_XSUB(j)  (1280 + 64 * (j))
#define XB_XGEN(j)  (2304 + 64 * (j))
#define XB_TOP      3328
#define XB_TOPGEN   3392
#define XCD_BAR_WORDS 3456
#define XB_SPIN_CAP (1u << 18)
__device__ __forceinline__ unsigned xb_ld(unsigned* p)              { return __hip_atomic_load(p, __ATOMIC_RELAXED, __HIP_MEMORY_SCOPE_AGENT); }
__device__ __forceinline__ unsigned xb_add(unsigned* p, unsigned v) { return __hip_atomic_fetch_add(p, v, __ATOMIC_RELAXED, __HIP_MEMORY_SCOPE_AGENT); }
__device__ __forceinline__ unsigned xb_xcc_id() { return (unsigned)__builtin_amdgcn_s_getreg((3 << 11) | 20) & 0xFu; }
#define XB_SPIN(cond, bar) do { unsigned _sp = 0; while (cond) { __builtin_amdgcn_s_sleep(1); \
    if ((++_sp & 255u) == 0u) { if (xb_ld(&(bar)[XB_TMO])) break; if (_sp > XB_SPIN_CAP) { atomicAdd(&(bar)[XB_TMO], 1u); break; } } } } while (0)
struct XcdBarrier { unsigned* bar; unsigned x; volatile LAS unsigned* st; };
__device__ __forceinline__ XcdBarrier xcd_barrier_post(unsigned* bar, volatile LAS unsigned* st) {
    XcdBarrier b; b.bar = bar; b.x = xb_xcc_id(); b.st = st;
    if (threadIdx.x == 0) (void)xb_add(&bar[XB_XCNT(b.x)], 1u);
    return b;
}
__device__ __forceinline__ void xcd_barrier_complete(unsigned* bar, unsigned x, unsigned& nloc, unsigned& nx) {
    const unsigned G = gridDim.x * gridDim.y * gridDim.z;
    unsigned sum, cnt, mine, sp = 0u;
    for (;;) {
        sum = 0u; cnt = 0u; mine = 0u;
#pragma unroll
        for (unsigned j = 0; j < 16; ++j) { const unsigned c = xb_ld(&bar[XB_XCNT(j)]); sum += c; cnt += (c > 0u) ? 1u : 0u; mine = (j == x) ? c : mine; }
        if (sum == G) break;
        __builtin_amdgcn_s_sleep(1);
        if ((++sp & 255u) == 0u) { if (xb_ld(&bar[XB_TMO])) break; if (sp > XB_SPIN_CAP) { atomicAdd(&bar[XB_TMO], 1u); break; } }
    }
    nloc = mine > 0u ? mine : 1u; nx = cnt > 0u ? cnt : 1u;
}
__device__ __forceinline__ void xcd_barrier(const XcdBarrier& b) {
    asm volatile("s_waitcnt vmcnt(0)" ::: "memory");
    __syncthreads();
    if (threadIdx.x == 0) {
        unsigned* bar = b.bar;
        __builtin_amdgcn_s_waitcnt(0);
        unsigned nloc = b.st[0], nx = b.st[1];
        if (nloc == 0u) { xcd_barrier_complete(bar, b.x, nloc, nx); b.st[0] = nloc; b.st[1] = nx; }
        const unsigned old = xb_add(&bar[XB_XSUB(b.x)], 1u);
        const unsigned gen = old / nloc;
        if (old + 1u == (gen + 1u) * nloc) {
            __builtin_amdgcn_fence(__ATOMIC_RELEASE, "agent");
            asm volatile("s_waitcnt vmcnt(0)" ::: "memory");
            const unsigned og = xb_add(&bar[XB_TOP], 1u);
            const unsigned tg = og / nx;
            if (og + 1u == (tg + 1u) * nx) xb_add(&bar[XB_TOPGEN], 1u);
            else XB_SPIN(xb_ld(&bar[XB_TOPGEN]) == tg, bar);
            __builtin_amdgcn_fence(__ATOMIC_ACQUIRE, "agent");
            xb_add(&bar[XB_XGEN(b.x)], 1u);
            asm volatile("s_waitcnt vmcnt(0)" ::: "memory");
        } else {
            XB_SPIN(xb_ld(&bar[XB_XGEN(b.x)]) == gen, bar);
            __builtin_amdgcn_fence(__ATOMIC_ACQUIRE, "agent");
            asm volatile("s_waitcnt vmcnt(0)" ::: "memory");
        }
    }
    __syncthreads();
}

template <class T> __device__ __forceinline__ T* as_global(T* p) { const unsigned long long v = (unsigned long long)p; return (T*)(__attribute__((address_space(1))) T*)v; }
template <class T> __device__ __forceinline__ T* opaque_global(T* p) { unsigned long long v = (unsigned long long)p; asm volatile("" : "+s"(v)); return (T*)(__attribute__((address_space(1))) T*)v; }
struct InPtrs { const float* const* p; __device__ __forceinline__ const float* operator[](int k) const { return as_global(p[k]); } };
struct Frame {
  LAS unsigned char* lds; int tid, lane, wave, G, bid; unsigned char* ws; InPtrs in; float* out;
};

struct TJob { const float* W; unsigned char* WT; int N, ldtB, k0, n0, up, mode; float sc; };
__device__ __forceinline__ int gu_row(int n, int up) { return 256 * (n >> 7) + (n & 127) + up * 128; }
constexpr int TR0 = 16 * 104, TR1 = 16 * 16, TR2 = 20 * 16, TR3 = 16 * 16, TR4 = 2 * 10 * 4, TR5 = 2 * 16 * 4, TR6 = 4 * 16, TR7 = 2 * 64 * 16 * 4, TR8 = 64 * 4 * 16;
constexpr int T_NITEMS = TR0 + TR1 + TR2 + TR3 + TR4 + TR5 + TR6 + TR7 + TR8;
__device__ __forceinline__ TJob tj_decode(const Frame& F, int it) {
  unsigned char* ws = F.ws; int r = it;
  if (r < TR0) { const int kb = r / 104, nb = r % 104; return TJob{F.in[1], ws + WS_WIN, INC, DM * 2, 128 * kb, 128 * nb, 0, 0, 1.f}; } r -= TR0;
  if (r < TR1) { const int kb = r / 16, nb = r % 16; return TJob{F.in[19], ws + WS_WPM, DM, RW * 2, 128 * kb, 128 * nb, 0, 0, 1.f}; } r -= TR1;
  if (r < TR2) { const int kb = r / 16, nb = r % 16; return TJob{F.in[20], ws + WS_WPR, DM, RW * 2, 128 * kb, 128 * nb, 0, 0, 1.f}; } r -= TR2;
  if (r < TR3) { const int kb = r / 16, nb = r % 16; return TJob{F.in[21], ws + WS_WO, DM, DM * 2, 128 * kb, 128 * nb, 0, 0, 1.f}; } r -= TR3;
  if (r < TR4) { const int which = r / 40, rr = r % 40, blk = rr / 4, q = rr % 4; return TJob{F.in[which ? 16 : 14] + (size_t)blk * 65536, ws + WS_WRAX + (size_t)blk * 512 * 256 * 2, 256, 256 * 2, 128 * (q >> 1), 128 * (q & 1), which, 1, 1.f}; } r -= TR4;
  if (r < TR5) { const int which = r / 64, q = r % 64, kb = q / 4, nb = q % 4; return TJob{F.in[which ? 30 : 29], ws + WS_WSGU, DE, DM, 128 * kb, 128 * nb, which, 3, 64.f}; } r -= TR5;
  if (r < TR6) { const int kb = r / 16, nb = r % 16; return TJob{F.in[31], ws + WS_WSD, DM, DE, 128 * kb, 128 * nb, 0, 2, 32.f}; } r -= TR6;
  if (r < TR7) { const int which = r / 4096, rr = r % 4096, e = rr / 64, q = rr % 64, kb = q / 4, nb = q % 4; return TJob{F.in[which ? 27 : 26] + (size_t)e * DM * DE, ws + WS_WEGU + (size_t)e * 1024 * DM, DE, DM, 128 * kb, 128 * nb, which, 3, 64.f}; } r -= TR7;
  { const int e = r / 64, q = r % 64, kb = q / 16, nb = q % 16; return TJob{F.in[28] + (size_t)e * DE * DM, ws + WS_WED + (size_t)e * DM * DE, DM, DE, 128 * kb, 128 * nb, 0, 2, 32.f}; }
}
__device__ __forceinline__ void tj_load(const TJob& j, f32x4 (&v)[8], int wave, int lane) {
  const float* p = j.W + (size_t)(j.k0 + 16 * wave + (lane >> 5)) * j.N + j.n0 + 4 * (lane & 31);
#pragma unroll
  for (int i = 0; i < 8; ++i) v[i] = __builtin_nontemporal_load((const f32x4*)(p + (size_t)(2 * i) * j.N));
}
__device__ __forceinline__ void tj_store(const TJob& j, const f32x4 (&v)[8], LAS float* scr, int wave, int lane, int tid) {
#pragma unroll
  for (int i = 0; i < 8; ++i) { LAS float* d = scr + (16 * wave + 2 * i + (lane >> 5)) * 129 + 4 * (lane & 31); d[0] = v[i][0]; d[1] = v[i][1]; d[2] = v[i][2]; d[3] = v[i][3]; }
  LBAR();
  if (j.mode < 2) {
#pragma unroll
    for (int it = 0; it < 4; ++it) { const int idx = it * 512 + tid, n = idx >> 4, c = idx & 15; const LAS float* s = scr + (8 * c) * 129 + n;
      u32x4 o; o.x = pk2(s[0 * 129], s[1 * 129]); o.y = pk2(s[2 * 129], s[3 * 129]); o.z = pk2(s[4 * 129], s[5 * 129]); o.w = pk2(s[6 * 129], s[7 * 129]);
      const int nn = j.n0 + n; const int row = j.mode ? gu_row(nn, j.up) : nn;
      *(u32x4*)(j.WT + (size_t)row * j.ldtB + (j.k0 + 8 * c) * 2) = o; }
  } else {
#pragma unroll
    for (int it = 0; it < 2; ++it) { const int idx = it * 512 + tid, n = idx >> 3, c = idx & 7; const LAS float* s = scr + (16 * c) * 129 + n;
      int w[4];
#pragma unroll
      for (int q = 0; q < 4; ++q) { int t = 0; t = __builtin_amdgcn_cvt_pk_fp8_f32(s[(4 * q) * 129] * j.sc, s[(4 * q + 1) * 129] * j.sc, t, false); t = __builtin_amdgcn_cvt_pk_fp8_f32(s[(4 * q + 2) * 129] * j.sc, s[(4 * q + 3) * 129] * j.sc, t, true); w[q] = t; }
      u32x4 o; o.x = (unsigned)w[0]; o.y = (unsigned)w[1]; o.z = (unsigned)w[2]; o.w = (unsigned)w[3];
      const int nn = j.n0 + n; const int row = (j.mode == 3) ? gu_row(nn, j.up) : nn;
      __builtin_nontemporal_store(o, (u32x4*)(j.WT + (size_t)row * j.ldtB + j.k0 + 16 * c)); }
  }
  LBAR();
}

__device__ __forceinline__ void phase_prologue(const Frame& F) {
  LAS float* scr = (LAS float*)F.lds;
  unsigned char* ws = F.ws;
  {
    f32x4 vA[8], vB[8]; TJob jA, jB;
    int it = F.bid;
    if (it < T_NITEMS) { jA = tj_decode(F, it); tj_load(jA, vA, F.wave, F.lane); }
    while (it < T_NITEMS) {
      { const int itn = it + F.G; jB = tj_decode(F, itn < T_NITEMS ? itn : T_NITEMS - 1); tj_load(jB, vB, F.wave, F.lane); }
      tj_store(jA, vA, scr, F.wave, F.lane, F.tid);
      it += F.G; if (it >= T_NITEMS) break;
      { const int itn = it + F.G; jA = tj_decode(F, itn < T_NITEMS ? itn : T_NITEMS - 1); tj_load(jA, vA, F.wave, F.lane); }
      tj_store(jB, vB, scr, F.wave, F.lane, F.tid);
      it += F.G;
    }
  }
  const int gt = F.bid * 512 + F.tid, NGT = F.G * 512;
  { const float* x = F.in[0]; bf16_t* xb = (bf16_t*)(ws + WS_XB);
    for (int i = gt; i < NTOK * DM / 8; i += NGT) { const f32x4 a = *(const f32x4*)(x + (size_t)i * 8), b = *(const f32x4*)(x + (size_t)i * 8 + 4);
      u32x4 o; o.x = pk2(a[0], a[1]); o.y = pk2(a[2], a[3]); o.z = pk2(b[0], b[1]); o.w = pk2(b[2], b[3]); *(u32x4*)(xb + (size_t)i * 8) = o; } }
  { const float* wif = F.in[8]; bf16_t* wt = (bf16_t*)(ws + WS_SMALL + SM_WIFT);
    for (int i = gt; i < 16 * 6144; i += NGT) { const int n = i / 6144, k = i % 6144; float v = wif[k * 16 + n]; if (k >= 2048 && k < 4096) v *= 16.0f; wt[i] = (bf16_t)f2bf(v); } }
  { const float* lam = F.in[18]; float* c8 = (float*)(ws + WS_SMALL + SM_C8); for (int i = gt; i < RW; i += NGT) c8[i] = -8.0f * log1pf(expf(-lam[i])); }
  { const float* rwt = F.in[24]; bf16_t* rh = (bf16_t*)(ws + WS_SMALL + SM_RWH); bf16_t* rl = (bf16_t*)(ws + WS_SMALL + SM_RWL);
    for (int i = gt; i < NE * DM; i += NGT) { const int n = i / DM, k = i % DM; const float v = rwt[k * NE + n]; const unsigned h = f2bf(v); rh[i] = (bf16_t)h; rl[i] = (bf16_t)f2bf(v - __uint_as_float(h << 16)); } }
  { float* lw64 = (float*)(ws + WS_LISTW) + (size_t)NE * NTOK; for (int i = gt; i < NTOK; i += NGT) lw64[i] = 1.0f; }
  { int* ctl = (int*)(ws + WS_CTL); for (int i = gt; i < 4096; i += NGT) ctl[i] = 0; }
}

__device__ __forceinline__ void phase_mprep(const Frame& F) {
  unsigned char* ws = F.ws;
  const bf16_t* PROJ = (const bf16_t*)(ws + WS_PROJ);
  bf16_t* Q = (bf16_t*)(ws + WS_Q); bf16_t* Kb = (bf16_t*)(ws + WS_K); bf16_t* V = (bf16_t*)(ws + WS_V); bf16_t* XCM = (bf16_t*)(ws + WS_XCM);
  const bf16_t* WIFT = (const bf16_t*)(ws + WS_SMALL + SM_WIFT);
  float* IG = (float*)(ws + WS_SMALL + SM_IG); float* LF = (float*)(ws + WS_SMALL + SM_LF);
  const int g = F.tid;
  f32x4 cw[4]; for (int j = 0; j < 4; ++j) cw[j] = *(const f32x4*)(F.in[3] + j * MW + 4 * g);
  const f32x4 cb = *(const f32x4*)(F.in[4] + 4 * g);
  f32x4 wq[4], wk[4], wv[4];
  for (int i = 0; i < 4; ++i) { wq[i] = *(const f32x4*)(F.in[5] + g * 16 + 4 * i); wk[i] = *(const f32x4*)(F.in[6] + g * 16 + 4 * i); wv[i] = *(const f32x4*)(F.in[7] + g * 16 + 4 * i); }
  LAS unsigned char* AIMG = F.lds; LAS float* red = (LAS float*)(F.lds + 98432);
  const int r = F.lane & 15, gq = F.lane >> 4;
  for (int tile = F.bid; tile < NTOK / 8; tile += F.G) {
    const int t0 = tile * 8, s0 = t0 & (SEQ - 1);
    u32x2 rw[11];
#pragma unroll
    for (int j = 0; j < 11; ++j) { const int pos = s0 - 3 + j; rw[j] = (pos >= 0) ? *(const u32x2*)(PROJ + (size_t)(t0 - 3 + j) * INC + 4 * g) : (u32x2){0u, 0u}; }
#pragma unroll
    for (int tt = 0; tt < 8; ++tt) {
      const int t = t0 + tt;
      f32x4 xw[4];
#pragma unroll
      for (int j = 0; j < 4; ++j) xw[j] = (f32x4){bflo(rw[tt + j].x), bfhi(rw[tt + j].x), bflo(rw[tt + j].y), bfhi(rw[tt + j].y)};
      const f32x4 cv = cb + cw[0] * xw[0] + cw[1] * xw[1] + cw[2] * xw[2] + cw[3] * xw[3];
      f32x4 xc; for (int i = 0; i < 4; ++i) xc[i] = cv[i] * __builtin_amdgcn_rcpf(1.0f + __expf(-cv[i]));
      const f32x4 q = xc[0] * wq[0] + xc[1] * wq[1] + xc[2] * wq[2] + xc[3] * wq[3];
      f32x4 k = xc[0] * wk[0] + xc[1] * wk[1] + xc[2] * wk[2] + xc[3] * wk[3];
      const f32x4 v = xw[3][0] * wv[0] + xw[3][1] * wv[1] + xw[3][2] * wv[2] + xw[3][3] * wv[3];
      k = k * 0.0625f;
      const size_t o = (size_t)t * MW + 4 * g;
      u32x2 wqv, wkv, wvv, wxc;
      wqv.x = pk2(q[0], q[1]); wqv.y = pk2(q[2], q[3]); *(u32x2*)(Q + o) = wqv;
      wkv.x = pk2(k[0], k[1]); wkv.y = pk2(k[2], k[3]); *(u32x2*)(Kb + o) = wkv;
      wvv.x = pk2(v[0], v[1]); wvv.y = pk2(v[2], v[3]); *(u32x2*)(V + o) = wvv;
      wxc.x = pk2(xc[0], xc[1]); wxc.y = pk2(xc[2], xc[3]); *(u32x2*)(XCM + o) = wxc;
      LAS unsigned char* ar = AIMG + tt * 12304 + 8 * g;
      *(LAS u32x2*)(ar) = wqv; *(LAS u32x2*)(ar + 4096) = wkv; *(LAS u32x2*)(ar + 8192) = wvv;
    }
    LBAR();
    {
      f32x4 acc = (f32x4){0.f, 0.f, 0.f, 0.f};
#pragma unroll
      for (int ib = 0; ib < 3; ++ib) {
        bf16x8 bfr[8];
#pragma unroll
        for (int i = 0; i < 8; ++i) { const int ks = F.wave * 24 + ib * 8 + i; bfr[i] = *(const bf16x8*)(WIFT + (size_t)r * 6144 + ks * 32 + 8 * gq); }
#pragma unroll
        for (int i = 0; i < 8; ++i) { const int ks = F.wave * 24 + ib * 8 + i;
          const bf16x8 a = *(const LAS bf16x8*)(AIMG + (r & 7) * 12304 + (ks * 32 + 8 * gq) * 2);
          acc = __builtin_amdgcn_mfma_f32_16x16x32_bf16(a, bfr[i], acc, 0, 0, 0); }
      }
#pragma unroll
      for (int j = 0; j < 4; ++j) red[F.wave * 256 + (4 * gq + j) * 16 + r] = acc[j];
    }
    LBAR();
    if (F.tid < 128) {
      const int row = F.tid >> 4, n = F.tid & 15;
      float s = F.in[9][n];
#pragma unroll
      for (int w = 0; w < 8; ++w) s += red[w * 256 + F.tid];
      const int t = t0 + row, b = t >> 12, sp = t & (SEQ - 1);
      if (n < 8) IG[(size_t)(b * 8 + n) * SEQ + sp] = s;
      else LF[(size_t)(b * 8 + (n - 8)) * SEQ + sp] = fminf(s, 0.f) - log1pf(__expf(-fabsf(s)));
    }
    LBAR();
  }
}

__device__ __forceinline__ void phase_rconv(const Frame& F) {
  unsigned char* ws = F.ws;
  const bf16_t* PROJ = (const bf16_t*)(ws + WS_PROJ); bf16_t* XCR = (bf16_t*)(ws + WS_XCR);
  const int gt = F.bid * 512 + F.tid, NGT = F.G * 512;
  for (int it = gt; it < (NTOK / 16) * 640; it += NGT) {
    const int tile = it / 640, g = it % 640, t0 = tile * 16, s0 = t0 & (SEQ - 1);
    f32x4 cw[4]; for (int j = 0; j < 4; ++j) cw[j] = *(const f32x4*)(F.in[12] + j * RW + 4 * g);
    const f32x4 cb = *(const f32x4*)(F.in[13] + 4 * g);
    u32x2 rw[19];
#pragma unroll
    for (int j = 0; j < 19; ++j) { const int pos = s0 - 3 + j; rw[j] = (pos >= 0) ? *(const u32x2*)(PROJ + (size_t)(t0 - 3 + j) * INC + O_XR + 4 * g) : (u32x2){0u, 0u}; }
#pragma unroll
    for (int tt = 0; tt < 16; ++tt) {
      f32x4 cv = cb;
#pragma unroll
      for (int j = 0; j < 4; ++j) cv = cv + cw[j] * (f32x4){bflo(rw[tt + j].x), bfhi(rw[tt + j].x), bflo(rw[tt + j].y), bfhi(rw[tt + j].y)};
      u32x2 w; w.x = pk2(cv[0], cv[1]); w.y = pk2(cv[2], cv[3]); *(u32x2*)(XCR + (size_t)(t0 + tt) * RW + 4 * g) = w;
    }
  }
}

__device__ __forceinline__ float chunk_m(const float* IG, const float* LF, int bh, int c, int lane, int wave, LAS float* CS) {
  for (int cc = wave; cc < c; cc += 8) {
    const float lf = LF[(size_t)bh * SEQ + 64 * cc + lane], ig = IG[(size_t)bh * SEQ + 64 * cc + lane];
    const float b = wave_scan_sum(lf, lane), gmax = wave_max(ig - b);
    if (lane == 63) { CS[cc] = b; CS[64 + cc] = b + gmax; }
  }
  __syncthreads();
  float A = 0.f, B = -INFINITY;
  if (lane < c) { A = CS[lane]; B = CS[64 + lane]; }
#pragma unroll
  for (int o = 1; o < 64; o <<= 1) { const float pA = __shfl_up(A, o), pB = __shfl_up(B, o); if (lane >= o) { B = fmaxf(pB + A, B); A = pA + A; } }
  const float mafter = fmaxf(A, B);
  const float mc = __shfl(mafter, c > 0 ? c - 1 : 0);
  return c > 0 ? mc : 0.f;
}

__device__ __forceinline__ void phase_m1(const Frame& F, const int bid2, const int G2) {
  unsigned char* ws = F.ws;
  const bf16_t* Q = (const bf16_t*)(ws + WS_Q); const bf16_t* Kb = (const bf16_t*)(ws + WS_K); const bf16_t* V = (const bf16_t*)(ws + WS_V);
  const float* IG = (const float*)(ws + WS_SMALL + SM_IG); const float* LF = (const float*)(ws + WS_SMALL + SM_LF);
  float* INTER = (float*)(ws + WS_SMALL + SM_INTER); float* EMR = (float*)(ws + WS_SMALL + SM_EMR); float* DENI = (float*)(ws + WS_SMALL + SM_DENI);
  bf16_t* HNI = (bf16_t*)(ws + WS_HNI);
  LAS unsigned char* QS = F.lds; LAS unsigned char* KS = F.lds + 33792; LAS unsigned char* VT = F.lds + 67584; LAS unsigned char* PS = F.lds + 104448;
  LAS float* SCg = (LAS float*)(F.lds + 113664); LAS float* SCM = SCg + 64;
  const int r = F.lane & 15, gq = F.lane >> 4, w = F.wave;
  for (int item = bid2; item < 16 * NCH; item += G2) {
    const int bh = item / NCH, c = item % NCH, b = bh >> 3, h = bh & 7, tok0 = b * SEQ + 64 * c;
    const float m = chunk_m(IG, LF, bh, c, F.lane, w, (LAS float*)(F.lds + 114176));
    const float lf_c = LF[(size_t)bh * SEQ + 64 * c + F.lane], ig_c = IG[(size_t)bh * SEQ + 64 * c + F.lane];
    const float b_l = wave_scan_sum(lf_c, F.lane), g_l = ig_c - b_l;
    const float M_l = fmaxf(m, wave_scan_max(g_l, F.lane));
    if (w == 0) { SCg[F.lane] = g_l; SCM[F.lane] = M_l; INTER[(size_t)(tok0 + F.lane) * 8 + h] = __expf(m - M_l); EMR[(size_t)(tok0 + F.lane) * 8 + h] = __expf(-(b_l + M_l)); }
#pragma unroll
    for (int i = 0; i < 4; ++i) {
      const int idx = i * 512 + F.tid, row = idx >> 5, c16 = idx & 31;
      const size_t go = (size_t)(tok0 + row) * MW + 256 * h + 8 * c16;
      *(LAS u32x4*)(QS + row * 528 + c16 * 16) = *(const u32x4*)(Q + go);
      *(LAS u32x4*)(KS + row * 528 + c16 * 16) = *(const u32x4*)(Kb + go);
    }
    {
      const int sp = F.tid & 31, cq = F.tid >> 5;
#pragma unroll
      for (int i = 0; i < 2; ++i) {
        const size_t go = (size_t)(tok0 + 2 * sp) * MW + 256 * h + 8 * (cq + 16 * i);
        const u32x4 v0 = *(const u32x4*)(V + go), v1 = *(const u32x4*)(V + go + MW);
        const unsigned a0[4] = {v0.x, v0.y, v0.z, v0.w}, a1[4] = {v1.x, v1.y, v1.z, v1.w};
#pragma unroll
        for (int e = 0; e < 4; ++e) { const int dv = 8 * (cq + 16 * i) + 2 * e;
          *(LAS unsigned*)(VT + dv * 144 + sp * 4) = (a0[e] & 0xffffu) | (a1[e] << 16);
          *(LAS unsigned*)(VT + (dv + 1) * 144 + sp * 4) = (a0[e] >> 16) | (a1[e] & 0xffff0000u); }
      }
    }
    __syncthreads();
    {
      const int mi = w & 3;
#pragma unroll
      for (int nn = 0; nn < 2; ++nn) {
        const int ni = 2 * (w >> 2) + nn;
        f32x4 acc = (f32x4){0.f, 0.f, 0.f, 0.f};
        if (ni <= mi) {
#pragma unroll
          for (int ks = 0; ks < 8; ++ks) {
            const bf16x8 a = *(const LAS bf16x8*)(QS + (16 * mi + r) * 528 + (32 * ks + 8 * gq) * 2);
            const bf16x8 bb = *(const LAS bf16x8*)(KS + (16 * ni + r) * 528 + (32 * ks + 8 * gq) * 2);
            acc = __builtin_amdgcn_mfma_f32_16x16x32_bf16(a, bb, acc, 0, 0, 0);
          }
        }
        const int s = 16 * ni + r; const float gs = SCg[s];
#pragma unroll
        for (int j = 0; j < 4; ++j) { const int l = 16 * mi + 4 * gq + j; const float p = (s <= l) ? acc[j] * __expf(gs - SCM[l]) : 0.f; *(LAS bf16_t*)(PS + l * 144 + s * 2) = (bf16_t)f2bf(p); }
      }
    }
    __syncthreads();
    if (F.tid < 64) { float s = 0.f; for (int k = 0; k < 64; ++k) s += bf1(*(const LAS bf16_t*)(PS + F.tid * 144 + k * 2)); DENI[(size_t)(tok0 + F.tid) * 8 + h] = s; }
#pragma unroll
    for (int nn = 0; nn < 2; ++nn) {
      const int ni = 2 * w + nn;
#pragma unroll
      for (int mi = 0; mi < 4; ++mi) {
        f32x4 acc = (f32x4){0.f, 0.f, 0.f, 0.f};
#pragma unroll
        for (int ks = 0; ks < 2; ++ks) {
          const bf16x8 a = *(const LAS bf16x8*)(PS + (16 * mi + r) * 144 + (32 * ks + 8 * gq) * 2);
          const bf16x8 bb = *(const LAS bf16x8*)(VT + (16 * ni + r) * 144 + (32 * ks + 8 * gq) * 2);
          acc = __builtin_amdgcn_mfma_f32_16x16x32_bf16(a, bb, acc, 0, 0, 0);
        }
#pragma unroll
        for (int j = 0; j < 4; ++j) HNI[(size_t)(tok0 + 16 * mi + 4 * gq + j) * MW + 256 * h + 16 * ni + r] = (bf16_t)f2bf(acc[j]);
      }
    }
    __syncthreads();
  }
}

__device__ __forceinline__ void phase_m2(const Frame& F, const int nblk) {
  unsigned char* ws = F.ws;
  const bf16_t* Q = (const bf16_t*)(ws + WS_Q); const bf16_t* Kb = (const bf16_t*)(ws + WS_K); const bf16_t* V = (const bf16_t*)(ws + WS_V);
  const float* IG = (const float*)(ws + WS_SMALL + SM_IG); const float* LF = (const float*)(ws + WS_SMALL + SM_LF);
  float* QN = (float*)(ws + WS_SMALL + SM_QN);
  bf16_t* HNE = (bf16_t*)(ws + WS_HNE);
  LAS unsigned char* QS = F.lds; LAS unsigned char* KT = F.lds + 33792; LAS unsigned char* WVT = F.lds + 70656; LAS unsigned char* CT = F.lds + 77568;
  LAS float* TD = (LAS float*)(F.lds + 111360); LAS float* CS = (LAS float*)(F.lds + 111616);
  float* DUMMY = (float*)(ws + WS_M2TAB + 4 * MiB);
  const int w = F.wave;
  for (int item = F.bid; item < 128; item += nblk) {
    const int bh = item >> 3, sl = item & 7, b = bh >> 3, h = bh & 7, dv0 = 32 * sl;
    float* TI = (float*)(ws + WS_M2TAB) + (size_t)item * 8192; float* TW = TI + 4096;
    const int lane = F.lane;
    for (int i = F.tid; i < (6912 + 33792) / 4; i += 512) *(LAS unsigned*)(WVT + 4 * i) = 0u;
    float gk[8], pk[8];
#pragma unroll
    for (int i = 0; i < 8; ++i) {
      const int cc = w + 8 * i;
      const float lf = LF[(size_t)bh * SEQ + 64 * cc + lane], ig = IG[(size_t)bh * SEQ + 64 * cc + lane];
      const float bl = wave_scan_sum(lf, lane), g = ig - bl;
      const float gmax = wave_max(g), pm = wave_scan_max(g, lane);
      gk[i] = g; pk[i] = pm;
      if (lane == 63) { CS[cc] = bl; CS[64 + cc] = bl + gmax; }
    }
    __syncthreads();
    {
      float A = CS[lane], B = CS[64 + lane]; const float gmx = B - A;
#pragma unroll
      for (int o = 1; o < 64; o <<= 1) { const float pA = __shfl_up(A, o), pB = __shfl_up(B, o); if (lane >= o) { B = fmaxf(pB + A, B); A = pA + A; } }
      const float mafter = fmaxf(A, B);
      float mstart = __shfl_up(mafter, 1); if (lane == 0) mstart = 0.f;
      const float M63 = fmaxf(mstart, gmx);
      if (w == 0) TD[lane] = __expf(mstart - M63);
#pragma unroll
      for (int i = 0; i < 8; ++i) {
        const int cc = w + 8 * i;
        const float ms = __shfl(mstart, cc), m6 = __shfl(M63, cc);
        TI[cc * 64 + lane] = __expf(ms - fmaxf(ms, pk[i])); TW[cc * 64 + lane] = __expf(gk[i] - m6);
      }
    }
    __threadfence(); __syncthreads();
    f32x4 acc[2][3];
#pragma unroll
    for (int a = 0; a < 2; ++a)
#pragma unroll
      for (int n = 0; n < 3; ++n) acc[a][n] = (f32x4){0.f, 0.f, 0.f, 0.f};
    u32x4 qrA[4], krA[2][2], vrA = (u32x4){0u, 0u, 0u, 0u}, qrB[4], krB[2][2], vrB = (u32x4){0u, 0u, 0u, 0u};
    float wsA = 0.f, wsB = 0.f; f32x4 ivA = (f32x4){0.f, 0.f, 0.f, 0.f}, ivB = ivA;
#define M2_LOAD(qreg, kreg, vreg, wsr, ivr, c) do { const int tk_ = b * SEQ + 64 * (c); \
      _Pragma("unroll") for (int i = 0; i < 4; ++i) { const int idx = i * 512 + tdx, row = idx >> 5, c16 = idx & 31; qreg[i] = *(const u32x4*)(Q + (size_t)(tk_ + row) * MW + 256 * h + 8 * c16); } \
      _Pragma("unroll") for (int i = 0; i < 2; ++i) { const size_t go = (size_t)(tk_ + 2 * sp) * MW + 256 * h + 8 * (cq + 16 * i); kreg[i][0] = *(const u32x4*)(Kb + go); kreg[i][1] = *(const u32x4*)(Kb + go + MW); } \
      vreg = *(const u32x4*)(V + (size_t)(tk_ + lane) * MW + 256 * h + dv0 + 8 * (w & 3)); \
      wsr = TW[(c) * 64 + lane]; \
      ivr = *(const f32x4*)(TI + (c) * 64 + 16 * (w & 3) + 4 * gq); } while (0)
#define M2_AMMA(mi, nt) \
        f32x4 a2 = (f32x4){0.f, 0.f, 0.f, 0.f}; \
        _Pragma("unroll") for (int ks = 0; ks < 8; ++ks) { \
          const bf16x8 a = *(const LAS bf16x8*)(QS + (16 * (mi) + r) * 528 + (32 * ks + 8 * gq) * 2); \
          const bf16x8 bb = *(const LAS bf16x8*)(CT + (16 * (nt) + r) * 528 + (32 * ks + 8 * gq) * 2); \
          a2 = __builtin_amdgcn_mfma_f32_16x16x32_bf16(a, bb, a2, 0, 0, 0); }
#define M2_ATILE_H(mi, nt, tok0, ivr) do { M2_AMMA(mi, nt) \
        _Pragma("unroll") for (int j = 0; j < 4; ++j) { const int l = 16 * (mi) + 4 * gq + j; \
          HNE[(size_t)((tok0) + l) * MW + 256 * h + dv0 + 16 * (nt) + r] = (bf16_t)f2bf(a2[j] * ivr[j]); } } while (0)
#define M2_ATILE_Q(mi, nt, tok0, ivr) do { M2_AMMA(mi, nt) \
        _Pragma("unroll") for (int j = 0; j < 4; ++j) { const int l = 16 * (mi) + 4 * gq + j; \
          float* qp = ((nt) == 2 && r == 0) ? (QN + (size_t)((tok0) + l) * 8 + h) : (DUMMY + tdx * 4 + j); *qp = a2[j] * ivr[j]; } } while (0)
#define M2_BODY(c, qreg, kreg, vreg, wsr, ivr) do { \
      int tdx = (int)threadIdx.x; asm volatile("" : "+v"(tdx)); \
      const int lane = tdx & 63, r = lane & 15, gq = lane >> 4, sp = tdx & 31, cq = tdx >> 5; \
      const int tok0 = b * SEQ + 64 * (c); \
      _Pragma("unroll") for (int i = 0; i < 4; ++i) { const int idx = i * 512 + tdx, row = idx >> 5, c16 = idx & 31; *(LAS u32x4*)(QS + row * 528 + c16 * 16) = qreg[i]; } \
      _Pragma("unroll") for (int i = 0; i < 2; ++i) { \
        const unsigned k0[4] = {kreg[i][0].x, kreg[i][0].y, kreg[i][0].z, kreg[i][0].w}, k1[4] = {kreg[i][1].x, kreg[i][1].y, kreg[i][1].z, kreg[i][1].w}; \
        _Pragma("unroll") for (int e = 0; e < 4; ++e) { const int dk = 8 * (cq + 16 * i) + 2 * e; \
          *(LAS unsigned*)(KT + dk * 144 + sp * 4) = (k0[e] & 0xffffu) | (k1[e] << 16); \
          *(LAS unsigned*)(KT + (dk + 1) * 144 + sp * 4) = (k0[e] >> 16) | (k1[e] & 0xffff0000u); } } \
      if (w < 4) { const unsigned vw[4] = {vreg.x, vreg.y, vreg.z, vreg.w}; \
        _Pragma("unroll") for (int e = 0; e < 4; ++e) { *(LAS bf16_t*)(WVT + (8 * w + 2 * e) * 144 + lane * 2) = (bf16_t)f2bf(bflo(vw[e]) * wsr); *(LAS bf16_t*)(WVT + (8 * w + 2 * e + 1) * 144 + lane * 2) = (bf16_t)f2bf(bfhi(vw[e]) * wsr); } \
      } else if (w == 4) { *(LAS bf16_t*)(WVT + 32 * 144 + lane * 2) = (bf16_t)f2bf(wsr); } \
      const f32x4 ivc = ivr; \
      { const int cn_ = ((c) + 2 < NCH) ? (c) + 2 : NCH - 1; M2_LOAD(qreg, kreg, vreg, wsr, ivr, cn_); } \
      LBAR(); \
      M2_ATILE_H(w & 3, w >> 2, tok0, ivc); \
      M2_ATILE_Q(w & 3, 2 + (w >> 2), tok0, ivc); \
      const float decay = TD[(c)]; \
      _Pragma("unroll") for (int mt = 0; mt < 2; ++mt) \
        _Pragma("unroll") for (int n2 = 0; n2 < 3; ++n2) { \
          f32x4 cacc = acc[mt][n2] * decay; \
          _Pragma("unroll") for (int ks = 0; ks < 2; ++ks) { \
            const bf16x8 a = *(const LAS bf16x8*)(KT + (32 * w + 16 * mt + r) * 144 + (32 * ks + 8 * gq) * 2); \
            const bf16x8 bb = *(const LAS bf16x8*)(WVT + (16 * n2 + r) * 144 + (32 * ks + 8 * gq) * 2); \
            cacc = __builtin_amdgcn_mfma_f32_16x16x32_bf16(a, bb, cacc, 0, 0, 0); } \
          acc[mt][n2] = cacc; } \
      LBAR(); \
      _Pragma("unroll") for (int mt = 0; mt < 2; ++mt) \
        _Pragma("unroll") for (int n2 = 0; n2 < 3; ++n2) { u32x2 q; q.x = pk2(acc[mt][n2][0], acc[mt][n2][1]); q.y = pk2(acc[mt][n2][2], acc[mt][n2][3]); \
          *(LAS u32x2*)(CT + (16 * n2 + r) * 528 + (32 * w + 16 * mt + 4 * gq) * 2) = q; } \
    } while (0)
    { const int tdx = F.tid, sp = tdx & 31, cq = tdx >> 5, gq = (tdx & 63) >> 4;
      M2_LOAD(qrA, krA, vrA, wsA, ivA, 0);
      M2_LOAD(qrB, krB, vrB, wsB, ivB, 1); }
    __syncthreads();
#pragma unroll 1
    for (int c = 0; c < NCH; c += 2) {
      M2_BODY(c, qrA, krA, vrA, wsA, ivA);
      M2_BODY(c + 1, qrB, krB, vrB, wsB, ivB);
    }
#undef M2_BODY
#undef M2_ATILE_H
#undef M2_ATILE_Q
#undef M2_AMMA
#undef M2_LOAD
    __syncthreads();
  }
}

__device__ __forceinline__ void phase_ragg(const Frame& F) {
  unsigned char* ws = F.ws;
  const float* RA = (const float*)(ws + WS_RA); const bf16_t* RBb = (const bf16_t*)(ws + WS_RB);
  float* AGGA = (float*)(ws + WS_SMALL + SM_AGGA); float* AGGB = (float*)(ws + WS_SMALL + SM_AGGB);
  const int gt = F.bid * 512 + F.tid, NGT = F.G * 512;
#pragma unroll 1
  for (int it = gt; it < 2 * NCH * RW; it += NGT) {
    const int bc = it / RW, ch = it - bc * RW;
    const float* pa = RA + (size_t)bc * 64 * RW + ch; const bf16_t* pb = RBb + (size_t)bc * 64 * RW + ch;
    float A = 1.f, B = 0.f;
#pragma unroll 1
    for (int tb = 0; tb < 8; ++tb) {
      float a[8]; float bb[8];
#pragma unroll
      for (int t = 0; t < 8; ++t) { a[t] = pa[(size_t)(tb * 8 + t) * RW]; bb[t] = bf1(pb[(size_t)(tb * 8 + t) * RW]); }
#pragma unroll
      for (int t = 0; t < 8; ++t) { A *= a[t]; B = a[t] * B + bb[t]; }
    }
    AGGA[it] = A; AGGB[it] = B;
  }
}
__device__ __forceinline__ void phase_rscan(const Frame& F) {
  unsigned char* ws = F.ws;
  const float* RA = (const float*)(ws + WS_RA); const bf16_t* RBb = (const bf16_t*)(ws + WS_RB);
  const float* AGGA = (const float*)(ws + WS_SMALL + SM_AGGA); const float* AGGB = (const float*)(ws + WS_SMALL + SM_AGGB);
  const bf16_t* PROJ = (const bf16_t*)(ws + WS_PROJ); bf16_t* YR = (bf16_t*)(ws + WS_YR);
  const int gt = F.bid * 512 + F.tid, NGT = F.G * 512;
  for (int it = gt; it < 2 * NCH * RW; it += NGT) {
    const int bc = it / RW, ch = it % RW, t0 = bc * 64, b = bc / NCH, cidx = bc % NCH;
    float hcar = 0.f;
    for (int c0 = 0; c0 < cidx; c0 += 16) {
      float ca[16], cb[16];
#pragma unroll
      for (int k = 0; k < 16; ++k) { const int cc = c0 + k; const int j = (b * NCH + (cc < cidx ? cc : 0)) * RW + ch; ca[k] = AGGA[j]; cb[k] = AGGB[j]; }
#pragma unroll
      for (int k = 0; k < 16; ++k) { if (c0 + k < cidx) hcar = ca[k] * hcar + cb[k]; }
    }
#pragma unroll
    for (int tb = 0; tb < 4; ++tb) {
      float a[16]; bf16_t bb[16], xg[16];
#pragma unroll
      for (int t = 0; t < 16; ++t) { const size_t o = (size_t)(t0 + tb * 16 + t) * RW + ch; a[t] = RA[o]; bb[t] = RBb[o]; xg[t] = PROJ[(size_t)(t0 + tb * 16 + t) * INC + O_XG + ch]; }
#pragma unroll
      for (int t = 0; t < 16; ++t) { hcar = a[t] * hcar + bf1(bb[t]); YR[(size_t)(t0 + tb * 16 + t) * RW + ch] = (bf16_t)f2bf(hcar * gelu_tanh(bf1(xg[t]))); }
    }
  }
}

__device__ __forceinline__ void phase_ym(const Frame& F) {
  unsigned char* ws = F.ws;
  const bf16_t* HNI = (const bf16_t*)(ws + WS_HNI); const bf16_t* HNE = (const bf16_t*)(ws + WS_HNE);
  const float* EMR = (const float*)(ws + WS_SMALL + SM_EMR); const float* DENI = (const float*)(ws + WS_SMALL + SM_DENI); const float* QN = (const float*)(ws + WS_SMALL + SM_QN);
  const bf16_t* XCM = (const bf16_t*)(ws + WS_XCM); const bf16_t* PROJ = (const bf16_t*)(ws + WS_PROJ); bf16_t* YM = (bf16_t*)(ws + WS_YM);
  const float* normw = F.in[10]; const float* skip = F.in[11];
  const int gw = F.bid * 8 + F.wave, NGW = F.G * 8, lane = F.lane;
  for (int t = gw; t < NTOK; t += NGW) {
    u32x2 a[8], e[8], xcw[8], zw[8]; float den[8], emr[8];
#pragma unroll
    for (int h = 0; h < 8; ++h) {
      const size_t o = (size_t)t * MW + 256 * h + 4 * lane;
      a[h] = *(const u32x2*)(HNI + o); e[h] = *(const u32x2*)(HNE + o); xcw[h] = *(const u32x2*)(XCM + o); zw[h] = *(const u32x2*)(PROJ + (size_t)t * INC + O_Z + 256 * h + 4 * lane);
      den[h] = DENI[t * 8 + h] + QN[t * 8 + h]; emr[h] = EMR[t * 8 + h];
    }
#pragma unroll
    for (int h = 0; h < 8; ++h) {
      const int col = 256 * h + 4 * lane;
      const float inv = 1.0f / fmaxf(fabsf(den[h]), emr[h]);
      const float hv[4] = {(bflo(a[h].x) + bflo(e[h].x)) * inv, (bfhi(a[h].x) + bfhi(e[h].x)) * inv, (bflo(a[h].y) + bflo(e[h].y)) * inv, (bfhi(a[h].y) + bfhi(e[h].y)) * inv};
      const float mean = wave_sum((hv[0] + hv[1]) + (hv[2] + hv[3])) * (1.0f / 256.0f);
      float d[4]; float s2 = 0.f;
#pragma unroll
      for (int j = 0; j < 4; ++j) { d[j] = hv[j] - mean; s2 += d[j] * d[j]; }
      const float rstd = rsqrtf(wave_sum(s2) * (1.0f / 256.0f) + LN_EPS);
      const f32x4 nw = *(const f32x4*)(normw + col), sk = *(const f32x4*)(skip + col);
      const float xc[4] = {bflo(xcw[h].x), bfhi(xcw[h].x), bflo(xcw[h].y), bfhi(xcw[h].y)}, z[4] = {bflo(zw[h].x), bfhi(zw[h].x), bflo(zw[h].y), bfhi(zw[h].y)};
      float y[4];
#pragma unroll
      for (int j = 0; j < 4; ++j) y[j] = (d[j] * rstd * nw[j] + sk[j] * xc[j]) * siluf_(z[j]);
      u32x2 w; w.x = pk2(y[0], y[1]); w.y = pk2(y[2], y[3]); *(u32x2*)(YM + (size_t)t * RW + col) = w;
    }
  }
}

__device__ __forceinline__ void phase_ln_router(const Frame& F) {
  unsigned char* ws = F.ws;
  float* X1 = (float*)(ws + WS_X1); unsigned char* X1Q = ws + WS_X1B;
  int* CNT = (int*)(ws + WS_CTL); int* LIST = (int*)(ws + WS_LIST); float* LISTW = (float*)(ws + WS_LISTW); int* TOKES = (int*)(ws + WS_TOKES);
  const float* g1 = F.in[22]; const float* b1 = F.in[23]; const float* rw = F.in[24]; const float* rbias = F.in[25];
  LAS unsigned char* XH = F.lds; LAS unsigned char* XL = F.lds + 65792;
  const bf16_t* RWH = (const bf16_t*)(ws + WS_SMALL + SM_RWH); const bf16_t* RWL = (const bf16_t*)(ws + WS_SMALL + SM_RWL);
  const int w = F.wave;
  for (int tile = F.bid; tile < NTOK / 16; tile += F.G) {
    const int t0 = tile * 16;
    int lane = F.lane; asm volatile("" : "+v"(lane));
    const int r16 = lane & 15, gq = lane >> 4;
#pragma unroll 1
    for (int q = 0; q < 2; ++q) {
      const int tl = 2 * w + q, t = t0 + tl;
      float* xr = X1 + (size_t)t * DM;
      f32x4 v[8]; float s = 0.f;
#pragma unroll
      for (int j = 0; j < 8; ++j) { v[j] = *(const f32x4*)(xr + 4 * lane + 256 * j); s += (v[j][0] + v[j][1]) + (v[j][2] + v[j][3]); }
      const float mean = wave_sum(s) * (1.0f / DM); float s2 = 0.f;
#pragma unroll
      for (int j = 0; j < 8; ++j) { v[j] = v[j] - mean; s2 += (v[j][0] * v[j][0] + v[j][1] * v[j][1]) + (v[j][2] * v[j][2] + v[j][3] * v[j][3]); }
      const float rstd = rsqrtf(wave_sum(s2) * (1.0f / DM) + LN_EPS);
#pragma unroll
      for (int j = 0; j < 8; ++j) {
        const int col = 4 * lane + 256 * j;
        const f32x4 gg = *(const f32x4*)(g1 + col), bb = *(const f32x4*)(b1 + col);
        const f32x4 o = v[j] * rstd * gg + bb;
        *(f32x4*)(xr + col) = o;
        u32x2 pw; pw.x = pk2(o[0], o[1]); pw.y = pk2(o[2], o[3]);
        { int q8 = 0; q8 = __builtin_amdgcn_cvt_pk_fp8_f32(o[0], o[1], q8, false); q8 = __builtin_amdgcn_cvt_pk_fp8_f32(o[2], o[3], q8, true); *(int*)(X1Q + (size_t)t * DM + col) = q8; }
        { float lo[4];
#pragma unroll
          for (int e = 0; e < 4; ++e) lo[e] = o[e] - __uint_as_float(f2bf(o[e]) << 16);
          *(LAS u32x2*)(XH + tl * 4112 + col * 2) = pw; u32x2 lw; lw.x = pk2(lo[0], lo[1]); lw.y = pk2(lo[2], lo[3]); *(LAS u32x2*)(XL + tl * 4112 + col * 2) = lw; }
      }
    }
    __syncthreads();
    f32x4 lacc[4];
    {
      const bf16_t* rh = RWH + (size_t)r16 * DM + 256 * w + 8 * gq; const bf16_t* rl = RWL + (size_t)r16 * DM + 256 * w + 8 * gq;
      const LAS unsigned char* xh = XH + r16 * 4112 + (256 * w + 8 * gq) * 2; const LAS unsigned char* xl = XL + r16 * 4112 + (256 * w + 8 * gq) * 2;
#pragma unroll
      for (int nt = 0; nt < 4; ++nt) {
        f32x4 a4 = (f32x4){0.f, 0.f, 0.f, 0.f};
#pragma unroll
        for (int kh = 0; kh < 2; ++kh) {
          bf16x8 bh[4], bl[4];
#pragma unroll
          for (int k2 = 0; k2 < 4; ++k2) { bh[k2] = *(const bf16x8*)(rh + (size_t)(16 * nt) * DM + 32 * (4 * kh + k2)); bl[k2] = *(const bf16x8*)(rl + (size_t)(16 * nt) * DM + 32 * (4 * kh + k2)); }
#pragma unroll
          for (int k2 = 0; k2 < 4; ++k2) {
            const bf16x8 ah = *(const LAS bf16x8*)(xh + 64 * (4 * kh + k2));
            const bf16x8 al = *(const LAS bf16x8*)(xl + 64 * (4 * kh + k2));
            a4 = __builtin_amdgcn_mfma_f32_16x16x32_bf16(ah, bh[k2], a4, 0, 0, 0);
            a4 = __builtin_amdgcn_mfma_f32_16x16x32_bf16(al, bh[k2], a4, 0, 0, 0);
            a4 = __builtin_amdgcn_mfma_f32_16x16x32_bf16(ah, bl[k2], a4, 0, 0, 0);
          }
          asm volatile("" ::: "memory");
        }
        lacc[nt] = a4;
      }
    }
    __syncthreads();
    LAS float* PART = (LAS float*)F.lds;
#pragma unroll
    for (int nt = 0; nt < 4; ++nt)
#pragma unroll
      for (int j = 0; j < 4; ++j) PART[(w * 16 + 4 * gq + j) * 64 + 16 * nt + r16] = lacc[nt][j];
    __syncthreads();
    LAS int* lcnt = (LAS int*)(F.lds + 40960); LAS int* lbase = lcnt + 64;
    if (F.tid < 64) lcnt[F.tid] = 0;
    __syncthreads();
    int lslot[2], rnk[2]; float wg[2];
#pragma unroll
    for (int q = 0; q < 2; ++q) {
      const int tl = 2 * w + q;
      float logit = 0.f;
#pragma unroll
      for (int ww = 0; ww < 8; ++ww) logit += PART[(ww * 16 + tl) * 64 + lane];
      const float score = 1.0f / (1.0f + expf(-logit));
      const float biased = score + rbias[lane];
      int cnt = 0;
#pragma unroll
      for (int d = 1; d < 8; ++d) { const int other = (lane & ~7) | ((lane + d) & 7); const float ov = __shfl(biased, other); cnt += (ov > biased || (ov == biased && other < lane)) ? 1 : 0; }
      float gs = cnt < 2 ? biased : 0.f;
      gs += __shfl_xor(gs, 1); gs += __shfl_xor(gs, 2); gs += __shfl_xor(gs, 4);
      const int gi = lane >> 3; int grank = 0;
#pragma unroll
      for (int gg = 0; gg < 8; ++gg) { const float og = __shfl(gs, 8 * gg); grank += (og > gs || (og == gs && gg < gi)) ? 1 : 0; }
      const float val = grank < 4 ? biased : -INFINITY;
      int erank = 0;
      for (int e2 = 0; e2 < 64; ++e2) { const float ov = __shfl(val, e2); erank += (ov > val || (ov == val && e2 < lane)) ? 1 : 0; }
      const bool chosen = erank < 8;
      const float wsum = wave_sum(chosen ? score : 0.f);
      rnk[q] = erank; wg[q] = score / wsum * 2.5f; lslot[q] = -1;
      if (chosen) lslot[q] = atomicAdd((int*)(lcnt + lane), 1);
    }
    __syncthreads();
    if (F.tid < 64) { const int c = lcnt[F.tid]; lbase[F.tid] = c ? atomicAdd(&CNT[F.tid * 64], c) : 0; }
    __syncthreads();
#pragma unroll
    for (int q = 0; q < 2; ++q) {
      if (lslot[q] >= 0) { const int t = t0 + 2 * w + q; const int slot = lbase[lane] + lslot[q];
        LIST[lane * NTOK + slot] = t; LISTW[lane * NTOK + slot] = wg[q]; TOKES[t * 8 + rnk[q]] = (lane << 16) | slot; }
    }
    __syncthreads();
  }
}

__device__ __forceinline__ MoeTab build_moe_tab(const Frame& F) {
  LAS int* tp = (LAS int*)(F.lds + LDS_X); LAS int* cp = tp + 68; LAS int* cn = tp + 136;
  const int* CNT = (const int*)(F.ws + WS_CTL);
  if (F.tid == 0) { int a = 0, b = 0; for (int e = 0; e < NE; ++e) { const int c = CNT[e * 64]; tp[e] = a; cp[e] = b; cn[e] = c; a += (c + 255) >> 8; b += c; } tp[NE] = a; cp[NE] = b; }
  __syncthreads();
  { LAS int* rt = tp + 256; if (F.tid < 384) { int e = 0; for (int k = 0; k < NE; ++k) { if (tp[k + 1] <= F.tid) e = k + 1; } rt[F.tid] = e < NE ? e : NE - 1; } }
  __syncthreads();
  MoeTab T; T.tp = tp; T.cp = cp; T.cnt = cn; T.n_rt = __builtin_amdgcn_readfirstlane(tp[NE]);
  return T;
}

__device__ __forceinline__ void phase_final(const Frame& F, const MoeTab& T) {
  unsigned char* ws = F.ws;
  const bf16_t* YRM = (const bf16_t*)(ws + WS_YRM); const int* TOKES = (const int*)(ws + WS_TOKES);
  const float* g2 = F.in[32]; const float* b2 = F.in[33];
  const int gw = F.bid * 8 + F.wave, NGW = F.G * 8, lane = F.lane;
  for (int t = gw; t < NTOK; t += NGW) {
    float* orow = F.out + (size_t)t * DM;
    f32x4 v[8];
    { const float* xrow = (const float*)(ws + WS_X1) + (size_t)t * DM; const bf16_t* ys = YRM + (size_t)(NTOK * 8 + t) * DM;
#pragma unroll
      for (int j = 0; j < 8; ++j) { const u32x2 wv = __builtin_nontemporal_load((const u32x2*)(ys + 4 * lane + 256 * j)); v[j] = *(const f32x4*)(xrow + 4 * lane + 256 * j) * ALPHA; v[j][0] += bflo(wv.x); v[j][1] += bfhi(wv.x); v[j][2] += bflo(wv.y); v[j][3] += bfhi(wv.y); } }
    const int esl = TOKES[t * 8 + (lane & 7)];
#pragma unroll
    for (int kb = 0; kb < 2; ++kb) {
      u32x2 yv[4][8];
#pragma unroll
      for (int k = 0; k < 4; ++k) {
        const int es = __shfl(esl, kb * 4 + k); const int e = es >> 16, slot = es & 0xffff;
        const bf16_t* yr = YRM + (size_t)(T.cp[e] + slot) * DM;
#pragma unroll
        for (int j = 0; j < 8; ++j) yv[k][j] = __builtin_nontemporal_load((const u32x2*)(yr + 4 * lane + 256 * j));
      }
#pragma unroll
      for (int k = 0; k < 4; ++k)
#pragma unroll
        for (int j = 0; j < 8; ++j) { v[j][0] += bflo(yv[k][j].x); v[j][1] += bfhi(yv[k][j].x); v[j][2] += bflo(yv[k][j].y); v[j][3] += bfhi(yv[k][j].y); }
    }
    float s = 0.f;
#pragma unroll
    for (int j = 0; j < 8; ++j) s += (v[j][0] + v[j][1]) + (v[j][2] + v[j][3]);
    const float mean = wave_sum(s) * (1.0f / DM); float s2 = 0.f;
#pragma unroll
    for (int j = 0; j < 8; ++j) { v[j] = v[j] - mean; s2 += (v[j][0] * v[j][0] + v[j][1] * v[j][1]) + (v[j][2] * v[j][2] + v[j][3] * v[j][3]); }
    const float rstd = rsqrtf(wave_sum(s2) * (1.0f / DM) + LN_EPS);
#pragma unroll
    for (int j = 0; j < 8; ++j) { const int col = 4 * lane + 256 * j; const f32x4 gg = *(const f32x4*)(g2 + col), bb = *(const f32x4*)(b2 + col); *(f32x4*)(orow + col) = v[j] * rstd * gg + bb; }
  }
}

__global__ void __launch_bounds__(512, 2) fwd_megakernel(Params p, int ph_lo, int ph_hi) {
  extern __shared__ __attribute__((aligned(16))) unsigned char lds_raw[];
  Frame F;
  F.lds = (LAS unsigned char*)lds_raw; F.tid = threadIdx.x; F.lane = F.tid & 63; F.wave = __builtin_amdgcn_readfirstlane(F.tid >> 6);
  F.G = gridDim.x; F.bid = blockIdx.x; F.ws = as_global(p.ws); F.in = InPtrs{p.in}; F.out = as_global(p.out);
  unsigned char* ws = as_global(p.ws);
#ifndef PHMASK
#define PHMASK 0xFFF
#endif
#define IN(k) (((PHMASK >> (k)) & 1) && ph_lo <= (k) && (k) < ph_hi)
#ifndef RPTMASK
#define RPTMASK 0
#endif
#define RPT(k) for (int _rp = 0; _rp < 1 + ((RPTMASK >> (k)) & 1); ++_rp)
#define FRESH() do { unsigned char* w2_ = opaque_global(p.ws); ws = w2_; F.ws = w2_; int l2_ = (int)__builtin_amdgcn_mbcnt_hi(~0u, __builtin_amdgcn_mbcnt_lo(~0u, 0u)); asm volatile("" : "+v"(l2_)); F.lane = l2_; F.tid = F.wave * 64 + l2_; } while (0)
#define SYNC(k) do { if (IN(k) && IN((k) + 1)) { xcd_barrier(xbar); } } while (0)
  { volatile LAS unsigned* st = (volatile LAS unsigned*)(F.lds + LDS_X + 4096); if (F.tid < 4) st[F.tid] = 0u; }
  __syncthreads();
  const XcdBarrier xbar = xcd_barrier_post((unsigned*)(ws + WS_CTL + 16384), (volatile LAS unsigned*)(F.lds + LDS_X + 4096));

  FRESH();
  if (IN(0)) RPT(0) { if (_rp) xcd_barrier(xbar); phase_prologue(F); }
  SYNC(0);
  FRESH();
  if (IN(1)) RPT(1) { if (_rp) xcd_barrier(xbar);
    SchedDense S{(const char*)(ws + WS_XB), (const char*)(ws + WS_WIN), NTOK / 256, INC / 256, F.G, F.bid, DM, DM, DM / 64};
    EpiStoreBf16 E{(bf16_t*)(ws + WS_PROJ), INC};
    pg8::gemm_phase<EpiStoreBf16, SchedDense, false>(F.lds, DM, DM, S, E);
  }
  SYNC(1);
  FRESH();
  if (IN(2)) RPT(2) { if (_rp) xcd_barrier(xbar); phase_mprep(F); phase_rconv(F); }
  SYNC(2);
  FRESH();
  if (IN(3)) RPT(3) { if (_rp) xcd_barrier(xbar);
    const int nm2 = F.G >> 1;
    if (F.bid < nm2) phase_m2(F, nm2);
    else {
      const int bid2 = F.bid - nm2, G2 = F.G - nm2;
      phase_m1(F, bid2, G2);
      int Kr = 4; asm volatile("" : "+s"(Kr));
      SchedRglru S{(const char*)(ws + WS_XCR), (const char*)(ws + WS_WRAX), G2, bid2, Kr};
      EpiRglru E{(const bf16_t*)(ws + WS_XCR), p.in[15], p.in[17], (const float*)(ws + WS_SMALL + SM_C8), (float*)(ws + WS_RA), (bf16_t*)(ws + WS_RB)};
      pg8::gemm_phase<EpiRglru, SchedRglru, false>(F.lds, RW, 256, S, E);
    }
  }
  SYNC(3);
  FRESH();
  if (IN(4)) RPT(4) { if (_rp) xcd_barrier(xbar); phase_ragg(F); phase_ym(F); }
  SYNC(4);
  FRESH();
  if (IN(5)) RPT(5) { if (_rp) xcd_barrier(xbar); phase_rscan(F); }
  SYNC(5);
  FRESH();
  if (IN(6)) RPT(6) { if (_rp) xcd_barrier(xbar);
    SchedMerge S{(const char*)(ws + WS_YM), (const char*)(ws + WS_YR), (const char*)(ws + WS_WPM), (const char*)(ws + WS_WPR), F.G, F.bid};
    EpiMergeF E{(const bf16_t*)(ws + WS_PROJ), p.in[2], (bf16_t*)(ws + WS_MERGED)};
    pg8::gemm_phase<EpiMergeF, SchedMerge, false>(F.lds, RW, RW, S, E);
  }
  SYNC(6);
  FRESH();
  if (IN(7)) RPT(7) { if (_rp) xcd_barrier(xbar);
    SchedDense S{(const char*)(ws + WS_MERGED), (const char*)(ws + WS_WO), NTOK / 256, DM / 256, F.G, F.bid, DM, DM, DM / 64};
    EpiWo E{p.in[0], (float*)(ws + WS_X1)};
    pg8::gemm_phase<EpiWo, SchedDense, false>(F.lds, DM, DM, S, E);
  }
  SYNC(7);
  FRESH();
  if (IN(8)) phase_ln_router(F);
  SYNC(8);
  FRESH();
  if (IN(9)) RPT(9) { if (_rp) xcd_barrier(xbar);
    const MoeTab T = build_moe_tab(F);
    SchedMoe<4, 1> S{T, (const int*)(ws + WS_LIST), (const char*)(ws + WS_X1B), (const char*)(ws + WS_WEGU), (const char*)(ws + WS_WSGU), F.G, F.bid, DM / 128};
    EpiMoe1 E{ws + WS_HMOE};
    pg8::gemm_phase<EpiMoe1, SchedMoe<4, 1>, true>(F.lds, DM / 2, DM / 2, S, E);
  }
  SYNC(9);
  FRESH();
  if (IN(10)) RPT(10) { if (_rp) xcd_barrier(xbar);
    const MoeTab T = build_moe_tab(F);
    int nt2 = DE / 128; asm volatile("" : "+s"(nt2));
    SchedMoe<8, 2> S{T, (const int*)(ws + WS_LIST), (const char*)(ws + WS_HMOE), (const char*)(ws + WS_WED), (const char*)(ws + WS_WSD), F.G, F.bid, nt2};
    EpiMoe2 E{(bf16_t*)(ws + WS_YRM), (const float*)(ws + WS_LISTW), (bf16_t*)(ws + WS_WIN)};
    pg8::gemm_phase<EpiMoe2, SchedMoe<8, 2>, false>(F.lds, DE / 2, DE / 2, S, E);
  }
  SYNC(10);
  FRESH();
  if (IN(11)) { const MoeTab T = build_moe_tab(F); phase_final(F, T); }
#undef IN
#undef SYNC
}

#ifndef N_LAUNCH_SPLIT
#define N_LAUNCH_SPLIT 0
#endif
extern "C" void kernel_launch(void* const* d_in, const int* in_sizes, int n_in, void* d_out, int out_size, void* d_ws, size_t ws_size, hipStream_t stream) {
  static int grid_blocks = 0;
  if (grid_blocks == 0) {
    int dev = 0, cus = 0, per_cu = 0;
    (void)hipGetDevice(&dev);
    (void)hipDeviceGetAttribute(&cus, hipDeviceAttributeMultiprocessorCount, dev);
    (void)hipFuncSetAttribute((const void*)fwd_megakernel, hipFuncAttributeMaxDynamicSharedMemorySize, LDS_BYTES);
    (void)hipOccupancyMaxActiveBlocksPerMultiprocessor(&per_cu, fwd_megakernel, 512, LDS_BYTES);
    if (per_cu < 1) { fprintf(stderr, "kernel_launch: occupancy query says %d blocks per CU\n", per_cu); per_cu = 1; }
    grid_blocks = cus * per_cu;
    fprintf(stderr, "kernel_launch: cus %d per_cu %d grid %d ws_size %zu (need %zu) n_in %d\n", cus, per_cu, grid_blocks, ws_size, (size_t)WS_END, n_in);
    if (ws_size < WS_END || n_in != 34) { fprintf(stderr, "kernel_launch: workspace too small or unexpected inputs; nothing launched\n"); grid_blocks = -1; }
  }
  if (grid_blocks < 0) return;
  (void)hipMemsetAsync((char*)d_ws + WS_CTL, 0, 65536, stream);
  Params p{};
  for (int i = 0; i < 34; ++i) p.in[i] = (const float*)d_in[i];
  p.out = (float*)d_out; p.ws = (unsigned char*)d_ws;
#if N_LAUNCH_SPLIT
  for (int ph = 0; ph < 12; ++ph) { hipLaunchKernelGGL(fwd_megakernel, dim3(grid_blocks), dim3(512), LDS_BYTES, stream, p, ph, ph + 1); }
#else
  int lo = 0, hi = 12;
  void* args[] = {&p, &lo, &hi};
  hipError_t e = hipLaunchCooperativeKernel((void*)fwd_megakernel, dim3(grid_blocks), dim3(512), args, LDS_BYTES, stream);
  if (e != hipSuccess) fprintf(stderr, "cooperative launch failed: %s (grid %d)\n", hipGetErrorString(e), grid_blocks);
#endif
}
```

```cpp
#include <hip/hip_runtime.h>
#include <hip/hip_cooperative_groups.h>
#include <cstdio>
#include <cstdint>
namespace cg = cooperative_groups;

#define LAS __attribute__((address_space(3)))
typedef unsigned short bf16_t;
typedef short bf16x8 __attribute__((ext_vector_type(8)));
typedef float f32x4 __attribute__((ext_vector_type(4)));
typedef float f32x2 __attribute__((ext_vector_type(2)));
typedef unsigned u32x4 __attribute__((ext_vector_type(4)));
typedef unsigned u32x2 __attribute__((ext_vector_type(2)));
typedef int i32x8 __attribute__((ext_vector_type(8)));
typedef int i32x4 __attribute__((ext_vector_type(4)));

constexpr int NTOK = 8192, DM = 2048, SEQ = 4096, MW = 2048, RW = 2560, INC = 13312, NH = 8, HD = 256, NE = 64, DE = 512;
constexpr int O_Z = 2048, O_XR = 4096, O_XG = 6656, O_G0 = 9216, O_G1 = 11264;
constexpr float LN_EPS = 1e-5f;
constexpr float ALPHA = 1.189207115002721f;
constexpr int NCH = 64;

constexpr size_t MiB = 1u << 20;
constexpr size_t WS_CTL = 0;
constexpr size_t WS_WIN = 1 * MiB, WS_RB = 1 * MiB, WS_M2TAB = 41 * MiB;
constexpr size_t WS_WPM = 53 * MiB  , WS_WPR = 63 * MiB, WS_WO = 73 * MiB, WS_WRAX = 81 * MiB, WS_WSGU = 84 * MiB, WS_WSD = 1014 * MiB;
constexpr size_t WS_WEGU = 88 * MiB, WS_WED = 344 * MiB;
constexpr size_t WS_XB = 472 * MiB, WS_HNI = 472 * MiB, WS_HMOE = 472 * MiB;
constexpr size_t WS_PROJ = 504 * MiB;
constexpr size_t WS_YRM = 560 * MiB;
constexpr size_t WS_Q = 712 * MiB, WS_K = 744 * MiB, WS_V = 776 * MiB, WS_YM = 712 * MiB  , WS_YR = 752 * MiB;
constexpr size_t WS_XCM = 808 * MiB, WS_MERGED = 808 * MiB;
constexpr size_t WS_XCR = 840 * MiB;
constexpr size_t WS_SMALL = 880 * MiB;
constexpr size_t WS_RA = 886 * MiB, WS_T1 = 886 * MiB, WS_X1B = 886 * MiB  ;
constexpr size_t WS_LIST = 918 * MiB, WS_LISTW = 920 * MiB  , WS_TOKES = 923 * MiB;
constexpr size_t WS_X1 = 950 * MiB;
constexpr size_t WS_HNE = 966 * MiB;
constexpr size_t WS_END = 1016 * MiB;
constexpr size_t SM_IG = 0, SM_LF = 256 * 1024, SM_INTER = 512 * 1024, SM_EMR = 768 * 1024, SM_DENI = 1024 * 1024, SM_QN = 1280 * 1024;
constexpr size_t SM_WIFT = 1536 * 1024;
constexpr size_t SM_C8 = 1792 * 1024;
constexpr size_t SM_RWH = 4608 * 1024, SM_RWL = 4864 * 1024;
constexpr size_t SM_AGGA = 2 * MiB, SM_AGGB = 2 * MiB + 1310720;

constexpr int LDS_BYTES = 147456;
constexpr int LDS_X = 131072;

struct Params {
  const float* in[34];
  float* out;
  unsigned char* ws;
};

typedef __bf16 hbf2_t __attribute__((ext_vector_type(2)));
typedef float hf2_t __attribute__((ext_vector_type(2)));
__device__ __forceinline__ unsigned pk2(float lo, float hi) { const hf2_t f = {lo, hi}; return __builtin_bit_cast(unsigned, __builtin_convertvector(f, hbf2_t)); }
__device__ __forceinline__ unsigned f2bf(float f) { return pk2(f, 0.f) & 0xffffu; }
__device__ __forceinline__ float bflo(unsigned w) { return __uint_as_float(w << 16); }
__device__ __forceinline__ float bfhi(unsigned w) { return __uint_as_float(w & 0xffff0000u); }
__device__ __forceinline__ float bf1(bf16_t b) { return __uint_as_float(((unsigned)b) << 16); }
__device__ __forceinline__ float sigmoidf_(float x) { return 1.0f / (1.0f + __expf(-x)); }
__device__ __forceinline__ float siluf_(float x) { return x / (1.0f + __expf(-x)); }
__device__ __forceinline__ float gelu_tanh(float x) { const float u = 0.7978845608028654f * (x + 0.044715f * x * x * x); return 0.5f * x * (1.0f + tanhf(u)); }
__device__ __forceinline__ float wave_sum(float v) {
#pragma unroll
  for (int o = 1; o < 64; o <<= 1) v += __shfl_xor(v, o);
  return v;
}
__device__ __forceinline__ float wave_max(float v) {
#pragma unroll
  for (int o = 1; o < 64; o <<= 1) v = fmaxf(v, __shfl_xor(v, o));
  return v;
}
__device__ __forceinline__ float wave_scan_sum(float v, int lane) {
#pragma unroll
  for (int o = 1; o < 64; o <<= 1) { const float t = __shfl_up(v, o); if (lane >= o) v += t; }
  return v;
}
__device__ __forceinline__ float wave_scan_max(float v, int lane) {
#pragma unroll
  for (int o = 1; o < 64; o <<= 1) { const float t = __shfl_up(v, o); if (lane >= o) v = fmaxf(v, t); }
  return v;
}
#define LDS_WAIT() asm volatile("s_waitcnt lgkmcnt(0)" ::: "memory")
#define LBAR() do { asm volatile("s_waitcnt lgkmcnt(0)" ::: "memory"); __builtin_amdgcn_s_barrier(); asm volatile("" ::: "memory"); } while (0)

namespace pg8 {
constexpr int BM = 256, BK = 64, HALF = 128, HTB = HALF * BK * 2, NXCD = 8, WGM = 8;
__device__ __forceinline__ int lds_byte(int r, int c) { const int st = (r >> 4) * 2 + (c >> 5), rr = r & 15, cc = c & 31, ob = rr * 64 + cc * 2; return st * 1024 + (ob ^ (((ob >> 9) & 1) << 5)); }
__device__ __forceinline__ void stage_rc(int b, int& R, int& C) { const int st = b / 1024, sb = b % 1024, swz = sb ^ (((sb >> 9) & 1) << 5); R = (st >> 1) * 16 + swz / 64; C = (st & 1) * 32 + (swz % 64) / 2; }

__device__ __forceinline__ int perm32(int rho) { const int n = rho >> 4, i = rho & 15; return 8 * (i >> 2) + 4 * n + (i & 3); }
struct UnitG { const char* A; const char* B; int pm, pn, e, cnt, mt, row0, nt, keep; };

__device__ __forceinline__ bool dense_order(int i, int G, int c, int nM, int nN, int& pm, int& pn) {
  const int nwg = nM * nN; const long L = (long)i * G + c; if (L >= nwg) return false;
  int wgid = (int)L; { const int q = nwg / NXCD, r = nwg % NXCD, xcd = wgid % NXCD, off = wgid / NXCD; wgid = (xcd < r ? xcd * (q + 1) : r * (q + 1) + (xcd - r) * q) + off; }
  const int nig = WGM * nN, gid = wgid / nig, fm = gid * WGM, gsz = (nM - fm) < WGM ? (nM - fm) : WGM;
  pm = fm + ((wgid % nig) % gsz); pn = (wgid % nig) / gsz; return true;
}

template <class Epi, class Sched, bool GATHER>
__device__ __forceinline__ void gemm_phase(LAS unsigned char* lds, const int lda, const int ldb, const Sched& S, const Epi& E) {
  const int tid = threadIdx.x, wid = __builtin_amdgcn_readfirstlane(tid >> 6), lane = tid & 63, wr = wid >> 2, wc = wid & 3, fr = lane & 15, fq = lane >> 4;
  int Rr[2], Cc[2];
  unsigned voffB[2];
  unsigned vA[2][2];
  unsigned nvA[2][2];
#pragma unroll
  for (int i = 0; i < 2; ++i) { stage_rc(tid * 16 + i * 8192, Rr[i], Cc[i]); const int Rb = Epi::PERM ? ((Rr[i] & ~31) + perm32(Rr[i] & 31)) : Rr[i]; voffB[i] = (unsigned)(Rb * ldb + Cc[i]) * 2u; }
  const size_t kstep = (size_t)(BK * 2);
  const size_t hstepA = (size_t)HALF * lda * 2, hstepB = (size_t)HALF * ldb * 2;
  const unsigned ldsw = (unsigned)wid * 1024u;
  const int aoff = lds_byte(wr * 64 + fr, fq * 8), boff = lds_byte(wc * 32 + fr, fq * 8);
#define PG8_SA(b, h) (((b) * 2 + (h)) * HTB)
#define PG8_SB(b, h) ((4 + (b) * 2 + (h)) * HTB)
#define PG8_STAGE_B(bufoff, gbase) do { _Pragma("unroll") for (int _i = 0; _i < 2; ++_i) \
    __builtin_amdgcn_global_load_lds((const unsigned*)((const char*)(gbase) + voffB[_i]), (LAS unsigned*)(lds + (bufoff) + ldsw + _i * 8192), 16, 0, 0); } while (0)
#define PG8_STAGE_A(bufoff, gbase, h) do { _Pragma("unroll") for (int _i = 0; _i < 2; ++_i) { \
    const char* _p = GATHER ? ((const char*)(gbase) + vA[h][_i]) : ((const char*)(gbase) + (h) * hstepA + vA[0][_i]); \
    __builtin_amdgcn_global_load_lds((const unsigned*)_p, (LAS unsigned*)(lds + (bufoff) + ldsw + _i * 8192), 16, 0, 0); } } while (0)
#define PG8_LD8(p) __builtin_shufflevector(*(const LAS i32x4*)(p), *(const LAS i32x4*)((p) + 1024), 0, 1, 2, 3, 4, 5, 6, 7)
#define PG8_LO(x) __builtin_bit_cast(bf16x8, __builtin_shufflevector(x, x, 0, 1, 2, 3))
#define PG8_HI(x) __builtin_bit_cast(bf16x8, __builtin_shufflevector(x, x, 4, 5, 6, 7))
#define PG8_LDA(dst, b, h) do { _Pragma("unroll") for (int m = 0; m < 4; ++m) dst[m] = PG8_LD8(lds + PG8_SA(b, h) + aoff + m * 2048); } while (0)
#define PG8_LDB(dst, b, h) do { _Pragma("unroll") for (int n = 0; n < 2; ++n) dst[n] = PG8_LD8(lds + PG8_SB(b, h) + boff + n * 2048); } while (0)
#define PG8_MMA(ai, bj, At, Bt) do { __builtin_amdgcn_s_setprio(1); _Pragma("unroll") for (int m = 0; m < 4; ++m) _Pragma("unroll") for (int n = 0; n < 2; ++n) { \
    acc[ai][bj][m][n] = __builtin_amdgcn_mfma_f32_16x16x32_bf16(PG8_LO(Bt[n]), PG8_LO(At[m]), acc[ai][bj][m][n], 0, 0, 0); \
    acc[ai][bj][m][n] = __builtin_amdgcn_mfma_f32_16x16x32_bf16(PG8_HI(Bt[n]), PG8_HI(At[m]), acc[ai][bj][m][n], 0, 0, 0); } __builtin_amdgcn_s_setprio(0); } while (0)
#define PG8_MMA8(ai, bj, At, Bt) do { __builtin_amdgcn_s_setprio(1); _Pragma("unroll") for (int m = 0; m < 4; ++m) _Pragma("unroll") for (int n = 0; n < 2; ++n) \
    acc[ai][bj][m][n] = __builtin_amdgcn_mfma_scale_f32_16x16x128_f8f6f4(Bt[n], At[m], acc[ai][bj][m][n], 0, 0, 0, 0x7F7F7F7F, 0, 0x7F7F7F7F); __builtin_amdgcn_s_setprio(0); } while (0)
#define PG8_MM(ai, bj, At, Bt) do { if (Epi::FP8) PG8_MMA8(ai, bj, At, Bt); else PG8_MMA(ai, bj, At, Bt); } while (0)
#define PG8_WAIT_V(n) asm volatile("s_waitcnt vmcnt(" #n ")" ::: "memory")
#define PG8_WAIT_L(n) asm volatile("s_waitcnt lgkmcnt(" #n ")" ::: "memory")
#define PG8_BAR __builtin_amdgcn_s_barrier()
#define PG8_SCHED __builtin_amdgcn_sched_barrier(0)
  UnitG cur, nxt; int ui = 0;
  if (!S.next(0, cur)) return;
#pragma unroll
  for (int h = 0; h < 2; ++h)
#pragma unroll
    for (int i = 0; i < 2; ++i) {
      if (GATHER) vA[h][i] = (unsigned)(S.arow(cur, h * HALF + Rr[i]) * lda + Cc[i]) * 2u;
      else vA[h][i] = (unsigned)(Rr[i] * lda + Cc[i]) * 2u;
      nvA[h][i] = vA[h][i];
    }
  f32x4 acc[2][2][4][2];
#pragma unroll
  for (int a = 0; a < 2; ++a)
#pragma unroll
    for (int b = 0; b < 2; ++b)
#pragma unroll
      for (int m = 0; m < 4; ++m)
#pragma unroll
        for (int n = 0; n < 2; ++n) acc[a][b][m][n] = (f32x4){0.f, 0.f, 0.f, 0.f};
  i32x8 At[4], B0[2], B1[2];
  const char* cA = cur.A; const char* cB = cur.B;
  { const char* pB0 = cB; const char* pB1 = cB + hstepB; const char* pA0 = cA; const char* pB2 = cB + kstep; const char* pA1 = cA + kstep; const char* pB3 = cB + hstepB + kstep;
    asm volatile("" : "+s"(pB0), "+s"(pB1), "+s"(pA0), "+s"(pB2), "+s"(pA1), "+s"(pB3));
  PG8_STAGE_B(PG8_SB(0, 0), pB0); PG8_STAGE_B(PG8_SB(0, 1), pB1); PG8_STAGE_A(PG8_SA(0, 0), pA0, 0); PG8_STAGE_A(PG8_SA(0, 1), pA0, 1);
  if (wr == 1) PG8_BAR;
  PG8_WAIT_V(2); PG8_BAR;
  PG8_STAGE_B(PG8_SB(1, 0), pB2); PG8_STAGE_A(PG8_SA(1, 0), pA1, 0); PG8_STAGE_B(PG8_SB(1, 1), pB3); }
  PG8_WAIT_V(6); PG8_BAR;
  for (;;) {
    const bool has_next = S.next(ui + 1, nxt);
    const char* nA = has_next ? nxt.A : cA; const char* nB = has_next ? nxt.B : cB;
    if (GATHER) {
      if (has_next) {
#pragma unroll
        for (int h = 0; h < 2; ++h)
#pragma unroll
          for (int i = 0; i < 2; ++i) nvA[h][i] = (unsigned)(S.arow(nxt, h * HALF + Rr[i]) * lda + Cc[i]) * 2u;
      }
    }
    const int nt = cur.nt;
#pragma unroll 1
    for (int t = 0; t < nt; t += 2) {
      const bool last = (t == nt - 2);
      const char* a1 = cA + (size_t)(t + 1) * kstep;
      const char* a2 = last ? nA : cA + (size_t)(t + 2) * kstep; const char* b2 = last ? nB : cB + (size_t)(t + 2) * kstep;
      const char* a3 = a2 + kstep; const char* b3 = b2 + kstep;
      asm volatile("" : "+s"(a1), "+s"(a2), "+s"(a3), "+s"(b2), "+s"(b3));
      PG8_LDB(B0, 0, 0); PG8_LDB(B1, 0, 1); PG8_SCHED; PG8_LDA(At, 0, 0); PG8_STAGE_A(PG8_SA(1, 1), a1, 1);
      if (GATHER) { if (last) {
#pragma unroll
        for (int h = 0; h < 2; ++h)
#pragma unroll
          for (int i = 0; i < 2; ++i) vA[h][i] = nvA[h][i]; } }
      PG8_WAIT_V(8); PG8_WAIT_L(0); PG8_BAR; PG8_MM(0, 0, At, B0); PG8_MM(0, 1, At, B1); PG8_BAR; PG8_SCHED;
      PG8_LDA(At, 0, 1); PG8_STAGE_B(PG8_SB(0, 0), b2); PG8_STAGE_B(PG8_SB(0, 1), b2 + hstepB); PG8_STAGE_A(PG8_SA(0, 0), a2, 0);
      PG8_WAIT_V(8); PG8_WAIT_L(0); PG8_BAR; PG8_MM(1, 0, At, B0); PG8_MM(1, 1, At, B1); PG8_BAR; PG8_SCHED;
      PG8_LDB(B0, 1, 0); PG8_LDB(B1, 1, 1); PG8_SCHED; PG8_LDA(At, 1, 0); PG8_STAGE_A(PG8_SA(0, 1), a2, 1);
      PG8_WAIT_V(8); PG8_WAIT_L(0); PG8_BAR; PG8_MM(0, 0, At, B0); PG8_MM(0, 1, At, B1); PG8_BAR; PG8_SCHED;
      PG8_LDA(At, 1, 1); PG8_STAGE_B(PG8_SB(1, 0), b3); PG8_STAGE_B(PG8_SB(1, 1), b3 + hstepB); PG8_STAGE_A(PG8_SA(1, 0), a3, 0);
      PG8_WAIT_V(8); PG8_WAIT_L(0); PG8_BAR; PG8_MM(1, 0, At, B0); PG8_MM(1, 1, At, B1); PG8_BAR; PG8_SCHED;
    }
    if (wr == 0) PG8_BAR;
    { int l2 = (int)__builtin_amdgcn_mbcnt_hi(~0u, __builtin_amdgcn_mbcnt_lo(~0u, 0u)); asm volatile("" : "+v"(l2));
      E(acc, cur, wr, wc, l2 & 15, l2 >> 4); }
    if (!has_next) break;
    if (!cur.keep) {
#pragma unroll
      for (int a = 0; a < 2; ++a)
#pragma unroll
        for (int b = 0; b < 2; ++b)
#pragma unroll
          for (int m = 0; m < 4; ++m)
#pragma unroll
            for (int n = 0; n < 2; ++n) acc[a][b][m][n] = (f32x4){0.f, 0.f, 0.f, 0.f};
    }
    cur = nxt; cA = nA; cB = nB; ++ui;
    if (wr == 1) PG8_BAR;
  }
  PG8_WAIT_V(0);
  PG8_BAR;
#undef PG8_SA
#undef PG8_SB
#undef PG8_STAGE_A
#undef PG8_STAGE_B
#undef PG8_LDA
#undef PG8_LDB
#undef PG8_MMA
#undef PG8_MMA8
#undef PG8_MM
#undef PG8_LD8
#undef PG8_LO
#undef PG8_HI
#undef PG8_WAIT_V
#undef PG8_WAIT_L
#undef PG8_BAR
#undef PG8_SCHED
}
}

__device__ __forceinline__ const char* uni_ptr(const char* p) {
  const unsigned long long v = (unsigned long long)p;
  const unsigned lo = __builtin_amdgcn_readfirstlane((unsigned)v), hi = __builtin_amdgcn_readfirstlane((unsigned)(v >> 32));
  return (const char*)(((unsigned long long)hi << 32) | lo);
}

struct SchedDense {
  const char* A; const char* B; int nM, nN, G, c, lda, ldb, nt;
  __device__ __forceinline__ bool next(int i, pg8::UnitG& u) const {
    int pm, pn; if (!pg8::dense_order(i, G, c, nM, nN, pm, pn)) return false;
    u.pm = pm; u.pn = pn; u.e = 0; u.cnt = 0; u.mt = 0; u.row0 = pm * 256; u.nt = nt; u.keep = 0;
    u.A = A + (size_t)pm * 256 * lda * 2; u.B = B + (size_t)pn * 256 * ldb * 2; return true;
  }
  __device__ __forceinline__ unsigned arow(const pg8::UnitG&, int r) const { return (unsigned)r; }
};

struct EpiStoreBf16 {
  static constexpr bool PERM = true, FP8 = false;
  bf16_t* O; int ldc;
  __device__ __forceinline__ void operator()(const f32x4 (&acc)[2][2][4][2], const pg8::UnitG& u, int wr, int wc, int fr, int fq) const {
    const int row0 = u.pm * 256 + wr * 64 + fr, col0 = u.pn * 256 + wc * 32 + 8 * fq;
#pragma unroll
    for (int ai = 0; ai < 2; ++ai)
#pragma unroll
      for (int m = 0; m < 4; ++m) { bf16_t* rowp = O + (size_t)(row0 + ai * 128 + m * 16) * ldc + col0;
#pragma unroll
        for (int bj = 0; bj < 2; ++bj) { const f32x4 v0 = acc[ai][bj][m][0], v1 = acc[ai][bj][m][1]; u32x4 w; w.x = pk2(v0[0], v0[1]); w.y = pk2(v0[2], v0[3]); w.z = pk2(v1[0], v1[1]); w.w = pk2(v1[2], v1[3]); *(u32x4*)(rowp + bj * 128) = w; } }
  }
};

struct SchedRglru {
  const char* XCR; const char* W; int G, c, nt4;
  __device__ __forceinline__ bool next(int i, pg8::UnitG& u) const {
    const int L = i * G + c; if (L >= 640) return false;
    const int blk = L >> 6, rem = L & 63; u.e = blk; u.pm = rem >> 1; u.pn = rem & 1; u.cnt = 0; u.mt = 0; u.row0 = u.pm * 256; u.nt = nt4; u.keep = 0;
    u.A = XCR + ((size_t)u.pm * 256 * RW + 256 * blk) * 2; u.B = W + ((size_t)(blk * 512 + u.pn * 256) * 256) * 2; return true;
  }
  __device__ __forceinline__ unsigned arow(const pg8::UnitG&, int r) const { return (unsigned)r; }
};
struct EpiRglru {
  static constexpr bool PERM = true, FP8 = false;
  const bf16_t* XCR; const float* ba; const float* bx; const float* C8; float* RA; bf16_t* RBo;
  __device__ __forceinline__ void operator()(const f32x4 (&acc)[2][2][4][2], const pg8::UnitG& u, int wr, int wc, int fr, int fq) const {
    const int row0 = u.pm * 256 + wr * 64 + fr;
#pragma unroll
    for (int n = 0; n < 2; ++n) {
      const int ch = 256 * u.e + 128 * u.pn + 32 * wc + 8 * fq + 4 * n;
      const f32x4 vba = *(const f32x4*)(ba + ch), vbx = *(const f32x4*)(bx + ch), c8 = *(const f32x4*)(C8 + ch);
#pragma unroll
      for (int ai = 0; ai < 2; ++ai)
#pragma unroll
        for (int m = 0; m < 4; ++m) {
          const size_t off = (size_t)(row0 + ai * 128 + m * 16) * RW + ch;
          const u32x2 xw = *(const u32x2*)(XCR + off);
          const float xc[4] = {bflo(xw.x), bfhi(xw.x), bflo(xw.y), bfhi(xw.y)};
          f32x4 av; float bv[4];
#pragma unroll
          for (int j = 0; j < 4; ++j) {
            const float r = __builtin_amdgcn_rcpf(1.0f + __expf(-(acc[ai][0][m][n][j] + vba[j])));
            const float ig = __builtin_amdgcn_rcpf(1.0f + __expf(-(acc[ai][1][m][n][j] + vbx[j])));
            const float la = c8[j] * r;
            const float a = __expf(la);
            const float x2 = 2.0f * la;
            const float poly = -x2 * (1.0f + x2 * 0.5f * (1.0f + x2 * (1.0f / 3.0f) * (1.0f + x2 * 0.25f * (1.0f + x2 * 0.2f))));
            const float om = (x2 > -0.25f) ? poly : (1.0f - a * a);
            av[j] = a;
            bv[j] = sqrtf(fmaxf(om, 0.f)) * (ig * xc[j]);
          }
          *(f32x4*)(RA + off) = av;
          u32x2 w; w.x = pk2(bv[0], bv[1]); w.y = pk2(bv[2], bv[3]); *(u32x2*)(RBo + off) = w;
          asm volatile("" ::: "memory");
        }
    }
  }
};

struct SchedMerge {
  const char* YM; const char* YR; const char* WPM; const char* WPR; int G, c;
  __device__ __forceinline__ bool next(int i, pg8::UnitG& u) const {
    int pm, pn; if (!pg8::dense_order(i >> 1, G, c, NTOK / 256, DM / 256, pm, pn)) return false;
    const int seg = i & 1;
    u.pm = pm; u.pn = pn; u.e = seg; u.cnt = 0; u.mt = 0; u.row0 = pm * 256; u.nt = seg ? RW / 64 : MW / 64; u.keep = seg ? 0 : 1;
    u.A = (seg ? YR : YM) + (size_t)pm * 256 * RW * 2; u.B = (seg ? WPR : WPM) + (size_t)pn * 256 * RW * 2; return true;
  }
  __device__ __forceinline__ unsigned arow(const pg8::UnitG&, int r) const { return (unsigned)r; }
};
struct EpiMergeF {
  static constexpr bool PERM = true, FP8 = false;
  const bf16_t* PROJ; const float* bgate; bf16_t* MRG;
  __device__ __forceinline__ void operator()(f32x4 (&acc)[2][2][4][2], const pg8::UnitG& u, int wr, int wc, int fr, int fq) const {
    const int row0 = u.pm * 256 + wr * 64 + fr, col0 = u.pn * 256 + wc * 32 + 8 * fq;
#pragma unroll
    for (int bj = 0; bj < 2; ++bj) {
      const int col = col0 + bj * 128;
      const f32x4 b00 = *(const f32x4*)(bgate + col), b01 = *(const f32x4*)(bgate + col + 4), b10 = *(const f32x4*)(bgate + DM + col), b11 = *(const f32x4*)(bgate + DM + col + 4);
#pragma unroll
      for (int ai = 0; ai < 2; ++ai)
#pragma unroll
        for (int m = 0; m < 4; ++m) {
          const size_t row = (size_t)(row0 + ai * 128 + m * 16);
          const u32x4 g1w = *(const u32x4*)(PROJ + row * INC + O_G1 + col);
          const float g1p[8] = {bflo(g1w.x), bfhi(g1w.x), bflo(g1w.y), bfhi(g1w.y), bflo(g1w.z), bfhi(g1w.z), bflo(g1w.w), bfhi(g1w.w)};
          if (u.e == 0) {
            const u32x4 g0w = *(const u32x4*)(PROJ + row * INC + O_G0 + col);
            const float g0p[8] = {bflo(g0w.x), bfhi(g0w.x), bflo(g0w.y), bfhi(g0w.y), bflo(g0w.z), bfhi(g0w.z), bflo(g0w.w), bfhi(g0w.w)};
#pragma unroll
            for (int j = 0; j < 4; ++j) {
              acc[ai][bj][m][0][j] *= (1.0f + __expf(-(g1p[j] + b10[j]))) * __builtin_amdgcn_rcpf(1.0f + __expf(-(g0p[j] + b00[j])));
              acc[ai][bj][m][1][j] *= (1.0f + __expf(-(g1p[4 + j] + b11[j]))) * __builtin_amdgcn_rcpf(1.0f + __expf(-(g0p[4 + j] + b01[j])));
            }
          } else {
            f32x4 v0, v1;
#pragma unroll
            for (int j = 0; j < 4; ++j) { v0[j] = acc[ai][bj][m][0][j] * __builtin_amdgcn_rcpf(1.0f + __expf(-(g1p[j] + b10[j]))); v1[j] = acc[ai][bj][m][1][j] * __builtin_amdgcn_rcpf(1.0f + __expf(-(g1p[4 + j] + b11[j]))); }
            u32x4 w; w.x = pk2(v0[0], v0[1]); w.y = pk2(v0[2], v0[3]); w.z = pk2(v1[0], v1[1]); w.w = pk2(v1[2], v1[3]); *(u32x4*)(MRG + row * DM + col) = w;
          }
        }
    }
  }
};

struct EpiWo {
  static constexpr bool PERM = false, FP8 = false;
  const float* X; float* O;
  __device__ __forceinline__ void operator()(const f32x4 (&acc)[2][2][4][2], const pg8::UnitG& u, int wr, int wc, int fr, int fq) const {
    const int row0 = u.pm * 256 + wr * 64 + fr, col0 = u.pn * 256 + wc * 32 + 4 * fq;
#pragma unroll
    for (int ai = 0; ai < 2; ++ai)
#pragma unroll
      for (int m = 0; m < 4; ++m) { const size_t off = (size_t)(row0 + ai * 128 + m * 16) * DM + col0;
#pragma unroll
        for (int bj = 0; bj < 2; ++bj)
#pragma unroll
          for (int n = 0; n < 2; ++n) { const f32x4 x = *(const f32x4*)(X + off + bj * 128 + n * 16); *(f32x4*)(O + off + bj * 128 + n * 16) = x * ALPHA + acc[ai][bj][m][n]; } }
  }
};

struct MoeTab { const LAS int* tp; const LAS int* cp; const LAS int* cnt; int n_rt; };
template <int NT  , int STAGE  >
struct SchedMoe {
  MoeTab T; const int* LIST; const char* Abase; const char* Wr; const char* Ws; int G, c, ntv;
  __device__ __forceinline__ bool next(int i, pg8::UnitG& u) const {
    const int L = i * G + c; const int total = NT * (T.n_rt + 32); if (L >= total) return false;
    const int rt = L / NT, pn = L % NT; u.pn = pn; u.nt = ntv; u.keep = 0;
    constexpr int KK = (STAGE == 1) ? DM / 2 : DE / 2;
    constexpr int NN = NT * 256;
    if (rt < T.n_rt) {
      const int e = __builtin_amdgcn_readfirstlane(T.tp[256 + rt]);
      const int mt = rt - __builtin_amdgcn_readfirstlane(T.tp[e]);
      u.e = e; u.mt = mt; u.cnt = __builtin_amdgcn_readfirstlane(T.cnt[e]); u.pm = rt; u.row0 = rt * 256;
      u.B = Wr + ((size_t)e * NN + (size_t)pn * 256) * KK * 2;
    } else {
      u.e = NE; u.mt = rt - T.n_rt; u.cnt = NTOK; u.pm = rt; u.row0 = rt * 256;
      u.B = Ws + (size_t)pn * 256 * KK * 2;
    }
    if (STAGE == 2) u.pm = __builtin_amdgcn_readfirstlane(T.cp[u.e]);
    if (STAGE == 1) u.A = Abase;
    else u.A = Abase + (size_t)rt * 256 * DE;
    return true;
  }
  __device__ __forceinline__ unsigned arow(const pg8::UnitG& u, int r) const {
    if (u.e < NE) { int slot = u.mt * 256 + r; if (slot >= u.cnt) slot = 0; return (unsigned)LIST[u.e * NTOK + slot]; }
    return (unsigned)(u.mt * 256 + r);
  }
};
struct EpiMoe1 {
  static constexpr bool PERM = true, FP8 = true;
  unsigned char* H;
  __device__ __forceinline__ void operator()(const f32x4 (&acc)[2][2][4][2], const pg8::UnitG& u, int wr, int wc, int fr, int fq) const {
    const int row0 = u.row0 + wr * 64 + fr, col0 = u.pn * 128 + wc * 32 + 8 * fq;
#pragma unroll
    for (int ai = 0; ai < 2; ++ai)
#pragma unroll
      for (int m = 0; m < 4; ++m) { unsigned char* rowp = H + (size_t)(row0 + ai * 128 + m * 16) * DE + col0;
        float v[8];
#pragma unroll
        for (int n = 0; n < 2; ++n) { const f32x4 g = acc[ai][0][m][n], up = acc[ai][1][m][n];
#pragma unroll
          for (int j = 0; j < 4; ++j) { const float gg = g[j] * 0.015625f; v[4 * n + j] = gg * __builtin_amdgcn_rcpf(1.0f + __expf(-gg)) * (up[j] * 0.015625f); } }
        int q0 = 0, q1 = 0; q0 = __builtin_amdgcn_cvt_pk_fp8_f32(v[0], v[1], q0, false); q0 = __builtin_amdgcn_cvt_pk_fp8_f32(v[2], v[3], q0, true); q1 = __builtin_amdgcn_cvt_pk_fp8_f32(v[4], v[5], q1, false); q1 = __builtin_amdgcn_cvt_pk_fp8_f32(v[6], v[7], q1, true);
        u32x2 w; w.x = (unsigned)q0; w.y = (unsigned)q1; *(u32x2*)rowp = w; }
  }
};
struct EpiMoe2 {
  static constexpr bool PERM = true, FP8 = true;
  bf16_t* YRM; const float* LISTW; bf16_t* DUMMY;
  __device__ __forceinline__ void operator()(const f32x4 (&acc)[2][2][4][2], const pg8::UnitG& u, int wr, int wc, int fr, int fq) const {
    const int slot0 = u.mt * 256 + wr * 64 + fr;
    bf16_t* base = YRM + (size_t)(u.pm + slot0) * DM + u.pn * 256 + wc * 32 + 8 * fq;
    bf16_t* sink = DUMMY + (size_t)blockIdx.x * 8192 + ((wr * 4 + wc) * 64 + fq * 16 + fr) * 8;
    const float* lw = LISTW + u.e * NTOK + slot0;
    float wv[8];
#pragma unroll
    for (int i = 0; i < 8; ++i) wv[i] = lw[(i >> 2) * 128 + (i & 3) * 16];
#pragma unroll
    for (int ai = 0; ai < 2; ++ai)
#pragma unroll
      for (int m = 0; m < 4; ++m) { const int ds = ai * 128 + m * 16;
        const float w = wv[ai * 4 + m] * 0.03125f;
        bf16_t* rowp = (slot0 + ds < u.cnt) ? base + (size_t)ds * DM : sink;
#pragma unroll
        for (int bj = 0; bj < 2; ++bj) { const f32x4 v0 = acc[ai][bj][m][0] * w, v1 = acc[ai][bj][m][1] * w; u32x4 q; q.x = pk2(v0[0], v0[1]); q.y = pk2(v0[2], v0[3]); q.z = pk2(v1[0], v1[1]); q.w = pk2(v1[2], v1[3]); *(u32x4*)(rowp + bj * 128) = q; } }
  }
};


#define XB_TMO      128
#define XB_XCNT(j)  (256  + 64 * (j))
#define XB_XSUB(j)  (1280 + 64 * (j))
#define XB_XGEN(j)  (2304 + 64 * (j))
#define XB_TOP      3328
#define XB_TOPGEN   3392
#define XCD_BAR_WORDS 3456
#define XB_SPIN_CAP (1u << 18)
__device__ __forceinline__ unsigned xb_ld(unsigned* p)              { return __hip_atomic_load(p, __ATOMIC_RELAXED, __HIP_MEMORY_SCOPE_AGENT); }
__device__ __forceinline__ unsigned xb_add(unsigned* p, unsigned v) { return __hip_atomic_fetch_add(p, v, __ATOMIC_RELAXED, __HIP_MEMORY_SCOPE_AGENT); }
__device__ __forceinline__ unsigned xb_xcc_id() { return (unsigned)__builtin_amdgcn_s_getreg((3 << 11) | 20) & 0xFu; }
#define XB_SPIN(cond, bar) do { unsigned _sp = 0; while (cond) { __builtin_amdgcn_s_sleep(1); \
    if ((++_sp & 255u) == 0u) { if (xb_ld(&(bar)[XB_TMO])) break; if (_sp > XB_SPIN_CAP) { atomicAdd(&(bar)[XB_TMO], 1u); break; } } } } while (0)
struct XcdBarrier { unsigned* bar; unsigned x; volatile LAS unsigned* st; };
__device__ __forceinline__ XcdBarrier xcd_barrier_post(unsigned* bar, volatile LAS unsigned* st) {
    XcdBarrier b; b.bar = bar; b.x = xb_xcc_id(); b.st = st;
    if (threadIdx.x == 0) (void)xb_add(&bar[XB_XCNT(b.x)], 1u);
    return b;
}
__device__ __forceinline__ void xcd_barrier_complete(unsigned* bar, unsigned x, unsigned& nloc, unsigned& nx) {
    const unsigned G = gridDim.x * gridDim.y * gridDim.z;
    unsigned sum, cnt, mine, sp = 0u;
    for (;;) {
        sum = 0u; cnt = 0u; mine = 0u;
#pragma unroll
        for (unsigned j = 0; j < 16; ++j) { const unsigned c = xb_ld(&bar[XB_XCNT(j)]); sum += c; cnt += (c > 0u) ? 1u : 0u; mine = (j == x) ? c : mine; }
        if (sum == G) break;
        __builtin_amdgcn_s_sleep(1);
        if ((++sp & 255u) == 0u) { if (xb_ld(&bar[XB_TMO])) break; if (sp > XB_SPIN_CAP) { atomicAdd(&bar[XB_TMO], 1u); break; } }
    }
    nloc = mine > 0u ? mine : 1u; nx = cnt > 0u ? cnt : 1u;
}
__device__ __forceinline__ void xcd_barrier(const XcdBarrier& b) {
    asm volatile("s_waitcnt vmcnt(0)" ::: "memory");
    __syncthreads();
    if (threadIdx.x == 0) {
        unsigned* bar = b.bar;
        __builtin_amdgcn_s_waitcnt(0);
        unsigned nloc = b.st[0], nx = b.st[1];
        if (nloc == 0u) { xcd_barrier_complete(bar, b.x, nloc, nx); b.st[0] = nloc; b.st[1] = nx; }
        const unsigned old = xb_add(&bar[XB_XSUB(b.x)], 1u);
        const unsigned gen = old / nloc;
        if (old + 1u == (gen + 1u) * nloc) {
            __builtin_amdgcn_fence(__ATOMIC_RELEASE, "agent");
            asm volatile("s_waitcnt vmcnt(0)" ::: "memory");
            const unsigned og = xb_add(&bar[XB_TOP], 1u);
            const unsigned tg = og / nx;
            if (og + 1u == (tg + 1u) * nx) xb_add(&bar[XB_TOPGEN], 1u);
            else XB_SPIN(xb_ld(&bar[XB_TOPGEN]) == tg, bar);
            __builtin_amdgcn_fence(__ATOMIC_ACQUIRE, "agent");
            xb_add(&bar[XB_XGEN(b.x)], 1u);
            asm volatile("s_waitcnt vmcnt(0)" ::: "memory");
        } else {
            XB_SPIN(xb_ld(&bar[XB_XGEN(b.x)]) == gen, bar);
            __builtin_amdgcn_fence(__ATOMIC_ACQUIRE, "agent");
            asm volatile("s_waitcnt vmcnt(0)" ::: "memory");
        }
    }
    __syncthreads();
}

template <class T> __device__ __forceinline__ T* as_global(T* p) { const unsigned long long v = (unsigned long long)p; return (T*)(__attribute__((address_space(1))) T*)v; }
template <class T> __device__ __forceinline__ T* opaque_global(T* p) { unsigned long long v = (unsigned long long)p; asm volatile("" : "+s"(v)); return (T*)(__attribute__((address_space(1))) T*)v; }
struct InPtrs { const float* const* p; __device__ __forceinline__ const float* operator[](int k) const { return as_global(p[k]); } };
struct Frame {
  LAS unsigned char* lds; int tid, lane, wave, G, bid; unsigned char* ws; InPtrs in; float* out;
};

struct TJob { const float* W; unsigned char* WT; int N, ldtB, k0, n0, up, mode; float sc; };
__device__ __forceinline__ int gu_row(int n, int up) { return 256 * (n >> 7) + (n & 127) + up * 128; }
constexpr int TR0 = 16 * 104, TR1 = 16 * 16, TR2 = 20 * 16, TR3 = 16 * 16, TR4 = 2 * 10 * 4, TR5 = 2 * 16 * 4, TR6 = 4 * 16, TR7 = 2 * 64 * 16 * 4, TR8 = 64 * 4 * 16;
constexpr int T_NITEMS = TR0 + TR1 + TR2 + TR3 + TR4 + TR5 + TR6 + TR7 + TR8;
__device__ __forceinline__ TJob tj_decode(const Frame& F, int it) {
  unsigned char* ws = F.ws; int r = it;
  if (r < TR0) { const int kb = r / 104, nb = r % 104; return TJob{F.in[1], ws + WS_WIN, INC, DM * 2, 128 * kb, 128 * nb, 0, 0, 1.f}; } r -= TR0;
  if (r < TR1) { const int kb = r / 16, nb = r % 16; return TJob{F.in[19], ws + WS_WPM, DM, RW * 2, 128 * kb, 128 * nb, 0, 0, 1.f}; } r -= TR1;
  if (r < TR2) { const int kb = r / 16, nb = r % 16; return TJob{F.in[20], ws + WS_WPR, DM, RW * 2, 128 * kb, 128 * nb, 0, 0, 1.f}; } r -= TR2;
  if (r < TR3) { const int kb = r / 16, nb = r % 16; return TJob{F.in[21], ws + WS_WO, DM, DM * 2, 128 * kb, 128 * nb, 0, 0, 1.f}; } r -= TR3;
  if (r < TR4) { const int which = r / 40, rr = r % 40, blk = rr / 4, q = rr % 4; return TJob{F.in[which ? 16 : 14] + (size_t)blk * 65536, ws + WS_WRAX + (size_t)blk * 512 * 256 * 2, 256, 256 * 2, 128 * (q >> 1), 128 * (q & 1), which, 1, 1.f}; } r -= TR4;
  if (r < TR5) { const int which = r / 64, q = r % 64, kb = q / 4, nb = q % 4; return TJob{F.in[which ? 30 : 29], ws + WS_WSGU, DE, DM, 128 * kb, 128 * nb, which, 3, 64.f}; } r -= TR5;
  if (r < TR6) { const int kb = r / 16, nb = r % 16; return TJob{F.in[31], ws + WS_WSD, DM, DE, 128 * kb, 128 * nb, 0, 2, 32.f}; } r -= TR6;
  if (r < TR7) { const int which = r / 4096, rr = r % 4096, e = rr / 64, q = rr % 64, kb = q / 4, nb = q % 4; return TJob{F.in[which ? 27 : 26] + (size_t)e * DM * DE, ws + WS_WEGU + (size_t)e * 1024 * DM, DE, DM, 128 * kb, 128 * nb, which, 3, 64.f}; } r -= TR7;
  { const int e = r / 64, q = r % 64, kb = q / 16, nb = q % 16; return TJob{F.in[28] + (size_t)e * DE * DM, ws + WS_WED + (size_t)e * DM * DE, DM, DE, 128 * kb, 128 * nb, 0, 2, 32.f}; }
}
__device__ __forceinline__ void tj_load(const TJob& j, f32x4 (&v)[8], int wave, int lane) {
  const float* p = j.W + (size_t)(j.k0 + 16 * wave + (lane >> 5)) * j.N + j.n0 + 4 * (lane & 31);
#pragma unroll
  for (int i = 0; i < 8; ++i) v[i] = __builtin_nontemporal_load((const f32x4*)(p + (size_t)(2 * i) * j.N));
}
__device__ __forceinline__ void tj_store(const TJob& j, const f32x4 (&v)[8], LAS float* scr, int wave, int lane, int tid) {
#pragma unroll
  for (int i = 0; i < 8; ++i) { LAS float* d = scr + (16 * wave + 2 * i + (lane >> 5)) * 129 + 4 * (lane & 31); d[0] = v[i][0]; d[1] = v[i][1]; d[2] = v[i][2]; d[3] = v[i][3]; }
  LBAR();
  if (j.mode < 2) {
#pragma unroll
    for (int it = 0; it < 4; ++it) { const int idx = it * 512 + tid, n = idx >> 4, c = idx & 15; const LAS float* s = scr + (8 * c) * 129 + n;
      u32x4 o; o.x = pk2(s[0 * 129], s[1 * 129]); o.y = pk2(s[2 * 129], s[3 * 129]); o.z = pk2(s[4 * 129], s[5 * 129]); o.w = pk2(s[6 * 129], s[7 * 129]);
      const int nn = j.n0 + n; const int row = j.mode ? gu_row(nn, j.up) : nn;
      *(u32x4*)(j.WT + (size_t)row * j.ldtB + (j.k0 + 8 * c) * 2) = o; }
  } else {
#pragma unroll
    for (int it = 0; it < 2; ++it) { const int idx = it * 512 + tid, n = idx >> 3, c = idx & 7; const LAS float* s = scr + (16 * c) * 129 + n;
      int w[4];
#pragma unroll
      for (int q = 0; q < 4; ++q) { int t = 0; t = __builtin_amdgcn_cvt_pk_fp8_f32(s[(4 * q) * 129] * j.sc, s[(4 * q + 1) * 129] * j.sc, t, false); t = __builtin_amdgcn_cvt_pk_fp8_f32(s[(4 * q + 2) * 129] * j.sc, s[(4 * q + 3) * 129] * j.sc, t, true); w[q] = t; }
      u32x4 o; o.x = (unsigned)w[0]; o.y = (unsigned)w[1]; o.z = (unsigned)w[2]; o.w = (unsigned)w[3];
      const int nn = j.n0 + n; const int row = (j.mode == 3) ? gu_row(nn, j.up) : nn;
      __builtin_nontemporal_store(o, (u32x4*)(j.WT + (size_t)row * j.ldtB + j.k0 + 16 * c)); }
  }
  LBAR();
}

__device__ __forceinline__ void phase_prologue(const Frame& F) {
  LAS float* scr = (LAS float*)F.lds;
  unsigned char* ws = F.ws;
  {
    f32x4 vA[8], vB[8]; TJob jA, jB;
    int it = F.bid;
    if (it < T_NITEMS) { jA = tj_decode(F, it); tj_load(jA, vA, F.wave, F.lane); }
    while (it < T_NITEMS) {
      { const int itn = it + F.G; jB = tj_decode(F, itn < T_NITEMS ? itn : T_NITEMS - 1); tj_load(jB, vB, F.wave, F.lane); }
      tj_store(jA, vA, scr, F.wave, F.lane, F.tid);
      it += F.G; if (it >= T_NITEMS) break;
      { const int itn = it + F.G; jA = tj_decode(F, itn < T_NITEMS ? itn : T_NITEMS - 1); tj_load(jA, vA, F.wave, F.lane); }
      tj_store(jB, vB, scr, F.wave, F.lane, F.tid);
      it += F.G;
    }
  }
  const int gt = F.bid * 512 + F.tid, NGT = F.G * 512;
  { const float* x = F.in[0]; bf16_t* xb = (bf16_t*)(ws + WS_XB);
    for (int i = gt; i < NTOK * DM / 8; i += NGT) { const f32x4 a = *(const f32x4*)(x + (size_t)i * 8), b = *(const f32x4*)(x + (size_t)i * 8 + 4);
      u32x4 o; o.x = pk2(a[0], a[1]); o.y = pk2(a[2], a[3]); o.z = pk2(b[0], b[1]); o.w = pk2(b[2], b[3]); *(u32x4*)(xb + (size_t)i * 8) = o; } }
  { const float* wif = F.in[8]; bf16_t* wt = (bf16_t*)(ws + WS_SMALL + SM_WIFT);
    for (int i = gt; i < 16 * 6144; i += NGT) { const int n = i / 6144, k = i % 6144; float v = wif[k * 16 + n]; if (k >= 2048 && k < 4096) v *= 16.0f; wt[i] = (bf16_t)f2bf(v); } }
  { const float* lam = F.in[18]; float* c8 = (float*)(ws + WS_SMALL + SM_C8); for (int i = gt; i < RW; i += NGT) c8[i] = -8.0f * log1pf(expf(-lam[i])); }
  { const float* rwt = F.in[24]; bf16_t* rh = (bf16_t*)(ws + WS_SMALL + SM_RWH); bf16_t* rl = (bf16_t*)(ws + WS_SMALL + SM_RWL);
    for (int i = gt; i < NE * DM; i += NGT) { const int n = i / DM, k = i % DM; const float v = rwt[k * NE + n]; const unsigned h = f2bf(v); rh[i] = (bf16_t)h; rl[i] = (bf16_t)f2bf(v - __uint_as_float(h << 16)); } }
  { float* lw64 = (float*)(ws + WS_LISTW) + (size_t)NE * NTOK; for (int i = gt; i < NTOK; i += NGT) lw64[i] = 1.0f; }
  { int* ctl = (int*)(ws + WS_CTL); for (int i = gt; i < 4096; i += NGT) ctl[i] = 0; }
}

__device__ __forceinline__ void phase_mprep(const Frame& F) {
  unsigned char* ws = F.ws;
  const bf16_t* PROJ = (const bf16_t*)(ws + WS_PROJ);
  bf16_t* Q = (bf16_t*)(ws + WS_Q); bf16_t* Kb = (bf16_t*)(ws + WS_K); bf16_t* V = (bf16_t*)(ws + WS_V); bf16_t* XCM = (bf16_t*)(ws + WS_XCM);
  const bf16_t* WIFT = (const bf16_t*)(ws + WS_SMALL + SM_WIFT);
  float* IG = (float*)(ws + WS_SMALL + SM_IG); float* LF = (float*)(ws + WS_SMALL + SM_LF);
  const int g = F.tid;
  f32x4 cw[4]; for (int j = 0; j < 4; ++j) cw[j] = *(const f32x4*)(F.in[3] + j * MW + 4 * g);
  const f32x4 cb = *(const f32x4*)(F.in[4] + 4 * g);
  f32x4 wq[4], wk[4], wv[4];
  for (int i = 0; i < 4; ++i) { wq[i] = *(const f32x4*)(F.in[5] + g * 16 + 4 * i); wk[i] = *(const f32x4*)(F.in[6] + g * 16 + 4 * i); wv[i] = *(const f32x4*)(F.in[7] + g * 16 + 4 * i); }
  LAS unsigned char* AIMG = F.lds; LAS float* red = (LAS float*)(F.lds + 98432);
  const int r = F.lane & 15, gq = F.lane >> 4;
  for (int tile = F.bid; tile < NTOK / 8; tile += F.G) {
    const int t0 = tile * 8, s0 = t0 & (SEQ - 1);
    u32x2 rw[11];
#pragma unroll
    for (int j = 0; j < 11; ++j) { const int pos = s0 - 3 + j; rw[j] = (pos >= 0) ? *(const u32x2*)(PROJ + (size_t)(t0 - 3 + j) * INC + 4 * g) : (u32x2){0u, 0u}; }
#pragma unroll
    for (int tt = 0; tt < 8; ++tt) {
      const int t = t0 + tt;
      f32x4 xw[4];
#pragma unroll
      for (int j = 0; j < 4; ++j) xw[j] = (f32x4){bflo(rw[tt + j].x), bfhi(rw[tt + j].x), bflo(rw[tt + j].y), bfhi(rw[tt + j].y)};
      const f32x4 cv = cb + cw[0] * xw[0] + cw[1] * xw[1] + cw[2] * xw[2] + cw[3] * xw[3];
      f32x4 xc; for (int i = 0; i < 4; ++i) xc[i] = cv[i] * __builtin_amdgcn_rcpf(1.0f + __expf(-cv[i]));
      const f32x4 q = xc[0] * wq[0] + xc[1] * wq[1] + xc[2] * wq[2] + xc[3] * wq[3];
      f32x4 k = xc[0] * wk[0] + xc[1] * wk[1] + xc[2] * wk[2] + xc[3] * wk[3];
      const f32x4 v = xw[3][0] * wv[0] + xw[3][1] * wv[1] + xw[3][2] * wv[2] + xw[3][3] * wv[3];
      k = k * 0.0625f;
      const size_t o = (size_t)t * MW + 4 * g;
      u32x2 wqv, wkv, wvv, wxc;
      wqv.x = pk2(q[0], q[1]); wqv.y = pk2(q[2], q[3]); *(u32x2*)(Q + o) = wqv;
      wkv.x = pk2(k[0], k[1]); wkv.y = pk2(k[2], k[3]); *(u32x2*)(Kb + o) = wkv;
      wvv.x = pk2(v[0], v[1]); wvv.y = pk2(v[2], v[3]); *(u32x2*)(V + o) = wvv;
      wxc.x = pk2(xc[0], xc[1]); wxc.y = pk2(xc[2], xc[3]); *(u32x2*)(XCM + o) = wxc;
      LAS unsigned char* ar = AIMG + tt * 12304 + 8 * g;
      *(LAS u32x2*)(ar) = wqv; *(LAS u32x2*)(ar + 4096) = wkv; *(LAS u32x2*)(ar + 8192) = wvv;
    }
    LBAR();
    {
      f32x4 acc = (f32x4){0.f, 0.f, 0.f, 0.f};
#pragma unroll
      for (int ib = 0; ib < 3; ++ib) {
        bf16x8 bfr[8];
#pragma unroll
        for (int i = 0; i < 8; ++i) { const int ks = F.wave * 24 + ib * 8 + i; bfr[i] = *(const bf16x8*)(WIFT + (size_t)r * 6144 + ks * 32 + 8 * gq); }
#pragma unroll
        for (int i = 0; i < 8; ++i) { const int ks = F.wave * 24 + ib * 8 + i;
          const bf16x8 a = *(const LAS bf16x8*)(AIMG + (r & 7) * 12304 + (ks * 32 + 8 * gq) * 2);
          acc = __builtin_amdgcn_mfma_f32_16x16x32_bf16(a, bfr[i], acc, 0, 0, 0); }
      }
#pragma unroll
      for (int j = 0; j < 4; ++j) red[F.wave * 256 + (4 * gq + j) * 16 + r] = acc[j];
    }
    LBAR();
    if (F.tid < 128) {
      const int row = F.tid >> 4, n = F.tid & 15;
      float s = F.in[9][n];
#pragma unroll
      for (int w = 0; w < 8; ++w) s += red[w * 256 + F.tid];
      const int t = t0 + row, b = t >> 12, sp = t & (SEQ - 1);
      if (n < 8) IG[(size_t)(b * 8 + n) * SEQ + sp] = s;
      else LF[(size_t)(b * 8 + (n - 8)) * SEQ + sp] = fminf(s, 0.f) - log1pf(__expf(-fabsf(s)));
    }
    LBAR();
  }
}

__device__ __forceinline__ void phase_rconv(const Frame& F) {
  unsigned char* ws = F.ws;
  const bf16_t* PROJ = (const bf16_t*)(ws + WS_PROJ); bf16_t* XCR = (bf16_t*)(ws + WS_XCR);
  const int gt = F.bid * 512 + F.tid, NGT = F.G * 512;
  for (int it = gt; it < (NTOK / 16) * 640; it += NGT) {
    const int tile = it / 640, g = it % 640, t0 = tile * 16, s0 = t0 & (SEQ - 1);
    f32x4 cw[4]; for (int j = 0; j < 4; ++j) cw[j] = *(const f32x4*)(F.in[12] + j * RW + 4 * g);
    const f32x4 cb = *(const f32x4*)(F.in[13] + 4 * g);
    u32x2 rw[19];
#pragma unroll
    for (int j = 0; j < 19; ++j) { const int pos = s0 - 3 + j; rw[j] = (pos >= 0) ? *(const u32x2*)(PROJ + (size_t)(t0 - 3 + j) * INC + O_XR + 4 * g) : (u32x2){0u, 0u}; }
#pragma unroll
    for (int tt = 0; tt < 16; ++tt) {
      f32x4 cv = cb;
#pragma unroll
      for (int j = 0; j < 4; ++j) cv = cv + cw[j] * (f32x4){bflo(rw[tt + j].x), bfhi(rw[tt + j].x), bflo(rw[tt + j].y), bfhi(rw[tt + j].y)};
      u32x2 w; w.x = pk2(cv[0], cv[1]); w.y = pk2(cv[2], cv[3]); *(u32x2*)(XCR + (size_t)(t0 + tt) * RW + 4 * g) = w;
    }
  }
}

__device__ __forceinline__ float chunk_m(const float* IG, const float* LF, int bh, int c, int lane, int wave, LAS float* CS) {
  for (int cc = wave; cc < c; cc += 8) {
    const float lf = LF[(size_t)bh * SEQ + 64 * cc + lane], ig = IG[(size_t)bh * SEQ + 64 * cc + lane];
    const float b = wave_scan_sum(lf, lane), gmax = wave_max(ig - b);
    if (lane == 63) { CS[cc] = b; CS[64 + cc] = b + gmax; }
  }
  __syncthreads();
  float A = 0.f, B = -INFINITY;
  if (lane < c) { A = CS[lane]; B = CS[64 + lane]; }
#pragma unroll
  for (int o = 1; o < 64; o <<= 1) { const float pA = __shfl_up(A, o), pB = __shfl_up(B, o); if (lane >= o) { B = fmaxf(pB + A, B); A = pA + A; } }
  const float mafter = fmaxf(A, B);
  const float mc = __shfl(mafter, c > 0 ? c - 1 : 0);
  return c > 0 ? mc : 0.f;
}

__device__ __forceinline__ void phase_m1(const Frame& F, const int bid2, const int G2) {
  unsigned char* ws = F.ws;
  const bf16_t* Q = (const bf16_t*)(ws + WS_Q); const bf16_t* Kb = (const bf16_t*)(ws + WS_K); const bf16_t* V = (const bf16_t*)(ws + WS_V);
  const float* IG = (const float*)(ws + WS_SMALL + SM_IG); const float* LF = (const float*)(ws + WS_SMALL + SM_LF);
  float* INTER = (float*)(ws + WS_SMALL + SM_INTER); float* EMR = (float*)(ws + WS_SMALL + SM_EMR); float* DENI = (float*)(ws + WS_SMALL + SM_DENI);
  bf16_t* HNI = (bf16_t*)(ws + WS_HNI);
  LAS unsigned char* QS = F.lds; LAS unsigned char* KS = F.lds + 33792; LAS unsigned char* VT = F.lds + 67584; LAS unsigned char* PS = F.lds + 104448;
  LAS float* SCg = (LAS float*)(F.lds + 113664); LAS float* SCM = SCg + 64;
  const int r = F.lane & 15, gq = F.lane >> 4, w = F.wave;
  for (int item = bid2; item < 16 * NCH; item += G2) {
    const int bh = item / NCH, c = item % NCH, b = bh >> 3, h = bh & 7, tok0 = b * SEQ + 64 * c;
    const float m = chunk_m(IG, LF, bh, c, F.lane, w, (LAS float*)(F.lds + 114176));
    const float lf_c = LF[(size_t)bh * SEQ + 64 * c + F.lane], ig_c = IG[(size_t)bh * SEQ + 64 * c + F.lane];
    const float b_l = wave_scan_sum(lf_c, F.lane), g_l = ig_c - b_l;
    const float M_l = fmaxf(m, wave_scan_max(g_l, F.lane));
    if (w == 0) { SCg[F.lane] = g_l; SCM[F.lane] = M_l; INTER[(size_t)(tok0 + F.lane) * 8 + h] = __expf(m - M_l); EMR[(size_t)(tok0 + F.lane) * 8 + h] = __expf(-(b_l + M_l)); }
#pragma unroll
    for (int i = 0; i < 4; ++i) {
      const int idx = i * 512 + F.tid, row = idx >> 5, c16 = idx & 31;
      const size_t go = (size_t)(tok0 + row) * MW + 256 * h + 8 * c16;
      *(LAS u32x4*)(QS + row * 528 + c16 * 16) = *(const u32x4*)(Q + go);
      *(LAS u32x4*)(KS + row * 528 + c16 * 16) = *(const u32x4*)(Kb + go);
    }
    {
      const int sp = F.tid & 31, cq = F.tid >> 5;
#pragma unroll
      for (int i = 0; i < 2; ++i) {
        const size_t go = (size_t)(tok0 + 2 * sp) * MW + 256 * h + 8 * (cq + 16 * i);
        const u32x4 v0 = *(const u32x4*)(V + go), v1 = *(const u32x4*)(V + go + MW);
        const unsigned a0[4] = {v0.x, v0.y, v0.z, v0.w}, a1[4] = {v1.x, v1.y, v1.z, v1.w};
#pragma unroll
        for (int e = 0; e < 4; ++e) { const int dv = 8 * (cq + 16 * i) + 2 * e;
          *(LAS unsigned*)(VT + dv * 144 + sp * 4) = (a0[e] & 0xffffu) | (a1[e] << 16);
          *(LAS unsigned*)(VT + (dv + 1) * 144 + sp * 4) = (a0[e] >> 16) | (a1[e] & 0xffff0000u); }
      }
    }
    __syncthreads();
    {
      const int mi = w & 3;
#pragma unroll
      for (int nn = 0; nn < 2; ++nn) {
        const int ni = 2 * (w >> 2) + nn;
        f32x4 acc = (f32x4){0.f, 0.f, 0.f, 0.f};
        if (ni <= mi) {
#pragma unroll
          for (int ks = 0; ks < 8; ++ks) {
            const bf16x8 a = *(const LAS bf16x8*)(QS + (16 * mi + r) * 528 + (32 * ks + 8 * gq) * 2);
            const bf16x8 bb = *(const LAS bf16x8*)(KS + (16 * ni + r) * 528 + (32 * ks + 8 * gq) * 2);
            acc = __builtin_amdgcn_mfma_f32_16x16x32_bf16(a, bb, acc, 0, 0, 0);
          }
        }
        const int s = 16 * ni + r; const float gs = SCg[s];
#pragma unroll
        for (int j = 0; j < 4; ++j) { const int l = 16 * mi + 4 * gq + j; const float p = (s <= l) ? acc[j] * __expf(gs - SCM[l]) : 0.f; *(LAS bf16_t*)(PS + l * 144 + s * 2) = (bf16_t)f2bf(p); }
      }
    }
    __syncthreads();
    if (F.tid < 64) { float s = 0.f; for (int k = 0; k < 64; ++k) s += bf1(*(const LAS bf16_t*)(PS + F.tid * 144 + k * 2)); DENI[(size_t)(tok0 + F.tid) * 8 + h] = s; }
#pragma unroll
    for (int nn = 0; nn < 2; ++nn) {
      const int ni = 2 * w + nn;
#pragma unroll
      for (int mi = 0; mi < 4; ++mi) {
        f32x4 acc = (f32x4){0.f, 0.f, 0.f, 0.f};
#pragma unroll
        for (int ks = 0; ks < 2; ++ks) {
          const bf16x8 a = *(const LAS bf16x8*)(PS + (16 * mi + r) * 144 + (32 * ks + 8 * gq) * 2);
          const bf16x8 bb = *(const LAS bf16x8*)(VT + (16 * ni + r) * 144 + (32 * ks + 8 * gq) * 2);
          acc = __builtin_amdgcn_mfma_f32_16x16x32_bf16(a, bb, acc, 0, 0, 0);
        }
#pragma unroll
        for (int j = 0; j < 4; ++j) HNI[(size_t)(tok0 + 16 * mi + 4 * gq + j) * MW + 256 * h + 16 * ni + r] = (bf16_t)f2bf(acc[j]);
      }
    }
    __syncthreads();
  }
}

__device__ __forceinline__ void phase_m2(const Frame& F, const int nblk) {
  unsigned char* ws = F.ws;
  const bf16_t* Q = (const bf16_t*)(ws + WS_Q); const bf16_t* Kb = (const bf16_t*)(ws + WS_K); const bf16_t* V = (const bf16_t*)(ws + WS_V);
  const float* IG = (const float*)(ws + WS_SMALL + SM_IG); const float* LF = (const float*)(ws + WS_SMALL + SM_LF);
  float* QN = (float*)(ws + WS_SMALL + SM_QN);
  bf16_t* HNE = (bf16_t*)(ws + WS_HNE);
  LAS unsigned char* QS = F.lds; LAS unsigned char* KT = F.lds + 33792; LAS unsigned char* WVT = F.lds + 70656; LAS unsigned char* CT = F.lds + 77568;
  LAS float* TD = (LAS float*)(F.lds + 111360); LAS float* CS = (LAS float*)(F.lds + 111616);
  float* DUMMY = (float*)(ws + WS_M2TAB + 4 * MiB);
  const int w = F.wave;
  for (int item = F.bid; item < 128; item += nblk) {
    const int bh = item >> 3, sl = item & 7, b = bh >> 3, h = bh & 7, dv0 = 32 * sl;
    float* TI = (float*)(ws + WS_M2TAB) + (size_t)item * 8192; float* TW = TI + 4096;
    const int lane = F.lane;
    for (int i = F.tid; i < (6912 + 33792) / 4; i += 512) *(LAS unsigned*)(WVT + 4 * i) = 0u;
    float gk[8], pk[8];
#pragma unroll
    for (int i = 0; i < 8; ++i) {
      const int cc = w + 8 * i;
      const float lf = LF[(size_t)bh * SEQ + 64 * cc + lane], ig = IG[(size_t)bh * SEQ + 64 * cc + lane];
      const float bl = wave_scan_sum(lf, lane), g = ig - bl;
      const float gmax = wave_max(g), pm = wave_scan_max(g, lane);
      gk[i] = g; pk[i] = pm;
      if (lane == 63) { CS[cc] = bl; CS[64 + cc] = bl + gmax; }
    }
    __syncthreads();
    {
      float A = CS[lane], B = CS[64 + lane]; const float gmx = B - A;
#pragma unroll
      for (int o = 1; o < 64; o <<= 1) { const float pA = __shfl_up(A, o), pB = __shfl_up(B, o); if (lane >= o) { B = fmaxf(pB + A, B); A = pA + A; } }
      const float mafter = fmaxf(A, B);
      float mstart = __shfl_up(mafter, 1); if (lane == 0) mstart = 0.f;
      const float M63 = fmaxf(mstart, gmx);
      if (w == 0) TD[lane] = __expf(mstart - M63);
#pragma unroll
      for (int i = 0; i < 8; ++i) {
        const int cc = w + 8 * i;
        const float ms = __shfl(mstart, cc), m6 = __shfl(M63, cc);
        TI[cc * 64 + lane] = __expf(ms - fmaxf(ms, pk[i])); TW[cc * 64 + lane] = __expf(gk[i] - m6);
      }
    }
    __threadfence(); __syncthreads();
    f32x4 acc[2][3];
#pragma unroll
    for (int a = 0; a < 2; ++a)
#pragma unroll
      for (int n = 0; n < 3; ++n) acc[a][n] = (f32x4){0.f, 0.f, 0.f, 0.f};
    u32x4 qrA[4], krA[2][2], vrA = (u32x4){0u, 0u, 0u, 0u}, qrB[4], krB[2][2], vrB = (u32x4){0u, 0u, 0u, 0u};
    float wsA = 0.f, wsB = 0.f; f32x4 ivA = (f32x4){0.f, 0.f, 0.f, 0.f}, ivB = ivA;
#define M2_LOAD(qreg, kreg, vreg, wsr, ivr, c) do { const int tk_ = b * SEQ + 64 * (c); \
      _Pragma("unroll") for (int i = 0; i < 4; ++i) { const int idx = i * 512 + tdx, row = idx >> 5, c16 = idx & 31; qreg[i] = *(const u32x4*)(Q + (size_t)(tk_ + row) * MW + 256 * h + 8 * c16); } \
      _Pragma("unroll") for (int i = 0; i < 2; ++i) { const size_t go = (size_t)(tk_ + 2 * sp) * MW + 256 * h + 8 * (cq + 16 * i); kreg[i][0] = *(const u32x4*)(Kb + go); kreg[i][1] = *(const u32x4*)(Kb + go + MW); } \
      vreg = *(const u32x4*)(V + (size_t)(tk_ + lane) * MW + 256 * h + dv0 + 8 * (w & 3)); \
      wsr = TW[(c) * 64 + lane]; \
      ivr = *(const f32x4*)(TI + (c) * 64 + 16 * (w & 3) + 4 * gq); } while (0)
#define M2_AMMA(mi, nt) \
        f32x4 a2 = (f32x4){0.f, 0.f, 0.f, 0.f}; \
        _Pragma("unroll") for (int ks = 0; ks < 8; ++ks) { \
          const bf16x8 a = *(const LAS bf16x8*)(QS + (16 * (mi) + r) * 528 + (32 * ks + 8 * gq) * 2); \
          const bf16x8 bb = *(const LAS bf16x8*)(CT + (16 * (nt) + r) * 528 + (32 * ks + 8 * gq) * 2); \
          a2 = __builtin_amdgcn_mfma_f32_16x16x32_bf16(a, bb, a2, 0, 0, 0); }
#define M2_ATILE_H(mi, nt, tok0, ivr) do { M2_AMMA(mi, nt) \
        _Pragma("unroll") for (int j = 0; j < 4; ++j) { const int l = 16 * (mi) + 4 * gq + j; \
          HNE[(size_t)((tok0) + l) * MW + 256 * h + dv0 + 16 * (nt) + r] = (bf16_t)f2bf(a2[j] * ivr[j]); } } while (0)
#define M2_ATILE_Q(mi, nt, tok0, ivr) do { M2_AMMA(mi, nt) \
        _Pragma("unroll") for (int j = 0; j < 4; ++j) { const int l = 16 * (mi) + 4 * gq + j; \
          float* qp = ((nt) == 2 && r == 0) ? (QN + (size_t)((tok0) + l) * 8 + h) : (DUMMY + tdx * 4 + j); *qp = a2[j] * ivr[j]; } } while (0)
#define M2_BODY(c, qreg, kreg, vreg, wsr, ivr) do { \
      int tdx = (int)threadIdx.x; asm volatile("" : "+v"(tdx)); \
      const int lane = tdx & 63, r = lane & 15, gq = lane >> 4, sp = tdx & 31, cq = tdx >> 5; \
      const int tok0 = b * SEQ + 64 * (c); \
      _Pragma("unroll") for (int i = 0; i < 4; ++i) { const int idx = i * 512 + tdx, row = idx >> 5, c16 = idx & 31; *(LAS u32x4*)(QS + row * 528 + c16 * 16) = qreg[i]; } \
      _Pragma("unroll") for (int i = 0; i < 2; ++i) { \
        const unsigned k0[4] = {kreg[i][0].x, kreg[i][0].y, kreg[i][0].z, kreg[i][0].w}, k1[4] = {kreg[i][1].x, kreg[i][1].y, kreg[i][1].z, kreg[i][1].w}; \
        _Pragma("unroll") for (int e = 0; e < 4; ++e) { const int dk = 8 * (cq + 16 * i) + 2 * e; \
          *(LAS unsigned*)(KT + dk * 144 + sp * 4) = (k0[e] & 0xffffu) | (k1[e] << 16); \
          *(LAS unsigned*)(KT + (dk + 1) * 144 + sp * 4) = (k0[e] >> 16) | (k1[e] & 0xffff0000u); } } \
      if (w < 4) { const unsigned vw[4] = {vreg.x, vreg.y, vreg.z, vreg.w}; \
        _Pragma("unroll") for (int e = 0; e < 4; ++e) { *(LAS bf16_t*)(WVT + (8 * w + 2 * e) * 144 + lane * 2) = (bf16_t)f2bf(bflo(vw[e]) * wsr); *(LAS bf16_t*)(WVT + (8 * w + 2 * e + 1) * 144 + lane * 2) = (bf16_t)f2bf(bfhi(vw[e]) * wsr); } \
      } else if (w == 4) { *(LAS bf16_t*)(WVT + 32 * 144 + lane * 2) = (bf16_t)f2bf(wsr); } \
      const f32x4 ivc = ivr; \
      { const int cn_ = ((c) + 2 < NCH) ? (c) + 2 : NCH - 1; M2_LOAD(qreg, kreg, vreg, wsr, ivr, cn_); } \
      LBAR(); \
      M2_ATILE_H(w & 3, w >> 2, tok0, ivc); \
      M2_ATILE_Q(w & 3, 2 + (w >> 2), tok0, ivc); \
      const float decay = TD[(c)]; \
      _Pragma("unroll") for (int mt = 0; mt < 2; ++mt) \
        _Pragma("unroll") for (int n2 = 0; n2 < 3; ++n2) { \
          f32x4 cacc = acc[mt][n2] * decay; \
          _Pragma("unroll") for (int ks = 0; ks < 2; ++ks) { \
            const bf16x8 a = *(const LAS bf16x8*)(KT + (32 * w + 16 * mt + r) * 144 + (32 * ks + 8 * gq) * 2); \
            const bf16x8 bb = *(const LAS bf16x8*)(WVT + (16 * n2 + r) * 144 + (32 * ks + 8 * gq) * 2); \
            cacc = __builtin_amdgcn_mfma_f32_16x16x32_bf16(a, bb, cacc, 0, 0, 0); } \
          acc[mt][n2] = cacc; } \
      LBAR(); \
      _Pragma("unroll") for (int mt = 0; mt < 2; ++mt) \
        _Pragma("unroll") for (int n2 = 0; n2 < 3; ++n2) { u32x2 q; q.x = pk2(acc[mt][n2][0], acc[mt][n2][1]); q.y = pk2(acc[mt][n2][2], acc[mt][n2][3]); \
          *(LAS u32x2*)(CT + (16 * n2 + r) * 528 + (32 * w + 16 * mt + 4 * gq) * 2) = q; } \
    } while (0)
    { const int tdx = F.tid, sp = tdx & 31, cq = tdx >> 5, gq = (tdx & 63) >> 4;
      M2_LOAD(qrA, krA, vrA, wsA, ivA, 0);
      M2_LOAD(qrB, krB, vrB, wsB, ivB, 1); }
    __syncthreads();
#pragma unroll 1
    for (int c = 0; c < NCH; c += 2) {
      M2_BODY(c, qrA, krA, vrA, wsA, ivA);
      M2_BODY(c + 1, qrB, krB, vrB, wsB, ivB);
    }
#undef M2_BODY
#undef M2_ATILE_H
#undef M2_ATILE_Q
#undef M2_AMMA
#undef M2_LOAD
    __syncthreads();
  }
}

__device__ __forceinline__ void phase_ragg(const Frame& F) {
  unsigned char* ws = F.ws;
  const float* RA = (const float*)(ws + WS_RA); const bf16_t* RBb = (const bf16_t*)(ws + WS_RB);
  float* AGGA = (float*)(ws + WS_SMALL + SM_AGGA); float* AGGB = (float*)(ws + WS_SMALL + SM_AGGB);
  const int gt = F.bid * 512 + F.tid, NGT = F.G * 512;
#pragma unroll 1
  for (int it = gt; it < 2 * NCH * (RW / 2); it += NGT) {
    const int bc = it / (RW / 2), ch = 2 * (it - bc * (RW / 2));
    const float* pa = RA + (size_t)bc * 64 * RW + ch; const bf16_t* pb = RBb + (size_t)bc * 64 * RW + ch;
    float A0 = 1.f, B0 = 0.f, A1 = 1.f, B1 = 0.f;
#pragma unroll 1
    for (int tb = 0; tb < 8; ++tb) {
      f32x2 a[8]; unsigned bb[8];
#pragma unroll
      for (int t = 0; t < 8; ++t) { a[t] = *(const f32x2*)(pa + (size_t)(tb * 8 + t) * RW); bb[t] = *(const unsigned*)(pb + (size_t)(tb * 8 + t) * RW); }
#pragma unroll
      for (int t = 0; t < 8; ++t) { A0 *= a[t][0]; B0 = a[t][0] * B0 + bflo(bb[t]); A1 *= a[t][1]; B1 = a[t][1] * B1 + bfhi(bb[t]); }
    }
    *(f32x2*)(AGGA + (size_t)bc * RW + ch) = (f32x2){A0, A1}; *(f32x2*)(AGGB + (size_t)bc * RW + ch) = (f32x2){B0, B1};
  }
}
__device__ __forceinline__ float gelu_fast(float x) {
  const float u = 0.7978845608028654f * (x + 0.044715f * x * x * x); return x * __builtin_amdgcn_rcpf(1.0f + __expf(-2.0f * u)); }
__device__ __forceinline__ void phase_rscan(const Frame& F) {
  unsigned char* ws = F.ws;
  const float* RA = (const float*)(ws + WS_RA); const bf16_t* RBb = (const bf16_t*)(ws + WS_RB);
  const float* AGGA = (const float*)(ws + WS_SMALL + SM_AGGA); const float* AGGB = (const float*)(ws + WS_SMALL + SM_AGGB);
  const bf16_t* PROJ = (const bf16_t*)(ws + WS_PROJ); bf16_t* YR = (bf16_t*)(ws + WS_YR);
  const int gt = F.bid * 512 + F.tid, NGT = F.G * 512;
  for (int it = gt; it < 2 * NCH * (RW / 2); it += NGT) {
    const int bc = it / (RW / 2), ch = 2 * (it % (RW / 2)), t0 = bc * 64, b = bc / NCH, cidx = bc % NCH;
    float h0 = 0.f, h1 = 0.f;
    for (int c0 = 0; c0 < cidx; c0 += 16) {
      f32x2 ca[16], cb[16];
#pragma unroll
      for (int k = 0; k < 16; ++k) { const int cc = c0 + k; const int j = (b * NCH + (cc < cidx ? cc : 0)) * RW + ch; ca[k] = *(const f32x2*)(AGGA + j); cb[k] = *(const f32x2*)(AGGB + j); }
#pragma unroll
      for (int k = 0; k < 16; ++k) { if (c0 + k < cidx) { h0 = ca[k][0] * h0 + cb[k][0]; h1 = ca[k][1] * h1 + cb[k][1]; } }
    }
#pragma unroll
    for (int tb = 0; tb < 4; ++tb) {
      f32x2 a[16]; unsigned bb[16], xg[16];
#pragma unroll
      for (int t = 0; t < 16; ++t) { const size_t o = (size_t)(t0 + tb * 16 + t) * RW + ch;
        a[t] = __builtin_nontemporal_load((const f32x2*)(RA + o)); bb[t] = __builtin_nontemporal_load((const unsigned*)(RBb + o)); xg[t] = __builtin_nontemporal_load((const unsigned*)(PROJ + (size_t)(t0 + tb * 16 + t) * INC + O_XG + ch)); }
#pragma unroll
      for (int t = 0; t < 16; ++t) { h0 = a[t][0] * h0 + bflo(bb[t]); h1 = a[t][1] * h1 + bfhi(bb[t]);
        *(unsigned*)(YR + (size_t)(t0 + tb * 16 + t) * RW + ch) = pk2(h0 * gelu_fast(bflo(xg[t])), h1 * gelu_fast(bfhi(xg[t]))); }
    }
  }
}

__device__ __forceinline__ void phase_ym(const Frame& F) {
  unsigned char* ws = F.ws;
  const bf16_t* HNI = (const bf16_t*)(ws + WS_HNI); const bf16_t* HNE = (const bf16_t*)(ws + WS_HNE);
  const float* EMR = (const float*)(ws + WS_SMALL + SM_EMR); const float* DENI = (const float*)(ws + WS_SMALL + SM_DENI); const float* QN = (const float*)(ws + WS_SMALL + SM_QN);
  const bf16_t* XCM = (const bf16_t*)(ws + WS_XCM); const bf16_t* PROJ = (const bf16_t*)(ws + WS_PROJ); bf16_t* YM = (bf16_t*)(ws + WS_YM);
  const float* normw = F.in[10]; const float* skip = F.in[11];
  const int gw = F.bid * 8 + F.wave, NGW = F.G * 8, lane = F.lane;
  for (int tA = gw; tA < NTOK; tA += 2 * NGW) {
    const int tBr = tA + NGW; const bool okB = tBr < NTOK; const int tB = okB ? tBr : tA;
    u32x2 a[2][8], e[2][8], xcw[2][8], zw[2][8]; float den[2][8], emr[2][8];
#pragma unroll
    for (int u = 0; u < 2; ++u) { const int t = u ? tB : tA;
#pragma unroll
      for (int h = 0; h < 8; ++h) {
        const size_t o = (size_t)t * MW + 256 * h + 4 * lane;
        a[u][h] = __builtin_nontemporal_load((const u32x2*)(HNI + o)); e[u][h] = __builtin_nontemporal_load((const u32x2*)(HNE + o)); xcw[u][h] = __builtin_nontemporal_load((const u32x2*)(XCM + o));
        zw[u][h] = __builtin_nontemporal_load((const u32x2*)(PROJ + (size_t)t * INC + O_Z + 256 * h + 4 * lane));
        den[u][h] = DENI[t * 8 + h] + QN[t * 8 + h]; emr[u][h] = EMR[t * 8 + h];
      } }
#pragma unroll
    for (int u = 0; u < 2; ++u) { const int t = u ? tB : tA;
      if (u == 0 || okB) {
#pragma unroll
      for (int h = 0; h < 8; ++h) {
        const int col = 256 * h + 4 * lane;
        const float inv = 1.0f / fmaxf(fabsf(den[u][h]), emr[u][h]);
        const float hv[4] = {(bflo(a[u][h].x) + bflo(e[u][h].x)) * inv, (bfhi(a[u][h].x) + bfhi(e[u][h].x)) * inv, (bflo(a[u][h].y) + bflo(e[u][h].y)) * inv, (bfhi(a[u][h].y) + bfhi(e[u][h].y)) * inv};
        const float mean = wave_sum((hv[0] + hv[1]) + (hv[2] + hv[3])) * (1.0f / 256.0f);
        float d[4]; float s2 = 0.f;
#pragma unroll
        for (int j = 0; j < 4; ++j) { d[j] = hv[j] - mean; s2 += d[j] * d[j]; }
        const float rstd = rsqrtf(wave_sum(s2) * (1.0f / 256.0f) + LN_EPS);
        const f32x4 nw = *(const f32x4*)(normw + col), sk = *(const f32x4*)(skip + col);
        const float xc[4] = {bflo(xcw[u][h].x), bfhi(xcw[u][h].x), bflo(xcw[u][h].y), bfhi(xcw[u][h].y)}, z[4] = {bflo(zw[u][h].x), bfhi(zw[u][h].x), bflo(zw[u][h].y), bfhi(zw[u][h].y)};
        float y[4];
#pragma unroll
        for (int j = 0; j < 4; ++j) y[j] = (d[j] * rstd * nw[j] + sk[j] * xc[j]) * siluf_(z[j]);
        u32x2 w; w.x = pk2(y[0], y[1]); w.y = pk2(y[2], y[3]); *(u32x2*)(YM + (size_t)t * RW + col) = w;
      } }
    }
  }
}

__device__ __forceinline__ void phase_ln_router(const Frame& F) {
  unsigned char* ws = F.ws;
  float* X1 = (float*)(ws + WS_X1); unsigned char* X1Q = ws + WS_X1B;
  int* CNT = (int*)(ws + WS_CTL); int* LIST = (int*)(ws + WS_LIST); float* LISTW = (float*)(ws + WS_LISTW); int* TOKES = (int*)(ws + WS_TOKES);
  const float* g1 = F.in[22]; const float* b1 = F.in[23]; const float* rw = F.in[24]; const float* rbias = F.in[25];
  LAS unsigned char* XH = F.lds; LAS unsigned char* XL = F.lds + 65792;
  const bf16_t* RWH = (const bf16_t*)(ws + WS_SMALL + SM_RWH); const bf16_t* RWL = (const bf16_t*)(ws + WS_SMALL + SM_RWL);
  const int w = F.wave;
  for (int tile = F.bid; tile < NTOK / 16; tile += F.G) {
    const int t0 = tile * 16;
    int lane = F.lane; asm volatile("" : "+v"(lane));
    const int r16 = lane & 15, gq = lane >> 4;
#pragma unroll 1
    for (int q = 0; q < 2; ++q) {
      const int tl = 2 * w + q, t = t0 + tl;
      float* xr = X1 + (size_t)t * DM;
      f32x4 v[8]; float s = 0.f;
#pragma unroll
      for (int j = 0; j < 8; ++j) { v[j] = *(const f32x4*)(xr + 4 * lane + 256 * j); s += (v[j][0] + v[j][1]) + (v[j][2] + v[j][3]); }
      const float mean = wave_sum(s) * (1.0f / DM); float s2 = 0.f;
#pragma unroll
      for (int j = 0; j < 8; ++j) { v[j] = v[j] - mean; s2 += (v[j][0] * v[j][0] + v[j][1] * v[j][1]) + (v[j][2] * v[j][2] + v[j][3] * v[j][3]); }
      const float rstd = rsqrtf(wave_sum(s2) * (1.0f / DM) + LN_EPS);
#pragma unroll
      for (int j = 0; j < 8; ++j) {
        const int col = 4 * lane + 256 * j;
        const f32x4 gg = *(const f32x4*)(g1 + col), bb = *(const f32x4*)(b1 + col);
        const f32x4 o = v[j] * rstd * gg + bb;
        *(f32x4*)(xr + col) = o;
        u32x2 pw; pw.x = pk2(o[0], o[1]); pw.y = pk2(o[2], o[3]);
        { int q8 = 0; q8 = __builtin_amdgcn_cvt_pk_fp8_f32(o[0], o[1], q8, false); q8 = __builtin_amdgcn_cvt_pk_fp8_f32(o[2], o[3], q8, true); *(int*)(X1Q + (size_t)t * DM + col) = q8; }
        { float lo[4];
#pragma unroll
          for (int e = 0; e < 4; ++e) lo[e] = o[e] - __uint_as_float(f2bf(o[e]) << 16);
          *(LAS u32x2*)(XH + tl * 4112 + col * 2) = pw; u32x2 lw; lw.x = pk2(lo[0], lo[1]); lw.y = pk2(lo[2], lo[3]); *(LAS u32x2*)(XL + tl * 4112 + col * 2) = lw; }
      }
    }
    __syncthreads();
    f32x4 lacc[4];
    {
      const bf16_t* rh = RWH + (size_t)r16 * DM + 256 * w + 8 * gq; const bf16_t* rl = RWL + (size_t)r16 * DM + 256 * w + 8 * gq;
      const LAS unsigned char* xh = XH + r16 * 4112 + (256 * w + 8 * gq) * 2; const LAS unsigned char* xl = XL + r16 * 4112 + (256 * w + 8 * gq) * 2;
#pragma unroll
      for (int nt = 0; nt < 4; ++nt) {
        f32x4 a4 = (f32x4){0.f, 0.f, 0.f, 0.f};
#pragma unroll
        for (int kh = 0; kh < 2; ++kh) {
          bf16x8 bh[4], bl[4];
#pragma unroll
          for (int k2 = 0; k2 < 4; ++k2) { bh[k2] = *(const bf16x8*)(rh + (size_t)(16 * nt) * DM + 32 * (4 * kh + k2)); bl[k2] = *(const bf16x8*)(rl + (size_t)(16 * nt) * DM + 32 * (4 * kh + k2)); }
#pragma unroll
          for (int k2 = 0; k2 < 4; ++k2) {
            const bf16x8 ah = *(const LAS bf16x8*)(xh + 64 * (4 * kh + k2));
            const bf16x8 al = *(const LAS bf16x8*)(xl + 64 * (4 * kh + k2));
            a4 = __builtin_amdgcn_mfma_f32_16x16x32_bf16(ah, bh[k2], a4, 0, 0, 0);
            a4 = __builtin_amdgcn_mfma_f32_16x16x32_bf16(al, bh[k2], a4, 0, 0, 0);
            a4 = __builtin_amdgcn_mfma_f32_16x16x32_bf16(ah, bl[k2], a4, 0, 0, 0);
          }
          asm volatile("" ::: "memory");
        }
        lacc[nt] = a4;
      }
    }
    __syncthreads();
    LAS float* PART = (LAS float*)F.lds;
#pragma unroll
    for (int nt = 0; nt < 4; ++nt)
#pragma unroll
      for (int j = 0; j < 4; ++j) PART[(w * 16 + 4 * gq + j) * 64 + 16 * nt + r16] = lacc[nt][j];
    __syncthreads();
    LAS int* lcnt = (LAS int*)(F.lds + 40960); LAS int* lbase = lcnt + 64;
    if (F.tid < 64) lcnt[F.tid] = 0;
    __syncthreads();
    int lslot[2], rnk[2]; float wg[2];
#pragma unroll
    for (int q = 0; q < 2; ++q) {
      const int tl = 2 * w + q;
      float logit = 0.f;
#pragma unroll
      for (int ww = 0; ww < 8; ++ww) logit += PART[(ww * 16 + tl) * 64 + lane];
      const float score = 1.0f / (1.0f + expf(-logit));
      const float biased = score + rbias[lane];
      int cnt = 0;
#pragma unroll
      for (int d = 1; d < 8; ++d) { const int other = (lane & ~7) | ((lane + d) & 7); const float ov = __shfl(biased, other); cnt += (ov > biased || (ov == biased && other < lane)) ? 1 : 0; }
      float gs = cnt < 2 ? biased : 0.f;
      gs += __shfl_xor(gs, 1); gs += __shfl_xor(gs, 2); gs += __shfl_xor(gs, 4);
      const int gi = lane >> 3; int grank = 0;
#pragma unroll
      for (int gg = 0; gg < 8; ++gg) { const float og = __shfl(gs, 8 * gg); grank += (og > gs || (og == gs && gg < gi)) ? 1 : 0; }
      const float val = grank < 4 ? biased : -INFINITY;
      int erank = 0;
      for (int e2 = 0; e2 < 64; ++e2) { const float ov = __shfl(val, e2); erank += (ov > val || (ov == val && e2 < lane)) ? 1 : 0; }
      const bool chosen = erank < 8;
      const float wsum = wave_sum(chosen ? score : 0.f);
      rnk[q] = erank; wg[q] = score / wsum * 2.5f; lslot[q] = -1;
      if (chosen) lslot[q] = atomicAdd((int*)(lcnt + lane), 1);
    }
    __syncthreads();
    if (F.tid < 64) { const int c = lcnt[F.tid]; lbase[F.tid] = c ? atomicAdd(&CNT[F.tid * 64], c) : 0; }
    __syncthreads();
#pragma unroll
    for (int q = 0; q < 2; ++q) {
      if (lslot[q] >= 0) { const int t = t0 + 2 * w + q; const int slot = lbase[lane] + lslot[q];
        LIST[lane * NTOK + slot] = t; LISTW[lane * NTOK + slot] = wg[q]; TOKES[t * 8 + rnk[q]] = (lane << 16) | slot; }
    }
    __syncthreads();
  }
}

__device__ __forceinline__ MoeTab build_moe_tab(const Frame& F) {
  LAS int* tp = (LAS int*)(F.lds + LDS_X); LAS int* cp = tp + 68; LAS int* cn = tp + 136;
  const int* CNT = (const int*)(F.ws + WS_CTL);
  if (F.tid == 0) { int a = 0, b = 0; for (int e = 0; e < NE; ++e) { const int c = CNT[e * 64]; tp[e] = a; cp[e] = b; cn[e] = c; a += (c + 255) >> 8; b += c; } tp[NE] = a; cp[NE] = b; }
  __syncthreads();
  { LAS int* rt = tp + 256; if (F.tid < 384) { int e = 0; for (int k = 0; k < NE; ++k) { if (tp[k + 1] <= F.tid) e = k + 1; } rt[F.tid] = e < NE ? e : NE - 1; } }
  __syncthreads();
  MoeTab T; T.tp = tp; T.cp = cp; T.cnt = cn; T.n_rt = __builtin_amdgcn_readfirstlane(tp[NE]);
  return T;
}

__device__ __forceinline__ void phase_final(const Frame& F, const MoeTab& T) {
  unsigned char* ws = F.ws;
  const bf16_t* YRM = (const bf16_t*)(ws + WS_YRM); const int* TOKES = (const int*)(ws + WS_TOKES);
  const float* g2 = F.in[32]; const float* b2 = F.in[33];
  const int gw = F.bid * 8 + F.wave, NGW = F.G * 8, lane = F.lane;
  for (int t = gw; t < NTOK; t += NGW) {
    float* orow = F.out + (size_t)t * DM;
    f32x4 v[8];
    { const float* xrow = (const float*)(ws + WS_X1) + (size_t)t * DM; const bf16_t* ys = YRM + (size_t)(NTOK * 8 + t) * DM;
#pragma unroll
      for (int j = 0; j < 8; ++j) { const u32x2 wv = __builtin_nontemporal_load((const u32x2*)(ys + 4 * lane + 256 * j)); v[j] = *(const f32x4*)(xrow + 4 * lane + 256 * j) * ALPHA; v[j][0] += bflo(wv.x); v[j][1] += bfhi(wv.x); v[j][2] += bflo(wv.y); v[j][3] += bfhi(wv.y); } }
    const int esl = TOKES[t * 8 + (lane & 7)];
#pragma unroll
    for (int kb = 0; kb < 2; ++kb) {
      u32x2 yv[4][8];
#pragma unroll
      for (int k = 0; k < 4; ++k) {
        const int es = __shfl(esl, kb * 4 + k); const int e = es >> 16, slot = es & 0xffff;
        const bf16_t* yr = YRM + (size_t)(T.cp[e] + slot) * DM;
#pragma unroll
        for (int j = 0; j < 8; ++j) yv[k][j] = __builtin_nontemporal_load((const u32x2*)(yr + 4 * lane + 256 * j));
      }
#pragma unroll
      for (int k = 0; k < 4; ++k)
#pragma unroll
        for (int j = 0; j < 8; ++j) { v[j][0] += bflo(yv[k][j].x); v[j][1] += bfhi(yv[k][j].x); v[j][2] += bflo(yv[k][j].y); v[j][3] += bfhi(yv[k][j].y); }
    }
    float s = 0.f;
#pragma unroll
    for (int j = 0; j < 8; ++j) s += (v[j][0] + v[j][1]) + (v[j][2] + v[j][3]);
    const float mean = wave_sum(s) * (1.0f / DM); float s2 = 0.f;
#pragma unroll
    for (int j = 0; j < 8; ++j) { v[j] = v[j] - mean; s2 += (v[j][0] * v[j][0] + v[j][1] * v[j][1]) + (v[j][2] * v[j][2] + v[j][3] * v[j][3]); }
    const float rstd = rsqrtf(wave_sum(s2) * (1.0f / DM) + LN_EPS);
#pragma unroll
    for (int j = 0; j < 8; ++j) { const int col = 4 * lane + 256 * j; const f32x4 gg = *(const f32x4*)(g2 + col), bb = *(const f32x4*)(b2 + col); *(f32x4*)(orow + col) = v[j] * rstd * gg + bb; }
  }
}

__global__ void __launch_bounds__(512, 2) fwd_megakernel(Params p, int ph_lo, int ph_hi) {
  extern __shared__ __attribute__((aligned(16))) unsigned char lds_raw[];
  Frame F;
  F.lds = (LAS unsigned char*)lds_raw; F.tid = threadIdx.x; F.lane = F.tid & 63; F.wave = __builtin_amdgcn_readfirstlane(F.tid >> 6);
  F.G = gridDim.x; F.bid = blockIdx.x; F.ws = as_global(p.ws); F.in = InPtrs{p.in}; F.out = as_global(p.out);
  unsigned char* ws = as_global(p.ws);
#ifndef PHMASK
#define PHMASK 0xFFF
#endif
#define IN(k) (((PHMASK >> (k)) & 1) && ph_lo <= (k) && (k) < ph_hi)
#ifndef RPTMASK
#define RPTMASK 0
#endif
#define RPT(k) for (int _rp = 0; _rp < 1 + ((RPTMASK >> (k)) & 1); ++_rp)
#define FRESH() do { unsigned char* w2_ = opaque_global(p.ws); ws = w2_; F.ws = w2_; int l2_ = (int)__builtin_amdgcn_mbcnt_hi(~0u, __builtin_amdgcn_mbcnt_lo(~0u, 0u)); asm volatile("" : "+v"(l2_)); F.lane = l2_; F.tid = F.wave * 64 + l2_; } while (0)
#define SYNC(k) do { if (IN(k) && IN((k) + 1)) { xcd_barrier(xbar); } } while (0)
  { volatile LAS unsigned* st = (volatile LAS unsigned*)(F.lds + LDS_X + 4096); if (F.tid < 4) st[F.tid] = 0u; }
  __syncthreads();
  const XcdBarrier xbar = xcd_barrier_post((unsigned*)(ws + WS_CTL + 16384), (volatile LAS unsigned*)(F.lds + LDS_X + 4096));

  FRESH();
  if (IN(0)) RPT(0) { if (_rp) xcd_barrier(xbar); phase_prologue(F); }
  SYNC(0);
  FRESH();
  if (IN(1)) RPT(1) { if (_rp) xcd_barrier(xbar);
    SchedDense S{(const char*)(ws + WS_XB), (const char*)(ws + WS_WIN), NTOK / 256, INC / 256, F.G, F.bid, DM, DM, DM / 64};
    EpiStoreBf16 E{(bf16_t*)(ws + WS_PROJ), INC};
    pg8::gemm_phase<EpiStoreBf16, SchedDense, false>(F.lds, DM, DM, S, E);
  }
  SYNC(1);
  FRESH();
  if (IN(2)) RPT(2) { if (_rp) xcd_barrier(xbar); phase_mprep(F); phase_rconv(F); }
  SYNC(2);
  FRESH();
  if (IN(3)) RPT(3) { if (_rp) xcd_barrier(xbar);
    const int nm2 = F.G >> 1;
    if (F.bid < nm2) phase_m2(F, nm2);
    else {
      const int bid2 = F.bid - nm2, G2 = F.G - nm2;
      phase_m1(F, bid2, G2);
      int Kr = 4; asm volatile("" : "+s"(Kr));
      SchedRglru S{(const char*)(ws + WS_XCR), (const char*)(ws + WS_WRAX), G2, bid2, Kr};
      EpiRglru E{(const bf16_t*)(ws + WS_XCR), p.in[15], p.in[17], (const float*)(ws + WS_SMALL + SM_C8), (float*)(ws + WS_RA), (bf16_t*)(ws + WS_RB)};
      pg8::gemm_phase<EpiRglru, SchedRglru, false>(F.lds, RW, 256, S, E);
    }
  }
  SYNC(3);
  FRESH();
  if (IN(4)) RPT(4) { if (_rp) xcd_barrier(xbar); phase_ragg(F); phase_ym(F); }
  SYNC(4);
  FRESH();
  if (IN(5)) RPT(5) { if (_rp) xcd_barrier(xbar); phase_rscan(F); }
  SYNC(5);
  FRESH();
  if (IN(6)) RPT(6) { if (_rp) xcd_barrier(xbar);
    SchedMerge S{(const char*)(ws + WS_YM), (const char*)(ws + WS_YR), (const char*)(ws + WS_WPM), (const char*)(ws + WS_WPR), F.G, F.bid};
    EpiMergeF E{(const bf16_t*)(ws + WS_PROJ), p.in[2], (bf16_t*)(ws + WS_MERGED)};
    pg8::gemm_phase<EpiMergeF, SchedMerge, false>(F.lds, RW, RW, S, E);
  }
  SYNC(6);
  FRESH();
  if (IN(7)) RPT(7) { if (_rp) xcd_barrier(xbar);
    SchedDense S{(const char*)(ws + WS_MERGED), (const char*)(ws + WS_WO), NTOK / 256, DM / 256, F.G, F.bid, DM, DM, DM / 64};
    EpiWo E{p.in[0], (float*)(ws + WS_X1)};
    pg8::gemm_phase<EpiWo, SchedDense, false>(F.lds, DM, DM, S, E);
  }
  SYNC(7);
  FRESH();
  if (IN(8)) phase_ln_router(F);
  SYNC(8);
  FRESH();
  if (IN(9)) RPT(9) { if (_rp) xcd_barrier(xbar);
    const MoeTab T = build_moe_tab(F);
    SchedMoe<4, 1> S{T, (const int*)(ws + WS_LIST), (const char*)(ws + WS_X1B), (const char*)(ws + WS_WEGU), (const char*)(ws + WS_WSGU), F.G, F.bid, DM / 128};
    EpiMoe1 E{ws + WS_HMOE};
    pg8::gemm_phase<EpiMoe1, SchedMoe<4, 1>, true>(F.lds, DM / 2, DM / 2, S, E);
  }
  SYNC(9);
  FRESH();
  if (IN(10)) RPT(10) { if (_rp) xcd_barrier(xbar);
    const MoeTab T = build_moe_tab(F);
    int nt2 = DE / 128; asm volatile("" : "+s"(nt2));
    SchedMoe<8, 2> S{T, (const int*)(ws + WS_LIST), (const char*)(ws + WS_HMOE), (const char*)(ws + WS_WED), (const char*)(ws + WS_WSD), F.G, F.bid, nt2};
    EpiMoe2 E{(bf16_t*)(ws + WS_YRM), (const float*)(ws + WS_LISTW), (bf16_t*)(ws + WS_WIN)};
    pg8::gemm_phase<EpiMoe2, SchedMoe<8, 2>, false>(F.lds, DE / 2, DE / 2, S, E);
  }
  SYNC(10);
  FRESH();
  if (IN(11)) { const MoeTab T = build_moe_tab(F); phase_final(F, T); }
#undef IN
#undef SYNC
}

#ifndef N_LAUNCH_SPLIT
#define N_LAUNCH_SPLIT 0
#endif
extern "C" void kernel_launch(void* const* d_in, const int* in_sizes, int n_in, void* d_out, int out_size, void* d_ws, size_t ws_size, hipStream_t stream) {
  static int grid_blocks = 0;
  if (grid_blocks == 0) {
    int dev = 0, cus = 0, per_cu = 0;
    (void)hipGetDevice(&dev);
    (void)hipDeviceGetAttribute(&cus, hipDeviceAttributeMultiprocessorCount, dev);
    (void)hipFuncSetAttribute((const void*)fwd_megakernel, hipFuncAttributeMaxDynamicSharedMemorySize, LDS_BYTES);
    (void)hipOccupancyMaxActiveBlocksPerMultiprocessor(&per_cu, fwd_megakernel, 512, LDS_BYTES);
    if (per_cu < 1) { fprintf(stderr, "kernel_launch: occupancy query says %d blocks per CU\n", per_cu); per_cu = 1; }
    grid_blocks = cus * per_cu;
    fprintf(stderr, "kernel_launch: cus %d per_cu %d grid %d ws_size %zu (need %zu) n_in %d\n", cus, per_cu, grid_blocks, ws_size, (size_t)WS_END, n_in);
    if (ws_size < WS_END || n_in != 34) { fprintf(stderr, "kernel_launch: workspace too small or unexpected inputs; nothing launched\n"); grid_blocks = -1; }
  }
  if (grid_blocks < 0) return;
  (void)hipMemsetAsync((char*)d_ws + WS_CTL, 0, 65536, stream);
  Params p{};
  for (int i = 0; i < 34; ++i) p.in[i] = (const float*)d_in[i];
  p.out = (float*)d_out; p.ws = (unsigned char*)d_ws;
#if N_LAUNCH_SPLIT
  for (int ph = 0; ph < 12; ++ph) { hipLaunchKernelGGL(fwd_megakernel, dim3(grid_blocks), dim3(512), LDS_BYTES, stream, p, ph, ph + 1); }
#else
  int lo = 0, hi = 12;
  void* args[] = {&p, &lo, &hi};
  hipError_t e = hipLaunchCooperativeKernel((void*)fwd_megakernel, dim3(grid_blocks), dim3(512), args, LDS_BYTES, stream);
  if (e != hipSuccess) fprintf(stderr, "cooperative launch failed: %s (grid %d)\n", hipGetErrorString(e), grid_blocks);
#endif
}
```

```cpp
#include <hip/hip_runtime.h>
#include <hip/hip_cooperative_groups.h>
#include <cstdio>
#include <cstdint>
namespace cg = cooperative_groups;

#define LAS __attribute__((address_space(3)))
typedef unsigned short bf16_t;
typedef short bf16x8 __attribute__((ext_vector_type(8)));
typedef float f32x4 __attribute__((ext_vector_type(4)));
typedef float f32x2 __attribute__((ext_vector_type(2)));
typedef unsigned u32x4 __attribute__((ext_vector_type(4)));
typedef unsigned u32x2 __attribute__((ext_vector_type(2)));
typedef int i32x8 __attribute__((ext_vector_type(8)));
typedef int i32x4 __attribute__((ext_vector_type(4)));

constexpr int NTOK = 8192, DM = 2048, SEQ = 4096, MW = 2048, RW = 2560, INC = 13312, NH = 8, HD = 256, NE = 64, DE = 512;
constexpr int O_Z = 2048, O_XR = 4096, O_XG = 6656, O_G0 = 9216, O_G1 = 11264;
constexpr float LN_EPS = 1e-5f;
constexpr float ALPHA = 1.189207115002721f;
constexpr int NCH = 64;

constexpr size_t MiB = 1u << 20;
constexpr size_t WS_CTL = 0;
constexpr size_t WS_WIN = 1 * MiB, WS_RB = 1 * MiB, WS_M2TAB = 41 * MiB;
constexpr size_t WS_WPM = 53 * MiB  , WS_WPR = 63 * MiB, WS_WO = 73 * MiB, WS_WRAX = 81 * MiB, WS_WSGU = 84 * MiB, WS_WSD = 1014 * MiB;
constexpr size_t WS_WEGU = 88 * MiB, WS_WED = 344 * MiB;
constexpr size_t WS_XB = 472 * MiB, WS_HNI = 472 * MiB, WS_HMOE = 472 * MiB;
constexpr size_t WS_PROJ = 504 * MiB;
constexpr size_t WS_YRM = 560 * MiB;
constexpr size_t WS_Q = 712 * MiB, WS_K = 744 * MiB, WS_V = 776 * MiB, WS_YM = 712 * MiB  , WS_YR = 752 * MiB;
constexpr size_t WS_XCM = 808 * MiB, WS_MERGED = 808 * MiB;
constexpr size_t WS_XCR = 840 * MiB;
constexpr size_t WS_SMALL = 880 * MiB;
constexpr size_t WS_RA = 886 * MiB, WS_T1 = 886 * MiB, WS_X1B = 886 * MiB  ;
constexpr size_t WS_LIST = 918 * MiB, WS_LISTW = 920 * MiB  , WS_TOKES = 923 * MiB;
constexpr size_t WS_X1 = 950 * MiB;
constexpr size_t WS_HNE = 966 * MiB;
constexpr size_t WS_END = 1016 * MiB;
constexpr size_t SM_IG = 0, SM_LF = 256 * 1024, SM_INTER = 512 * 1024, SM_EMR = 768 * 1024, SM_DENI = 1024 * 1024, SM_QN = 1280 * 1024;
constexpr size_t SM_WIFT = 1536 * 1024;
constexpr size_t SM_C8 = 1792 * 1024;
constexpr size_t SM_RWH = 4608 * 1024, SM_RWL = 4864 * 1024;
constexpr size_t SM_AGGA = 2 * MiB, SM_AGGB = 2 * MiB + 1310720;

constexpr int LDS_BYTES = 147456;
constexpr int LDS_X = 131072;

struct Params {
  const float* in[34];
  float* out;
  unsigned char* ws;
};

typedef __bf16 hbf2_t __attribute__((ext_vector_type(2)));
typedef float hf2_t __attribute__((ext_vector_type(2)));
__device__ __forceinline__ unsigned pk2(float lo, float hi) { const hf2_t f = {lo, hi}; return __builtin_bit_cast(unsigned, __builtin_convertvector(f, hbf2_t)); }
__device__ __forceinline__ unsigned f2bf(float f) { return pk2(f, 0.f) & 0xffffu; }
__device__ __forceinline__ float bflo(unsigned w) { return __uint_as_float(w << 16); }
__device__ __forceinline__ float bfhi(unsigned w) { return __uint_as_float(w & 0xffff0000u); }
__device__ __forceinline__ float bf1(bf16_t b) { return __uint_as_float(((unsigned)b) << 16); }
__device__ __forceinline__ float sigmoidf_(float x) { return 1.0f / (1.0f + __expf(-x)); }
__device__ __forceinline__ float siluf_(float x) { return x / (1.0f + __expf(-x)); }
__device__ __forceinline__ float gelu_tanh(float x) { const float u = 0.7978845608028654f * (x + 0.044715f * x * x * x); return 0.5f * x * (1.0f + tanhf(u)); }
__device__ __forceinline__ float wave_sum(float v) {
#pragma unroll
  for (int o = 1; o < 64; o <<= 1) v += __shfl_xor(v, o);
  return v;
}
__device__ __forceinline__ float wave_max(float v) {
#pragma unroll
  for (int o = 1; o < 64; o <<= 1) v = fmaxf(v, __shfl_xor(v, o));
  return v;
}
__device__ __forceinline__ float wave_scan_sum(float v, int lane) {
#pragma unroll
  for (int o = 1; o < 64; o <<= 1) { const float t = __shfl_up(v, o); if (lane >= o) v += t; }
  return v;
}
__device__ __forceinline__ float wave_scan_max(float v, int lane) {
#pragma unroll
  for (int o = 1; o < 64; o <<= 1) { const float t = __shfl_up(v, o); if (lane >= o) v = fmaxf(v, t); }
  return v;
}
#define LDS_WAIT() asm volatile("s_waitcnt lgkmcnt(0)" ::: "memory")
#define LBAR() do { asm volatile("s_waitcnt lgkmcnt(0)" ::: "memory"); __builtin_amdgcn_s_barrier(); asm volatile("" ::: "memory"); } while (0)

namespace pg8 {
constexpr int BM = 256, BK = 64, HALF = 128, HTB = HALF * BK * 2, NXCD = 8, WGM = 8;
__device__ __forceinline__ int lds_byte(int r, int c) { const int st = (r >> 4) * 2 + (c >> 5), rr = r & 15, cc = c & 31, ob = rr * 64 + cc * 2; return st * 1024 + (ob ^ (((ob >> 9) & 1) << 5)); }
__device__ __forceinline__ void stage_rc(int b, int& R, int& C) { const int st = b / 1024, sb = b % 1024, swz = sb ^ (((sb >> 9) & 1) << 5); R = (st >> 1) * 16 + swz / 64; C = (st & 1) * 32 + (swz % 64) / 2; }

__device__ __forceinline__ int perm32(int rho) { const int n = rho >> 4, i = rho & 15; return 8 * (i >> 2) + 4 * n + (i & 3); }
struct UnitG { const char* A; const char* B; int pm, pn, e, cnt, mt, row0, nt, keep; };

__device__ __forceinline__ bool dense_order(int i, int G, int c, int nM, int nN, int& pm, int& pn) {
  const int nwg = nM * nN; const long L = (long)i * G + c; if (L >= nwg) return false;
  int wgid = (int)L; { const int q = nwg / NXCD, r = nwg % NXCD, xcd = wgid % NXCD, off = wgid / NXCD; wgid = (xcd < r ? xcd * (q + 1) : r * (q + 1) + (xcd - r) * q) + off; }
  const int nig = WGM * nN, gid = wgid / nig, fm = gid * WGM, gsz = (nM - fm) < WGM ? (nM - fm) : WGM;
  pm = fm + ((wgid % nig) % gsz); pn = (wgid % nig) / gsz; return true;
}

template <class Epi, class Sched, bool GATHER>
__device__ __forceinline__ void gemm_phase(LAS unsigned char* lds, const int lda, const int ldb, const Sched& S, const Epi& E) {
  const int tid = threadIdx.x, wid = __builtin_amdgcn_readfirstlane(tid >> 6), lane = tid & 63, wr = wid >> 2, wc = wid & 3, fr = lane & 15, fq = lane >> 4;
  int Rr[2], Cc[2];
  unsigned voffB[2];
  unsigned vA[2][2];
  unsigned nvA[2][2];
#pragma unroll
  for (int i = 0; i < 2; ++i) { stage_rc(tid * 16 + i * 8192, Rr[i], Cc[i]); const int Rb = Epi::PERM ? ((Rr[i] & ~31) + perm32(Rr[i] & 31)) : Rr[i]; voffB[i] = (unsigned)(Rb * ldb + Cc[i]) * 2u; }
  const size_t kstep = (size_t)(BK * 2);
  const size_t hstepA = (size_t)HALF * lda * 2, hstepB = (size_t)HALF * ldb * 2;
  const unsigned ldsw = (unsigned)wid * 1024u;
  const int aoff = lds_byte(wr * 64 + fr, fq * 8), boff = lds_byte(wc * 32 + fr, fq * 8);
#define PG8_SA(b, h) (((b) * 2 + (h)) * HTB)
#define PG8_SB(b, h) ((4 + (b) * 2 + (h)) * HTB)
#define PG8_STAGE_B(bufoff, gbase) do { _Pragma("unroll") for (int _i = 0; _i < 2; ++_i) \
    __builtin_amdgcn_global_load_lds((const unsigned*)((const char*)(gbase) + voffB[_i]), (LAS unsigned*)(lds + (bufoff) + ldsw + _i * 8192), 16, 0, 0); } while (0)
#define PG8_STAGE_A(bufoff, gbase, h) do { _Pragma("unroll") for (int _i = 0; _i < 2; ++_i) { \
    const char* _p = GATHER ? ((const char*)(gbase) + vA[h][_i]) : ((const char*)(gbase) + (h) * hstepA + vA[0][_i]); \
    __builtin_amdgcn_global_load_lds((const unsigned*)_p, (LAS unsigned*)(lds + (bufoff) + ldsw + _i * 8192), 16, 0, 0); } } while (0)
#define PG8_LD8(p) __builtin_shufflevector(*(const LAS i32x4*)(p), *(const LAS i32x4*)((p) + 1024), 0, 1, 2, 3, 4, 5, 6, 7)
#define PG8_LO(x) __builtin_bit_cast(bf16x8, __builtin_shufflevector(x, x, 0, 1, 2, 3))
#define PG8_HI(x) __builtin_bit_cast(bf16x8, __builtin_shufflevector(x, x, 4, 5, 6, 7))
#define PG8_LDA(dst, b, h) do { _Pragma("unroll") for (int m = 0; m < 4; ++m) dst[m] = PG8_LD8(lds + PG8_SA(b, h) + aoff + m * 2048); } while (0)
#define PG8_LDB(dst, b, h) do { _Pragma("unroll") for (int n = 0; n < 2; ++n) dst[n] = PG8_LD8(lds + PG8_SB(b, h) + boff + n * 2048); } while (0)
#define PG8_MMA(ai, bj, At, Bt) do { __builtin_amdgcn_s_setprio(1); _Pragma("unroll") for (int m = 0; m < 4; ++m) _Pragma("unroll") for (int n = 0; n < 2; ++n) { \
    acc[ai][bj][m][n] = __builtin_amdgcn_mfma_f32_16x16x32_bf16(PG8_LO(Bt[n]), PG8_LO(At[m]), acc[ai][bj][m][n], 0, 0, 0); \
    acc[ai][bj][m][n] = __builtin_amdgcn_mfma_f32_16x16x32_bf16(PG8_HI(Bt[n]), PG8_HI(At[m]), acc[ai][bj][m][n], 0, 0, 0); } __builtin_amdgcn_s_setprio(0); } while (0)
#define PG8_MMA8(ai, bj, At, Bt) do { __builtin_amdgcn_s_setprio(1); _Pragma("unroll") for (int m = 0; m < 4; ++m) _Pragma("unroll") for (int n = 0; n < 2; ++n) \
    acc[ai][bj][m][n] = __builtin_amdgcn_mfma_scale_f32_16x16x128_f8f6f4(Bt[n], At[m], acc[ai][bj][m][n], 0, 0, 0, 0x7F7F7F7F, 0, 0x7F7F7F7F); __builtin_amdgcn_s_setprio(0); } while (0)
#define PG8_MM(ai, bj, At, Bt) do { if (Epi::FP8) PG8_MMA8(ai, bj, At, Bt); else PG8_MMA(ai, bj, At, Bt); } while (0)
#define PG8_WAIT_V(n) asm volatile("s_waitcnt vmcnt(" #n ")" ::: "memory")
#define PG8_WAIT_L(n) asm volatile("s_waitcnt lgkmcnt(" #n ")" ::: "memory")
#define PG8_BAR __builtin_amdgcn_s_barrier()
#define PG8_SCHED __builtin_amdgcn_sched_barrier(0)
  UnitG cur, nxt; int ui = 0;
  if (!S.next(0, cur)) return;
#pragma unroll
  for (int h = 0; h < 2; ++h)
#pragma unroll
    for (int i = 0; i < 2; ++i) {
      if (GATHER) vA[h][i] = (unsigned)(S.arow(cur, h * HALF + Rr[i]) * lda + Cc[i]) * 2u;
      else vA[h][i] = (unsigned)(Rr[i] * lda + Cc[i]) * 2u;
      nvA[h][i] = vA[h][i];
    }
  f32x4 acc[2][2][4][2];
#pragma unroll
  for (int a = 0; a < 2; ++a)
#pragma unroll
    for (int b = 0; b < 2; ++b)
#pragma unroll
      for (int m = 0; m < 4; ++m)
#pragma unroll
        for (int n = 0; n < 2; ++n) acc[a][b][m][n] = (f32x4){0.f, 0.f, 0.f, 0.f};
  i32x8 At[4], B0[2], B1[2];
  const char* cA = cur.A; const char* cB = cur.B;
  { const char* pB0 = cB; const char* pB1 = cB + hstepB; const char* pA0 = cA; const char* pB2 = cB + kstep; const char* pA1 = cA + kstep; const char* pB3 = cB + hstepB + kstep;
    asm volatile("" : "+s"(pB0), "+s"(pB1), "+s"(pA0), "+s"(pB2), "+s"(pA1), "+s"(pB3));
  PG8_STAGE_B(PG8_SB(0, 0), pB0); PG8_STAGE_B(PG8_SB(0, 1), pB1); PG8_STAGE_A(PG8_SA(0, 0), pA0, 0); PG8_STAGE_A(PG8_SA(0, 1), pA0, 1);
  if (wr == 1) PG8_BAR;
  PG8_WAIT_V(2); PG8_BAR;
  PG8_STAGE_B(PG8_SB(1, 0), pB2); PG8_STAGE_A(PG8_SA(1, 0), pA1, 0); PG8_STAGE_B(PG8_SB(1, 1), pB3); }
  PG8_WAIT_V(6); PG8_BAR;
  for (;;) {
    const bool has_next = S.next(ui + 1, nxt);
    const char* nA = has_next ? nxt.A : cA; const char* nB = has_next ? nxt.B : cB;
    if (GATHER) {
      if (has_next) {
#pragma unroll
        for (int h = 0; h < 2; ++h)
#pragma unroll
          for (int i = 0; i < 2; ++i) nvA[h][i] = (unsigned)(S.arow(nxt, h * HALF + Rr[i]) * lda + Cc[i]) * 2u;
      }
    }
    const int nt = cur.nt;
#pragma unroll 1
    for (int t = 0; t < nt; t += 2) {
      const bool last = (t == nt - 2);
      const char* a1 = cA + (size_t)(t + 1) * kstep;
      const char* a2 = last ? nA : cA + (size_t)(t + 2) * kstep; const char* b2 = last ? nB : cB + (size_t)(t + 2) * kstep;
      const char* a3 = a2 + kstep; const char* b3 = b2 + kstep;
      asm volatile("" : "+s"(a1), "+s"(a2), "+s"(a3), "+s"(b2), "+s"(b3));
      PG8_LDB(B0, 0, 0); PG8_LDB(B1, 0, 1); PG8_SCHED; PG8_LDA(At, 0, 0); PG8_STAGE_A(PG8_SA(1, 1), a1, 1);
      if (GATHER) { if (last) {
#pragma unroll
        for (int h = 0; h < 2; ++h)
#pragma unroll
          for (int i = 0; i < 2; ++i) vA[h][i] = nvA[h][i]; } }
      PG8_WAIT_V(8); PG8_WAIT_L(0); PG8_BAR; PG8_MM(0, 0, At, B0); PG8_MM(0, 1, At, B1); PG8_BAR; PG8_SCHED;
      PG8_LDA(At, 0, 1); PG8_STAGE_B(PG8_SB(0, 0), b2); PG8_STAGE_B(PG8_SB(0, 1), b2 + hstepB); PG8_STAGE_A(PG8_SA(0, 0), a2, 0);
      PG8_WAIT_V(8); PG8_WAIT_L(0); PG8_BAR; PG8_MM(1, 0, At, B0); PG8_MM(1, 1, At, B1); PG8_BAR; PG8_SCHED;
      PG8_LDB(B0, 1, 0); PG8_LDB(B1, 1, 1); PG8_SCHED; PG8_LDA(At, 1, 0); PG8_STAGE_A(PG8_SA(0, 1), a2, 1);
      PG8_WAIT_V(8); PG8_WAIT_L(0); PG8_BAR; PG8_MM(0, 0, At, B0); PG8_MM(0, 1, At, B1); PG8_BAR; PG8_SCHED;
      PG8_LDA(At, 1, 1); PG8_STAGE_B(PG8_SB(1, 0), b3); PG8_STAGE_B(PG8_SB(1, 1), b3 + hstepB); PG8_STAGE_A(PG8_SA(1, 0), a3, 0);
      PG8_WAIT_V(8); PG8_WAIT_L(0); PG8_BAR; PG8_MM(1, 0, At, B0); PG8_MM(1, 1, At, B1); PG8_BAR; PG8_SCHED;
    }
    if (wr == 0) PG8_BAR;
    { int l2 = (int)__builtin_amdgcn_mbcnt_hi(~0u, __builtin_amdgcn_mbcnt_lo(~0u, 0u)); asm volatile("" : "+v"(l2));
      E(acc, cur, wr, wc, l2 & 15, l2 >> 4); }
    if (!has_next) break;
    if (!cur.keep) {
#pragma unroll
      for (int a = 0; a < 2; ++a)
#pragma unroll
        for (int b = 0; b < 2; ++b)
#pragma unroll
          for (int m = 0; m < 4; ++m)
#pragma unroll
            for (int n = 0; n < 2; ++n) acc[a][b][m][n] = (f32x4){0.f, 0.f, 0.f, 0.f};
    }
    cur = nxt; cA = nA; cB = nB; ++ui;
    if (wr == 1) PG8_BAR;
  }
  PG8_WAIT_V(0);
  PG8_BAR;
#undef PG8_SA
#undef PG8_SB
#undef PG8_STAGE_A
#undef PG8_STAGE_B
#undef PG8_LDA
#undef PG8_LDB
#undef PG8_MMA
#undef PG8_MMA8
#undef PG8_MM
#undef PG8_LD8
#undef PG8_LO
#undef PG8_HI
#undef PG8_WAIT_V
#undef PG8_WAIT_L
#undef PG8_BAR
#undef PG8_SCHED
}
}

__device__ __forceinline__ const char* uni_ptr(const char* p) {
  const unsigned long long v = (unsigned long long)p;
  const unsigned lo = __builtin_amdgcn_readfirstlane((unsigned)v), hi = __builtin_amdgcn_readfirstlane((unsigned)(v >> 32));
  return (const char*)(((unsigned long long)hi << 32) | lo);
}

struct SchedDense {
  const char* A; const char* B; int nM, nN, G, c, lda, ldb, nt;
  __device__ __forceinline__ bool next(int i, pg8::UnitG& u) const {
    int pm, pn; if (!pg8::dense_order(i, G, c, nM, nN, pm, pn)) return false;
    u.pm = pm; u.pn = pn; u.e = 0; u.cnt = 0; u.mt = 0; u.row0 = pm * 256; u.nt = nt; u.keep = 0;
    u.A = A + (size_t)pm * 256 * lda * 2; u.B = B + (size_t)pn * 256 * ldb * 2; return true;
  }
  __device__ __forceinline__ unsigned arow(const pg8::UnitG&, int r) const { return (unsigned)r; }
};

struct EpiStoreBf16 {
  static constexpr bool PERM = true, FP8 = false;
  bf16_t* O; int ldc;
  __device__ __forceinline__ void operator()(const f32x4 (&acc)[2][2][4][2], const pg8::UnitG& u, int wr, int wc, int fr, int fq) const {
    const int row0 = u.pm * 256 + wr * 64 + fr, col0 = u.pn * 256 + wc * 32 + 8 * fq;
#pragma unroll
    for (int ai = 0; ai < 2; ++ai)
#pragma unroll
      for (int m = 0; m < 4; ++m) { bf16_t* rowp = O + (size_t)(row0 + ai * 128 + m * 16) * ldc + col0;
#pragma unroll
        for (int bj = 0; bj < 2; ++bj) { const f32x4 v0 = acc[ai][bj][m][0], v1 = acc[ai][bj][m][1]; u32x4 w; w.x = pk2(v0[0], v0[1]); w.y = pk2(v0[2], v0[3]); w.z = pk2(v1[0], v1[1]); w.w = pk2(v1[2], v1[3]); *(u32x4*)(rowp + bj * 128) = w; } }
  }
};

struct SchedRglru {
  const char* XCR; const char* W; int G, c, nt4;
  __device__ __forceinline__ bool next(int i, pg8::UnitG& u) const {
    const int L = i * G + c; if (L >= 640) return false;
    const int blk = L >> 6, rem = L & 63; u.e = blk; u.pm = rem >> 1; u.pn = rem & 1; u.cnt = 0; u.mt = 0; u.row0 = u.pm * 256; u.nt = nt4; u.keep = 0;
    u.A = XCR + ((size_t)u.pm * 256 * RW + 256 * blk) * 2; u.B = W + ((size_t)(blk * 512 + u.pn * 256) * 256) * 2; return true;
  }
  __device__ __forceinline__ unsigned arow(const pg8::UnitG&, int r) const { return (unsigned)r; }
};
struct EpiRglru {
  static constexpr bool PERM = true, FP8 = false;
  const bf16_t* XCR; const float* ba; const float* bx; const float* C8; float* RA; bf16_t* RBo;
  __device__ __forceinline__ void operator()(const f32x4 (&acc)[2][2][4][2], const pg8::UnitG& u, int wr, int wc, int fr, int fq) const {
    const int row0 = u.pm * 256 + wr * 64 + fr;
#pragma unroll
    for (int n = 0; n < 2; ++n) {
      const int ch = 256 * u.e + 128 * u.pn + 32 * wc + 8 * fq + 4 * n;
      const f32x4 vba = *(const f32x4*)(ba + ch), vbx = *(const f32x4*)(bx + ch), c8 = *(const f32x4*)(C8 + ch);
#pragma unroll
      for (int ai = 0; ai < 2; ++ai)
#pragma unroll
        for (int m = 0; m < 4; ++m) {
          const size_t off = (size_t)(row0 + ai * 128 + m * 16) * RW + ch;
          const u32x2 xw = *(const u32x2*)(XCR + off);
          const float xc[4] = {bflo(xw.x), bfhi(xw.x), bflo(xw.y), bfhi(xw.y)};
          f32x4 av; float bv[4];
#pragma unroll
          for (int j = 0; j < 4; ++j) {
            const float r = __builtin_amdgcn_rcpf(1.0f + __expf(-(acc[ai][0][m][n][j] + vba[j])));
            const float ig = __builtin_amdgcn_rcpf(1.0f + __expf(-(acc[ai][1][m][n][j] + vbx[j])));
            const float la = c8[j] * r;
            const float a = __expf(la);
            const float x2 = 2.0f * la;
            const float poly = -x2 * (1.0f + x2 * 0.5f * (1.0f + x2 * (1.0f / 3.0f) * (1.0f + x2 * 0.25f * (1.0f + x2 * 0.2f))));
            const float om = (x2 > -0.25f) ? poly : (1.0f - a * a);
            av[j] = a;
            bv[j] = sqrtf(fmaxf(om, 0.f)) * (ig * xc[j]);
          }
          *(f32x4*)(RA + off) = av;
          u32x2 w; w.x = pk2(bv[0], bv[1]); w.y = pk2(bv[2], bv[3]); *(u32x2*)(RBo + off) = w;
          asm volatile("" ::: "memory");
        }
    }
  }
};

struct SchedMerge {
  const char* YM; const char* YR; const char* WPM; const char* WPR; int G, c;
  __device__ __forceinline__ bool next(int i, pg8::UnitG& u) const {
    int pm, pn; if (!pg8::dense_order(i >> 1, G, c, NTOK / 256, DM / 256, pm, pn)) return false;
    const int seg = i & 1;
    u.pm = pm; u.pn = pn; u.e = seg; u.cnt = 0; u.mt = 0; u.row0 = pm * 256; u.nt = seg ? RW / 64 : MW / 64; u.keep = seg ? 0 : 1;
    u.A = (seg ? YR : YM) + (size_t)pm * 256 * RW * 2; u.B = (seg ? WPR : WPM) + (size_t)pn * 256 * RW * 2; return true;
  }
  __device__ __forceinline__ unsigned arow(const pg8::UnitG&, int r) const { return (unsigned)r; }
};
struct EpiMergeF {
  static constexpr bool PERM = true, FP8 = false;
  const bf16_t* PROJ; const float* bgate; bf16_t* MRG;
  __device__ __forceinline__ void operator()(f32x4 (&acc)[2][2][4][2], const pg8::UnitG& u, int wr, int wc, int fr, int fq) const {
    const int row0 = u.pm * 256 + wr * 64 + fr, col0 = u.pn * 256 + wc * 32 + 8 * fq;
    if (u.e == 0) {
#pragma unroll
      for (int bj = 0; bj < 2; ++bj) {
        const int col = col0 + bj * 128;
        const f32x4 b00 = *(const f32x4*)(bgate + col), b01 = *(const f32x4*)(bgate + col + 4), b10 = *(const f32x4*)(bgate + DM + col), b11 = *(const f32x4*)(bgate + DM + col + 4);
#pragma unroll
        for (int ai = 0; ai < 2; ++ai)
#pragma unroll
          for (int m = 0; m < 4; ++m) {
            const size_t row = (size_t)(row0 + ai * 128 + m * 16);
            const u32x4 g1w = *(const u32x4*)(PROJ + row * INC + O_G1 + col);
            const float g1p[8] = {bflo(g1w.x), bfhi(g1w.x), bflo(g1w.y), bfhi(g1w.y), bflo(g1w.z), bfhi(g1w.z), bflo(g1w.w), bfhi(g1w.w)};
            const u32x4 g0w = *(const u32x4*)(PROJ + row * INC + O_G0 + col);
            const float g0p[8] = {bflo(g0w.x), bfhi(g0w.x), bflo(g0w.y), bfhi(g0w.y), bflo(g0w.z), bfhi(g0w.z), bflo(g0w.w), bfhi(g0w.w)};
#pragma unroll
            for (int j = 0; j < 4; ++j) {
              acc[ai][bj][m][0][j] *= (1.0f + __expf(-(g1p[j] + b10[j]))) * __builtin_amdgcn_rcpf(1.0f + __expf(-(g0p[j] + b00[j])));
              acc[ai][bj][m][1][j] *= (1.0f + __expf(-(g1p[4 + j] + b11[j]))) * __builtin_amdgcn_rcpf(1.0f + __expf(-(g0p[4 + j] + b01[j])));
            }
            if (m & 1) asm volatile("" ::: "memory");
          }
      }
    } else {
#pragma unroll
      for (int bj = 0; bj < 2; ++bj) {
        const int col = col0 + bj * 128;
        const f32x4 b10 = *(const f32x4*)(bgate + DM + col), b11 = *(const f32x4*)(bgate + DM + col + 4);
#pragma unroll
        for (int ai = 0; ai < 2; ++ai) {
          u32x4 g1a[4];
#pragma unroll
          for (int m = 0; m < 4; ++m) g1a[m] = *(const u32x4*)(PROJ + (size_t)(row0 + ai * 128 + m * 16) * INC + O_G1 + col);
#pragma unroll
          for (int m = 0; m < 4; ++m) {
            const size_t row = (size_t)(row0 + ai * 128 + m * 16);
            const u32x4 g1w = g1a[m];
            const float g1p[8] = {bflo(g1w.x), bfhi(g1w.x), bflo(g1w.y), bfhi(g1w.y), bflo(g1w.z), bfhi(g1w.z), bflo(g1w.w), bfhi(g1w.w)};
            f32x4 v0, v1;
#pragma unroll
            for (int j = 0; j < 4; ++j) { v0[j] = acc[ai][bj][m][0][j] * __builtin_amdgcn_rcpf(1.0f + __expf(-(g1p[j] + b10[j]))); v1[j] = acc[ai][bj][m][1][j] * __builtin_amdgcn_rcpf(1.0f + __expf(-(g1p[4 + j] + b11[j]))); }
            u32x4 w; w.x = pk2(v0[0], v0[1]); w.y = pk2(v0[2], v0[3]); w.z = pk2(v1[0], v1[1]); w.w = pk2(v1[2], v1[3]); *(u32x4*)(MRG + row * DM + col) = w;
          }
        }
      }
    }
  }
};

struct EpiWo {
  static constexpr bool PERM = false, FP8 = false;
  const float* X; float* O;
  __device__ __forceinline__ void operator()(const f32x4 (&acc)[2][2][4][2], const pg8::UnitG& u, int wr, int wc, int fr, int fq) const {
    const int row0 = u.pm * 256 + wr * 64 + fr, col0 = u.pn * 256 + wc * 32 + 4 * fq;
#pragma unroll
    for (int ai = 0; ai < 2; ++ai) {
      f32x4 xa[4][4];
#pragma unroll
      for (int m = 0; m < 4; ++m) { const size_t off = (size_t)(row0 + ai * 128 + m * 16) * DM + col0;
#pragma unroll
        for (int q = 0; q < 4; ++q) xa[m][q] = *(const f32x4*)(X + off + (q >> 1) * 128 + (q & 1) * 16); }
#pragma unroll
      for (int m = 0; m < 4; ++m) { const size_t off = (size_t)(row0 + ai * 128 + m * 16) * DM + col0;
#pragma unroll
        for (int q = 0; q < 4; ++q) *(f32x4*)(O + off + (q >> 1) * 128 + (q & 1) * 16) = xa[m][q] * ALPHA + acc[ai][q >> 1][m][q & 1]; }
    }
  }
};

struct MoeTab { const LAS int* tp; const LAS int* cp; const LAS int* cnt; int n_rt; };
template <int NT  , int STAGE  >
struct SchedMoe {
  MoeTab T; const int* LIST; const char* Abase; const char* Wr; const char* Ws; int G, c, ntv;
  __device__ __forceinline__ bool next(int i, pg8::UnitG& u) const {
    const int L = i * G + c; const int total = NT * (T.n_rt + 32); if (L >= total) return false;
    const int rt = L / NT, pn = L % NT; u.pn = pn; u.nt = ntv; u.keep = 0;
    constexpr int KK = (STAGE == 1) ? DM / 2 : DE / 2;
    constexpr int NN = NT * 256;
    if (rt < T.n_rt) {
      const int e = __builtin_amdgcn_readfirstlane(T.tp[256 + rt]);
      const int mt = rt - __builtin_amdgcn_readfirstlane(T.tp[e]);
      u.e = e; u.mt = mt; u.cnt = __builtin_amdgcn_readfirstlane(T.cnt[e]); u.pm = rt; u.row0 = rt * 256;
      u.B = Wr + ((size_t)e * NN + (size_t)pn * 256) * KK * 2;
    } else {
      u.e = NE; u.mt = rt - T.n_rt; u.cnt = NTOK; u.pm = rt; u.row0 = rt * 256;
      u.B = Ws + (size_t)pn * 256 * KK * 2;
    }
    if (STAGE == 2) u.pm = __builtin_amdgcn_readfirstlane(T.cp[u.e]);
    if (STAGE == 1) u.A = Abase;
    else u.A = Abase + (size_t)rt * 256 * DE;
    return true;
  }
  __device__ __forceinline__ unsigned arow(const pg8::UnitG& u, int r) const {
    if (u.e < NE) { int slot = u.mt * 256 + r; if (slot >= u.cnt) slot = 0; return (unsigned)LIST[u.e * NTOK + slot]; }
    return (unsigned)(u.mt * 256 + r);
  }
};
struct EpiMoe1 {
  static constexpr bool PERM = true, FP8 = true;
  unsigned char* H;
  __device__ __forceinline__ void operator()(const f32x4 (&acc)[2][2][4][2], const pg8::UnitG& u, int wr, int wc, int fr, int fq) const {
    const int row0 = u.row0 + wr * 64 + fr, col0 = u.pn * 128 + wc * 32 + 8 * fq;
#pragma unroll
    for (int ai = 0; ai < 2; ++ai)
#pragma unroll
      for (int m = 0; m < 4; ++m) { unsigned char* rowp = H + (size_t)(row0 + ai * 128 + m * 16) * DE + col0;
        float v[8];
#pragma unroll
        for (int n = 0; n < 2; ++n) { const f32x4 g = acc[ai][0][m][n], up = acc[ai][1][m][n];
#pragma unroll
          for (int j = 0; j < 4; ++j) { const float gg = g[j] * 0.015625f; v[4 * n + j] = gg * __builtin_amdgcn_rcpf(1.0f + __expf(-gg)) * (up[j] * 0.015625f); } }
        int q0 = 0, q1 = 0; q0 = __builtin_amdgcn_cvt_pk_fp8_f32(v[0], v[1], q0, false); q0 = __builtin_amdgcn_cvt_pk_fp8_f32(v[2], v[3], q0, true); q1 = __builtin_amdgcn_cvt_pk_fp8_f32(v[4], v[5], q1, false); q1 = __builtin_amdgcn_cvt_pk_fp8_f32(v[6], v[7], q1, true);
        u32x2 w; w.x = (unsigned)q0; w.y = (unsigned)q1; *(u32x2*)rowp = w; }
  }
};
struct EpiMoe2 {
  static constexpr bool PERM = true, FP8 = true;
  bf16_t* YRM; const float* LISTW; bf16_t* DUMMY;
  __device__ __forceinline__ void operator()(const f32x4 (&acc)[2][2][4][2], const pg8::UnitG& u, int wr, int wc, int fr, int fq) const {
    const int slot0 = u.mt * 256 + wr * 64 + fr;
    bf16_t* base = YRM + (size_t)(u.pm + slot0) * DM + u.pn * 256 + wc * 32 + 8 * fq;
    bf16_t* sink = DUMMY + (size_t)blockIdx.x * 8192 + ((wr * 4 + wc) * 64 + fq * 16 + fr) * 8;
    const float* lw = LISTW + u.e * NTOK + slot0;
    float wv[8];
#pragma unroll
    for (int i = 0; i < 8; ++i) wv[i] = lw[(i >> 2) * 128 + (i & 3) * 16];
#pragma unroll
    for (int ai = 0; ai < 2; ++ai)
#pragma unroll
      for (int m = 0; m < 4; ++m) { const int ds = ai * 128 + m * 16;
        const float w = wv[ai * 4 + m] * 0.03125f;
        bf16_t* rowp = (slot0 + ds < u.cnt) ? base + (size_t)ds * DM : sink;
#pragma unroll
        for (int bj = 0; bj < 2; ++bj) { const f32x4 v0 = acc[ai][bj][m][0] * w, v1 = acc[ai][bj][m][1] * w; u32x4 q; q.x = pk2(v0[0], v0[1]); q.y = pk2(v0[2], v0[3]); q.z = pk2(v1[0], v1[1]); q.w = pk2(v1[2], v1[3]); *(u32x4*)(rowp + bj * 128) = q; } }
  }
};


#define XB_TMO      128
#define XB_XCNT(j)  (256  + 64 * (j))
#define XB_XSUB(j)  (1280 + 64 * (j))
#define XB_XGEN(j)  (2304 + 64 * (j))
#define XB_TOP      3328
#define XB_TOPGEN   3392
#define XCD_BAR_WORDS 3456
#define XB_SPIN_CAP (1u << 18)
__device__ __forceinline__ unsigned xb_ld(unsigned* p)              { return __hip_atomic_load(p, __ATOMIC_RELAXED, __HIP_MEMORY_SCOPE_AGENT); }
__device__ __forceinline__ unsigned xb_add(unsigned* p, unsigned v) { return __hip_atomic_fetch_add(p, v, __ATOMIC_RELAXED, __HIP_MEMORY_SCOPE_AGENT); }
__device__ __forceinline__ unsigned xb_xcc_id() { return (unsigned)__builtin_amdgcn_s_getreg((3 << 11) | 20) & 0xFu; }
#define XB_SPIN(cond, bar) do { unsigned _sp = 0; while (cond) { __builtin_amdgcn_s_sleep(1); \
    if ((++_sp & 255u) == 0u) { if (xb_ld(&(bar)[XB_TMO])) break; if (_sp > XB_SPIN_CAP) { atomicAdd(&(bar)[XB_TMO], 1u); break; } } } } while (0)
struct XcdBarrier { unsigned* bar; unsigned x; volatile LAS unsigned* st; };
__device__ __forceinline__ XcdBarrier xcd_barrier_post(unsigned* bar, volatile LAS unsigned* st) {
    XcdBarrier b; b.bar = bar; b.x = xb_xcc_id(); b.st = st;
    if (threadIdx.x == 0) (void)xb_add(&bar[XB_XCNT(b.x)], 1u);
    return b;
}
__device__ __forceinline__ void xcd_barrier_complete(unsigned* bar, unsigned x, unsigned& nloc, unsigned& nx) {
    const unsigned G = gridDim.x * gridDim.y * gridDim.z;
    unsigned sum, cnt, mine, sp = 0u;
    for (;;) {
        sum = 0u; cnt = 0u; mine = 0u;
#pragma unroll
        for (unsigned j = 0; j < 16; ++j) { const unsigned c = xb_ld(&bar[XB_XCNT(j)]); sum += c; cnt += (c > 0u) ? 1u : 0u; mine = (j == x) ? c : mine; }
        if (sum == G) break;
        __builtin_amdgcn_s_sleep(1);
        if ((++sp & 255u) == 0u) { if (xb_ld(&bar[XB_TMO])) break; if (sp > XB_SPIN_CAP) { atomicAdd(&bar[XB_TMO], 1u); break; } }
    }
    nloc = mine > 0u ? mine : 1u; nx = cnt > 0u ? cnt : 1u;
}
__device__ __forceinline__ void xcd_barrier(const XcdBarrier& b) {
    asm volatile("s_waitcnt vmcnt(0)" ::: "memory");
    __syncthreads();
    if (threadIdx.x == 0) {
        unsigned* bar = b.bar;
        __builtin_amdgcn_s_waitcnt(0);
        unsigned nloc = b.st[0], nx = b.st[1];
        if (nloc == 0u) { xcd_barrier_complete(bar, b.x, nloc, nx); b.st[0] = nloc; b.st[1] = nx; }
        const unsigned old = xb_add(&bar[XB_XSUB(b.x)], 1u);
        const unsigned gen = old / nloc;
        if (old + 1u == (gen + 1u) * nloc) {
            __builtin_amdgcn_fence(__ATOMIC_RELEASE, "agent");
            asm volatile("s_waitcnt vmcnt(0)" ::: "memory");
            const unsigned og = xb_add(&bar[XB_TOP], 1u);
            const unsigned tg = og / nx;
            if (og + 1u == (tg + 1u) * nx) xb_add(&bar[XB_TOPGEN], 1u);
            else XB_SPIN(xb_ld(&bar[XB_TOPGEN]) == tg, bar);
            __builtin_amdgcn_fence(__ATOMIC_ACQUIRE, "agent");
            xb_add(&bar[XB_XGEN(b.x)], 1u);
            asm volatile("s_waitcnt vmcnt(0)" ::: "memory");
        } else {
            XB_SPIN(xb_ld(&bar[XB_XGEN(b.x)]) == gen, bar);
            __builtin_amdgcn_fence(__ATOMIC_ACQUIRE, "agent");
            asm volatile("s_waitcnt vmcnt(0)" ::: "memory");
        }
    }
    __syncthreads();
}

template <class T> __device__ __forceinline__ T* as_global(T* p) { const unsigned long long v = (unsigned long long)p; return (T*)(__attribute__((address_space(1))) T*)v; }
template <class T> __device__ __forceinline__ T* opaque_global(T* p) { unsigned long long v = (unsigned long long)p; asm volatile("" : "+s"(v)); return (T*)(__attribute__((address_space(1))) T*)v; }
struct InPtrs { const float* const* p; __device__ __forceinline__ const float* operator[](int k) const { return as_global(p[k]); } };
struct Frame {
  LAS unsigned char* lds; int tid, lane, wave, G, bid; unsigned char* ws; InPtrs in; float* out;
};

struct TJob { const float* W; unsigned char* WT; int N, ldtB, k0, n0, up, mode; float sc; };
__device__ __forceinline__ int gu_row(int n, int up) { return 256 * (n >> 7) + (n & 127) + up * 128; }
constexpr int TR0 = 16 * 104, TR1 = 16 * 16, TR2 = 20 * 16, TR3 = 16 * 16, TR4 = 2 * 10 * 4, TR5 = 2 * 16 * 4, TR6 = 4 * 16, TR7 = 2 * 64 * 16 * 4, TR8 = 64 * 4 * 16;
constexpr int T_NITEMS = TR0 + TR1 + TR2 + TR3 + TR4 + TR5 + TR6 + TR7 + TR8;
__device__ __forceinline__ TJob tj_decode(const Frame& F, int it) {
  unsigned char* ws = F.ws; int r = it;
  if (r < TR0) { const int kb = r / 104, nb = r % 104; return TJob{F.in[1], ws + WS_WIN, INC, DM * 2, 128 * kb, 128 * nb, 0, 0, 1.f}; } r -= TR0;
  if (r < TR1) { const int kb = r / 16, nb = r % 16; return TJob{F.in[19], ws + WS_WPM, DM, RW * 2, 128 * kb, 128 * nb, 0, 0, 1.f}; } r -= TR1;
  if (r < TR2) { const int kb = r / 16, nb = r % 16; return TJob{F.in[20], ws + WS_WPR, DM, RW * 2, 128 * kb, 128 * nb, 0, 0, 1.f}; } r -= TR2;
  if (r < TR3) { const int kb = r / 16, nb = r % 16; return TJob{F.in[21], ws + WS_WO, DM, DM * 2, 128 * kb, 128 * nb, 0, 0, 1.f}; } r -= TR3;
  if (r < TR4) { const int which = r / 40, rr = r % 40, blk = rr / 4, q = rr % 4; return TJob{F.in[which ? 16 : 14] + (size_t)blk * 65536, ws + WS_WRAX + (size_t)blk * 512 * 256 * 2, 256, 256 * 2, 128 * (q >> 1), 128 * (q & 1), which, 1, 1.f}; } r -= TR4;
  if (r < TR5) { const int which = r / 64, q = r % 64, kb = q / 4, nb = q % 4; return TJob{F.in[which ? 30 : 29], ws + WS_WSGU, DE, DM, 128 * kb, 128 * nb, which, 3, 64.f}; } r -= TR5;
  if (r < TR6) { const int kb = r / 16, nb = r % 16; return TJob{F.in[31], ws + WS_WSD, DM, DE, 128 * kb, 128 * nb, 0, 2, 32.f}; } r -= TR6;
  if (r < TR7) { const int which = r / 4096, rr = r % 4096, e = rr / 64, q = rr % 64, kb = q / 4, nb = q % 4; return TJob{F.in[which ? 27 : 26] + (size_t)e * DM * DE, ws + WS_WEGU + (size_t)e * 1024 * DM, DE, DM, 128 * kb, 128 * nb, which, 3, 64.f}; } r -= TR7;
  { const int e = r / 64, q = r % 64, kb = q / 16, nb = q % 16; return TJob{F.in[28] + (size_t)e * DE * DM, ws + WS_WED + (size_t)e * DM * DE, DM, DE, 128 * kb, 128 * nb, 0, 2, 32.f}; }
}
__device__ __forceinline__ void tj_load(const TJob& j, f32x4 (&v)[8], int wave, int lane) {
  const float* p = j.W + (size_t)(j.k0 + 16 * wave + (lane >> 5)) * j.N + j.n0 + 4 * (lane & 31);
#pragma unroll
  for (int i = 0; i < 8; ++i) v[i] = __builtin_nontemporal_load((const f32x4*)(p + (size_t)(2 * i) * j.N));
}
__device__ __forceinline__ void tj_store(const TJob& j, const f32x4 (&v)[8], LAS float* scr, int wave, int lane, int tid) {
#pragma unroll
  for (int i = 0; i < 8; ++i) { LAS float* d = scr + (16 * wave + 2 * i + (lane >> 5)) * 129 + 4 * (lane & 31); d[0] = v[i][0]; d[1] = v[i][1]; d[2] = v[i][2]; d[3] = v[i][3]; }
  LBAR();
  if (j.mode < 2) {
#pragma unroll
    for (int it = 0; it < 4; ++it) { const int idx = it * 512 + tid, n = idx >> 4, c = idx & 15; const LAS float* s = scr + (8 * c) * 129 + n;
      u32x4 o; o.x = pk2(s[0 * 129], s[1 * 129]); o.y = pk2(s[2 * 129], s[3 * 129]); o.z = pk2(s[4 * 129], s[5 * 129]); o.w = pk2(s[6 * 129], s[7 * 129]);
      const int nn = j.n0 + n; const int row = j.mode ? gu_row(nn, j.up) : nn;
      *(u32x4*)(j.WT + (size_t)row * j.ldtB + (j.k0 + 8 * c) * 2) = o; }
  } else {
#pragma unroll
    for (int it = 0; it < 2; ++it) { const int idx = it * 512 + tid, n = idx >> 3, c = idx & 7; const LAS float* s = scr + (16 * c) * 129 + n;
      int w[4];
#pragma unroll
      for (int q = 0; q < 4; ++q) { int t = 0; t = __builtin_amdgcn_cvt_pk_fp8_f32(s[(4 * q) * 129] * j.sc, s[(4 * q + 1) * 129] * j.sc, t, false); t = __builtin_amdgcn_cvt_pk_fp8_f32(s[(4 * q + 2) * 129] * j.sc, s[(4 * q + 3) * 129] * j.sc, t, true); w[q] = t; }
      u32x4 o; o.x = (unsigned)w[0]; o.y = (unsigned)w[1]; o.z = (unsigned)w[2]; o.w = (unsigned)w[3];
      const int nn = j.n0 + n; const int row = (j.mode == 3) ? gu_row(nn, j.up) : nn;
      __builtin_nontemporal_store(o, (u32x4*)(j.WT + (size_t)row * j.ldtB + j.k0 + 16 * c)); }
  }
  LBAR();
}

__device__ __forceinline__ void phase_prologue(const Frame& F) {
  LAS float* scr = (LAS float*)F.lds;
  unsigned char* ws = F.ws;
  {
    f32x4 vA[8], vB[8]; TJob jA, jB;
    int it = F.bid;
    if (it < T_NITEMS) { jA = tj_decode(F, it); tj_load(jA, vA, F.wave, F.lane); }
    while (it < T_NITEMS) {
      { const int itn = it + F.G; jB = tj_decode(F, itn < T_NITEMS ? itn : T_NITEMS - 1); tj_load(jB, vB, F.wave, F.lane); }
      tj_store(jA, vA, scr, F.wave, F.lane, F.tid);
      it += F.G; if (it >= T_NITEMS) break;
      { const int itn = it + F.G; jA = tj_decode(F, itn < T_NITEMS ? itn : T_NITEMS - 1); tj_load(jA, vA, F.wave, F.lane); }
      tj_store(jB, vB, scr, F.wave, F.lane, F.tid);
      it += F.G;
    }
  }
  const int gt = F.bid * 512 + F.tid, NGT = F.G * 512;
  { const float* x = F.in[0]; bf16_t* xb = (bf16_t*)(ws + WS_XB);
    for (int i = gt; i < NTOK * DM / 8; i += NGT) { const f32x4 a = *(const f32x4*)(x + (size_t)i * 8), b = *(const f32x4*)(x + (size_t)i * 8 + 4);
      u32x4 o; o.x = pk2(a[0], a[1]); o.y = pk2(a[2], a[3]); o.z = pk2(b[0], b[1]); o.w = pk2(b[2], b[3]); *(u32x4*)(xb + (size_t)i * 8) = o; } }
  { const float* wif = F.in[8]; bf16_t* wt = (bf16_t*)(ws + WS_SMALL + SM_WIFT);
    for (int i = gt; i < 16 * 6144; i += NGT) { const int n = i / 6144, k = i % 6144; float v = wif[k * 16 + n]; if (k >= 2048 && k < 4096) v *= 16.0f; wt[i] = (bf16_t)f2bf(v); } }
  { const float* lam = F.in[18]; float* c8 = (float*)(ws + WS_SMALL + SM_C8); for (int i = gt; i < RW; i += NGT) c8[i] = -8.0f * log1pf(expf(-lam[i])); }
  { const float* rwt = F.in[24]; bf16_t* rh = (bf16_t*)(ws + WS_SMALL + SM_RWH); bf16_t* rl = (bf16_t*)(ws + WS_SMALL + SM_RWL);
    for (int i = gt; i < NE * DM; i += NGT) { const int n = i / DM, k = i % DM; const float v = rwt[k * NE + n]; const unsigned h = f2bf(v); rh[i] = (bf16_t)h; rl[i] = (bf16_t)f2bf(v - __uint_as_float(h << 16)); } }
  { float* lw64 = (float*)(ws + WS_LISTW) + (size_t)NE * NTOK; for (int i = gt; i < NTOK; i += NGT) lw64[i] = 1.0f; }
  { int* ctl = (int*)(ws + WS_CTL); for (int i = gt; i < 4096; i += NGT) ctl[i] = 0; }
}

__device__ __forceinline__ void phase_mprep(const Frame& F) {
  unsigned char* ws = F.ws;
  const bf16_t* PROJ = (const bf16_t*)(ws + WS_PROJ);
  bf16_t* Q = (bf16_t*)(ws + WS_Q); bf16_t* Kb = (bf16_t*)(ws + WS_K); bf16_t* V = (bf16_t*)(ws + WS_V); bf16_t* XCM = (bf16_t*)(ws + WS_XCM);
  const bf16_t* WIFT = (const bf16_t*)(ws + WS_SMALL + SM_WIFT);
  float* IG = (float*)(ws + WS_SMALL + SM_IG); float* LF = (float*)(ws + WS_SMALL + SM_LF);
  const int g = F.tid;
  f32x4 cw[4]; for (int j = 0; j < 4; ++j) cw[j] = *(const f32x4*)(F.in[3] + j * MW + 4 * g);
  const f32x4 cb = *(const f32x4*)(F.in[4] + 4 * g);
  f32x4 wq[4], wk[4], wv[4];
  for (int i = 0; i < 4; ++i) { wq[i] = *(const f32x4*)(F.in[5] + g * 16 + 4 * i); wk[i] = *(const f32x4*)(F.in[6] + g * 16 + 4 * i); wv[i] = *(const f32x4*)(F.in[7] + g * 16 + 4 * i); }
  LAS unsigned char* AIMG = F.lds; LAS float* red = (LAS float*)(F.lds + 98432);
  const int r = F.lane & 15, gq = F.lane >> 4;
  for (int tile = F.bid; tile < NTOK / 8; tile += F.G) {
    const int t0 = tile * 8, s0 = t0 & (SEQ - 1);
    u32x2 rw[11];
#pragma unroll
    for (int j = 0; j < 11; ++j) { const int pos = s0 - 3 + j; rw[j] = (pos >= 0) ? *(const u32x2*)(PROJ + (size_t)(t0 - 3 + j) * INC + 4 * g) : (u32x2){0u, 0u}; }
#pragma unroll
    for (int tt = 0; tt < 8; ++tt) {
      const int t = t0 + tt;
      f32x4 xw[4];
#pragma unroll
      for (int j = 0; j < 4; ++j) xw[j] = (f32x4){bflo(rw[tt + j].x), bfhi(rw[tt + j].x), bflo(rw[tt + j].y), bfhi(rw[tt + j].y)};
      const f32x4 cv = cb + cw[0] * xw[0] + cw[1] * xw[1] + cw[2] * xw[2] + cw[3] * xw[3];
      f32x4 xc; for (int i = 0; i < 4; ++i) xc[i] = cv[i] * __builtin_amdgcn_rcpf(1.0f + __expf(-cv[i]));
      const f32x4 q = xc[0] * wq[0] + xc[1] * wq[1] + xc[2] * wq[2] + xc[3] * wq[3];
      f32x4 k = xc[0] * wk[0] + xc[1] * wk[1] + xc[2] * wk[2] + xc[3] * wk[3];
      const f32x4 v = xw[3][0] * wv[0] + xw[3][1] * wv[1] + xw[3][2] * wv[2] + xw[3][3] * wv[3];
      k = k * 0.0625f;
      const size_t o = (size_t)t * MW + 4 * g;
      u32x2 wqv, wkv, wvv, wxc;
      wqv.x = pk2(q[0], q[1]); wqv.y = pk2(q[2], q[3]); *(u32x2*)(Q + o) = wqv;
      wkv.x = pk2(k[0], k[1]); wkv.y = pk2(k[2], k[3]); *(u32x2*)(Kb + o) = wkv;
      wvv.x = pk2(v[0], v[1]); wvv.y = pk2(v[2], v[3]); *(u32x2*)(V + o) = wvv;
      wxc.x = pk2(xc[0], xc[1]); wxc.y = pk2(xc[2], xc[3]); *(u32x2*)(XCM + o) = wxc;
      LAS unsigned char* ar = AIMG + tt * 12304 + 8 * g;
      *(LAS u32x2*)(ar) = wqv; *(LAS u32x2*)(ar + 4096) = wkv; *(LAS u32x2*)(ar + 8192) = wvv;
    }
    LBAR();
    {
      f32x4 acc = (f32x4){0.f, 0.f, 0.f, 0.f};
#pragma unroll
      for (int ib = 0; ib < 3; ++ib) {
        bf16x8 bfr[8];
#pragma unroll
        for (int i = 0; i < 8; ++i) { const int ks = F.wave * 24 + ib * 8 + i; bfr[i] = *(const bf16x8*)(WIFT + (size_t)r * 6144 + ks * 32 + 8 * gq); }
#pragma unroll
        for (int i = 0; i < 8; ++i) { const int ks = F.wave * 24 + ib * 8 + i;
          const bf16x8 a = *(const LAS bf16x8*)(AIMG + (r & 7) * 12304 + (ks * 32 + 8 * gq) * 2);
          acc = __builtin_amdgcn_mfma_f32_16x16x32_bf16(a, bfr[i], acc, 0, 0, 0); }
      }
#pragma unroll
      for (int j = 0; j < 4; ++j) red[F.wave * 256 + (4 * gq + j) * 16 + r] = acc[j];
    }
    LBAR();
    if (F.tid < 128) {
      const int row = F.tid >> 4, n = F.tid & 15;
      float s = F.in[9][n];
#pragma unroll
      for (int w = 0; w < 8; ++w) s += red[w * 256 + F.tid];
      const int t = t0 + row, b = t >> 12, sp = t & (SEQ - 1);
      if (n < 8) IG[(size_t)(b * 8 + n) * SEQ + sp] = s;
      else LF[(size_t)(b * 8 + (n - 8)) * SEQ + sp] = fminf(s, 0.f) - log1pf(__expf(-fabsf(s)));
    }
    LBAR();
  }
}

__device__ __forceinline__ void phase_rconv(const Frame& F) {
  unsigned char* ws = F.ws;
  const bf16_t* PROJ = (const bf16_t*)(ws + WS_PROJ); bf16_t* XCR = (bf16_t*)(ws + WS_XCR);
  const int gt = F.bid * 512 + F.tid, NGT = F.G * 512;
  const int per = ((NTOK / 16) * 640 + F.G - 1) / F.G;
  for (int i2 = F.tid; i2 < per; i2 += 512) {
    const int it = F.bid * per + i2; if (it >= (NTOK / 16) * 640) break;
    const int tile = it / 640, g = it % 640, t0 = tile * 16, s0 = t0 & (SEQ - 1);
    f32x4 cw[4]; for (int j = 0; j < 4; ++j) cw[j] = *(const f32x4*)(F.in[12] + j * RW + 4 * g);
    const f32x4 cb = *(const f32x4*)(F.in[13] + 4 * g);
    u32x2 rw[19];
#pragma unroll
    for (int j = 0; j < 19; ++j) { const int pos = s0 - 3 + j; rw[j] = (pos >= 0) ? *(const u32x2*)(PROJ + (size_t)(t0 - 3 + j) * INC + O_XR + 4 * g) : (u32x2){0u, 0u}; }
#pragma unroll
    for (int tt = 0; tt < 16; ++tt) {
      f32x4 cv = cb;
#pragma unroll
      for (int j = 0; j < 4; ++j) cv = cv + cw[j] * (f32x4){bflo(rw[tt + j].x), bfhi(rw[tt + j].x), bflo(rw[tt + j].y), bfhi(rw[tt + j].y)};
      u32x2 w; w.x = pk2(cv[0], cv[1]); w.y = pk2(cv[2], cv[3]); *(u32x2*)(XCR + (size_t)(t0 + tt) * RW + 4 * g) = w;
    }
  }
}

__device__ __forceinline__ float chunk_m(const float* IG, const float* LF, int bh, int c, int lane, int wave, LAS float* CS) {
  for (int cc = wave; cc < c; cc += 8) {
    const float lf = LF[(size_t)bh * SEQ + 64 * cc + lane], ig = IG[(size_t)bh * SEQ + 64 * cc + lane];
    const float b = wave_scan_sum(lf, lane), gmax = wave_max(ig - b);
    if (lane == 63) { CS[cc] = b; CS[64 + cc] = b + gmax; }
  }
  __syncthreads();
  float A = 0.f, B = -INFINITY;
  if (lane < c) { A = CS[lane]; B = CS[64 + lane]; }
#pragma unroll
  for (int o = 1; o < 64; o <<= 1) { const float pA = __shfl_up(A, o), pB = __shfl_up(B, o); if (lane >= o) { B = fmaxf(pB + A, B); A = pA + A; } }
  const float mafter = fmaxf(A, B);
  const float mc = __shfl(mafter, c > 0 ? c - 1 : 0);
  return c > 0 ? mc : 0.f;
}

__device__ __forceinline__ void phase_m1(const Frame& F, const int bid2, const int G2) {
  unsigned char* ws = F.ws;
  const bf16_t* Q = (const bf16_t*)(ws + WS_Q); const bf16_t* Kb = (const bf16_t*)(ws + WS_K); const bf16_t* V = (const bf16_t*)(ws + WS_V);
  const float* IG = (const float*)(ws + WS_SMALL + SM_IG); const float* LF = (const float*)(ws + WS_SMALL + SM_LF);
  float* INTER = (float*)(ws + WS_SMALL + SM_INTER); float* EMR = (float*)(ws + WS_SMALL + SM_EMR); float* DENI = (float*)(ws + WS_SMALL + SM_DENI);
  bf16_t* HNI = (bf16_t*)(ws + WS_HNI);
  LAS unsigned char* QS = F.lds; LAS unsigned char* KS = F.lds + 33792; LAS unsigned char* VT = F.lds + 67584; LAS unsigned char* PS = F.lds + 104448;
  LAS float* SCg = (LAS float*)(F.lds + 113664); LAS float* SCM = SCg + 64;
  const int r = F.lane & 15, gq = F.lane >> 4, w = F.wave;
  for (int item = bid2; item < 16 * NCH; item += G2) {
    const int bh = item / NCH, c = item % NCH, b = bh >> 3, h = bh & 7, tok0 = b * SEQ + 64 * c;
    const float m = chunk_m(IG, LF, bh, c, F.lane, w, (LAS float*)(F.lds + 114176));
    const float lf_c = LF[(size_t)bh * SEQ + 64 * c + F.lane], ig_c = IG[(size_t)bh * SEQ + 64 * c + F.lane];
    const float b_l = wave_scan_sum(lf_c, F.lane), g_l = ig_c - b_l;
    const float M_l = fmaxf(m, wave_scan_max(g_l, F.lane));
    if (w == 0) { SCg[F.lane] = g_l; SCM[F.lane] = M_l; INTER[(size_t)(tok0 + F.lane) * 8 + h] = __expf(m - M_l); EMR[(size_t)(tok0 + F.lane) * 8 + h] = __expf(-(b_l + M_l)); }
#pragma unroll
    for (int i = 0; i < 4; ++i) {
      const int idx = i * 512 + F.tid, row = idx >> 5, c16 = idx & 31;
      const size_t go = (size_t)(tok0 + row) * MW + 256 * h + 8 * c16;
      *(LAS u32x4*)(QS + row * 528 + c16 * 16) = *(const u32x4*)(Q + go);
      *(LAS u32x4*)(KS + row * 528 + c16 * 16) = *(const u32x4*)(Kb + go);
    }
    {
      const int sp = F.tid & 31, cq = F.tid >> 5;
#pragma unroll
      for (int i = 0; i < 2; ++i) {
        const size_t go = (size_t)(tok0 + 2 * sp) * MW + 256 * h + 8 * (cq + 16 * i);
        const u32x4 v0 = *(const u32x4*)(V + go), v1 = *(const u32x4*)(V + go + MW);
        const unsigned a0[4] = {v0.x, v0.y, v0.z, v0.w}, a1[4] = {v1.x, v1.y, v1.z, v1.w};
#pragma unroll
        for (int e = 0; e < 4; ++e) { const int dv = 8 * (cq + 16 * i) + 2 * e;
          *(LAS unsigned*)(VT + dv * 144 + sp * 4) = (a0[e] & 0xffffu) | (a1[e] << 16);
          *(LAS unsigned*)(VT + (dv + 1) * 144 + sp * 4) = (a0[e] >> 16) | (a1[e] & 0xffff0000u); }
      }
    }
    __syncthreads();
    {
      const int mi = w & 3;
#pragma unroll
      for (int nn = 0; nn < 2; ++nn) {
        const int ni = 2 * (w >> 2) + nn;
        f32x4 acc = (f32x4){0.f, 0.f, 0.f, 0.f};
        if (ni <= mi) {
#pragma unroll
          for (int ks = 0; ks < 8; ++ks) {
            const bf16x8 a = *(const LAS bf16x8*)(QS + (16 * mi + r) * 528 + (32 * ks + 8 * gq) * 2);
            const bf16x8 bb = *(const LAS bf16x8*)(KS + (16 * ni + r) * 528 + (32 * ks + 8 * gq) * 2);
            acc = __builtin_amdgcn_mfma_f32_16x16x32_bf16(a, bb, acc, 0, 0, 0);
          }
        }
        const int s = 16 * ni + r; const float gs = SCg[s];
#pragma unroll
        for (int j = 0; j < 4; ++j) { const int l = 16 * mi + 4 * gq + j; const float p = (s <= l) ? acc[j] * __expf(gs - SCM[l]) : 0.f; *(LAS bf16_t*)(PS + l * 144 + s * 2) = (bf16_t)f2bf(p); }
      }
    }
    __syncthreads();
    if (F.tid < 64) { float s = 0.f; for (int k = 0; k < 64; ++k) s += bf1(*(const LAS bf16_t*)(PS + F.tid * 144 + k * 2)); DENI[(size_t)(tok0 + F.tid) * 8 + h] = s; }
#pragma unroll
    for (int nn = 0; nn < 2; ++nn) {
      const int ni = 2 * w + nn;
#pragma unroll
      for (int mi = 0; mi < 4; ++mi) {
        f32x4 acc = (f32x4){0.f, 0.f, 0.f, 0.f};
#pragma unroll
        for (int ks = 0; ks < 2; ++ks) {
          const bf16x8 a = *(const LAS bf16x8*)(PS + (16 * mi + r) * 144 + (32 * ks + 8 * gq) * 2);
          const bf16x8 bb = *(const LAS bf16x8*)(VT + (16 * ni + r) * 144 + (32 * ks + 8 * gq) * 2);
          acc = __builtin_amdgcn_mfma_f32_16x16x32_bf16(a, bb, acc, 0, 0, 0);
        }
#pragma unroll
        for (int j = 0; j < 4; ++j) HNI[(size_t)(tok0 + 16 * mi + 4 * gq + j) * MW + 256 * h + 16 * ni + r] = (bf16_t)f2bf(acc[j]);
      }
    }
    __syncthreads();
  }
}

__device__ __forceinline__ void phase_m2(const Frame& F, const int nblk) {
  unsigned char* ws = F.ws;
  const bf16_t* Q = (const bf16_t*)(ws + WS_Q); const bf16_t* Kb = (const bf16_t*)(ws + WS_K); const bf16_t* V = (const bf16_t*)(ws + WS_V);
  const float* IG = (const float*)(ws + WS_SMALL + SM_IG); const float* LF = (const float*)(ws + WS_SMALL + SM_LF);
  float* QN = (float*)(ws + WS_SMALL + SM_QN);
  bf16_t* HNE = (bf16_t*)(ws + WS_HNE);
  LAS unsigned char* QS = F.lds; LAS unsigned char* KT = F.lds + 33792; LAS unsigned char* WVT = F.lds + 70656; LAS unsigned char* CT = F.lds + 77568;
  LAS float* TD = (LAS float*)(F.lds + 111360); LAS float* CS = (LAS float*)(F.lds + 111616);
  float* DUMMY = (float*)(ws + WS_M2TAB + 4 * MiB);
  const int w = F.wave;
  for (int item = F.bid; item < 128; item += nblk) {
    const int bh = item >> 3, sl = item & 7, b = bh >> 3, h = bh & 7, dv0 = 32 * sl;
    float* TI = (float*)(ws + WS_M2TAB) + (size_t)item * 8192; float* TW = TI + 4096;
    const int lane = F.lane;
    for (int i = F.tid; i < (6912 + 33792) / 4; i += 512) *(LAS unsigned*)(WVT + 4 * i) = 0u;
    float gk[8], pk[8];
#pragma unroll
    for (int i = 0; i < 8; ++i) {
      const int cc = w + 8 * i;
      const float lf = LF[(size_t)bh * SEQ + 64 * cc + lane], ig = IG[(size_t)bh * SEQ + 64 * cc + lane];
      const float bl = wave_scan_sum(lf, lane), g = ig - bl;
      const float gmax = wave_max(g), pm = wave_scan_max(g, lane);
      gk[i] = g; pk[i] = pm;
      if (lane == 63) { CS[cc] = bl; CS[64 + cc] = bl + gmax; }
    }
    __syncthreads();
    {
      float A = CS[lane], B = CS[64 + lane]; const float gmx = B - A;
#pragma unroll
      for (int o = 1; o < 64; o <<= 1) { const float pA = __shfl_up(A, o), pB = __shfl_up(B, o); if (lane >= o) { B = fmaxf(pB + A, B); A = pA + A; } }
      const float mafter = fmaxf(A, B);
      float mstart = __shfl_up(mafter, 1); if (lane == 0) mstart = 0.f;
      const float M63 = fmaxf(mstart, gmx);
      if (w == 0) TD[lane] = __expf(mstart - M63);
#pragma unroll
      for (int i = 0; i < 8; ++i) {
        const int cc = w + 8 * i;
        const float ms = __shfl(mstart, cc), m6 = __shfl(M63, cc);
        TI[cc * 64 + lane] = __expf(ms - fmaxf(ms, pk[i])); TW[cc * 64 + lane] = __expf(gk[i] - m6);
      }
    }
    __threadfence(); __syncthreads();
    f32x4 acc[2][3];
#pragma unroll
    for (int a = 0; a < 2; ++a)
#pragma unroll
      for (int n = 0; n < 3; ++n) acc[a][n] = (f32x4){0.f, 0.f, 0.f, 0.f};
    u32x4 qrA[4], krA[2][2], vrA = (u32x4){0u, 0u, 0u, 0u}, qrB[4], krB[2][2], vrB = (u32x4){0u, 0u, 0u, 0u};
    float wsA = 0.f, wsB = 0.f; f32x4 ivA = (f32x4){0.f, 0.f, 0.f, 0.f}, ivB = ivA;
#define M2_LOAD(qreg, kreg, vreg, wsr, ivr, c) do { const int tk_ = b * SEQ + 64 * (c); \
      _Pragma("unroll") for (int i = 0; i < 4; ++i) { const int idx = i * 512 + tdx, row = idx >> 5, c16 = idx & 31; qreg[i] = *(const u32x4*)(Q + (size_t)(tk_ + row) * MW + 256 * h + 8 * c16); } \
      _Pragma("unroll") for (int i = 0; i < 2; ++i) { const size_t go = (size_t)(tk_ + 2 * sp) * MW + 256 * h + 8 * (cq + 16 * i); kreg[i][0] = *(const u32x4*)(Kb + go); kreg[i][1] = *(const u32x4*)(Kb + go + MW); } \
      vreg = *(const u32x4*)(V + (size_t)(tk_ + lane) * MW + 256 * h + dv0 + 8 * (w & 3)); \
      wsr = TW[(c) * 64 + lane]; \
      ivr = *(const f32x4*)(TI + (c) * 64 + 16 * (w & 3) + 4 * gq); } while (0)
#define M2_AMMA(mi, nt) \
        f32x4 a2 = (f32x4){0.f, 0.f, 0.f, 0.f}; \
        _Pragma("unroll") for (int ks = 0; ks < 8; ++ks) { \
          const bf16x8 a = *(const LAS bf16x8*)(QS + (16 * (mi) + r) * 528 + (32 * ks + 8 * gq) * 2); \
          const bf16x8 bb = *(const LAS bf16x8*)(CT + (16 * (nt) + r) * 528 + (32 * ks + 8 * gq) * 2); \
          a2 = __builtin_amdgcn_mfma_f32_16x16x32_bf16(a, bb, a2, 0, 0, 0); }
#define M2_ATILE_H(mi, nt, tok0, ivr) do { M2_AMMA(mi, nt) \
        _Pragma("unroll") for (int j = 0; j < 4; ++j) { const int l = 16 * (mi) + 4 * gq + j; \
          HNE[(size_t)((tok0) + l) * MW + 256 * h + dv0 + 16 * (nt) + r] = (bf16_t)f2bf(a2[j] * ivr[j]); } } while (0)
#define M2_ATILE_Q(mi, nt, tok0, ivr) do { M2_AMMA(mi, nt) \
        _Pragma("unroll") for (int j = 0; j < 4; ++j) { const int l = 16 * (mi) + 4 * gq + j; \
          float* qp = ((nt) == 2 && r == 0) ? (QN + (size_t)((tok0) + l) * 8 + h) : (DUMMY + tdx * 4 + j); *qp = a2[j] * ivr[j]; } } while (0)
#define M2_BODY(c, qreg, kreg, vreg, wsr, ivr) do { \
      int tdx = (int)threadIdx.x; asm volatile("" : "+v"(tdx)); \
      const int lane = tdx & 63, r = lane & 15, gq = lane >> 4, sp = tdx & 31, cq = tdx >> 5; \
      const int tok0 = b * SEQ + 64 * (c); \
      _Pragma("unroll") for (int i = 0; i < 4; ++i) { const int idx = i * 512 + tdx, row = idx >> 5, c16 = idx & 31; *(LAS u32x4*)(QS + row * 528 + c16 * 16) = qreg[i]; } \
      _Pragma("unroll") for (int i = 0; i < 2; ++i) { \
        const unsigned k0[4] = {kreg[i][0].x, kreg[i][0].y, kreg[i][0].z, kreg[i][0].w}, k1[4] = {kreg[i][1].x, kreg[i][1].y, kreg[i][1].z, kreg[i][1].w}; \
        _Pragma("unroll") for (int e = 0; e < 4; ++e) { const int dk = 8 * (cq + 16 * i) + 2 * e; \
          *(LAS unsigned*)(KT + dk * 144 + sp * 4) = (k0[e] & 0xffffu) | (k1[e] << 16); \
          *(LAS unsigned*)(KT + (dk + 1) * 144 + sp * 4) = (k0[e] >> 16) | (k1[e] & 0xffff0000u); } } \
      if (w < 4) { const unsigned vw[4] = {vreg.x, vreg.y, vreg.z, vreg.w}; \
        _Pragma("unroll") for (int e = 0; e < 4; ++e) { *(LAS bf16_t*)(WVT + (8 * w + 2 * e) * 144 + lane * 2) = (bf16_t)f2bf(bflo(vw[e]) * wsr); *(LAS bf16_t*)(WVT + (8 * w + 2 * e + 1) * 144 + lane * 2) = (bf16_t)f2bf(bfhi(vw[e]) * wsr); } \
      } else if (w == 4) { *(LAS bf16_t*)(WVT + 32 * 144 + lane * 2) = (bf16_t)f2bf(wsr); } \
      const f32x4 ivc = ivr; \
      { const int cn_ = ((c) + 2 < NCH) ? (c) + 2 : NCH - 1; M2_LOAD(qreg, kreg, vreg, wsr, ivr, cn_); } \
      LBAR(); \
      M2_ATILE_H(w & 3, w >> 2, tok0, ivc); \
      M2_ATILE_Q(w & 3, 2 + (w >> 2), tok0, ivc); \
      const float decay = TD[(c)]; \
      _Pragma("unroll") for (int mt = 0; mt < 2; ++mt) \
        _Pragma("unroll") for (int n2 = 0; n2 < 3; ++n2) { \
          f32x4 cacc = acc[mt][n2] * decay; \
          _Pragma("unroll") for (int ks = 0; ks < 2; ++ks) { \
            const bf16x8 a = *(const LAS bf16x8*)(KT + (32 * w + 16 * mt + r) * 144 + (32 * ks + 8 * gq) * 2); \
            const bf16x8 bb = *(const LAS bf16x8*)(WVT + (16 * n2 + r) * 144 + (32 * ks + 8 * gq) * 2); \
            cacc = __builtin_amdgcn_mfma_f32_16x16x32_bf16(a, bb, cacc, 0, 0, 0); } \
          acc[mt][n2] = cacc; } \
      LBAR(); \
      _Pragma("unroll") for (int mt = 0; mt < 2; ++mt) \
        _Pragma("unroll") for (int n2 = 0; n2 < 3; ++n2) { u32x2 q; q.x = pk2(acc[mt][n2][0], acc[mt][n2][1]); q.y = pk2(acc[mt][n2][2], acc[mt][n2][3]); \
          *(LAS u32x2*)(CT + (16 * n2 + r) * 528 + (32 * w + 16 * mt + 4 * gq) * 2) = q; } \
    } while (0)
    { const int tdx = F.tid, sp = tdx & 31, cq = tdx >> 5, gq = (tdx & 63) >> 4;
      M2_LOAD(qrA, krA, vrA, wsA, ivA, 0);
      M2_LOAD(qrB, krB, vrB, wsB, ivB, 1); }
    __syncthreads();
#pragma unroll 1
    for (int c = 0; c < NCH; c += 2) {
      M2_BODY(c, qrA, krA, vrA, wsA, ivA);
      M2_BODY(c + 1, qrB, krB, vrB, wsB, ivB);
    }
#undef M2_BODY
#undef M2_ATILE_H
#undef M2_ATILE_Q
#undef M2_AMMA
#undef M2_LOAD
    __syncthreads();
  }
}

__device__ __forceinline__ void phase_ragg(const Frame& F) {
  unsigned char* ws = F.ws;
  const float* RA = (const float*)(ws + WS_RA); const bf16_t* RBb = (const bf16_t*)(ws + WS_RB);
  float* AGGA = (float*)(ws + WS_SMALL + SM_AGGA); float* AGGB = (float*)(ws + WS_SMALL + SM_AGGB);
  const int gt = F.bid * 512 + F.tid, NGT = F.G * 512;
  const int per = (2 * NCH * (RW / 2) + F.G - 1) / F.G;
#pragma unroll 1
  for (int i2 = F.tid; i2 < per; i2 += 512) {
    const int it = F.bid * per + i2; if (it >= 2 * NCH * (RW / 2)) break;
    const int bc = it / (RW / 2), ch = 2 * (it - bc * (RW / 2));
    const float* pa = RA + (size_t)bc * 64 * RW + ch; const bf16_t* pb = RBb + (size_t)bc * 64 * RW + ch;
    float A0 = 1.f, B0 = 0.f, A1 = 1.f, B1 = 0.f;
#pragma unroll 1
    for (int tb = 0; tb < 8; ++tb) {
      f32x2 a[8]; unsigned bb[8];
#pragma unroll
      for (int t = 0; t < 8; ++t) { a[t] = *(const f32x2*)(pa + (size_t)(tb * 8 + t) * RW); bb[t] = *(const unsigned*)(pb + (size_t)(tb * 8 + t) * RW); }
#pragma unroll
      for (int t = 0; t < 8; ++t) { A0 *= a[t][0]; B0 = a[t][0] * B0 + bflo(bb[t]); A1 *= a[t][1]; B1 = a[t][1] * B1 + bfhi(bb[t]); }
    }
    *(f32x2*)(AGGA + (size_t)bc * RW + ch) = (f32x2){A0, A1}; *(f32x2*)(AGGB + (size_t)bc * RW + ch) = (f32x2){B0, B1};
  }
}
__device__ __forceinline__ float gelu_fast(float x) {
  const float u = 0.7978845608028654f * (x + 0.044715f * x * x * x); return x * __builtin_amdgcn_rcpf(1.0f + __expf(-2.0f * u)); }
__device__ __forceinline__ void phase_rscan(const Frame& F) {
  unsigned char* ws = F.ws;
  const float* RA = (const float*)(ws + WS_RA); const bf16_t* RBb = (const bf16_t*)(ws + WS_RB);
  const float* AGGA = (const float*)(ws + WS_SMALL + SM_AGGA); const float* AGGB = (const float*)(ws + WS_SMALL + SM_AGGB);
  const bf16_t* PROJ = (const bf16_t*)(ws + WS_PROJ); bf16_t* YR = (bf16_t*)(ws + WS_YR);
  const int gt = F.bid * 512 + F.tid, NGT = F.G * 512;
#define RS_LD(a, bb, xg, tb) do { _Pragma("unroll") for (int t = 0; t < 8; ++t) { const size_t o = (size_t)(t0 + (tb) * 8 + t) * RW + ch; \
      a[t] = __builtin_nontemporal_load((const f32x2*)(RA + o)); bb[t] = __builtin_nontemporal_load((const unsigned*)(RBb + o)); \
      xg[t] = __builtin_nontemporal_load((const unsigned*)(PROJ + (size_t)(t0 + (tb) * 8 + t) * INC + O_XG + ch)); } } while (0)
#define RS_DO(a, bb, xg, tb) do { _Pragma("unroll") for (int t = 0; t < 8; ++t) { h0 = a[t][0] * h0 + bflo(bb[t]); h1 = a[t][1] * h1 + bfhi(bb[t]); \
      *(unsigned*)(YR + (size_t)(t0 + (tb) * 8 + t) * RW + ch) = pk2(h0 * gelu_fast(bflo(xg[t])), h1 * gelu_fast(bfhi(xg[t]))); } } while (0)
#define RS_CLD(ca, cb, c0) do { _Pragma("unroll") for (int k = 0; k < 8; ++k) { const int cc = (c0) + k; const int j = (b * NCH + (cc < cidx ? cc : 0)) * RW + ch; ca[k] = *(const f32x2*)(AGGA + j); cb[k] = *(const f32x2*)(AGGB + j); } } while (0)
#define RS_CDO(ca, cb, c0) do { _Pragma("unroll") for (int k = 0; k < 8; ++k) { if ((c0) + k < cidx) { h0 = ca[k][0] * h0 + cb[k][0]; h1 = ca[k][1] * h1 + cb[k][1]; } } } while (0)
  const int per = (2 * NCH * (RW / 2) + F.G - 1) / F.G;
  for (int i2 = F.tid; i2 < per; i2 += 512) {
    const int it = F.bid * per + i2; if (it >= 2 * NCH * (RW / 2)) break;
    const int bc = it / (RW / 2), ch = 2 * (it % (RW / 2)), t0 = bc * 64, b = bc / NCH, cidx = bc % NCH;
    float h0 = 0.f, h1 = 0.f;
    f32x2 aA[8], aB[8]; unsigned bA[8], bB[8], xA[8], xB[8];
    RS_LD(aA, bA, xA, 0);
    {
      f32x2 caA[8], cbA[8], caB[8], cbB[8];
      RS_CLD(caA, cbA, 0);
      for (int c0 = 0; c0 < cidx; c0 += 16) {
        RS_CLD(caB, cbB, c0 + 8);
        RS_CDO(caA, cbA, c0);
        RS_CLD(caA, cbA, c0 + 16);
        RS_CDO(caB, cbB, c0 + 8);
      }
    }
#pragma unroll
    for (int tb = 0; tb < 8; tb += 2) {
      RS_LD(aB, bB, xB, tb + 1);
      RS_DO(aA, bA, xA, tb);
      if (tb + 2 < 8) RS_LD(aA, bA, xA, tb + 2);
      RS_DO(aB, bB, xB, tb + 1);
    }
  }
#undef RS_LD
#undef RS_DO
#undef RS_CLD
#undef RS_CDO
}

__device__ __forceinline__ void phase_ym(const Frame& F) {
  unsigned char* ws = F.ws;
  const bf16_t* HNI = (const bf16_t*)(ws + WS_HNI); const bf16_t* HNE = (const bf16_t*)(ws + WS_HNE);
  const float* EMR = (const float*)(ws + WS_SMALL + SM_EMR); const float* DENI = (const float*)(ws + WS_SMALL + SM_DENI); const float* QN = (const float*)(ws + WS_SMALL + SM_QN);
  const bf16_t* XCM = (const bf16_t*)(ws + WS_XCM); const bf16_t* PROJ = (const bf16_t*)(ws + WS_PROJ); bf16_t* YM = (bf16_t*)(ws + WS_YM);
  const float* normw = F.in[10]; const float* skip = F.in[11];
  const int gw = F.bid * 8 + F.wave, NGW = F.G * 8, lane = F.lane;
  for (int tA = gw; tA < NTOK; tA += 2 * NGW) {
    const int tBr = tA + NGW; const bool okB = tBr < NTOK; const int tB = okB ? tBr : tA;
    u32x2 a[2][8], e[2][8], xcw[2][8], zw[2][8]; float den[2][8], emr[2][8];
#pragma unroll
    for (int u = 0; u < 2; ++u) { const int t = u ? tB : tA;
#pragma unroll
      for (int h = 0; h < 8; ++h) {
        const size_t o = (size_t)t * MW + 256 * h + 4 * lane;
        a[u][h] = __builtin_nontemporal_load((const u32x2*)(HNI + o)); e[u][h] = __builtin_nontemporal_load((const u32x2*)(HNE + o)); xcw[u][h] = __builtin_nontemporal_load((const u32x2*)(XCM + o));
        zw[u][h] = __builtin_nontemporal_load((const u32x2*)(PROJ + (size_t)t * INC + O_Z + 256 * h + 4 * lane));
        den[u][h] = DENI[t * 8 + h] + QN[t * 8 + h]; emr[u][h] = EMR[t * 8 + h];
      } }
#pragma unroll
    for (int u = 0; u < 2; ++u) { const int t = u ? tB : tA;
      if (u == 0 || okB) {
#pragma unroll
      for (int h = 0; h < 8; ++h) {
        const int col = 256 * h + 4 * lane;
        const float inv = 1.0f / fmaxf(fabsf(den[u][h]), emr[u][h]);
        const float hv[4] = {(bflo(a[u][h].x) + bflo(e[u][h].x)) * inv, (bfhi(a[u][h].x) + bfhi(e[u][h].x)) * inv, (bflo(a[u][h].y) + bflo(e[u][h].y)) * inv, (bfhi(a[u][h].y) + bfhi(e[u][h].y)) * inv};
        const float mean = wave_sum((hv[0] + hv[1]) + (hv[2] + hv[3])) * (1.0f / 256.0f);
        float d[4]; float s2 = 0.f;
#pragma unroll
        for (int j = 0; j < 4; ++j) { d[j] = hv[j] - mean; s2 += d[j] * d[j]; }
        const float rstd = rsqrtf(wave_sum(s2) * (1.0f / 256.0f) + LN_EPS);
        const f32x4 nw = *(const f32x4*)(normw + col), sk = *(const f32x4*)(skip + col);
        const float xc[4] = {bflo(xcw[u][h].x), bfhi(xcw[u][h].x), bflo(xcw[u][h].y), bfhi(xcw[u][h].y)}, z[4] = {bflo(zw[u][h].x), bfhi(zw[u][h].x), bflo(zw[u][h].y), bfhi(zw[u][h].y)};
        float y[4];
#pragma unroll
        for (int j = 0; j < 4; ++j) y[j] = (d[j] * rstd * nw[j] + sk[j] * xc[j]) * siluf_(z[j]);
        u32x2 w; w.x = pk2(y[0], y[1]); w.y = pk2(y[2], y[3]); *(u32x2*)(YM + (size_t)t * RW + col) = w;
      } }
    }
  }
}

__device__ __forceinline__ void phase_ln_router(const Frame& F) {
  unsigned char* ws = F.ws;
  float* X1 = (float*)(ws + WS_X1); unsigned char* X1Q = ws + WS_X1B;
  int* CNT = (int*)(ws + WS_CTL); int* LIST = (int*)(ws + WS_LIST); float* LISTW = (float*)(ws + WS_LISTW); int* TOKES = (int*)(ws + WS_TOKES);
  const float* g1 = F.in[22]; const float* b1 = F.in[23]; const float* rw = F.in[24]; const float* rbias = F.in[25];
  LAS unsigned char* XH = F.lds; LAS unsigned char* XL = F.lds + 65792;
  const bf16_t* RWH = (const bf16_t*)(ws + WS_SMALL + SM_RWH); const bf16_t* RWL = (const bf16_t*)(ws + WS_SMALL + SM_RWL);
  const int w = F.wave;
  for (int tile = F.bid; tile < NTOK / 16; tile += F.G) {
    const int t0 = tile * 16;
    int lane = F.lane; asm volatile("" : "+v"(lane));
    const int r16 = lane & 15, gq = lane >> 4;
#pragma unroll 1
    for (int q = 0; q < 2; ++q) {
      const int tl = 2 * w + q, t = t0 + tl;
      float* xr = X1 + (size_t)t * DM;
      f32x4 v[8]; float s = 0.f;
#pragma unroll
      for (int j = 0; j < 8; ++j) { v[j] = *(const f32x4*)(xr + 4 * lane + 256 * j); s += (v[j][0] + v[j][1]) + (v[j][2] + v[j][3]); }
      const float mean = wave_sum(s) * (1.0f / DM); float s2 = 0.f;
#pragma unroll
      for (int j = 0; j < 8; ++j) { v[j] = v[j] - mean; s2 += (v[j][0] * v[j][0] + v[j][1] * v[j][1]) + (v[j][2] * v[j][2] + v[j][3] * v[j][3]); }
      const float rstd = rsqrtf(wave_sum(s2) * (1.0f / DM) + LN_EPS);
#pragma unroll
      for (int j = 0; j < 8; ++j) {
        const int col = 4 * lane + 256 * j;
        const f32x4 gg = *(const f32x4*)(g1 + col), bb = *(const f32x4*)(b1 + col);
        const f32x4 o = v[j] * rstd * gg + bb;
        *(f32x4*)(xr + col) = o;
        u32x2 pw; pw.x = pk2(o[0], o[1]); pw.y = pk2(o[2], o[3]);
        { int q8 = 0; q8 = __builtin_amdgcn_cvt_pk_fp8_f32(o[0], o[1], q8, false); q8 = __builtin_amdgcn_cvt_pk_fp8_f32(o[2], o[3], q8, true); *(int*)(X1Q + (size_t)t * DM + col) = q8; }
        { float lo[4];
#pragma unroll
          for (int e = 0; e < 4; ++e) lo[e] = o[e] - __uint_as_float(f2bf(o[e]) << 16);
          *(LAS u32x2*)(XH + tl * 4112 + col * 2) = pw; u32x2 lw; lw.x = pk2(lo[0], lo[1]); lw.y = pk2(lo[2], lo[3]); *(LAS u32x2*)(XL + tl * 4112 + col * 2) = lw; }
      }
    }
    __syncthreads();
    f32x4 lacc[4];
    {
      const bf16_t* rh = RWH + (size_t)r16 * DM + 256 * w + 8 * gq; const bf16_t* rl = RWL + (size_t)r16 * DM + 256 * w + 8 * gq;
      const LAS unsigned char* xh = XH + r16 * 4112 + (256 * w + 8 * gq) * 2; const LAS unsigned char* xl = XL + r16 * 4112 + (256 * w + 8 * gq) * 2;
#pragma unroll
      for (int nt = 0; nt < 4; ++nt) {
        f32x4 a4 = (f32x4){0.f, 0.f, 0.f, 0.f};
#pragma unroll
        for (int kh = 0; kh < 2; ++kh) {
          bf16x8 bh[4], bl[4];
#pragma unroll
          for (int k2 = 0; k2 < 4; ++k2) { bh[k2] = *(const bf16x8*)(rh + (size_t)(16 * nt) * DM + 32 * (4 * kh + k2)); bl[k2] = *(const bf16x8*)(rl + (size_t)(16 * nt) * DM + 32 * (4 * kh + k2)); }
#pragma unroll
          for (int k2 = 0; k2 < 4; ++k2) {
            const bf16x8 ah = *(const LAS bf16x8*)(xh + 64 * (4 * kh + k2));
            const bf16x8 al = *(const LAS bf16x8*)(xl + 64 * (4 * kh + k2));
            a4 = __builtin_amdgcn_mfma_f32_16x16x32_bf16(ah, bh[k2], a4, 0, 0, 0);
            a4 = __builtin_amdgcn_mfma_f32_16x16x32_bf16(al, bh[k2], a4, 0, 0, 0);
            a4 = __builtin_amdgcn_mfma_f32_16x16x32_bf16(ah, bl[k2], a4, 0, 0, 0);
          }
          asm volatile("" ::: "memory");
        }
        lacc[nt] = a4;
      }
    }
    __syncthreads();
    LAS float* PART = (LAS float*)F.lds;
#pragma unroll
    for (int nt = 0; nt < 4; ++nt)
#pragma unroll
      for (int j = 0; j < 4; ++j) PART[(w * 16 + 4 * gq + j) * 64 + 16 * nt + r16] = lacc[nt][j];
    __syncthreads();
    LAS int* lcnt = (LAS int*)(F.lds + 40960); LAS int* lbase = lcnt + 64;
    if (F.tid < 64) lcnt[F.tid] = 0;
    __syncthreads();
    int lslot[2], rnk[2]; float wg[2];
#pragma unroll
    for (int q = 0; q < 2; ++q) {
      const int tl = 2 * w + q;
      float logit = 0.f;
#pragma unroll
      for (int ww = 0; ww < 8; ++ww) logit += PART[(ww * 16 + tl) * 64 + lane];
      const float score = 1.0f / (1.0f + expf(-logit));
      const float biased = score + rbias[lane];
      int cnt = 0;
#pragma unroll
      for (int d = 1; d < 8; ++d) { const int other = (lane & ~7) | ((lane + d) & 7); const float ov = __shfl(biased, other); cnt += (ov > biased || (ov == biased && other < lane)) ? 1 : 0; }
      float gs = cnt < 2 ? biased : 0.f;
      gs += __shfl_xor(gs, 1); gs += __shfl_xor(gs, 2); gs += __shfl_xor(gs, 4);
      const int gi = lane >> 3; int grank = 0;
#pragma unroll
      for (int gg = 0; gg < 8; ++gg) { const float og = __shfl(gs, 8 * gg); grank += (og > gs || (og == gs && gg < gi)) ? 1 : 0; }
      const float val = grank < 4 ? biased : -INFINITY;
      int erank = 0;
      for (int e2 = 0; e2 < 64; ++e2) { const float ov = __shfl(val, e2); erank += (ov > val || (ov == val && e2 < lane)) ? 1 : 0; }
      const bool chosen = erank < 8;
      const float wsum = wave_sum(chosen ? score : 0.f);
      rnk[q] = erank; wg[q] = score / wsum * 2.5f; lslot[q] = -1;
      if (chosen) lslot[q] = atomicAdd((int*)(lcnt + lane), 1);
    }
    __syncthreads();
    if (F.tid < 64) { const int c = lcnt[F.tid]; lbase[F.tid] = c ? atomicAdd(&CNT[F.tid * 64], c) : 0; }
    __syncthreads();
#pragma unroll
    for (int q = 0; q < 2; ++q) {
      if (lslot[q] >= 0) { const int t = t0 + 2 * w + q; const int slot = lbase[lane] + lslot[q];
        LIST[lane * NTOK + slot] = t; LISTW[lane * NTOK + slot] = wg[q]; TOKES[t * 8 + rnk[q]] = (lane << 16) | slot; }
    }
    __syncthreads();
  }
}

__device__ __forceinline__ MoeTab build_moe_tab(const Frame& F) {
  LAS int* tp = (LAS int*)(F.lds + LDS_X); LAS int* cp = tp + 68; LAS int* cn = tp + 136;
  const int* CNT = (const int*)(F.ws + WS_CTL);
  if (F.tid == 0) { int a = 0, b = 0; for (int e = 0; e < NE; ++e) { const int c = CNT[e * 64]; tp[e] = a; cp[e] = b; cn[e] = c; a += (c + 255) >> 8; b += c; } tp[NE] = a; cp[NE] = b; }
  __syncthreads();
  { LAS int* rt = tp + 256; if (F.tid < 384) { int e = 0; for (int k = 0; k < NE; ++k) { if (tp[k + 1] <= F.tid) e = k + 1; } rt[F.tid] = e < NE ? e : NE - 1; } }
  __syncthreads();
  MoeTab T; T.tp = tp; T.cp = cp; T.cnt = cn; T.n_rt = __builtin_amdgcn_readfirstlane(tp[NE]);
  return T;
}

__device__ __forceinline__ void phase_final(const Frame& F, const MoeTab& T) {
  unsigned char* ws = F.ws;
  const bf16_t* YRM = (const bf16_t*)(ws + WS_YRM); const int* TOKES = (const int*)(ws + WS_TOKES);
  const float* g2 = F.in[32]; const float* b2 = F.in[33];
  const int gw = F.bid * 8 + F.wave, NGW = F.G * 8, lane = F.lane;
  for (int t = gw; t < NTOK; t += NGW) {
    float* orow = F.out + (size_t)t * DM;
    f32x4 v[8];
    { const float* xrow = (const float*)(ws + WS_X1) + (size_t)t * DM; const bf16_t* ys = YRM + (size_t)(NTOK * 8 + t) * DM;
#pragma unroll
      for (int j = 0; j < 8; ++j) { const u32x2 wv = __builtin_nontemporal_load((const u32x2*)(ys + 4 * lane + 256 * j)); v[j] = *(const f32x4*)(xrow + 4 * lane + 256 * j) * ALPHA; v[j][0] += bflo(wv.x); v[j][1] += bfhi(wv.x); v[j][2] += bflo(wv.y); v[j][3] += bfhi(wv.y); } }
    const int esl = TOKES[t * 8 + (lane & 7)];
#pragma unroll
    for (int kb = 0; kb < 2; ++kb) {
      u32x2 yv[4][8];
#pragma unroll
      for (int k = 0; k < 4; ++k) {
        const int es = __shfl(esl, kb * 4 + k); const int e = es >> 16, slot = es & 0xffff;
        const bf16_t* yr = YRM + (size_t)(T.cp[e] + slot) * DM;
#pragma unroll
        for (int j = 0; j < 8; ++j) yv[k][j] = __builtin_nontemporal_load((const u32x2*)(yr + 4 * lane + 256 * j));
      }
#pragma unroll
      for (int k = 0; k < 4; ++k)
#pragma unroll
        for (int j = 0; j < 8; ++j) { v[j][0] += bflo(yv[k][j].x); v[j][1] += bfhi(yv[k][j].x); v[j][2] += bflo(yv[k][j].y); v[j][3] += bfhi(yv[k][j].y); }
    }
    float s = 0.f;
#pragma unroll
    for (int j = 0; j < 8; ++j) s += (v[j][0] + v[j][1]) + (v[j][2] + v[j][3]);
    const float mean = wave_sum(s) * (1.0f / DM); float s2 = 0.f;
#pragma unroll
    for (int j = 0; j < 8; ++j) { v[j] = v[j] - mean; s2 += (v[j][0] * v[j][0] + v[j][1] * v[j][1]) + (v[j][2] * v[j][2] + v[j][3] * v[j][3]); }
    const float rstd = rsqrtf(wave_sum(s2) * (1.0f / DM) + LN_EPS);
#pragma unroll
    for (int j = 0; j < 8; ++j) { const int col = 4 * lane + 256 * j; const f32x4 gg = *(const f32x4*)(g2 + col), bb = *(const f32x4*)(b2 + col); *(f32x4*)(orow + col) = v[j] * rstd * gg + bb; }
  }
}

__global__ void __launch_bounds__(512, 2) fwd_megakernel(Params p, int ph_lo, int ph_hi) {
  extern __shared__ __attribute__((aligned(16))) unsigned char lds_raw[];
  Frame F;
  F.lds = (LAS unsigned char*)lds_raw; F.tid = threadIdx.x; F.lane = F.tid & 63; F.wave = __builtin_amdgcn_readfirstlane(F.tid >> 6);
  F.G = gridDim.x; F.bid = blockIdx.x; F.ws = as_global(p.ws); F.in = InPtrs{p.in}; F.out = as_global(p.out);
  unsigned char* ws = as_global(p.ws);
#ifndef PHMASK
#define PHMASK 0xFFF
#endif
#define IN(k) (((PHMASK >> (k)) & 1) && ph_lo <= (k) && (k) < ph_hi)
#ifndef RPTMASK
#define RPTMASK 0
#endif
#define RPT(k) for (int _rp = 0; _rp < 1 + ((RPTMASK >> (k)) & 1); ++_rp)
#define FRESH() do { unsigned char* w2_ = opaque_global(p.ws); ws = w2_; F.ws = w2_; int l2_ = (int)__builtin_amdgcn_mbcnt_hi(~0u, __builtin_amdgcn_mbcnt_lo(~0u, 0u)); asm volatile("" : "+v"(l2_)); F.lane = l2_; F.tid = F.wave * 64 + l2_; } while (0)
#define SYNC(k) do { if (IN(k) && IN((k) + 1)) { xcd_barrier(xbar); } } while (0)
  { volatile LAS unsigned* st = (volatile LAS unsigned*)(F.lds + LDS_X + 4096); if (F.tid < 4) st[F.tid] = 0u; }
  __syncthreads();
  const XcdBarrier xbar = xcd_barrier_post((unsigned*)(ws + WS_CTL + 16384), (volatile LAS unsigned*)(F.lds + LDS_X + 4096));

  FRESH();
  if (IN(0)) RPT(0) { if (_rp) xcd_barrier(xbar); phase_prologue(F); }
  SYNC(0);
  FRESH();
  if (IN(1)) RPT(1) { if (_rp) xcd_barrier(xbar);
    SchedDense S{(const char*)(ws + WS_XB), (const char*)(ws + WS_WIN), NTOK / 256, INC / 256, F.G, F.bid, DM, DM, DM / 64};
    EpiStoreBf16 E{(bf16_t*)(ws + WS_PROJ), INC};
    pg8::gemm_phase<EpiStoreBf16, SchedDense, false>(F.lds, DM, DM, S, E);
  }
  SYNC(1);
  FRESH();
  if (IN(2)) RPT(2) { if (_rp) xcd_barrier(xbar); phase_mprep(F); phase_rconv(F); }
  SYNC(2);
  FRESH();
  if (IN(3)) RPT(3) { if (_rp) xcd_barrier(xbar);
    const int nm2 = F.G >> 1;
    if (F.bid < nm2) phase_m2(F, nm2);
    else {
      const int bid2 = F.bid - nm2, G2 = F.G - nm2;
      phase_m1(F, bid2, G2);
      int Kr = 4; asm volatile("" : "+s"(Kr));
      SchedRglru S{(const char*)(ws + WS_XCR), (const char*)(ws + WS_WRAX), G2, bid2, Kr};
      EpiRglru E{(const bf16_t*)(ws + WS_XCR), p.in[15], p.in[17], (const float*)(ws + WS_SMALL + SM_C8), (float*)(ws + WS_RA), (bf16_t*)(ws + WS_RB)};
      pg8::gemm_phase<EpiRglru, SchedRglru, false>(F.lds, RW, 256, S, E);
    }
  }
  SYNC(3);
  FRESH();
  if (IN(4)) RPT(4) { if (_rp) xcd_barrier(xbar); phase_ragg(F); phase_ym(F); }
  SYNC(4);
  FRESH();
  if (IN(5)) RPT(5) { if (_rp) xcd_barrier(xbar); phase_rscan(F); }
  SYNC(5);
  FRESH();
  if (IN(6)) RPT(6) { if (_rp) xcd_barrier(xbar);
    SchedMerge S{(const char*)(ws + WS_YM), (const char*)(ws + WS_YR), (const char*)(ws + WS_WPM), (const char*)(ws + WS_WPR), F.G, F.bid};
    EpiMergeF E{(const bf16_t*)(ws + WS_PROJ), p.in[2], (bf16_t*)(ws + WS_MERGED)};
    pg8::gemm_phase<EpiMergeF, SchedMerge, false>(F.lds, RW, RW, S, E);
  }
  SYNC(6);
  FRESH();
  if (IN(7)) RPT(7) { if (_rp) xcd_barrier(xbar);
    SchedDense S{(const char*)(ws + WS_MERGED), (const char*)(ws + WS_WO), NTOK / 256, DM / 256, F.G, F.bid, DM, DM, DM / 64};
    EpiWo E{p.in[0], (float*)(ws + WS_X1)};
    pg8::gemm_phase<EpiWo, SchedDense, false>(F.lds, DM, DM, S, E);
  }
  SYNC(7);
  FRESH();
  if (IN(8)) phase_ln_router(F);
  SYNC(8);
  FRESH();
  if (IN(9)) RPT(9) { if (_rp) xcd_barrier(xbar);
    const MoeTab T = build_moe_tab(F);
    SchedMoe<4, 1> S{T, (const int*)(ws + WS_LIST), (const char*)(ws + WS_X1B), (const char*)(ws + WS_WEGU), (const char*)(ws + WS_WSGU), F.G, F.bid, DM / 128};
    EpiMoe1 E{ws + WS_HMOE};
    pg8::gemm_phase<EpiMoe1, SchedMoe<4, 1>, true>(F.lds, DM / 2, DM / 2, S, E);
  }
  SYNC(9);
  FRESH();
  if (IN(10)) RPT(10) { if (_rp) xcd_barrier(xbar);
    const MoeTab T = build_moe_tab(F);
    int nt2 = DE / 128; asm volatile("" : "+s"(nt2));
    SchedMoe<8, 2> S{T, (const int*)(ws + WS_LIST), (const char*)(ws + WS_HMOE), (const char*)(ws + WS_WED), (const char*)(ws + WS_WSD), F.G, F.bid, nt2};
    EpiMoe2 E{(bf16_t*)(ws + WS_YRM), (const float*)(ws + WS_LISTW), (bf16_t*)(ws + WS_WIN)};
    pg8::gemm_phase<EpiMoe2, SchedMoe<8, 2>, false>(F.lds, DE / 2, DE / 2, S, E);
  }
  SYNC(10);
  FRESH();
  if (IN(11)) { const MoeTab T = build_moe_tab(F); phase_final(F, T); }
#undef IN
#undef SYNC
}

#ifndef N_LAUNCH_SPLIT
#define N_LAUNCH_SPLIT 0
#endif
extern "C" void kernel_launch(void* const* d_in, const int* in_sizes, int n_in, void* d_out, int out_size, void* d_ws, size_t ws_size, hipStream_t stream) {
  static int grid_blocks = 0;
  if (grid_blocks == 0) {
    int dev = 0, cus = 0, per_cu = 0;
    (void)hipGetDevice(&dev);
    (void)hipDeviceGetAttribute(&cus, hipDeviceAttributeMultiprocessorCount, dev);
    (void)hipFuncSetAttribute((const void*)fwd_megakernel, hipFuncAttributeMaxDynamicSharedMemorySize, LDS_BYTES);
    (void)hipOccupancyMaxActiveBlocksPerMultiprocessor(&per_cu, fwd_megakernel, 512, LDS_BYTES);
    if (per_cu < 1) { fprintf(stderr, "kernel_launch: occupancy query says %d blocks per CU\n", per_cu); per_cu = 1; }
    grid_blocks = cus * per_cu;
    fprintf(stderr, "kernel_launch: cus %d per_cu %d grid %d ws_size %zu (need %zu) n_in %d\n", cus, per_cu, grid_blocks, ws_size, (size_t)WS_END, n_in);
    if (ws_size < WS_END || n_in != 34) { fprintf(stderr, "kernel_launch: workspace too small or unexpected inputs; nothing launched\n"); grid_blocks = -1; }
  }
  if (grid_blocks < 0) return;
  (void)hipMemsetAsync((char*)d_ws + WS_CTL, 0, 65536, stream);
  Params p{};
  for (int i = 0; i < 34; ++i) p.in[i] = (const float*)d_in[i];
  p.out = (float*)d_out; p.ws = (unsigned char*)d_ws;
#if N_LAUNCH_SPLIT
  for (int ph = 0; ph < 12; ++ph) { hipLaunchKernelGGL(fwd_megakernel, dim3(grid_blocks), dim3(512), LDS_BYTES, stream, p, ph, ph + 1); }
#else
  int lo = 0, hi = 12;
  void* args[] = {&p, &lo, &hi};
  hipError_t e = hipLaunchCooperativeKernel((void*)fwd_megakernel, dim3(grid_blocks), dim3(512), args, LDS_BYTES, stream);
  if (e != hipSuccess) fprintf(stderr, "cooperative launch failed: %s (grid %d)\n", hipGetErrorString(e), grid_blocks);
#endif
}
```

```cpp
#include <hip/hip_runtime.h>
#include <hip/hip_cooperative_groups.h>
#include <cstdio>
#include <cstdint>
namespace cg = cooperative_groups;

#define LAS __attribute__((address_space(3)))
typedef unsigned short bf16_t;
typedef short bf16x8 __attribute__((ext_vector_type(8)));
typedef float f32x4 __attribute__((ext_vector_type(4)));
typedef float f32x2 __attribute__((ext_vector_type(2)));
typedef unsigned u32x4 __attribute__((ext_vector_type(4)));
typedef unsigned u32x2 __attribute__((ext_vector_type(2)));
typedef int i32x8 __attribute__((ext_vector_type(8)));
typedef int i32x4 __attribute__((ext_vector_type(4)));

constexpr int NTOK = 8192, DM = 2048, SEQ = 4096, MW = 2048, RW = 2560, INC = 13312, NH = 8, HD = 256, NE = 64, DE = 512;
constexpr int O_Z = 2048, O_XR = 4096, O_XG = 6656, O_G0 = 9216, O_G1 = 11264;
constexpr float LN_EPS = 1e-5f;
constexpr float ALPHA = 1.189207115002721f;
constexpr int NCH = 64;

constexpr size_t MiB = 1u << 20;
constexpr size_t WS_CTL = 0;
constexpr size_t WS_WIN = 1 * MiB, WS_RB = 1 * MiB, WS_M2TAB = 41 * MiB;
constexpr size_t WS_WPM = 53 * MiB  , WS_WPR = 63 * MiB, WS_WO = 73 * MiB, WS_WRAX = 81 * MiB, WS_WSGU = 84 * MiB, WS_WSD = 1014 * MiB;
constexpr size_t WS_WEGU = 88 * MiB, WS_WED = 344 * MiB;
constexpr size_t WS_XB = 472 * MiB, WS_HNI = 472 * MiB, WS_HMOE = 472 * MiB;
constexpr size_t WS_PROJ = 504 * MiB;
constexpr size_t WS_YRM = 560 * MiB;
constexpr size_t WS_Q = 712 * MiB, WS_K = 744 * MiB, WS_V = 776 * MiB, WS_YM = 712 * MiB  , WS_YR = 752 * MiB;
constexpr size_t WS_XCM = 808 * MiB, WS_MERGED = 808 * MiB;
constexpr size_t WS_XCR = 840 * MiB;
constexpr size_t WS_SMALL = 880 * MiB;
constexpr size_t WS_RA = 886 * MiB, WS_T1 = 886 * MiB, WS_X1B = 886 * MiB  ;
constexpr size_t WS_LIST = 918 * MiB, WS_LISTW = 920 * MiB  , WS_TOKES = 923 * MiB;
constexpr size_t WS_X1 = 950 * MiB;
constexpr size_t WS_HNE = 966 * MiB;
constexpr size_t WS_END = 1016 * MiB;
constexpr size_t SM_IG = 0, SM_LF = 256 * 1024, SM_INTER = 512 * 1024, SM_EMR = 768 * 1024, SM_DENI = 1024 * 1024, SM_QN = 1280 * 1024;
constexpr size_t SM_WIFT = 1536 * 1024;
constexpr size_t SM_C8 = 1792 * 1024;
constexpr size_t SM_RWH = 4608 * 1024, SM_RWL = 4864 * 1024;
constexpr size_t SM_AGGA = 2 * MiB, SM_AGGB = 2 * MiB + 1310720;

constexpr int LDS_BYTES = 147456;
constexpr int LDS_X = 131072;

struct Params {
  const float* in[34];
  float* out;
  unsigned char* ws;
};

typedef __bf16 hbf2_t __attribute__((ext_vector_type(2)));
typedef float hf2_t __attribute__((ext_vector_type(2)));
__device__ __forceinline__ unsigned pk2(float lo, float hi) { const hf2_t f = {lo, hi}; return __builtin_bit_cast(unsigned, __builtin_convertvector(f, hbf2_t)); }
__device__ __forceinline__ unsigned f2bf(float f) { return pk2(f, 0.f) & 0xffffu; }
__device__ __forceinline__ float bflo(unsigned w) { return __uint_as_float(w << 16); }
__device__ __forceinline__ float bfhi(unsigned w) { return __uint_as_float(w & 0xffff0000u); }
__device__ __forceinline__ float bf1(bf16_t b) { return __uint_as_float(((unsigned)b) << 16); }
__device__ __forceinline__ float sigmoidf_(float x) { return 1.0f / (1.0f + __expf(-x)); }
__device__ __forceinline__ float siluf_(float x) { return x / (1.0f + __expf(-x)); }
__device__ __forceinline__ float gelu_tanh(float x) { const float u = 0.7978845608028654f * (x + 0.044715f * x * x * x); return 0.5f * x * (1.0f + tanhf(u)); }
__device__ __forceinline__ float wave_sum(float v) {
#pragma unroll
  for (int o = 1; o < 64; o <<= 1) v += __shfl_xor(v, o);
  return v;
}
__device__ __forceinline__ float wave_max(float v) {
#pragma unroll
  for (int o = 1; o < 64; o <<= 1) v = fmaxf(v, __shfl_xor(v, o));
  return v;
}
__device__ __forceinline__ float wave_scan_sum(float v, int lane) {
#pragma unroll
  for (int o = 1; o < 64; o <<= 1) { const float t = __shfl_up(v, o); if (lane >= o) v += t; }
  return v;
}
__device__ __forceinline__ float wave_scan_max(float v, int lane) {
#pragma unroll
  for (int o = 1; o < 64; o <<= 1) { const float t = __shfl_up(v, o); if (lane >= o) v = fmaxf(v, t); }
  return v;
}
#define LDS_WAIT() asm volatile("s_waitcnt lgkmcnt(0)" ::: "memory")
#define LBAR() do { asm volatile("s_waitcnt lgkmcnt(0)" ::: "memory"); __builtin_amdgcn_s_barrier(); asm volatile("" ::: "memory"); } while (0)

namespace pg8 {
constexpr int BM = 256, BK = 64, HALF = 128, HTB = HALF * BK * 2, NXCD = 8, WGM = 8;
__device__ __forceinline__ int lds_byte(int r, int c) { const int st = (r >> 4) * 2 + (c >> 5), rr = r & 15, cc = c & 31, ob = rr * 64 + cc * 2; return st * 1024 + (ob ^ (((ob >> 9) & 1) << 5)); }
__device__ __forceinline__ void stage_rc(int b, int& R, int& C) { const int st = b / 1024, sb = b % 1024, swz = sb ^ (((sb >> 9) & 1) << 5); R = (st >> 1) * 16 + swz / 64; C = (st & 1) * 32 + (swz % 64) / 2; }

__device__ __forceinline__ int perm32(int rho) { const int n = rho >> 4, i = rho & 15; return 8 * (i >> 2) + 4 * n + (i & 3); }
struct UnitG { const char* A; const char* B; int pm, pn, e, cnt, mt, row0, nt, keep; };

__device__ __forceinline__ bool dense_order(int i, int G, int c, int nM, int nN, int& pm, int& pn) {
  const int nwg = nM * nN; const long L = (long)i * G + c; if (L >= nwg) return false;
  int wgid = (int)L; { const int q = nwg / NXCD, r = nwg % NXCD, xcd = wgid % NXCD, off = wgid / NXCD; wgid = (xcd < r ? xcd * (q + 1) : r * (q + 1) + (xcd - r) * q) + off; }
  const int nig = WGM * nN, gid = wgid / nig, fm = gid * WGM, gsz = (nM - fm) < WGM ? (nM - fm) : WGM;
  pm = fm + ((wgid % nig) % gsz); pn = (wgid % nig) / gsz; return true;
}

template <class Epi, class Sched, bool GATHER>
__device__ __forceinline__ void gemm_phase(LAS unsigned char* lds, const int lda, const int ldb, const Sched& S, const Epi& E) {
  const int tid = threadIdx.x, wid = __builtin_amdgcn_readfirstlane(tid >> 6), lane = tid & 63, wr = wid >> 2, wc = wid & 3, fr = lane & 15, fq = lane >> 4;
  int Rr[2], Cc[2];
  unsigned voffB[2];
  unsigned vA[2][2];
  unsigned nvA[2][2];
#pragma unroll
  for (int i = 0; i < 2; ++i) { stage_rc(tid * 16 + i * 8192, Rr[i], Cc[i]); const int Rb = Epi::PERM ? ((Rr[i] & ~31) + perm32(Rr[i] & 31)) : Rr[i]; voffB[i] = (unsigned)(Rb * ldb + Cc[i]) * 2u; }
  const size_t kstep = (size_t)(BK * 2);
  const size_t hstepA = (size_t)HALF * lda * 2, hstepB = (size_t)HALF * ldb * 2;
  const unsigned ldsw = (unsigned)wid * 1024u;
  const int aoff = lds_byte(wr * 64 + fr, fq * 8), boff = lds_byte(wc * 32 + fr, fq * 8);
#define PG8_SA(b, h) (((b) * 2 + (h)) * HTB)
#define PG8_SB(b, h) ((4 + (b) * 2 + (h)) * HTB)
#define PG8_STAGE_B(bufoff, gbase) do { _Pragma("unroll") for (int _i = 0; _i < 2; ++_i) \
    __builtin_amdgcn_global_load_lds((const unsigned*)((const char*)(gbase) + voffB[_i]), (LAS unsigned*)(lds + (bufoff) + ldsw + _i * 8192), 16, 0, 0); } while (0)
#define PG8_STAGE_A(bufoff, gbase, h) do { _Pragma("unroll") for (int _i = 0; _i < 2; ++_i) { \
    const char* _p = GATHER ? ((const char*)(gbase) + vA[h][_i]) : ((const char*)(gbase) + (h) * hstepA + vA[0][_i]); \
    __builtin_amdgcn_global_load_lds((const unsigned*)_p, (LAS unsigned*)(lds + (bufoff) + ldsw + _i * 8192), 16, 0, 0); } } while (0)
#define PG8_LD8(p) __builtin_shufflevector(*(const LAS i32x4*)(p), *(const LAS i32x4*)((p) + 1024), 0, 1, 2, 3, 4, 5, 6, 7)
#define PG8_LO(x) __builtin_bit_cast(bf16x8, __builtin_shufflevector(x, x, 0, 1, 2, 3))
#define PG8_HI(x) __builtin_bit_cast(bf16x8, __builtin_shufflevector(x, x, 4, 5, 6, 7))
#define PG8_LDA(dst, b, h) do { _Pragma("unroll") for (int m = 0; m < 4; ++m) dst[m] = PG8_LD8(lds + PG8_SA(b, h) + aoff + m * 2048); } while (0)
#define PG8_LDB(dst, b, h) do { _Pragma("unroll") for (int n = 0; n < 2; ++n) dst[n] = PG8_LD8(lds + PG8_SB(b, h) + boff + n * 2048); } while (0)
#define PG8_MMA(ai, bj, At, Bt) do { __builtin_amdgcn_s_setprio(1); _Pragma("unroll") for (int m = 0; m < 4; ++m) _Pragma("unroll") for (int n = 0; n < 2; ++n) { \
    acc[ai][bj][m][n] = __builtin_amdgcn_mfma_f32_16x16x32_bf16(PG8_LO(Bt[n]), PG8_LO(At[m]), acc[ai][bj][m][n], 0, 0, 0); \
    acc[ai][bj][m][n] = __builtin_amdgcn_mfma_f32_16x16x32_bf16(PG8_HI(Bt[n]), PG8_HI(At[m]), acc[ai][bj][m][n], 0, 0, 0); } __builtin_amdgcn_s_setprio(0); } while (0)
#define PG8_MMA8(ai, bj, At, Bt) do { __builtin_amdgcn_s_setprio(1); _Pragma("unroll") for (int m = 0; m < 4; ++m) _Pragma("unroll") for (int n = 0; n < 2; ++n) \
    acc[ai][bj][m][n] = __builtin_amdgcn_mfma_scale_f32_16x16x128_f8f6f4(Bt[n], At[m], acc[ai][bj][m][n], 0, 0, 0, 0x7F7F7F7F, 0, 0x7F7F7F7F); __builtin_amdgcn_s_setprio(0); } while (0)
#define PG8_MM(ai, bj, At, Bt) do { if (Epi::FP8) PG8_MMA8(ai, bj, At, Bt); else PG8_MMA(ai, bj, At, Bt); } while (0)
#define PG8_WAIT_V(n) asm volatile("s_waitcnt vmcnt(" #n ")" ::: "memory")
#define PG8_WAIT_L(n) asm volatile("s_waitcnt lgkmcnt(" #n ")" ::: "memory")
#define PG8_BAR __builtin_amdgcn_s_barrier()
#define PG8_SCHED __builtin_amdgcn_sched_barrier(0)
  UnitG cur, nxt; int ui = 0;
  if (!S.next(0, cur)) return;
#pragma unroll
  for (int h = 0; h < 2; ++h)
#pragma unroll
    for (int i = 0; i < 2; ++i) {
      if (GATHER) vA[h][i] = (unsigned)(S.arow(cur, h * HALF + Rr[i]) * lda + Cc[i]) * 2u;
      else vA[h][i] = (unsigned)(Rr[i] * lda + Cc[i]) * 2u;
      nvA[h][i] = vA[h][i];
    }
  f32x4 acc[2][2][4][2];
#pragma unroll
  for (int a = 0; a < 2; ++a)
#pragma unroll
    for (int b = 0; b < 2; ++b)
#pragma unroll
      for (int m = 0; m < 4; ++m)
#pragma unroll
        for (int n = 0; n < 2; ++n) acc[a][b][m][n] = (f32x4){0.f, 0.f, 0.f, 0.f};
  i32x8 At[4], B0[2], B1[2];
  const char* cA = cur.A; const char* cB = cur.B;
  { const char* pB0 = cB; const char* pB1 = cB + hstepB; const char* pA0 = cA; const char* pB2 = cB + kstep; const char* pA1 = cA + kstep; const char* pB3 = cB + hstepB + kstep;
    asm volatile("" : "+s"(pB0), "+s"(pB1), "+s"(pA0), "+s"(pB2), "+s"(pA1), "+s"(pB3));
  PG8_STAGE_B(PG8_SB(0, 0), pB0); PG8_STAGE_B(PG8_SB(0, 1), pB1); PG8_STAGE_A(PG8_SA(0, 0), pA0, 0); PG8_STAGE_A(PG8_SA(0, 1), pA0, 1);
  if (wr == 1) PG8_BAR;
  PG8_WAIT_V(2); PG8_BAR;
  PG8_STAGE_B(PG8_SB(1, 0), pB2); PG8_STAGE_A(PG8_SA(1, 0), pA1, 0); PG8_STAGE_B(PG8_SB(1, 1), pB3); }
  PG8_WAIT_V(6); PG8_BAR;
  for (;;) {
    const bool has_next = S.next(ui + 1, nxt);
    const char* nA = has_next ? nxt.A : cA; const char* nB = has_next ? nxt.B : cB;
    if (GATHER) {
      if (has_next) {
#pragma unroll
        for (int h = 0; h < 2; ++h)
#pragma unroll
          for (int i = 0; i < 2; ++i) nvA[h][i] = (unsigned)(S.arow(nxt, h * HALF + Rr[i]) * lda + Cc[i]) * 2u;
      }
    }
    const int nt = cur.nt;
#pragma unroll 1
    for (int t = 0; t < nt; t += 2) {
      const bool last = (t == nt - 2);
      const char* a1 = cA + (size_t)(t + 1) * kstep;
      const char* a2 = last ? nA : cA + (size_t)(t + 2) * kstep; const char* b2 = last ? nB : cB + (size_t)(t + 2) * kstep;
      const char* a3 = a2 + kstep; const char* b3 = b2 + kstep;
      asm volatile("" : "+s"(a1), "+s"(a2), "+s"(a3), "+s"(b2), "+s"(b3));
      PG8_LDB(B0, 0, 0); PG8_LDB(B1, 0, 1); PG8_SCHED; PG8_LDA(At, 0, 0); PG8_STAGE_A(PG8_SA(1, 1), a1, 1);
      if (GATHER) { if (last) {
#pragma unroll
        for (int h = 0; h < 2; ++h)
#pragma unroll
          for (int i = 0; i < 2; ++i) vA[h][i] = nvA[h][i]; } }
      PG8_WAIT_V(8); PG8_WAIT_L(0); PG8_BAR; PG8_MM(0, 0, At, B0); PG8_MM(0, 1, At, B1); PG8_BAR; PG8_SCHED;
      PG8_LDA(At, 0, 1); PG8_STAGE_B(PG8_SB(0, 0), b2); PG8_STAGE_B(PG8_SB(0, 1), b2 + hstepB); PG8_STAGE_A(PG8_SA(0, 0), a2, 0);
      PG8_WAIT_V(8); PG8_WAIT_L(0); PG8_BAR; PG8_MM(1, 0, At, B0); PG8_MM(1, 1, At, B1); PG8_BAR; PG8_SCHED;
      PG8_LDB(B0, 1, 0); PG8_LDB(B1, 1, 1); PG8_SCHED; PG8_LDA(At, 1, 0); PG8_STAGE_A(PG8_SA(0, 1), a2, 1);
      PG8_WAIT_V(8); PG8_WAIT_L(0); PG8_BAR; PG8_MM(0, 0, At, B0); PG8_MM(0, 1, At, B1); PG8_BAR; PG8_SCHED;
      PG8_LDA(At, 1, 1); PG8_STAGE_B(PG8_SB(1, 0), b3); PG8_STAGE_B(PG8_SB(1, 1), b3 + hstepB); PG8_STAGE_A(PG8_SA(1, 0), a3, 0);
      PG8_WAIT_V(8); PG8_WAIT_L(0); PG8_BAR; PG8_MM(1, 0, At, B0); PG8_MM(1, 1, At, B1); PG8_BAR; PG8_SCHED;
    }
    if (wr == 0) PG8_BAR;
    { int l2 = (int)__builtin_amdgcn_mbcnt_hi(~0u, __builtin_amdgcn_mbcnt_lo(~0u, 0u)); asm volatile("" : "+v"(l2));
      E(acc, cur, wr, wc, l2 & 15, l2 >> 4); }
    if (!has_next) break;
    if (!cur.keep) {
#pragma unroll
      for (int a = 0; a < 2; ++a)
#pragma unroll
        for (int b = 0; b < 2; ++b)
#pragma unroll
          for (int m = 0; m < 4; ++m)
#pragma unroll
            for (int n = 0; n < 2; ++n) acc[a][b][m][n] = (f32x4){0.f, 0.f, 0.f, 0.f};
    }
    cur = nxt; cA = nA; cB = nB; ++ui;
    if (wr == 1) PG8_BAR;
  }
  PG8_WAIT_V(0);
  PG8_BAR;
#undef PG8_SA
#undef PG8_SB
#undef PG8_STAGE_A
#undef PG8_STAGE_B
#undef PG8_LDA
#undef PG8_LDB
#undef PG8_MMA
#undef PG8_MMA8
#undef PG8_MM
#undef PG8_LD8
#undef PG8_LO
#undef PG8_HI
#undef PG8_WAIT_V
#undef PG8_WAIT_L
#undef PG8_BAR
#undef PG8_SCHED
}
}

__device__ __forceinline__ const char* uni_ptr(const char* p) {
  const unsigned long long v = (unsigned long long)p;
  const unsigned lo = __builtin_amdgcn_readfirstlane((unsigned)v), hi = __builtin_amdgcn_readfirstlane((unsigned)(v >> 32));
  return (const char*)(((unsigned long long)hi << 32) | lo);
}

struct SchedDense {
  const char* A; const char* B; int nM, nN, G, c, lda, ldb, nt;
  __device__ __forceinline__ bool next(int i, pg8::UnitG& u) const {
    int pm, pn; if (!pg8::dense_order(i, G, c, nM, nN, pm, pn)) return false;
    u.pm = pm; u.pn = pn; u.e = 0; u.cnt = 0; u.mt = 0; u.row0 = pm * 256; u.nt = nt; u.keep = 0;
    u.A = A + (size_t)pm * 256 * lda * 2; u.B = B + (size_t)pn * 256 * ldb * 2; return true;
  }
  __device__ __forceinline__ unsigned arow(const pg8::UnitG&, int r) const { return (unsigned)r; }
};

struct EpiStoreBf16 {
  static constexpr bool PERM = true, FP8 = false;
  bf16_t* O; int ldc;
  __device__ __forceinline__ void operator()(const f32x4 (&acc)[2][2][4][2], const pg8::UnitG& u, int wr, int wc, int fr, int fq) const {
    const int row0 = u.pm * 256 + wr * 64 + fr, col0 = u.pn * 256 + wc * 32 + 8 * fq;
#pragma unroll
    for (int ai = 0; ai < 2; ++ai)
#pragma unroll
      for (int m = 0; m < 4; ++m) { bf16_t* rowp = O + (size_t)(row0 + ai * 128 + m * 16) * ldc + col0;
#pragma unroll
        for (int bj = 0; bj < 2; ++bj) { const f32x4 v0 = acc[ai][bj][m][0], v1 = acc[ai][bj][m][1]; u32x4 w; w.x = pk2(v0[0], v0[1]); w.y = pk2(v0[2], v0[3]); w.z = pk2(v1[0], v1[1]); w.w = pk2(v1[2], v1[3]); *(u32x4*)(rowp + bj * 128) = w; } }
  }
};

struct SchedRglru {
  const char* XCR; const char* W; int G, c, nt4;
  __device__ __forceinline__ bool next(int i, pg8::UnitG& u) const {
    const int L = i * G + c; if (L >= 640) return false;
    const int blk = L >> 6, rem = L & 63; u.e = blk; u.pm = rem >> 1; u.pn = rem & 1; u.cnt = 0; u.mt = 0; u.row0 = u.pm * 256; u.nt = nt4; u.keep = 0;
    u.A = XCR + ((size_t)u.pm * 256 * RW + 256 * blk) * 2; u.B = W + ((size_t)(blk * 512 + u.pn * 256) * 256) * 2; return true;
  }
  __device__ __forceinline__ unsigned arow(const pg8::UnitG&, int r) const { return (unsigned)r; }
};
struct EpiRglru {
  static constexpr bool PERM = true, FP8 = false;
  const bf16_t* XCR; const float* ba; const float* bx; const float* C8; float* RA; bf16_t* RBo;
  __device__ __forceinline__ void operator()(const f32x4 (&acc)[2][2][4][2], const pg8::UnitG& u, int wr, int wc, int fr, int fq) const {
    const int row0 = u.pm * 256 + wr * 64 + fr;
#pragma unroll
    for (int n = 0; n < 2; ++n) {
      const int ch = 256 * u.e + 128 * u.pn + 32 * wc + 8 * fq + 4 * n;
      const f32x4 vba = *(const f32x4*)(ba + ch), vbx = *(const f32x4*)(bx + ch), c8 = *(const f32x4*)(C8 + ch);
#pragma unroll
      for (int ai = 0; ai < 2; ++ai)
#pragma unroll
        for (int m = 0; m < 4; ++m) {
          const size_t off = (size_t)(row0 + ai * 128 + m * 16) * RW + ch;
          const u32x2 xw = *(const u32x2*)(XCR + off);
          const float xc[4] = {bflo(xw.x), bfhi(xw.x), bflo(xw.y), bfhi(xw.y)};
          f32x4 av; float bv[4];
#pragma unroll
          for (int j = 0; j < 4; ++j) {
            const float r = __builtin_amdgcn_rcpf(1.0f + __expf(-(acc[ai][0][m][n][j] + vba[j])));
            const float ig = __builtin_amdgcn_rcpf(1.0f + __expf(-(acc[ai][1][m][n][j] + vbx[j])));
            const float la = c8[j] * r;
            const float a = __expf(la);
            const float x2 = 2.0f * la;
            const float poly = -x2 * (1.0f + x2 * 0.5f * (1.0f + x2 * (1.0f / 3.0f) * (1.0f + x2 * 0.25f * (1.0f + x2 * 0.2f))));
            const float om = (x2 > -0.25f) ? poly : (1.0f - a * a);
            av[j] = a;
            bv[j] = sqrtf(fmaxf(om, 0.f)) * (ig * xc[j]);
          }
          *(f32x4*)(RA + off) = av;
          u32x2 w; w.x = pk2(bv[0], bv[1]); w.y = pk2(bv[2], bv[3]); *(u32x2*)(RBo + off) = w;
          asm volatile("" ::: "memory");
        }
    }
  }
};

struct SchedMerge {
  const char* YM; const char* YR; const char* WPM; const char* WPR; int G, c;
  __device__ __forceinline__ bool next(int i, pg8::UnitG& u) const {
    int pm, pn; if (!pg8::dense_order(i >> 1, G, c, NTOK / 256, DM / 256, pm, pn)) return false;
    const int seg = i & 1;
    u.pm = pm; u.pn = pn; u.e = seg; u.cnt = 0; u.mt = 0; u.row0 = pm * 256; u.nt = seg ? RW / 64 : MW / 64; u.keep = seg ? 0 : 1;
    u.A = (seg ? YR : YM) + (size_t)pm * 256 * RW * 2; u.B = (seg ? WPR : WPM) + (size_t)pn * 256 * RW * 2; return true;
  }
  __device__ __forceinline__ unsigned arow(const pg8::UnitG&, int r) const { return (unsigned)r; }
};
struct EpiMergeF {
  static constexpr bool PERM = true, FP8 = false;
  const bf16_t* PROJ; const float* bgate; bf16_t* MRG;
  __device__ __forceinline__ void operator()(f32x4 (&acc)[2][2][4][2], const pg8::UnitG& u, int wr, int wc, int fr, int fq) const {
    const int row0 = u.pm * 256 + wr * 64 + fr, col0 = u.pn * 256 + wc * 32 + 8 * fq;
    if (u.e == 0) {
#pragma unroll
      for (int bj = 0; bj < 2; ++bj) {
        const int col = col0 + bj * 128;
        const f32x4 b00 = *(const f32x4*)(bgate + col), b01 = *(const f32x4*)(bgate + col + 4), b10 = *(const f32x4*)(bgate + DM + col), b11 = *(const f32x4*)(bgate + DM + col + 4);
#pragma unroll
        for (int ai = 0; ai < 2; ++ai)
#pragma unroll
          for (int m = 0; m < 4; ++m) {
            const size_t row = (size_t)(row0 + ai * 128 + m * 16);
            const u32x4 g1w = *(const u32x4*)(PROJ + row * INC + O_G1 + col);
            const float g1p[8] = {bflo(g1w.x), bfhi(g1w.x), bflo(g1w.y), bfhi(g1w.y), bflo(g1w.z), bfhi(g1w.z), bflo(g1w.w), bfhi(g1w.w)};
            const u32x4 g0w = *(const u32x4*)(PROJ + row * INC + O_G0 + col);
            const float g0p[8] = {bflo(g0w.x), bfhi(g0w.x), bflo(g0w.y), bfhi(g0w.y), bflo(g0w.z), bfhi(g0w.z), bflo(g0w.w), bfhi(g0w.w)};
#pragma unroll
            for (int j = 0; j < 4; ++j) {
              acc[ai][bj][m][0][j] *= (1.0f + __expf(-(g1p[j] + b10[j]))) * __builtin_amdgcn_rcpf(1.0f + __expf(-(g0p[j] + b00[j])));
              acc[ai][bj][m][1][j] *= (1.0f + __expf(-(g1p[4 + j] + b11[j]))) * __builtin_amdgcn_rcpf(1.0f + __expf(-(g0p[4 + j] + b01[j])));
            }
            if (m & 1) asm volatile("" ::: "memory");
          }
      }
    } else {
#pragma unroll
      for (int bj = 0; bj < 2; ++bj) {
        const int col = col0 + bj * 128;
        const f32x4 b10 = *(const f32x4*)(bgate + DM + col), b11 = *(const f32x4*)(bgate + DM + col + 4);
#pragma unroll
        for (int ai = 0; ai < 2; ++ai) {
          u32x4 g1a[4];
#pragma unroll
          for (int m = 0; m < 4; ++m) g1a[m] = *(const u32x4*)(PROJ + (size_t)(row0 + ai * 128 + m * 16) * INC + O_G1 + col);
#pragma unroll
          for (int m = 0; m < 4; ++m) {
            const size_t row = (size_t)(row0 + ai * 128 + m * 16);
            const u32x4 g1w = g1a[m];
            const float g1p[8] = {bflo(g1w.x), bfhi(g1w.x), bflo(g1w.y), bfhi(g1w.y), bflo(g1w.z), bfhi(g1w.z), bflo(g1w.w), bfhi(g1w.w)};
            f32x4 v0, v1;
#pragma unroll
            for (int j = 0; j < 4; ++j) { v0[j] = acc[ai][bj][m][0][j] * __builtin_amdgcn_rcpf(1.0f + __expf(-(g1p[j] + b10[j]))); v1[j] = acc[ai][bj][m][1][j] * __builtin_amdgcn_rcpf(1.0f + __expf(-(g1p[4 + j] + b11[j]))); }
            u32x4 w; w.x = pk2(v0[0], v0[1]); w.y = pk2(v0[2], v0[3]); w.z = pk2(v1[0], v1[1]); w.w = pk2(v1[2], v1[3]); *(u32x4*)(MRG + row * DM + col) = w;
          }
        }
      }
    }
  }
};

struct EpiWo {
  static constexpr bool PERM = false, FP8 = false;
  const float* X; float* O;
  __device__ __forceinline__ void operator()(const f32x4 (&acc)[2][2][4][2], const pg8::UnitG& u, int wr, int wc, int fr, int fq) const {
    const int row0 = u.pm * 256 + wr * 64 + fr, col0 = u.pn * 256 + wc * 32 + 4 * fq;
#pragma unroll
    for (int ai = 0; ai < 2; ++ai) {
      f32x4 xa[4][4];
#pragma unroll
      for (int m = 0; m < 4; ++m) { const size_t off = (size_t)(row0 + ai * 128 + m * 16) * DM + col0;
#pragma unroll
        for (int q = 0; q < 4; ++q) xa[m][q] = *(const f32x4*)(X + off + (q >> 1) * 128 + (q & 1) * 16); }
#pragma unroll
      for (int m = 0; m < 4; ++m) { const size_t off = (size_t)(row0 + ai * 128 + m * 16) * DM + col0;
#pragma unroll
        for (int q = 0; q < 4; ++q) *(f32x4*)(O + off + (q >> 1) * 128 + (q & 1) * 16) = xa[m][q] * ALPHA + acc[ai][q >> 1][m][q & 1]; }
    }
  }
};

struct MoeTab { const LAS int* tp; const LAS int* cp; const LAS int* cnt; int n_rt; };
template <int NT  , int STAGE  >
struct SchedMoe {
  MoeTab T; const int* LIST; const char* Abase; const char* Wr; const char* Ws; int G, c, ntv;
  __device__ __forceinline__ bool next(int i, pg8::UnitG& u) const {
    const int L = i * G + c; const int total = NT * (T.n_rt + 32); if (L >= total) return false;
    const int rt = L / NT, pn = L % NT; u.pn = pn; u.nt = ntv; u.keep = 0;
    constexpr int KK = (STAGE == 1) ? DM / 2 : DE / 2;
    constexpr int NN = NT * 256;
    if (rt < T.n_rt) {
      const int e = __builtin_amdgcn_readfirstlane(T.tp[256 + rt]);
      const int mt = rt - __builtin_amdgcn_readfirstlane(T.tp[e]);
      u.e = e; u.mt = mt; u.cnt = __builtin_amdgcn_readfirstlane(T.cnt[e]); u.pm = rt; u.row0 = rt * 256;
      u.B = Wr + ((size_t)e * NN + (size_t)pn * 256) * KK * 2;
    } else {
      u.e = NE; u.mt = rt - T.n_rt; u.cnt = NTOK; u.pm = rt; u.row0 = rt * 256;
      u.B = Ws + (size_t)pn * 256 * KK * 2;
    }
    if (STAGE == 2) u.pm = __builtin_amdgcn_readfirstlane(T.cp[u.e]);
    if (STAGE == 1) u.A = Abase;
    else u.A = Abase + (size_t)rt * 256 * DE;
    return true;
  }
  __device__ __forceinline__ unsigned arow(const pg8::UnitG& u, int r) const {
    if (u.e < NE) { int slot = u.mt * 256 + r; if (slot >= u.cnt) slot = 0; return (unsigned)LIST[u.e * NTOK + slot]; }
    return (unsigned)(u.mt * 256 + r);
  }
};
struct EpiMoe1 {
  static constexpr bool PERM = true, FP8 = true;
  unsigned char* H;
  __device__ __forceinline__ void operator()(const f32x4 (&acc)[2][2][4][2], const pg8::UnitG& u, int wr, int wc, int fr, int fq) const {
    const int row0 = u.row0 + wr * 64 + fr, col0 = u.pn * 128 + wc * 32 + 8 * fq;
#pragma unroll
    for (int ai = 0; ai < 2; ++ai)
#pragma unroll
      for (int m = 0; m < 4; ++m) { unsigned char* rowp = H + (size_t)(row0 + ai * 128 + m * 16) * DE + col0;
        float v[8];
#pragma unroll
        for (int n = 0; n < 2; ++n) { const f32x4 g = acc[ai][0][m][n], up = acc[ai][1][m][n];
#pragma unroll
          for (int j = 0; j < 4; ++j) { const float gg = g[j] * 0.015625f; v[4 * n + j] = gg * __builtin_amdgcn_rcpf(1.0f + __expf(-gg)) * (up[j] * 0.015625f); } }
        int q0 = 0, q1 = 0; q0 = __builtin_amdgcn_cvt_pk_fp8_f32(v[0], v[1], q0, false); q0 = __builtin_amdgcn_cvt_pk_fp8_f32(v[2], v[3], q0, true); q1 = __builtin_amdgcn_cvt_pk_fp8_f32(v[4], v[5], q1, false); q1 = __builtin_amdgcn_cvt_pk_fp8_f32(v[6], v[7], q1, true);
        u32x2 w; w.x = (unsigned)q0; w.y = (unsigned)q1; *(u32x2*)rowp = w; }
  }
};
struct EpiMoe2 {
  static constexpr bool PERM = true, FP8 = true;
  bf16_t* YRM; const float* LISTW; bf16_t* DUMMY;
  __device__ __forceinline__ void operator()(const f32x4 (&acc)[2][2][4][2], const pg8::UnitG& u, int wr, int wc, int fr, int fq) const {
    const int slot0 = u.mt * 256 + wr * 64 + fr;
    bf16_t* base = YRM + (size_t)(u.pm + slot0) * DM + u.pn * 256 + wc * 32 + 8 * fq;
    bf16_t* sink = DUMMY + (size_t)blockIdx.x * 8192 + ((wr * 4 + wc) * 64 + fq * 16 + fr) * 8;
    const float* lw = LISTW + u.e * NTOK + slot0;
    float wv[8];
#pragma unroll
    for (int i = 0; i < 8; ++i) wv[i] = lw[(i >> 2) * 128 + (i & 3) * 16];
#pragma unroll
    for (int ai = 0; ai < 2; ++ai)
#pragma unroll
      for (int m = 0; m < 4; ++m) { const int ds = ai * 128 + m * 16;
        const float w = wv[ai * 4 + m] * 0.03125f;
        bf16_t* rowp = (slot0 + ds < u.cnt) ? base + (size_t)ds * DM : sink;
#pragma unroll
        for (int bj = 0; bj < 2; ++bj) { const f32x4 v0 = acc[ai][bj][m][0] * w, v1 = acc[ai][bj][m][1] * w; u32x4 q; q.x = pk2(v0[0], v0[1]); q.y = pk2(v0[2], v0[3]); q.z = pk2(v1[0], v1[1]); q.w = pk2(v1[2], v1[3]); *(u32x4*)(rowp + bj * 128) = q; } }
  }
};


#define XB_TMO      128
#define XB_XCNT(j)  (256  + 64 * (j))
#define XB_XSUB(j)  (1280 + 64 * (j))
#define XB_XGEN(j)  (2304 + 64 * (j))
#define XB_TOP      3328
#define XB_TOPGEN   3392
#define XCD_BAR_WORDS 3456
#define XB_SPIN_CAP (1u << 18)
__device__ __forceinline__ unsigned xb_ld(unsigned* p)              { return __hip_atomic_load(p, __ATOMIC_RELAXED, __HIP_MEMORY_SCOPE_AGENT); }
__device__ __forceinline__ unsigned xb_add(unsigned* p, unsigned v) { return __hip_atomic_fetch_add(p, v, __ATOMIC_RELAXED, __HIP_MEMORY_SCOPE_AGENT); }
__device__ __forceinline__ unsigned xb_xcc_id() { return (unsigned)__builtin_amdgcn_s_getreg((3 << 11) | 20) & 0xFu; }
#define XB_SPIN(cond, bar) do { unsigned _sp = 0; while (cond) { __builtin_amdgcn_s_sleep(1); \
    if ((++_sp & 255u) == 0u) { if (xb_ld(&(bar)[XB_TMO])) break; if (_sp > XB_SPIN_CAP) { atomicAdd(&(bar)[XB_TMO], 1u); break; } } } } while (0)
struct XcdBarrier { unsigned* bar; unsigned x; volatile LAS unsigned* st; };
__device__ __forceinline__ XcdBarrier xcd_barrier_post(unsigned* bar, volatile LAS unsigned* st) {
    XcdBarrier b; b.bar = bar; b.x = xb_xcc_id(); b.st = st;
    if (threadIdx.x == 0) (void)xb_add(&bar[XB_XCNT(b.x)], 1u);
    return b;
}
__device__ __forceinline__ void xcd_barrier_complete(unsigned* bar, unsigned x, unsigned& nloc, unsigned& nx) {
    const unsigned G = gridDim.x * gridDim.y * gridDim.z;
    unsigned sum, cnt, mine, sp = 0u;
    for (;;) {
        sum = 0u; cnt = 0u; mine = 0u;
#pragma unroll
        for (unsigned j = 0; j < 16; ++j) { const unsigned c = xb_ld(&bar[XB_XCNT(j)]); sum += c; cnt += (c > 0u) ? 1u : 0u; mine = (j == x) ? c : mine; }
        if (sum == G) break;
        __builtin_amdgcn_s_sleep(1);
        if ((++sp & 255u) == 0u) { if (xb_ld(&bar[XB_TMO])) break; if (sp > XB_SPIN_CAP) { atomicAdd(&bar[XB_TMO], 1u); break; } }
    }
    nloc = mine > 0u ? mine : 1u; nx = cnt > 0u ? cnt : 1u;
}
__device__ __forceinline__ void xcd_barrier(const XcdBarrier& b) {
    asm volatile("s_waitcnt vmcnt(0)" ::: "memory");
    __syncthreads();
    if (threadIdx.x == 0) {
        unsigned* bar = b.bar;
        __builtin_amdgcn_s_waitcnt(0);
        unsigned nloc = b.st[0], nx = b.st[1];
        if (nloc == 0u) { xcd_barrier_complete(bar, b.x, nloc, nx); b.st[0] = nloc; b.st[1] = nx; }
        const unsigned old = xb_add(&bar[XB_XSUB(b.x)], 1u);
        const unsigned gen = old / nloc;
        if (old + 1u == (gen + 1u) * nloc) {
            __builtin_amdgcn_fence(__ATOMIC_RELEASE, "agent");
            asm volatile("s_waitcnt vmcnt(0)" ::: "memory");
            const unsigned og = xb_add(&bar[XB_TOP], 1u);
            const unsigned tg = og / nx;
            if (og + 1u == (tg + 1u) * nx) xb_add(&bar[XB_TOPGEN], 1u);
            else XB_SPIN(xb_ld(&bar[XB_TOPGEN]) == tg, bar);
            __builtin_amdgcn_fence(__ATOMIC_ACQUIRE, "agent");
            xb_add(&bar[XB_XGEN(b.x)], 1u);
            asm volatile("s_waitcnt vmcnt(0)" ::: "memory");
        } else {
            XB_SPIN(xb_ld(&bar[XB_XGEN(b.x)]) == gen, bar);
            __builtin_amdgcn_fence(__ATOMIC_ACQUIRE, "agent");
            asm volatile("s_waitcnt vmcnt(0)" ::: "memory");
        }
    }
    __syncthreads();
}

template <class T> __device__ __forceinline__ T* as_global(T* p) { const unsigned long long v = (unsigned long long)p; return (T*)(__attribute__((address_space(1))) T*)v; }
template <class T> __device__ __forceinline__ T* opaque_global(T* p) { unsigned long long v = (unsigned long long)p; asm volatile("" : "+s"(v)); return (T*)(__attribute__((address_space(1))) T*)v; }
struct InPtrs { const float* const* p; __device__ __forceinline__ const float* operator[](int k) const { return as_global(p[k]); } };
struct Frame {
  LAS unsigned char* lds; int tid, lane, wave, G, bid; unsigned char* ws; InPtrs in; float* out;
};

struct TJob { const float* W; unsigned char* WT; int N, ldtB, k0, n0, up, mode; float sc; };
__device__ __forceinline__ int gu_row(int n, int up) { return 256 * (n >> 7) + (n & 127) + up * 128; }
constexpr int TR0 = 16 * 104, TR1 = 16 * 16, TR2 = 20 * 16, TR3 = 16 * 16, TR4 = 2 * 10 * 4, TR5 = 2 * 16 * 4, TR6 = 4 * 16, TR7 = 2 * 64 * 16 * 4, TR8 = 64 * 4 * 16;
constexpr int T_NITEMS = TR0 + TR1 + TR2 + TR3 + TR4 + TR5 + TR6 + TR7 + TR8;
__device__ __forceinline__ TJob tj_decode(const Frame& F, int it) {
  unsigned char* ws = F.ws; int r = it;
  if (r < TR0) { const int kb = r / 104, nb = r % 104; return TJob{F.in[1], ws + WS_WIN, INC, DM * 2, 128 * kb, 128 * nb, 0, 0, 1.f}; } r -= TR0;
  if (r < TR1) { const int kb = r / 16, nb = r % 16; return TJob{F.in[19], ws + WS_WPM, DM, RW * 2, 128 * kb, 128 * nb, 0, 0, 1.f}; } r -= TR1;
  if (r < TR2) { const int kb = r / 16, nb = r % 16; return TJob{F.in[20], ws + WS_WPR, DM, RW * 2, 128 * kb, 128 * nb, 0, 0, 1.f}; } r -= TR2;
  if (r < TR3) { const int kb = r / 16, nb = r % 16; return TJob{F.in[21], ws + WS_WO, DM, DM * 2, 128 * kb, 128 * nb, 0, 0, 1.f}; } r -= TR3;
  if (r < TR4) { const int which = r / 40, rr = r % 40, blk = rr / 4, q = rr % 4; return TJob{F.in[which ? 16 : 14] + (size_t)blk * 65536, ws + WS_WRAX + (size_t)blk * 512 * 256 * 2, 256, 256 * 2, 128 * (q >> 1), 128 * (q & 1), which, 1, 1.f}; } r -= TR4;
  if (r < TR5) { const int which = r / 64, q = r % 64, kb = q / 4, nb = q % 4; return TJob{F.in[which ? 30 : 29], ws + WS_WSGU, DE, DM, 128 * kb, 128 * nb, which, 3, 64.f}; } r -= TR5;
  if (r < TR6) { const int kb = r / 16, nb = r % 16; return TJob{F.in[31], ws + WS_WSD, DM, DE, 128 * kb, 128 * nb, 0, 2, 32.f}; } r -= TR6;
  if (r < TR7) { const int which = r / 4096, rr = r % 4096, e = rr / 64, q = rr % 64, kb = q / 4, nb = q % 4; return TJob{F.in[which ? 27 : 26] + (size_t)e * DM * DE, ws + WS_WEGU + (size_t)e * 1024 * DM, DE, DM, 128 * kb, 128 * nb, which, 3, 64.f}; } r -= TR7;
  { const int e = r / 64, q = r % 64, kb = q / 16, nb = q % 16; return TJob{F.in[28] + (size_t)e * DE * DM, ws + WS_WED + (size_t)e * DM * DE, DM, DE, 128 * kb, 128 * nb, 0, 2, 32.f}; }
}
__device__ __forceinline__ void tj_load(const TJob& j, f32x4 (&v)[8], int wave, int lane) {
  const float* p = j.W + (size_t)(j.k0 + 16 * wave + (lane >> 5)) * j.N + j.n0 + 4 * (lane & 31);
#pragma unroll
  for (int i = 0; i < 8; ++i) v[i] = __builtin_nontemporal_load((const f32x4*)(p + (size_t)(2 * i) * j.N));
}
__device__ __forceinline__ void tj_store(const TJob& j, const f32x4 (&v)[8], LAS float* scr, int wave, int lane, int tid) {
#pragma unroll
  for (int i = 0; i < 8; ++i) { LAS float* d = scr + (16 * wave + 2 * i + (lane >> 5)) * 129 + 4 * (lane & 31); d[0] = v[i][0]; d[1] = v[i][1]; d[2] = v[i][2]; d[3] = v[i][3]; }
  LBAR();
  if (j.mode < 2) {
#pragma unroll
    for (int it = 0; it < 4; ++it) { const int idx = it * 512 + tid, n = idx >> 4, c = idx & 15; const LAS float* s = scr + (8 * c) * 129 + n;
      u32x4 o; o.x = pk2(s[0 * 129], s[1 * 129]); o.y = pk2(s[2 * 129], s[3 * 129]); o.z = pk2(s[4 * 129], s[5 * 129]); o.w = pk2(s[6 * 129], s[7 * 129]);
      const int nn = j.n0 + n; const int row = j.mode ? gu_row(nn, j.up) : nn;
      *(u32x4*)(j.WT + (size_t)row * j.ldtB + (j.k0 + 8 * c) * 2) = o; }
  } else {
#pragma unroll
    for (int it = 0; it < 2; ++it) { const int idx = it * 512 + tid, n = idx >> 3, c = idx & 7; const LAS float* s = scr + (16 * c) * 129 + n;
      int w[4];
#pragma unroll
      for (int q = 0; q < 4; ++q) { int t = 0; t = __builtin_amdgcn_cvt_pk_fp8_f32(s[(4 * q) * 129] * j.sc, s[(4 * q + 1) * 129] * j.sc, t, false); t = __builtin_amdgcn_cvt_pk_fp8_f32(s[(4 * q + 2) * 129] * j.sc, s[(4 * q + 3) * 129] * j.sc, t, true); w[q] = t; }
      u32x4 o; o.x = (unsigned)w[0]; o.y = (unsigned)w[1]; o.z = (unsigned)w[2]; o.w = (unsigned)w[3];
      const int nn = j.n0 + n; const int row = (j.mode == 3) ? gu_row(nn, j.up) : nn;
      __builtin_nontemporal_store(o, (u32x4*)(j.WT + (size_t)row * j.ldtB + j.k0 + 16 * c)); }
  }
  LBAR();
}

__device__ __forceinline__ void tile_range(const Frame& F, const int it0, const int step, const int end) {
  LAS float* scr = (LAS float*)F.lds;
  f32x4 vA[8], vB[8]; TJob jA, jB;
  int it = it0;
  if (it < end) { jA = tj_decode(F, it); tj_load(jA, vA, F.wave, F.lane); }
  while (it < end) {
    { const int itn = it + step; jB = tj_decode(F, itn < end ? itn : end - 1); tj_load(jB, vB, F.wave, F.lane); }
    tj_store(jA, vA, scr, F.wave, F.lane, F.tid);
    it += step; if (it >= end) break;
    { const int itn = it + step; jA = tj_decode(F, itn < end ? itn : end - 1); tj_load(jA, vA, F.wave, F.lane); }
    tj_store(jB, vB, scr, F.wave, F.lane, F.tid);
    it += step;
  }
}
constexpr int KD1 = 16, KD3 = 16;
__device__ __forceinline__ int defer1_blocks(int G) { const int rem = (NTOK / 256) * (INC / 256) % G; return rem ? G - rem : 0; }
__device__ __forceinline__ int defer1_count(int G) { return defer1_blocks(G) * KD1; }
__device__ __forceinline__ int defer3_count(int G) { return (G - (G >> 1)) * KD3; }

__device__ __forceinline__ void phase_prologue(const Frame& F) {
  unsigned char* ws = F.ws;
  tile_range(F, F.bid, F.G, T_NITEMS - defer1_count(F.G) - defer3_count(F.G));
  const int gt = F.bid * 512 + F.tid, NGT = F.G * 512;
  { const float* x = F.in[0]; bf16_t* xb = (bf16_t*)(ws + WS_XB);
    for (int i = gt; i < NTOK * DM / 8; i += NGT) { const f32x4 a = *(const f32x4*)(x + (size_t)i * 8), b = *(const f32x4*)(x + (size_t)i * 8 + 4);
      u32x4 o; o.x = pk2(a[0], a[1]); o.y = pk2(a[2], a[3]); o.z = pk2(b[0], b[1]); o.w = pk2(b[2], b[3]); *(u32x4*)(xb + (size_t)i * 8) = o; } }
  { const float* wif = F.in[8]; bf16_t* wt = (bf16_t*)(ws + WS_SMALL + SM_WIFT);
    for (int i = gt; i < 16 * 6144; i += NGT) { const int n = i / 6144, k = i % 6144; float v = wif[k * 16 + n]; if (k >= 2048 && k < 4096) v *= 16.0f; wt[i] = (bf16_t)f2bf(v); } }
  { const float* lam = F.in[18]; float* c8 = (float*)(ws + WS_SMALL + SM_C8); for (int i = gt; i < RW; i += NGT) c8[i] = -8.0f * log1pf(expf(-lam[i])); }
  { const float* rwt = F.in[24]; bf16_t* rh = (bf16_t*)(ws + WS_SMALL + SM_RWH); bf16_t* rl = (bf16_t*)(ws + WS_SMALL + SM_RWL);
    for (int i = gt; i < NE * DM; i += NGT) { const int n = i / DM, k = i % DM; const float v = rwt[k * NE + n]; const unsigned h = f2bf(v); rh[i] = (bf16_t)h; rl[i] = (bf16_t)f2bf(v - __uint_as_float(h << 16)); } }
  { float* lw64 = (float*)(ws + WS_LISTW) + (size_t)NE * NTOK; for (int i = gt; i < NTOK; i += NGT) lw64[i] = 1.0f; }
  { int* ctl = (int*)(ws + WS_CTL); for (int i = gt; i < 4096; i += NGT) ctl[i] = 0; }
}

__device__ __forceinline__ void phase_mprep(const Frame& F) {
  unsigned char* ws = F.ws;
  const bf16_t* PROJ = (const bf16_t*)(ws + WS_PROJ);
  bf16_t* Q = (bf16_t*)(ws + WS_Q); bf16_t* Kb = (bf16_t*)(ws + WS_K); bf16_t* V = (bf16_t*)(ws + WS_V); bf16_t* XCM = (bf16_t*)(ws + WS_XCM);
  const bf16_t* WIFT = (const bf16_t*)(ws + WS_SMALL + SM_WIFT);
  float* IG = (float*)(ws + WS_SMALL + SM_IG); float* LF = (float*)(ws + WS_SMALL + SM_LF);
  const int g = F.tid;
  f32x4 cw[4]; for (int j = 0; j < 4; ++j) cw[j] = *(const f32x4*)(F.in[3] + j * MW + 4 * g);
  const f32x4 cb = *(const f32x4*)(F.in[4] + 4 * g);
  f32x4 wq[4], wk[4], wv[4];
  for (int i = 0; i < 4; ++i) { wq[i] = *(const f32x4*)(F.in[5] + g * 16 + 4 * i); wk[i] = *(const f32x4*)(F.in[6] + g * 16 + 4 * i); wv[i] = *(const f32x4*)(F.in[7] + g * 16 + 4 * i); }
  LAS unsigned char* AIMG = F.lds; LAS float* red = (LAS float*)(F.lds + 98432);
  const int r = F.lane & 15, gq = F.lane >> 4;
  for (int tile = F.bid; tile < NTOK / 8; tile += F.G) {
    const int t0 = tile * 8, s0 = t0 & (SEQ - 1);
    u32x2 rw[11];
#pragma unroll
    for (int j = 0; j < 11; ++j) { const int pos = s0 - 3 + j; rw[j] = (pos >= 0) ? *(const u32x2*)(PROJ + (size_t)(t0 - 3 + j) * INC + 4 * g) : (u32x2){0u, 0u}; }
#pragma unroll
    for (int tt = 0; tt < 8; ++tt) {
      const int t = t0 + tt;
      f32x4 xw[4];
#pragma unroll
      for (int j = 0; j < 4; ++j) xw[j] = (f32x4){bflo(rw[tt + j].x), bfhi(rw[tt + j].x), bflo(rw[tt + j].y), bfhi(rw[tt + j].y)};
      const f32x4 cv = cb + cw[0] * xw[0] + cw[1] * xw[1] + cw[2] * xw[2] + cw[3] * xw[3];
      f32x4 xc; for (int i = 0; i < 4; ++i) xc[i] = cv[i] * __builtin_amdgcn_rcpf(1.0f + __expf(-cv[i]));
      const f32x4 q = xc[0] * wq[0] + xc[1] * wq[1] + xc[2] * wq[2] + xc[3] * wq[3];
      f32x4 k = xc[0] * wk[0] + xc[1] * wk[1] + xc[2] * wk[2] + xc[3] * wk[3];
      const f32x4 v = xw[3][0] * wv[0] + xw[3][1] * wv[1] + xw[3][2] * wv[2] + xw[3][3] * wv[3];
      k = k * 0.0625f;
      const size_t o = (size_t)t * MW + 4 * g;
      u32x2 wqv, wkv, wvv, wxc;
      wqv.x = pk2(q[0], q[1]); wqv.y = pk2(q[2], q[3]); *(u32x2*)(Q + o) = wqv;
      wkv.x = pk2(k[0], k[1]); wkv.y = pk2(k[2], k[3]); *(u32x2*)(Kb + o) = wkv;
      wvv.x = pk2(v[0], v[1]); wvv.y = pk2(v[2], v[3]); *(u32x2*)(V + o) = wvv;
      wxc.x = pk2(xc[0], xc[1]); wxc.y = pk2(xc[2], xc[3]); *(u32x2*)(XCM + o) = wxc;
      LAS unsigned char* ar = AIMG + tt * 12304 + 8 * g;
      *(LAS u32x2*)(ar) = wqv; *(LAS u32x2*)(ar + 4096) = wkv; *(LAS u32x2*)(ar + 8192) = wvv;
    }
    LBAR();
    {
      f32x4 acc = (f32x4){0.f, 0.f, 0.f, 0.f};
#pragma unroll
      for (int ib = 0; ib < 3; ++ib) {
        bf16x8 bfr[8];
#pragma unroll
        for (int i = 0; i < 8; ++i) { const int ks = F.wave * 24 + ib * 8 + i; bfr[i] = *(const bf16x8*)(WIFT + (size_t)r * 6144 + ks * 32 + 8 * gq); }
#pragma unroll
        for (int i = 0; i < 8; ++i) { const int ks = F.wave * 24 + ib * 8 + i;
          const bf16x8 a = *(const LAS bf16x8*)(AIMG + (r & 7) * 12304 + (ks * 32 + 8 * gq) * 2);
          acc = __builtin_amdgcn_mfma_f32_16x16x32_bf16(a, bfr[i], acc, 0, 0, 0); }
      }
#pragma unroll
      for (int j = 0; j < 4; ++j) red[F.wave * 256 + (4 * gq + j) * 16 + r] = acc[j];
    }
    LBAR();
    if (F.tid < 128) {
      const int row = F.tid >> 4, n = F.tid & 15;
      float s = F.in[9][n];
#pragma unroll
      for (int w = 0; w < 8; ++w) s += red[w * 256 + F.tid];
      const int t = t0 + row, b = t >> 12, sp = t & (SEQ - 1);
      if (n < 8) IG[(size_t)(b * 8 + n) * SEQ + sp] = s;
      else LF[(size_t)(b * 8 + (n - 8)) * SEQ + sp] = fminf(s, 0.f) - log1pf(__expf(-fabsf(s)));
    }
    LBAR();
  }
}

__device__ __forceinline__ void phase_rconv(const Frame& F) {
  unsigned char* ws = F.ws;
  const bf16_t* PROJ = (const bf16_t*)(ws + WS_PROJ); bf16_t* XCR = (bf16_t*)(ws + WS_XCR);
  const int gt = F.bid * 512 + F.tid, NGT = F.G * 512;
  const int per = ((NTOK / 16) * 640 + F.G - 1) / F.G;
  for (int i2 = F.tid; i2 < per; i2 += 512) {
    const int it = F.bid * per + i2; if (it >= (NTOK / 16) * 640) break;
    const int tile = it / 640, g = it % 640, t0 = tile * 16, s0 = t0 & (SEQ - 1);
    f32x4 cw[4]; for (int j = 0; j < 4; ++j) cw[j] = *(const f32x4*)(F.in[12] + j * RW + 4 * g);
    const f32x4 cb = *(const f32x4*)(F.in[13] + 4 * g);
    u32x2 rw[19];
#pragma unroll
    for (int j = 0; j < 19; ++j) { const int pos = s0 - 3 + j; rw[j] = (pos >= 0) ? *(const u32x2*)(PROJ + (size_t)(t0 - 3 + j) * INC + O_XR + 4 * g) : (u32x2){0u, 0u}; }
#pragma unroll
    for (int tt = 0; tt < 16; ++tt) {
      f32x4 cv = cb;
#pragma unroll
      for (int j = 0; j < 4; ++j) cv = cv + cw[j] * (f32x4){bflo(rw[tt + j].x), bfhi(rw[tt + j].x), bflo(rw[tt + j].y), bfhi(rw[tt + j].y)};
      u32x2 w; w.x = pk2(cv[0], cv[1]); w.y = pk2(cv[2], cv[3]); *(u32x2*)(XCR + (size_t)(t0 + tt) * RW + 4 * g) = w;
    }
  }
}

__device__ __forceinline__ float chunk_m(const float* IG, const float* LF, int bh, int c, int lane, int wave, LAS float* CS) {
  for (int cc = wave; cc < c; cc += 8) {
    const float lf = LF[(size_t)bh * SEQ + 64 * cc + lane], ig = IG[(size_t)bh * SEQ + 64 * cc + lane];
    const float b = wave_scan_sum(lf, lane), gmax = wave_max(ig - b);
    if (lane == 63) { CS[cc] = b; CS[64 + cc] = b + gmax; }
  }
  __syncthreads();
  float A = 0.f, B = -INFINITY;
  if (lane < c) { A = CS[lane]; B = CS[64 + lane]; }
#pragma unroll
  for (int o = 1; o < 64; o <<= 1) { const float pA = __shfl_up(A, o), pB = __shfl_up(B, o); if (lane >= o) { B = fmaxf(pB + A, B); A = pA + A; } }
  const float mafter = fmaxf(A, B);
  const float mc = __shfl(mafter, c > 0 ? c - 1 : 0);
  return c > 0 ? mc : 0.f;
}

__device__ __forceinline__ void phase_m1(const Frame& F, const int bid2, const int G2) {
  unsigned char* ws = F.ws;
  const bf16_t* Q = (const bf16_t*)(ws + WS_Q); const bf16_t* Kb = (const bf16_t*)(ws + WS_K); const bf16_t* V = (const bf16_t*)(ws + WS_V);
  const float* IG = (const float*)(ws + WS_SMALL + SM_IG); const float* LF = (const float*)(ws + WS_SMALL + SM_LF);
  float* INTER = (float*)(ws + WS_SMALL + SM_INTER); float* EMR = (float*)(ws + WS_SMALL + SM_EMR); float* DENI = (float*)(ws + WS_SMALL + SM_DENI);
  bf16_t* HNI = (bf16_t*)(ws + WS_HNI);
  LAS unsigned char* QS = F.lds; LAS unsigned char* KS = F.lds + 33792; LAS unsigned char* VT = F.lds + 67584; LAS unsigned char* PS = F.lds + 104448;
  LAS float* SCg = (LAS float*)(F.lds + 113664); LAS float* SCM = SCg + 64;
  const int r = F.lane & 15, gq = F.lane >> 4, w = F.wave;
  for (int item = bid2; item < 16 * NCH; item += G2) {
    const int bh = item / NCH, c = item % NCH, b = bh >> 3, h = bh & 7, tok0 = b * SEQ + 64 * c;
    const float m = chunk_m(IG, LF, bh, c, F.lane, w, (LAS float*)(F.lds + 114176));
    const float lf_c = LF[(size_t)bh * SEQ + 64 * c + F.lane], ig_c = IG[(size_t)bh * SEQ + 64 * c + F.lane];
    const float b_l = wave_scan_sum(lf_c, F.lane), g_l = ig_c - b_l;
    const float M_l = fmaxf(m, wave_scan_max(g_l, F.lane));
    if (w == 0) { SCg[F.lane] = g_l; SCM[F.lane] = M_l; INTER[(size_t)(tok0 + F.lane) * 8 + h] = __expf(m - M_l); EMR[(size_t)(tok0 + F.lane) * 8 + h] = __expf(-(b_l + M_l)); }
#pragma unroll
    for (int i = 0; i < 4; ++i) {
      const int idx = i * 512 + F.tid, row = idx >> 5, c16 = idx & 31;
      const size_t go = (size_t)(tok0 + row) * MW + 256 * h + 8 * c16;
      *(LAS u32x4*)(QS + row * 528 + c16 * 16) = *(const u32x4*)(Q + go);
      *(LAS u32x4*)(KS + row * 528 + c16 * 16) = *(const u32x4*)(Kb + go);
    }
    {
      const int sp = F.tid & 31, cq = F.tid >> 5;
#pragma unroll
      for (int i = 0; i < 2; ++i) {
        const size_t go = (size_t)(tok0 + 2 * sp) * MW + 256 * h + 8 * (cq + 16 * i);
        const u32x4 v0 = *(const u32x4*)(V + go), v1 = *(const u32x4*)(V + go + MW);
        const unsigned a0[4] = {v0.x, v0.y, v0.z, v0.w}, a1[4] = {v1.x, v1.y, v1.z, v1.w};
#pragma unroll
        for (int e = 0; e < 4; ++e) { const int dv = 8 * (cq + 16 * i) + 2 * e;
          *(LAS unsigned*)(VT + dv * 144 + sp * 4) = (a0[e] & 0xffffu) | (a1[e] << 16);
          *(LAS unsigned*)(VT + (dv + 1) * 144 + sp * 4) = (a0[e] >> 16) | (a1[e] & 0xffff0000u); }
      }
    }
    __syncthreads();
    {
      const int mi = w & 3;
#pragma unroll
      for (int nn = 0; nn < 2; ++nn) {
        const int ni = 2 * (w >> 2) + nn;
        f32x4 acc = (f32x4){0.f, 0.f, 0.f, 0.f};
        if (ni <= mi) {
#pragma unroll
          for (int ks = 0; ks < 8; ++ks) {
            const bf16x8 a = *(const LAS bf16x8*)(QS + (16 * mi + r) * 528 + (32 * ks + 8 * gq) * 2);
            const bf16x8 bb = *(const LAS bf16x8*)(KS + (16 * ni + r) * 528 + (32 * ks + 8 * gq) * 2);
            acc = __builtin_amdgcn_mfma_f32_16x16x32_bf16(a, bb, acc, 0, 0, 0);
          }
        }
        const int s = 16 * ni + r; const float gs = SCg[s];
#pragma unroll
        for (int j = 0; j < 4; ++j) { const int l = 16 * mi + 4 * gq + j; const float p = (s <= l) ? acc[j] * __expf(gs - SCM[l]) : 0.f; *(LAS bf16_t*)(PS + l * 144 + s * 2) = (bf16_t)f2bf(p); }
      }
    }
    __syncthreads();
    if (F.tid < 64) { float s = 0.f; for (int k = 0; k < 64; ++k) s += bf1(*(const LAS bf16_t*)(PS + F.tid * 144 + k * 2)); DENI[(size_t)(tok0 + F.tid) * 8 + h] = s; }
#pragma unroll
    for (int nn = 0; nn < 2; ++nn) {
      const int ni = 2 * w + nn;
#pragma unroll
      for (int mi = 0; mi < 4; ++mi) {
        f32x4 acc = (f32x4){0.f, 0.f, 0.f, 0.f};
#pragma unroll
        for (int ks = 0; ks < 2; ++ks) {
          const bf16x8 a = *(const LAS bf16x8*)(PS + (16 * mi + r) * 144 + (32 * ks + 8 * gq) * 2);
          const bf16x8 bb = *(const LAS bf16x8*)(VT + (16 * ni + r) * 144 + (32 * ks + 8 * gq) * 2);
          acc = __builtin_amdgcn_mfma_f32_16x16x32_bf16(a, bb, acc, 0, 0, 0);
        }
#pragma unroll
        for (int j = 0; j < 4; ++j) HNI[(size_t)(tok0 + 16 * mi + 4 * gq + j) * MW + 256 * h + 16 * ni + r] = (bf16_t)f2bf(acc[j]);
      }
    }
    __syncthreads();
  }
}

__device__ __forceinline__ void phase_m2(const Frame& F, const int nblk) {
  unsigned char* ws = F.ws;
  const bf16_t* Q = (const bf16_t*)(ws + WS_Q); const bf16_t* Kb = (const bf16_t*)(ws + WS_K); const bf16_t* V = (const bf16_t*)(ws + WS_V);
  const float* IG = (const float*)(ws + WS_SMALL + SM_IG); const float* LF = (const float*)(ws + WS_SMALL + SM_LF);
  float* QN = (float*)(ws + WS_SMALL + SM_QN);
  bf16_t* HNE = (bf16_t*)(ws + WS_HNE);
  LAS unsigned char* QS = F.lds; LAS unsigned char* KT = F.lds + 33792; LAS unsigned char* WVT = F.lds + 70656; LAS unsigned char* CT = F.lds + 77568;
  LAS float* TD = (LAS float*)(F.lds + 111360); LAS float* CS = (LAS float*)(F.lds + 111616);
  float* DUMMY = (float*)(ws + WS_M2TAB + 4 * MiB);
  const int w = F.wave;
  for (int item = F.bid; item < 128; item += nblk) {
    const int bh = item >> 3, sl = item & 7, b = bh >> 3, h = bh & 7, dv0 = 32 * sl;
    float* TI = (float*)(ws + WS_M2TAB) + (size_t)item * 8192; float* TW = TI + 4096;
    const int lane = F.lane;
    for (int i = F.tid; i < (6912 + 33792) / 4; i += 512) *(LAS unsigned*)(WVT + 4 * i) = 0u;
    float gk[8], pk[8];
#pragma unroll
    for (int i = 0; i < 8; ++i) {
      const int cc = w + 8 * i;
      const float lf = LF[(size_t)bh * SEQ + 64 * cc + lane], ig = IG[(size_t)bh * SEQ + 64 * cc + lane];
      const float bl = wave_scan_sum(lf, lane), g = ig - bl;
      const float gmax = wave_max(g), pm = wave_scan_max(g, lane);
      gk[i] = g; pk[i] = pm;
      if (lane == 63) { CS[cc] = bl; CS[64 + cc] = bl + gmax; }
    }
    __syncthreads();
    {
      float A = CS[lane], B = CS[64 + lane]; const float gmx = B - A;
#pragma unroll
      for (int o = 1; o < 64; o <<= 1) { const float pA = __shfl_up(A, o), pB = __shfl_up(B, o); if (lane >= o) { B = fmaxf(pB + A, B); A = pA + A; } }
      const float mafter = fmaxf(A, B);
      float mstart = __shfl_up(mafter, 1); if (lane == 0) mstart = 0.f;
      const float M63 = fmaxf(mstart, gmx);
      if (w == 0) TD[lane] = __expf(mstart - M63);
#pragma unroll
      for (int i = 0; i < 8; ++i) {
        const int cc = w + 8 * i;
        const float ms = __shfl(mstart, cc), m6 = __shfl(M63, cc);
        TI[cc * 64 + lane] = __expf(ms - fmaxf(ms, pk[i])); TW[cc * 64 + lane] = __expf(gk[i] - m6);
      }
    }
    __threadfence(); __syncthreads();
    f32x4 acc[2][3];
#pragma unroll
    for (int a = 0; a < 2; ++a)
#pragma unroll
      for (int n = 0; n < 3; ++n) acc[a][n] = (f32x4){0.f, 0.f, 0.f, 0.f};
    u32x4 qrA[4], krA[2][2], vrA = (u32x4){0u, 0u, 0u, 0u}, qrB[4], krB[2][2], vrB = (u32x4){0u, 0u, 0u, 0u};
    float wsA = 0.f, wsB = 0.f; f32x4 ivA = (f32x4){0.f, 0.f, 0.f, 0.f}, ivB = ivA;
#define M2_LOAD(qreg, kreg, vreg, wsr, ivr, c) do { const int tk_ = b * SEQ + 64 * (c); \
      _Pragma("unroll") for (int i = 0; i < 4; ++i) { const int idx = i * 512 + tdx, row = idx >> 5, c16 = idx & 31; qreg[i] = *(const u32x4*)(Q + (size_t)(tk_ + row) * MW + 256 * h + 8 * c16); } \
      _Pragma("unroll") for (int i = 0; i < 2; ++i) { const size_t go = (size_t)(tk_ + 2 * sp) * MW + 256 * h + 8 * (cq + 16 * i); kreg[i][0] = *(const u32x4*)(Kb + go); kreg[i][1] = *(const u32x4*)(Kb + go + MW); } \
      vreg = *(const u32x4*)(V + (size_t)(tk_ + lane) * MW + 256 * h + dv0 + 8 * (w & 3)); \
      wsr = TW[(c) * 64 + lane]; \
      ivr = *(const f32x4*)(TI + (c) * 64 + 16 * (w & 3) + 4 * gq); } while (0)
#define M2_AMMA(mi, nt) \
        f32x4 a2 = (f32x4){0.f, 0.f, 0.f, 0.f}; \
        _Pragma("unroll") for (int ks = 0; ks < 8; ++ks) { \
          const bf16x8 a = *(const LAS bf16x8*)(QS + (16 * (mi) + r) * 528 + (32 * ks + 8 * gq) * 2); \
          const bf16x8 bb = *(const LAS bf16x8*)(CT + (16 * (nt) + r) * 528 + (32 * ks + 8 * gq) * 2); \
          a2 = __builtin_amdgcn_mfma_f32_16x16x32_bf16(a, bb, a2, 0, 0, 0); }
#define M2_ATILE_H(mi, nt, tok0, ivr) do { M2_AMMA(mi, nt) \
        _Pragma("unroll") for (int j = 0; j < 4; ++j) { const int l = 16 * (mi) + 4 * gq + j; \
          HNE[(size_t)((tok0) + l) * MW + 256 * h + dv0 + 16 * (nt) + r] = (bf16_t)f2bf(a2[j] * ivr[j]); } } while (0)
#define M2_ATILE_Q(mi, nt, tok0, ivr) do { M2_AMMA(mi, nt) \
        _Pragma("unroll") for (int j = 0; j < 4; ++j) { const int l = 16 * (mi) + 4 * gq + j; \
          float* qp = ((nt) == 2 && r == 0) ? (QN + (size_t)((tok0) + l) * 8 + h) : (DUMMY + tdx * 4 + j); *qp = a2[j] * ivr[j]; } } while (0)
#define M2_BODY(c, qreg, kreg, vreg, wsr, ivr) do { \
      int tdx = (int)threadIdx.x; asm volatile("" : "+v"(tdx)); \
      const int lane = tdx & 63, r = lane & 15, gq = lane >> 4, sp = tdx & 31, cq = tdx >> 5; \
      const int tok0 = b * SEQ + 64 * (c); \
      _Pragma("unroll") for (int i = 0; i < 4; ++i) { const int idx = i * 512 + tdx, row = idx >> 5, c16 = idx & 31; *(LAS u32x4*)(QS + row * 528 + c16 * 16) = qreg[i]; } \
      _Pragma("unroll") for (int i = 0; i < 2; ++i) { \
        const unsigned k0[4] = {kreg[i][0].x, kreg[i][0].y, kreg[i][0].z, kreg[i][0].w}, k1[4] = {kreg[i][1].x, kreg[i][1].y, kreg[i][1].z, kreg[i][1].w}; \
        _Pragma("unroll") for (int e = 0; e < 4; ++e) { const int dk = 8 * (cq + 16 * i) + 2 * e; \
          *(LAS unsigned*)(KT + dk * 144 + sp * 4) = (k0[e] & 0xffffu) | (k1[e] << 16); \
          *(LAS unsigned*)(KT + (dk + 1) * 144 + sp * 4) = (k0[e] >> 16) | (k1[e] & 0xffff0000u); } } \
      if (w < 4) { const unsigned vw[4] = {vreg.x, vreg.y, vreg.z, vreg.w}; \
        _Pragma("unroll") for (int e = 0; e < 4; ++e) { *(LAS bf16_t*)(WVT + (8 * w + 2 * e) * 144 + lane * 2) = (bf16_t)f2bf(bflo(vw[e]) * wsr); *(LAS bf16_t*)(WVT + (8 * w + 2 * e + 1) * 144 + lane * 2) = (bf16_t)f2bf(bfhi(vw[e]) * wsr); } \
      } else if (w == 4) { *(LAS bf16_t*)(WVT + 32 * 144 + lane * 2) = (bf16_t)f2bf(wsr); } \
      const f32x4 ivc = ivr; \
      { const int cn_ = ((c) + 2 < NCH) ? (c) + 2 : NCH - 1; M2_LOAD(qreg, kreg, vreg, wsr, ivr, cn_); } \
      LBAR(); \
      M2_ATILE_H(w & 3, w >> 2, tok0, ivc); \
      M2_ATILE_Q(w & 3, 2 + (w >> 2), tok0, ivc); \
      const float decay = TD[(c)]; \
      _Pragma("unroll") for (int mt = 0; mt < 2; ++mt) \
        _Pragma("unroll") for (int n2 = 0; n2 < 3; ++n2) { \
          f32x4 cacc = acc[mt][n2] * decay; \
          _Pragma("unroll") for (int ks = 0; ks < 2; ++ks) { \
            const bf16x8 a = *(const LAS bf16x8*)(KT + (32 * w + 16 * mt + r) * 144 + (32 * ks + 8 * gq) * 2); \
            const bf16x8 bb = *(const LAS bf16x8*)(WVT + (16 * n2 + r) * 144 + (32 * ks + 8 * gq) * 2); \
            cacc = __builtin_amdgcn_mfma_f32_16x16x32_bf16(a, bb, cacc, 0, 0, 0); } \
          acc[mt][n2] = cacc; } \
      LBAR(); \
      _Pragma("unroll") for (int mt = 0; mt < 2; ++mt) \
        _Pragma("unroll") for (int n2 = 0; n2 < 3; ++n2) { u32x2 q; q.x = pk2(acc[mt][n2][0], acc[mt][n2][1]); q.y = pk2(acc[mt][n2][2], acc[mt][n2][3]); \
          *(LAS u32x2*)(CT + (16 * n2 + r) * 528 + (32 * w + 16 * mt + 4 * gq) * 2) = q; } \
    } while (0)
    { const int tdx = F.tid, sp = tdx & 31, cq = tdx >> 5, gq = (tdx & 63) >> 4;
      M2_LOAD(qrA, krA, vrA, wsA, ivA, 0);
      M2_LOAD(qrB, krB, vrB, wsB, ivB, 1); }
    __syncthreads();
#pragma unroll 1
    for (int c = 0; c < NCH; c += 2) {
      M2_BODY(c, qrA, krA, vrA, wsA, ivA);
      M2_BODY(c + 1, qrB, krB, vrB, wsB, ivB);
    }
#undef M2_BODY
#undef M2_ATILE_H
#undef M2_ATILE_Q
#undef M2_AMMA
#undef M2_LOAD
    __syncthreads();
  }
}

__device__ __forceinline__ void phase_ragg(const Frame& F) {
  unsigned char* ws = F.ws;
  const float* RA = (const float*)(ws + WS_RA); const bf16_t* RBb = (const bf16_t*)(ws + WS_RB);
  float* AGGA = (float*)(ws + WS_SMALL + SM_AGGA); float* AGGB = (float*)(ws + WS_SMALL + SM_AGGB);
  const int gt = F.bid * 512 + F.tid, NGT = F.G * 512;
  const int per = (2 * NCH * (RW / 2) + F.G - 1) / F.G;
#pragma unroll 1
  for (int i2 = F.tid; i2 < per; i2 += 512) {
    const int it = F.bid * per + i2; if (it >= 2 * NCH * (RW / 2)) break;
    const int bc = it / (RW / 2), ch = 2 * (it - bc * (RW / 2));
    const float* pa = RA + (size_t)bc * 64 * RW + ch; const bf16_t* pb = RBb + (size_t)bc * 64 * RW + ch;
    float A0 = 1.f, B0 = 0.f, A1 = 1.f, B1 = 0.f;
#pragma unroll 1
    for (int tb = 0; tb < 8; ++tb) {
      f32x2 a[8]; unsigned bb[8];
#pragma unroll
      for (int t = 0; t < 8; ++t) { a[t] = *(const f32x2*)(pa + (size_t)(tb * 8 + t) * RW); bb[t] = *(const unsigned*)(pb + (size_t)(tb * 8 + t) * RW); }
#pragma unroll
      for (int t = 0; t < 8; ++t) { A0 *= a[t][0]; B0 = a[t][0] * B0 + bflo(bb[t]); A1 *= a[t][1]; B1 = a[t][1] * B1 + bfhi(bb[t]); }
    }
    *(f32x2*)(AGGA + (size_t)bc * RW + ch) = (f32x2){A0, A1}; *(f32x2*)(AGGB + (size_t)bc * RW + ch) = (f32x2){B0, B1};
  }
}
__device__ __forceinline__ float gelu_fast(float x) {
  const float u = 0.7978845608028654f * (x + 0.044715f * x * x * x); return x * __builtin_amdgcn_rcpf(1.0f + __expf(-2.0f * u)); }
__device__ __forceinline__ void phase_rscan(const Frame& F) {
  unsigned char* ws = F.ws;
  const float* RA = (const float*)(ws + WS_RA); const bf16_t* RBb = (const bf16_t*)(ws + WS_RB);
  const float* AGGA = (const float*)(ws + WS_SMALL + SM_AGGA); const float* AGGB = (const float*)(ws + WS_SMALL + SM_AGGB);
  const bf16_t* PROJ = (const bf16_t*)(ws + WS_PROJ); bf16_t* YR = (bf16_t*)(ws + WS_YR);
  const int gt = F.bid * 512 + F.tid, NGT = F.G * 512;
#define RS_LD(a, bb, xg, tb) do { _Pragma("unroll") for (int t = 0; t < 8; ++t) { const size_t o = (size_t)(t0 + (tb) * 8 + t) * RW + ch; \
      a[t] = __builtin_nontemporal_load((const f32x2*)(RA + o)); bb[t] = __builtin_nontemporal_load((const unsigned*)(RBb + o)); \
      xg[t] = __builtin_nontemporal_load((const unsigned*)(PROJ + (size_t)(t0 + (tb) * 8 + t) * INC + O_XG + ch)); } } while (0)
#define RS_DO(a, bb, xg, tb) do { _Pragma("unroll") for (int t = 0; t < 8; ++t) { h0 = a[t][0] * h0 + bflo(bb[t]); h1 = a[t][1] * h1 + bfhi(bb[t]); \
      *(unsigned*)(YR + (size_t)(t0 + (tb) * 8 + t) * RW + ch) = pk2(h0 * gelu_fast(bflo(xg[t])), h1 * gelu_fast(bfhi(xg[t]))); } } while (0)
#define RS_CLD(ca, cb, c0) do { _Pragma("unroll") for (int k = 0; k < 8; ++k) { const int cc = (c0) + k; const int j = (b * NCH + (cc < cidx ? cc : 0)) * RW + ch; ca[k] = *(const f32x2*)(AGGA + j); cb[k] = *(const f32x2*)(AGGB + j); } } while (0)
#define RS_CDO(ca, cb, c0) do { _Pragma("unroll") for (int k = 0; k < 8; ++k) { if ((c0) + k < cidx) { h0 = ca[k][0] * h0 + cb[k][0]; h1 = ca[k][1] * h1 + cb[k][1]; } } } while (0)
  const int per = (2 * NCH * (RW / 2) + F.G - 1) / F.G;
  for (int i2 = F.tid; i2 < per; i2 += 512) {
    const int it = F.bid * per + i2; if (it >= 2 * NCH * (RW / 2)) break;
    const int bc = it / (RW / 2), ch = 2 * (it % (RW / 2)), t0 = bc * 64, b = bc / NCH, cidx = bc % NCH;
    float h0 = 0.f, h1 = 0.f;
    f32x2 aA[8], aB[8]; unsigned bA[8], bB[8], xA[8], xB[8];
    RS_LD(aA, bA, xA, 0);
    {
      f32x2 caA[8], cbA[8], caB[8], cbB[8];
      RS_CLD(caA, cbA, 0);
      for (int c0 = 0; c0 < cidx; c0 += 16) {
        RS_CLD(caB, cbB, c0 + 8);
        RS_CDO(caA, cbA, c0);
        RS_CLD(caA, cbA, c0 + 16);
        RS_CDO(caB, cbB, c0 + 8);
      }
    }
#pragma unroll
    for (int tb = 0; tb < 8; tb += 2) {
      RS_LD(aB, bB, xB, tb + 1);
      RS_DO(aA, bA, xA, tb);
      if (tb + 2 < 8) RS_LD(aA, bA, xA, tb + 2);
      RS_DO(aB, bB, xB, tb + 1);
    }
  }
#undef RS_LD
#undef RS_DO
#undef RS_CLD
#undef RS_CDO
}

__device__ __forceinline__ void phase_ym(const Frame& F) {
  unsigned char* ws = F.ws;
  const bf16_t* HNI = (const bf16_t*)(ws + WS_HNI); const bf16_t* HNE = (const bf16_t*)(ws + WS_HNE);
  const float* EMR = (const float*)(ws + WS_SMALL + SM_EMR); const float* DENI = (const float*)(ws + WS_SMALL + SM_DENI); const float* QN = (const float*)(ws + WS_SMALL + SM_QN);
  const bf16_t* XCM = (const bf16_t*)(ws + WS_XCM); const bf16_t* PROJ = (const bf16_t*)(ws + WS_PROJ); bf16_t* YM = (bf16_t*)(ws + WS_YM);
  const float* normw = F.in[10]; const float* skip = F.in[11];
  const int gw = F.bid * 8 + F.wave, NGW = F.G * 8, lane = F.lane;
  for (int tA = gw; tA < NTOK; tA += 2 * NGW) {
    const int tBr = tA + NGW; const bool okB = tBr < NTOK; const int tB = okB ? tBr : tA;
    u32x2 a[2][8], e[2][8], xcw[2][8], zw[2][8]; float den[2][8], emr[2][8];
#pragma unroll
    for (int u = 0; u < 2; ++u) { const int t = u ? tB : tA;
#pragma unroll
      for (int h = 0; h < 8; ++h) {
        const size_t o = (size_t)t * MW + 256 * h + 4 * lane;
        a[u][h] = __builtin_nontemporal_load((const u32x2*)(HNI + o)); e[u][h] = __builtin_nontemporal_load((const u32x2*)(HNE + o)); xcw[u][h] = __builtin_nontemporal_load((const u32x2*)(XCM + o));
        zw[u][h] = __builtin_nontemporal_load((const u32x2*)(PROJ + (size_t)t * INC + O_Z + 256 * h + 4 * lane));
        den[u][h] = DENI[t * 8 + h] + QN[t * 8 + h]; emr[u][h] = EMR[t * 8 + h];
      } }
#pragma unroll
    for (int u = 0; u < 2; ++u) { const int t = u ? tB : tA;
      if (u == 0 || okB) {
#pragma unroll
      for (int h = 0; h < 8; ++h) {
        const int col = 256 * h + 4 * lane;
        const float inv = 1.0f / fmaxf(fabsf(den[u][h]), emr[u][h]);
        const float hv[4] = {(bflo(a[u][h].x) + bflo(e[u][h].x)) * inv, (bfhi(a[u][h].x) + bfhi(e[u][h].x)) * inv, (bflo(a[u][h].y) + bflo(e[u][h].y)) * inv, (bfhi(a[u][h].y) + bfhi(e[u][h].y)) * inv};
        const float mean = wave_sum((hv[0] + hv[1]) + (hv[2] + hv[3])) * (1.0f / 256.0f);
        float d[4]; float s2 = 0.f;
#pragma unroll
        for (int j = 0; j < 4; ++j) { d[j] = hv[j] - mean; s2 += d[j] * d[j]; }
        const float rstd = rsqrtf(wave_sum(s2) * (1.0f / 256.0f) + LN_EPS);
        const f32x4 nw = *(const f32x4*)(normw + col), sk = *(const f32x4*)(skip + col);
        const float xc[4] = {bflo(xcw[u][h].x), bfhi(xcw[u][h].x), bflo(xcw[u][h].y), bfhi(xcw[u][h].y)}, z[4] = {bflo(zw[u][h].x), bfhi(zw[u][h].x), bflo(zw[u][h].y), bfhi(zw[u][h].y)};
        float y[4];
#pragma unroll
        for (int j = 0; j < 4; ++j) y[j] = (d[j] * rstd * nw[j] + sk[j] * xc[j]) * siluf_(z[j]);
        u32x2 w; w.x = pk2(y[0], y[1]); w.y = pk2(y[2], y[3]); *(u32x2*)(YM + (size_t)t * RW + col) = w;
      } }
    }
  }
}

__device__ __forceinline__ void phase_ln_router(const Frame& F) {
  unsigned char* ws = F.ws;
  float* X1 = (float*)(ws + WS_X1); unsigned char* X1Q = ws + WS_X1B;
  int* CNT = (int*)(ws + WS_CTL); int* LIST = (int*)(ws + WS_LIST); float* LISTW = (float*)(ws + WS_LISTW); int* TOKES = (int*)(ws + WS_TOKES);
  const float* g1 = F.in[22]; const float* b1 = F.in[23]; const float* rw = F.in[24]; const float* rbias = F.in[25];
  LAS unsigned char* XH = F.lds; LAS unsigned char* XL = F.lds + 65792;
  const bf16_t* RWH = (const bf16_t*)(ws + WS_SMALL + SM_RWH); const bf16_t* RWL = (const bf16_t*)(ws + WS_SMALL + SM_RWL);
  const int w = F.wave;
  for (int tile = F.bid; tile < NTOK / 16; tile += F.G) {
    const int t0 = tile * 16;
    int lane = F.lane; asm volatile("" : "+v"(lane));
    const int r16 = lane & 15, gq = lane >> 4;
#pragma unroll 1
    for (int q = 0; q < 2; ++q) {
      const int tl = 2 * w + q, t = t0 + tl;
      float* xr = X1 + (size_t)t * DM;
      f32x4 v[8]; float s = 0.f;
#pragma unroll
      for (int j = 0; j < 8; ++j) { v[j] = *(const f32x4*)(xr + 4 * lane + 256 * j); s += (v[j][0] + v[j][1]) + (v[j][2] + v[j][3]); }
      const float mean = wave_sum(s) * (1.0f / DM); float s2 = 0.f;
#pragma unroll
      for (int j = 0; j < 8; ++j) { v[j] = v[j] - mean; s2 += (v[j][0] * v[j][0] + v[j][1] * v[j][1]) + (v[j][2] * v[j][2] + v[j][3] * v[j][3]); }
      const float rstd = rsqrtf(wave_sum(s2) * (1.0f / DM) + LN_EPS);
#pragma unroll
      for (int j = 0; j < 8; ++j) {
        const int col = 4 * lane + 256 * j;
        const f32x4 gg = *(const f32x4*)(g1 + col), bb = *(const f32x4*)(b1 + col);
        const f32x4 o = v[j] * rstd * gg + bb;
        *(f32x4*)(xr + col) = o;
        u32x2 pw; pw.x = pk2(o[0], o[1]); pw.y = pk2(o[2], o[3]);
        { int q8 = 0; q8 = __builtin_amdgcn_cvt_pk_fp8_f32(o[0], o[1], q8, false); q8 = __builtin_amdgcn_cvt_pk_fp8_f32(o[2], o[3], q8, true); *(int*)(X1Q + (size_t)t * DM + col) = q8; }
        { float lo[4];
#pragma unroll
          for (int e = 0; e < 4; ++e) lo[e] = o[e] - __uint_as_float(f2bf(o[e]) << 16);
          *(LAS u32x2*)(XH + tl * 4112 + col * 2) = pw; u32x2 lw; lw.x = pk2(lo[0], lo[1]); lw.y = pk2(lo[2], lo[3]); *(LAS u32x2*)(XL + tl * 4112 + col * 2) = lw; }
      }
    }
    __syncthreads();
    f32x4 lacc[4];
    {
      const bf16_t* rh = RWH + (size_t)r16 * DM + 256 * w + 8 * gq; const bf16_t* rl = RWL + (size_t)r16 * DM + 256 * w + 8 * gq;
      const LAS unsigned char* xh = XH + r16 * 4112 + (256 * w + 8 * gq) * 2; const LAS unsigned char* xl = XL + r16 * 4112 + (256 * w + 8 * gq) * 2;
#pragma unroll
      for (int nt = 0; nt < 4; ++nt) {
        f32x4 a4 = (f32x4){0.f, 0.f, 0.f, 0.f};
#pragma unroll
        for (int kh = 0; kh < 2; ++kh) {
          bf16x8 bh[4], bl[4];
#pragma unroll
          for (int k2 = 0; k2 < 4; ++k2) { bh[k2] = *(const bf16x8*)(rh + (size_t)(16 * nt) * DM + 32 * (4 * kh + k2)); bl[k2] = *(const bf16x8*)(rl + (size_t)(16 * nt) * DM + 32 * (4 * kh + k2)); }
#pragma unroll
          for (int k2 = 0; k2 < 4; ++k2) {
            const bf16x8 ah = *(const LAS bf16x8*)(xh + 64 * (4 * kh + k2));
            const bf16x8 al = *(const LAS bf16x8*)(xl + 64 * (4 * kh + k2));
            a4 = __builtin_amdgcn_mfma_f32_16x16x32_bf16(ah, bh[k2], a4, 0, 0, 0);
            a4 = __builtin_amdgcn_mfma_f32_16x16x32_bf16(al, bh[k2], a4, 0, 0, 0);
            a4 = __builtin_amdgcn_mfma_f32_16x16x32_bf16(ah, bl[k2], a4, 0, 0, 0);
          }
          asm volatile("" ::: "memory");
        }
        lacc[nt] = a4;
      }
    }
    __syncthreads();
    LAS float* PART = (LAS float*)F.lds;
#pragma unroll
    for (int nt = 0; nt < 4; ++nt)
#pragma unroll
      for (int j = 0; j < 4; ++j) PART[(w * 16 + 4 * gq + j) * 64 + 16 * nt + r16] = lacc[nt][j];
    __syncthreads();
    LAS int* lcnt = (LAS int*)(F.lds + 40960); LAS int* lbase = lcnt + 64;
    if (F.tid < 64) lcnt[F.tid] = 0;
    __syncthreads();
    int lslot[2], rnk[2]; float wg[2];
#pragma unroll
    for (int q = 0; q < 2; ++q) {
      const int tl = 2 * w + q;
      float logit = 0.f;
#pragma unroll
      for (int ww = 0; ww < 8; ++ww) logit += PART[(ww * 16 + tl) * 64 + lane];
      const float score = 1.0f / (1.0f + expf(-logit));
      const float biased = score + rbias[lane];
      int cnt = 0;
#pragma unroll
      for (int d = 1; d < 8; ++d) { const int other = (lane & ~7) | ((lane + d) & 7); const float ov = __shfl(biased, other); cnt += (ov > biased || (ov == biased && other < lane)) ? 1 : 0; }
      float gs = cnt < 2 ? biased : 0.f;
      gs += __shfl_xor(gs, 1); gs += __shfl_xor(gs, 2); gs += __shfl_xor(gs, 4);
      const int gi = lane >> 3; int grank = 0;
#pragma unroll
      for (int gg = 0; gg < 8; ++gg) { const float og = __shfl(gs, 8 * gg); grank += (og > gs || (og == gs && gg < gi)) ? 1 : 0; }
      const float val = grank < 4 ? biased : -INFINITY;
      int erank = 0;
      for (int e2 = 0; e2 < 64; ++e2) { const float ov = __shfl(val, e2); erank += (ov > val || (ov == val && e2 < lane)) ? 1 : 0; }
      const bool chosen = erank < 8;
      const float wsum = wave_sum(chosen ? score : 0.f);
      rnk[q] = erank; wg[q] = score / wsum * 2.5f; lslot[q] = -1;
      if (chosen) lslot[q] = atomicAdd((int*)(lcnt + lane), 1);
    }
    __syncthreads();
    if (F.tid < 64) { const int c = lcnt[F.tid]; lbase[F.tid] = c ? atomicAdd(&CNT[F.tid * 64], c) : 0; }
    __syncthreads();
#pragma unroll
    for (int q = 0; q < 2; ++q) {
      if (lslot[q] >= 0) { const int t = t0 + 2 * w + q; const int slot = lbase[lane] + lslot[q];
        LIST[lane * NTOK + slot] = t; LISTW[lane * NTOK + slot] = wg[q]; TOKES[t * 8 + rnk[q]] = (lane << 16) | slot; }
    }
    __syncthreads();
  }
}

__device__ __forceinline__ MoeTab build_moe_tab(const Frame& F) {
  LAS int* tp = (LAS int*)(F.lds + LDS_X); LAS int* cp = tp + 68; LAS int* cn = tp + 136;
  const int* CNT = (const int*)(F.ws + WS_CTL);
  if (F.tid == 0) { int a = 0, b = 0; for (int e = 0; e < NE; ++e) { const int c = CNT[e * 64]; tp[e] = a; cp[e] = b; cn[e] = c; a += (c + 255) >> 8; b += c; } tp[NE] = a; cp[NE] = b; }
  __syncthreads();
  { LAS int* rt = tp + 256; if (F.tid < 384) { int e = 0; for (int k = 0; k < NE; ++k) { if (tp[k + 1] <= F.tid) e = k + 1; } rt[F.tid] = e < NE ? e : NE - 1; } }
  __syncthreads();
  MoeTab T; T.tp = tp; T.cp = cp; T.cnt = cn; T.n_rt = __builtin_amdgcn_readfirstlane(tp[NE]);
  return T;
}

__device__ __forceinline__ void phase_final(const Frame& F, const MoeTab& T) {
  unsigned char* ws = F.ws;
  const bf16_t* YRM = (const bf16_t*)(ws + WS_YRM); const int* TOKES = (const int*)(ws + WS_TOKES);
  const float* g2 = F.in[32]; const float* b2 = F.in[33];
  const int gw = F.bid * 8 + F.wave, NGW = F.G * 8, lane = F.lane;
  for (int t = gw; t < NTOK; t += NGW) {
    float* orow = F.out + (size_t)t * DM;
    f32x4 v[8];
    { const float* xrow = (const float*)(ws + WS_X1) + (size_t)t * DM; const bf16_t* ys = YRM + (size_t)(NTOK * 8 + t) * DM;
#pragma unroll
      for (int j = 0; j < 8; ++j) { const u32x2 wv = __builtin_nontemporal_load((const u32x2*)(ys + 4 * lane + 256 * j)); v[j] = *(const f32x4*)(xrow + 4 * lane + 256 * j) * ALPHA; v[j][0] += bflo(wv.x); v[j][1] += bfhi(wv.x); v[j][2] += bflo(wv.y); v[j][3] += bfhi(wv.y); } }
    const int esl = TOKES[t * 8 + (lane & 7)];
#pragma unroll
    for (int kb = 0; kb < 2; ++kb) {
      u32x2 yv[4][8];
#pragma unroll
      for (int k = 0; k < 4; ++k) {
        const int es = __shfl(esl, kb * 4 + k); const int e = es >> 16, slot = es & 0xffff;
        const bf16_t* yr = YRM + (size_t)(T.cp[e] + slot) * DM;
#pragma unroll
        for (int j = 0; j < 8; ++j) yv[k][j] = __builtin_nontemporal_load((const u32x2*)(yr + 4 * lane + 256 * j));
      }
#pragma unroll
      for (int k = 0; k < 4; ++k)
#pragma unroll
        for (int j = 0; j < 8; ++j) { v[j][0] += bflo(yv[k][j].x); v[j][1] += bfhi(yv[k][j].x); v[j][2] += bflo(yv[k][j].y); v[j][3] += bfhi(yv[k][j].y); }
    }
    float s = 0.f;
#pragma unroll
    for (int j = 0; j < 8; ++j) s += (v[j][0] + v[j][1]) + (v[j][2] + v[j][3]);
    const float mean = wave_sum(s) * (1.0f / DM); float s2 = 0.f;
#pragma unroll
    for (int j = 0; j < 8; ++j) { v[j] = v[j] - mean; s2 += (v[j][0] * v[j][0] + v[j][1] * v[j][1]) + (v[j][2] * v[j][2] + v[j][3] * v[j][3]); }
    const float rstd = rsqrtf(wave_sum(s2) * (1.0f / DM) + LN_EPS);
#pragma unroll
    for (int j = 0; j < 8; ++j) { const int col = 4 * lane + 256 * j; const f32x4 gg = *(const f32x4*)(g2 + col), bb = *(const f32x4*)(b2 + col); *(f32x4*)(orow + col) = v[j] * rstd * gg + bb; }
  }
}

__global__ void __launch_bounds__(512, 2) fwd_megakernel(Params p, int ph_lo, int ph_hi) {
  extern __shared__ __attribute__((aligned(16))) unsigned char lds_raw[];
  Frame F;
  F.lds = (LAS unsigned char*)lds_raw; F.tid = threadIdx.x; F.lane = F.tid & 63; F.wave = __builtin_amdgcn_readfirstlane(F.tid >> 6);
  F.G = gridDim.x; F.bid = blockIdx.x; F.ws = as_global(p.ws); F.in = InPtrs{p.in}; F.out = as_global(p.out);
  unsigned char* ws = as_global(p.ws);
#ifndef PHMASK
#define PHMASK 0xFFF
#endif
#define IN(k) (((PHMASK >> (k)) & 1) && ph_lo <= (k) && (k) < ph_hi)
#ifndef RPTMASK
#define RPTMASK 0
#endif
#define RPT(k) for (int _rp = 0; _rp < 1 + ((RPTMASK >> (k)) & 1); ++_rp)
#define FRESH() do { unsigned char* w2_ = opaque_global(p.ws); ws = w2_; F.ws = w2_; int l2_ = (int)__builtin_amdgcn_mbcnt_hi(~0u, __builtin_amdgcn_mbcnt_lo(~0u, 0u)); asm volatile("" : "+v"(l2_)); F.lane = l2_; F.tid = F.wave * 64 + l2_; } while (0)
#define SYNC(k) do { if (IN(k) && IN((k) + 1)) { xcd_barrier(xbar); } } while (0)
  { volatile LAS unsigned* st = (volatile LAS unsigned*)(F.lds + LDS_X + 4096); if (F.tid < 4) st[F.tid] = 0u; }
  __syncthreads();
  const XcdBarrier xbar = xcd_barrier_post((unsigned*)(ws + WS_CTL + 16384), (volatile LAS unsigned*)(F.lds + LDS_X + 4096));

  FRESH();
  if (IN(0)) RPT(0) { if (_rp) xcd_barrier(xbar); phase_prologue(F); }
  SYNC(0);
  FRESH();
  if (IN(1)) RPT(1) { if (_rp) xcd_barrier(xbar);
    SchedDense S{(const char*)(ws + WS_XB), (const char*)(ws + WS_WIN), NTOK / 256, INC / 256, F.G, F.bid, DM, DM, DM / 64};
    EpiStoreBf16 E{(bf16_t*)(ws + WS_PROJ), INC};
    pg8::gemm_phase<EpiStoreBf16, SchedDense, false>(F.lds, DM, DM, S, E);
    { const int nb = defer1_blocks(F.G), first = F.G - nb;
      if (nb && F.bid >= first) { const int base = T_NITEMS - defer1_count(F.G) - defer3_count(F.G); tile_range(F, base + (F.bid - first), nb, base + defer1_count(F.G)); } }
  }
  SYNC(1);
  FRESH();
  if (IN(2)) RPT(2) { if (_rp) xcd_barrier(xbar); phase_mprep(F); phase_rconv(F); }
  SYNC(2);
  FRESH();
  if (IN(3)) RPT(3) { if (_rp) xcd_barrier(xbar);
    const int nm2 = F.G >> 1;
    if (F.bid < nm2) phase_m2(F, nm2);
    else {
      const int bid2 = F.bid - nm2, G2 = F.G - nm2;
      phase_m1(F, bid2, G2);
      int Kr = 4; asm volatile("" : "+s"(Kr));
      SchedRglru S{(const char*)(ws + WS_XCR), (const char*)(ws + WS_WRAX), G2, bid2, Kr};
      EpiRglru E{(const bf16_t*)(ws + WS_XCR), p.in[15], p.in[17], (const float*)(ws + WS_SMALL + SM_C8), (float*)(ws + WS_RA), (bf16_t*)(ws + WS_RB)};
      pg8::gemm_phase<EpiRglru, SchedRglru, false>(F.lds, RW, 256, S, E);
      { const int base = T_NITEMS - defer3_count(F.G); if (defer3_count(F.G)) tile_range(F, base + bid2, G2, T_NITEMS); }
    }
  }
  SYNC(3);
  FRESH();
  if (IN(4)) RPT(4) { if (_rp) xcd_barrier(xbar); phase_ragg(F); phase_ym(F); }
  SYNC(4);
  FRESH();
  if (IN(5)) RPT(5) { if (_rp) xcd_barrier(xbar); phase_rscan(F); }
  SYNC(5);
  FRESH();
  if (IN(6)) RPT(6) { if (_rp) xcd_barrier(xbar);
    SchedMerge S{(const char*)(ws + WS_YM), (const char*)(ws + WS_YR), (const char*)(ws + WS_WPM), (const char*)(ws + WS_WPR), F.G, F.bid};
    EpiMergeF E{(const bf16_t*)(ws + WS_PROJ), p.in[2], (bf16_t*)(ws + WS_MERGED)};
    pg8::gemm_phase<EpiMergeF, SchedMerge, false>(F.lds, RW, RW, S, E);
  }
  SYNC(6);
  FRESH();
  if (IN(7)) RPT(7) { if (_rp) xcd_barrier(xbar);
    SchedDense S{(const char*)(ws + WS_MERGED), (const char*)(ws + WS_WO), NTOK / 256, DM / 256, F.G, F.bid, DM, DM, DM / 64};
    EpiWo E{p.in[0], (float*)(ws + WS_X1)};
    pg8::gemm_phase<EpiWo, SchedDense, false>(F.lds, DM, DM, S, E);
  }
  SYNC(7);
  FRESH();
  if (IN(8)) phase_ln_router(F);
  SYNC(8);
  FRESH();
  if (IN(9)) RPT(9) { if (_rp) xcd_barrier(xbar);
    const MoeTab T = build_moe_tab(F);
    SchedMoe<4, 1> S{T, (const int*)(ws + WS_LIST), (const char*)(ws + WS_X1B), (const char*)(ws + WS_WEGU), (const char*)(ws + WS_WSGU), F.G, F.bid, DM / 128};
    EpiMoe1 E{ws + WS_HMOE};
    pg8::gemm_phase<EpiMoe1, SchedMoe<4, 1>, true>(F.lds, DM / 2, DM / 2, S, E);
  }
  SYNC(9);
  FRESH();
  if (IN(10)) RPT(10) { if (_rp) xcd_barrier(xbar);
    const MoeTab T = build_moe_tab(F);
    int nt2 = DE / 128; asm volatile("" : "+s"(nt2));
    SchedMoe<8, 2> S{T, (const int*)(ws + WS_LIST), (const char*)(ws + WS_HMOE), (const char*)(ws + WS_WED), (const char*)(ws + WS_WSD), F.G, F.bid, nt2};
    EpiMoe2 E{(bf16_t*)(ws + WS_YRM), (const float*)(ws + WS_LISTW), (bf16_t*)(ws + WS_WIN)};
    pg8::gemm_phase<EpiMoe2, SchedMoe<8, 2>, false>(F.lds, DE / 2, DE / 2, S, E);
  }
  SYNC(10);
  FRESH();
  if (IN(11)) { const MoeTab T = build_moe_tab(F); phase_final(F, T); }
#undef IN
#undef SYNC
}

#ifndef N_LAUNCH_SPLIT
#define N_LAUNCH_SPLIT 0
#endif
extern "C" void kernel_launch(void* const* d_in, const int* in_sizes, int n_in, void* d_out, int out_size, void* d_ws, size_t ws_size, hipStream_t stream) {
  static int grid_blocks = 0;
  if (grid_blocks == 0) {
    int dev = 0, cus = 0, per_cu = 0;
    (void)hipGetDevice(&dev);
    (void)hipDeviceGetAttribute(&cus, hipDeviceAttributeMultiprocessorCount, dev);
    (void)hipFuncSetAttribute((const void*)fwd_megakernel, hipFuncAttributeMaxDynamicSharedMemorySize, LDS_BYTES);
    (void)hipOccupancyMaxActiveBlocksPerMultiprocessor(&per_cu, fwd_megakernel, 512, LDS_BYTES);
    if (per_cu < 1) { fprintf(stderr, "kernel_launch: occupancy query says %d blocks per CU\n", per_cu); per_cu = 1; }
    grid_blocks = cus * per_cu;
    fprintf(stderr, "kernel_launch: cus %d per_cu %d grid %d ws_size %zu (need %zu) n_in %d\n", cus, per_cu, grid_blocks, ws_size, (size_t)WS_END, n_in);
    if (ws_size < WS_END || n_in != 34) { fprintf(stderr, "kernel_launch: workspace too small or unexpected inputs; nothing launched\n"); grid_blocks = -1; }
  }
  if (grid_blocks < 0) return;
  (void)hipMemsetAsync((char*)d_ws + WS_CTL, 0, 65536, stream);
  Params p{};
  for (int i = 0; i < 34; ++i) p.in[i] = (const float*)d_in[i];
  p.out = (float*)d_out; p.ws = (unsigned char*)d_ws;
#if N_LAUNCH_SPLIT
  for (int ph = 0; ph < 12; ++ph) { hipLaunchKernelGGL(fwd_megakernel, dim3(grid_blocks), dim3(512), LDS_BYTES, stream, p, ph, ph + 1); }
#else
  int lo = 0, hi = 12;
  void* args[] = {&p, &lo, &hi};
  hipError_t e = hipLaunchCooperativeKernel((void*)fwd_megakernel, dim3(grid_blocks), dim3(512), args, LDS_BYTES, stream);
  if (e != hipSuccess) fprintf(stderr, "cooperative launch failed: %s (grid %d)\n", hipGetErrorString(e), grid_blocks);
#endif
}
```

```cpp
#include <hip/hip_runtime.h>
#include <hip/hip_cooperative_groups.h>
#include <cstdio>
#include <cstdint>
namespace cg = cooperative_groups;

#define LAS __attribute__((address_space(3)))
typedef unsigned short bf16_t;
typedef short bf16x8 __attribute__((ext_vector_type(8)));
typedef float f32x4 __attribute__((ext_vector_type(4)));
typedef float f32x2 __attribute__((ext_vector_type(2)));
typedef unsigned u32x4 __attribute__((ext_vector_type(4)));
typedef unsigned u32x2 __attribute__((ext_vector_type(2)));
typedef int i32x8 __attribute__((ext_vector_type(8)));
typedef int i32x4 __attribute__((ext_vector_type(4)));

constexpr int NTOK = 8192, DM = 2048, SEQ = 4096, MW = 2048, RW = 2560, INC = 13312, NH = 8, HD = 256, NE = 64, DE = 512;
constexpr int O_Z = 2048, O_XR = 4096, O_XG = 6656, O_G0 = 9216, O_G1 = 11264;
constexpr float LN_EPS = 1e-5f;
constexpr float ALPHA = 1.189207115002721f;
constexpr int NCH = 64;

constexpr size_t MiB = 1u << 20;
constexpr size_t WS_CTL = 0;
constexpr size_t WS_WIN = 1 * MiB, WS_RB = 1 * MiB, WS_M2TAB = 41 * MiB;
constexpr size_t WS_WPM = 53 * MiB  , WS_WPR = 63 * MiB, WS_WO = 73 * MiB, WS_WRAX = 81 * MiB, WS_WSGU = 84 * MiB, WS_WSD = 1014 * MiB;
constexpr size_t WS_WEGU = 88 * MiB, WS_WED = 344 * MiB;
constexpr size_t WS_XB = 472 * MiB, WS_HNI = 472 * MiB, WS_HMOE = 472 * MiB;
constexpr size_t WS_PROJ = 504 * MiB;
constexpr size_t WS_YRM = 560 * MiB;
constexpr size_t WS_Q = 712 * MiB, WS_K = 744 * MiB, WS_V = 776 * MiB, WS_YM = 712 * MiB  , WS_YR = 752 * MiB;
constexpr size_t WS_XCM = 808 * MiB, WS_MERGED = 808 * MiB;
constexpr size_t WS_XCR = 840 * MiB;
constexpr size_t WS_SMALL = 880 * MiB;
constexpr size_t WS_RA = 886 * MiB, WS_T1 = 886 * MiB, WS_X1B = 886 * MiB  ;
constexpr size_t WS_LIST = 918 * MiB, WS_LISTW = 920 * MiB  , WS_TOKES = 923 * MiB;
constexpr size_t WS_X1 = 950 * MiB;
constexpr size_t WS_HNE = 966 * MiB;
constexpr size_t WS_END = 1016 * MiB;
constexpr size_t SM_IG = 0, SM_LF = 256 * 1024, SM_INTER = 512 * 1024, SM_EMR = 768 * 1024, SM_DENI = 1024 * 1024, SM_QN = 1280 * 1024;
constexpr size_t SM_WIFT = 1536 * 1024;
constexpr size_t SM_C8 = 1792 * 1024;
constexpr size_t SM_RWH = 4608 * 1024, SM_RWL = 4864 * 1024;
constexpr size_t SM_AGGA = 2 * MiB, SM_AGGB = 2 * MiB + 1310720;

constexpr int LDS_BYTES = 147456;
constexpr int LDS_X = 131072;

struct Params {
  const float* in[34];
  float* out;
  unsigned char* ws;
};

typedef __bf16 hbf2_t __attribute__((ext_vector_type(2)));
typedef float hf2_t __attribute__((ext_vector_type(2)));
__device__ __forceinline__ unsigned pk2(float lo, float hi) { const hf2_t f = {lo, hi}; return __builtin_bit_cast(unsigned, __builtin_convertvector(f, hbf2_t)); }
__device__ __forceinline__ unsigned f2bf(float f) { return pk2(f, 0.f) & 0xffffu; }
__device__ __forceinline__ float bflo(unsigned w) { return __uint_as_float(w << 16); }
__device__ __forceinline__ float bfhi(unsigned w) { return __uint_as_float(w & 0xffff0000u); }
__device__ __forceinline__ float bf1(bf16_t b) { return __uint_as_float(((unsigned)b) << 16); }
__device__ __forceinline__ float sigmoidf_(float x) { return 1.0f / (1.0f + __expf(-x)); }
__device__ __forceinline__ float siluf_(float x) { return x / (1.0f + __expf(-x)); }
__device__ __forceinline__ float gelu_tanh(float x) { const float u = 0.7978845608028654f * (x + 0.044715f * x * x * x); return 0.5f * x * (1.0f + tanhf(u)); }
__device__ __forceinline__ float wave_sum(float v) {
#pragma unroll
  for (int o = 1; o < 64; o <<= 1) v += __shfl_xor(v, o);
  return v;
}
__device__ __forceinline__ float wave_max(float v) {
#pragma unroll
  for (int o = 1; o < 64; o <<= 1) v = fmaxf(v, __shfl_xor(v, o));
  return v;
}
__device__ __forceinline__ float wave_scan_sum(float v, int lane) {
#pragma unroll
  for (int o = 1; o < 64; o <<= 1) { const float t = __shfl_up(v, o); if (lane >= o) v += t; }
  return v;
}
__device__ __forceinline__ float wave_scan_max(float v, int lane) {
#pragma unroll
  for (int o = 1; o < 64; o <<= 1) { const float t = __shfl_up(v, o); if (lane >= o) v = fmaxf(v, t); }
  return v;
}
#define LDS_WAIT() asm volatile("s_waitcnt lgkmcnt(0)" ::: "memory")
#define LBAR() do { asm volatile("s_waitcnt lgkmcnt(0)" ::: "memory"); __builtin_amdgcn_s_barrier(); asm volatile("" ::: "memory"); } while (0)

namespace pg8 {
constexpr int BM = 256, BK = 64, HALF = 128, HTB = HALF * BK * 2, NXCD = 8, WGM = 8;
__device__ __forceinline__ int lds_byte(int r, int c) { const int st = (r >> 4) * 2 + (c >> 5), rr = r & 15, cc = c & 31, ob = rr * 64 + cc * 2; return st * 1024 + (ob ^ (((ob >> 9) & 1) << 5)); }
__device__ __forceinline__ void stage_rc(int b, int& R, int& C) { const int st = b / 1024, sb = b % 1024, swz = sb ^ (((sb >> 9) & 1) << 5); R = (st >> 1) * 16 + swz / 64; C = (st & 1) * 32 + (swz % 64) / 2; }

__device__ __forceinline__ int perm32(int rho) { const int n = rho >> 4, i = rho & 15; return 8 * (i >> 2) + 4 * n + (i & 3); }
struct UnitG { const char* A; const char* B; int pm, pn, e, cnt, mt, row0, nt, keep; };

__device__ __forceinline__ bool dense_order(int i, int G, int c, int nM, int nN, int& pm, int& pn) {
  const int nwg = nM * nN; const long L = (long)i * G + c; if (L >= nwg) return false;
  int wgid = (int)L; { const int q = nwg / NXCD, r = nwg % NXCD, xcd = wgid % NXCD, off = wgid / NXCD; wgid = (xcd < r ? xcd * (q + 1) : r * (q + 1) + (xcd - r) * q) + off; }
  const int nig = WGM * nN, gid = wgid / nig, fm = gid * WGM, gsz = (nM - fm) < WGM ? (nM - fm) : WGM;
  pm = fm + ((wgid % nig) % gsz); pn = (wgid % nig) / gsz; return true;
}

template <class Epi, class Sched, bool GATHER>
__device__ __forceinline__ void gemm_phase(LAS unsigned char* lds, const int lda, const int ldb, const Sched& S, const Epi& E) {
  const int tid = threadIdx.x, wid = __builtin_amdgcn_readfirstlane(tid >> 6), lane = tid & 63, wr = wid >> 2, wc = wid & 3, fr = lane & 15, fq = lane >> 4;
  int Rr[2], Cc[2];
  unsigned voffB[2];
  unsigned vA[2][2];
  unsigned nvA[2][2];
#pragma unroll
  for (int i = 0; i < 2; ++i) { stage_rc(tid * 16 + i * 8192, Rr[i], Cc[i]); const int Rb = Epi::PERM ? ((Rr[i] & ~31) + perm32(Rr[i] & 31)) : Rr[i]; voffB[i] = (unsigned)(Rb * ldb + Cc[i]) * 2u; }
  const size_t kstep = (size_t)(BK * 2);
  const size_t hstepA = (size_t)HALF * lda * 2, hstepB = (size_t)HALF * ldb * 2;
  const unsigned ldsw = (unsigned)wid * 1024u;
  const int aoff = lds_byte(wr * 64 + fr, fq * 8), boff = lds_byte(wc * 32 + fr, fq * 8);
#define PG8_SA(b, h) (((b) * 2 + (h)) * HTB)
#define PG8_SB(b, h) ((4 + (b) * 2 + (h)) * HTB)
#define PG8_STAGE_B(bufoff, gbase) do { _Pragma("unroll") for (int _i = 0; _i < 2; ++_i) \
    __builtin_amdgcn_global_load_lds((const unsigned*)((const char*)(gbase) + voffB[_i]), (LAS unsigned*)(lds + (bufoff) + ldsw + _i * 8192), 16, 0, 0); } while (0)
#define PG8_STAGE_A(bufoff, gbase, h) do { _Pragma("unroll") for (int _i = 0; _i < 2; ++_i) { \
    const char* _p = GATHER ? ((const char*)(gbase) + vA[h][_i]) : ((const char*)(gbase) + (h) * hstepA + vA[0][_i]); \
    __builtin_amdgcn_global_load_lds((const unsigned*)_p, (LAS unsigned*)(lds + (bufoff) + ldsw + _i * 8192), 16, 0, 0); } } while (0)
#define PG8_LD8(p) __builtin_shufflevector(*(const LAS i32x4*)(p), *(const LAS i32x4*)((p) + 1024), 0, 1, 2, 3, 4, 5, 6, 7)
#define PG8_LO(x) __builtin_bit_cast(bf16x8, __builtin_shufflevector(x, x, 0, 1, 2, 3))
#define PG8_HI(x) __builtin_bit_cast(bf16x8, __builtin_shufflevector(x, x, 4, 5, 6, 7))
#define PG8_LDA(dst, b, h) do { _Pragma("unroll") for (int m = 0; m < 4; ++m) dst[m] = PG8_LD8(lds + PG8_SA(b, h) + aoff + m * 2048); } while (0)
#define PG8_LDB(dst, b, h) do { _Pragma("unroll") for (int n = 0; n < 2; ++n) dst[n] = PG8_LD8(lds + PG8_SB(b, h) + boff + n * 2048); } while (0)
#define PG8_MMA(ai, bj, At, Bt) do { __builtin_amdgcn_s_setprio(1); _Pragma("unroll") for (int m = 0; m < 4; ++m) _Pragma("unroll") for (int n = 0; n < 2; ++n) { \
    acc[ai][bj][m][n] = __builtin_amdgcn_mfma_f32_16x16x32_bf16(PG8_LO(Bt[n]), PG8_LO(At[m]), acc[ai][bj][m][n], 0, 0, 0); \
    acc[ai][bj][m][n] = __builtin_amdgcn_mfma_f32_16x16x32_bf16(PG8_HI(Bt[n]), PG8_HI(At[m]), acc[ai][bj][m][n], 0, 0, 0); } __builtin_amdgcn_s_setprio(0); } while (0)
#define PG8_MMA8(ai, bj, At, Bt) do { __builtin_amdgcn_s_setprio(1); _Pragma("unroll") for (int m = 0; m < 4; ++m) _Pragma("unroll") for (int n = 0; n < 2; ++n) \
    acc[ai][bj][m][n] = __builtin_amdgcn_mfma_scale_f32_16x16x128_f8f6f4(Bt[n], At[m], acc[ai][bj][m][n], 0, 0, 0, 0x7F7F7F7F, 0, 0x7F7F7F7F); __builtin_amdgcn_s_setprio(0); } while (0)
#define PG8_MM(ai, bj, At, Bt) do { if (Epi::FP8) PG8_MMA8(ai, bj, At, Bt); else PG8_MMA(ai, bj, At, Bt); } while (0)
#define PG8_WAIT_V(n) asm volatile("s_waitcnt vmcnt(" #n ")" ::: "memory")
#define PG8_WAIT_L(n) asm volatile("s_waitcnt lgkmcnt(" #n ")" ::: "memory")
#define PG8_BAR __builtin_amdgcn_s_barrier()
#define PG8_SCHED __builtin_amdgcn_sched_barrier(0)
  UnitG cur, nxt; int ui = 0;
  if (!S.next(0, cur)) return;
#pragma unroll
  for (int h = 0; h < 2; ++h)
#pragma unroll
    for (int i = 0; i < 2; ++i) {
      if (GATHER) vA[h][i] = (unsigned)(S.arow(cur, h * HALF + Rr[i]) * lda + Cc[i]) * 2u;
      else vA[h][i] = (unsigned)(Rr[i] * lda + Cc[i]) * 2u;
      nvA[h][i] = vA[h][i];
    }
  f32x4 acc[2][2][4][2];
#pragma unroll
  for (int a = 0; a < 2; ++a)
#pragma unroll
    for (int b = 0; b < 2; ++b)
#pragma unroll
      for (int m = 0; m < 4; ++m)
#pragma unroll
        for (int n = 0; n < 2; ++n) acc[a][b][m][n] = (f32x4){0.f, 0.f, 0.f, 0.f};
  i32x8 At[4], B0[2], B1[2];
  const char* cA = cur.A; const char* cB = cur.B;
  { const char* pB0 = cB; const char* pB1 = cB + hstepB; const char* pA0 = cA; const char* pB2 = cB + kstep; const char* pA1 = cA + kstep; const char* pB3 = cB + hstepB + kstep;
    asm volatile("" : "+s"(pB0), "+s"(pB1), "+s"(pA0), "+s"(pB2), "+s"(pA1), "+s"(pB3));
  PG8_STAGE_B(PG8_SB(0, 0), pB0); PG8_STAGE_B(PG8_SB(0, 1), pB1); PG8_STAGE_A(PG8_SA(0, 0), pA0, 0); PG8_STAGE_A(PG8_SA(0, 1), pA0, 1);
  if (wr == 1) PG8_BAR;
  PG8_WAIT_V(2); PG8_BAR;
  PG8_STAGE_B(PG8_SB(1, 0), pB2); PG8_STAGE_A(PG8_SA(1, 0), pA1, 0); PG8_STAGE_B(PG8_SB(1, 1), pB3); }
  PG8_WAIT_V(6); PG8_BAR;
  for (;;) {
    const bool has_next = S.next(ui + 1, nxt);
    const char* nA = has_next ? nxt.A : cA; const char* nB = has_next ? nxt.B : cB;
    if (GATHER) {
      if (has_next) {
#pragma unroll
        for (int h = 0; h < 2; ++h)
#pragma unroll
          for (int i = 0; i < 2; ++i) nvA[h][i] = (unsigned)(S.arow(nxt, h * HALF + Rr[i]) * lda + Cc[i]) * 2u;
      }
    }
    const int nt = cur.nt;
#pragma unroll 1
    for (int t = 0; t < nt; t += 2) {
      const bool last = (t == nt - 2);
      const char* a1 = cA + (size_t)(t + 1) * kstep;
      const char* a2 = last ? nA : cA + (size_t)(t + 2) * kstep; const char* b2 = last ? nB : cB + (size_t)(t + 2) * kstep;
      const char* a3 = a2 + kstep; const char* b3 = b2 + kstep;
      asm volatile("" : "+s"(a1), "+s"(a2), "+s"(a3), "+s"(b2), "+s"(b3));
      PG8_LDB(B0, 0, 0); PG8_LDB(B1, 0, 1); PG8_SCHED; PG8_LDA(At, 0, 0); PG8_STAGE_A(PG8_SA(1, 1), a1, 1);
      if (GATHER) { if (last) {
#pragma unroll
        for (int h = 0; h < 2; ++h)
#pragma unroll
          for (int i = 0; i < 2; ++i) vA[h][i] = nvA[h][i]; } }
      PG8_WAIT_V(8); PG8_WAIT_L(0); PG8_BAR; PG8_MM(0, 0, At, B0); PG8_MM(0, 1, At, B1); PG8_BAR; PG8_SCHED;
      PG8_LDA(At, 0, 1); PG8_STAGE_B(PG8_SB(0, 0), b2); PG8_STAGE_B(PG8_SB(0, 1), b2 + hstepB); PG8_STAGE_A(PG8_SA(0, 0), a2, 0);
      PG8_WAIT_V(8); PG8_WAIT_L(0); PG8_BAR; PG8_MM(1, 0, At, B0); PG8_MM(1, 1, At, B1); PG8_BAR; PG8_SCHED;
      PG8_LDB(B0, 1, 0); PG8_LDB(B1, 1, 1); PG8_SCHED; PG8_LDA(At, 1, 0); PG8_STAGE_A(PG8_SA(0, 1), a2, 1);
      PG8_WAIT_V(8); PG8_WAIT_L(0); PG8_BAR; PG8_MM(0, 0, At, B0); PG8_MM(0, 1, At, B1); PG8_BAR; PG8_SCHED;
      PG8_LDA(At, 1, 1); PG8_STAGE_B(PG8_SB(1, 0), b3); PG8_STAGE_B(PG8_SB(1, 1), b3 + hstepB); PG8_STAGE_A(PG8_SA(1, 0), a3, 0);
      PG8_WAIT_V(8); PG8_WAIT_L(0); PG8_BAR; PG8_MM(1, 0, At, B0); PG8_MM(1, 1, At, B1); PG8_BAR; PG8_SCHED;
    }
    if (wr == 0) PG8_BAR;
    { int l2 = (int)__builtin_amdgcn_mbcnt_hi(~0u, __builtin_amdgcn_mbcnt_lo(~0u, 0u)); asm volatile("" : "+v"(l2));
      E(acc, cur, wr, wc, l2 & 15, l2 >> 4); }
    if (!has_next) break;
    if (!cur.keep) {
#pragma unroll
      for (int a = 0; a < 2; ++a)
#pragma unroll
        for (int b = 0; b < 2; ++b)
#pragma unroll
          for (int m = 0; m < 4; ++m)
#pragma unroll
            for (int n = 0; n < 2; ++n) acc[a][b][m][n] = (f32x4){0.f, 0.f, 0.f, 0.f};
    }
    cur = nxt; cA = nA; cB = nB; ++ui;
    if (wr == 1) PG8_BAR;
  }
  PG8_WAIT_V(0);
  PG8_BAR;
#undef PG8_SA
#undef PG8_SB
#undef PG8_STAGE_A
#undef PG8_STAGE_B
#undef PG8_LDA
#undef PG8_LDB
#undef PG8_MMA
#undef PG8_MMA8
#undef PG8_MM
#undef PG8_LD8
#undef PG8_LO
#undef PG8_HI
#undef PG8_WAIT_V
#undef PG8_WAIT_L
#undef PG8_BAR
#undef PG8_SCHED
}
}

__device__ __forceinline__ const char* uni_ptr(const char* p) {
  const unsigned long long v = (unsigned long long)p;
  const unsigned lo = __builtin_amdgcn_readfirstlane((unsigned)v), hi = __builtin_amdgcn_readfirstlane((unsigned)(v >> 32));
  return (const char*)(((unsigned long long)hi << 32) | lo);
}

struct SchedDense {
  const char* A; const char* B; int nM, nN, G, c, lda, ldb, nt;
  __device__ __forceinline__ bool next(int i, pg8::UnitG& u) const {
    int pm, pn; if (!pg8::dense_order(i, G, c, nM, nN, pm, pn)) return false;
    u.pm = pm; u.pn = pn; u.e = 0; u.cnt = 0; u.mt = 0; u.row0 = pm * 256; u.nt = nt; u.keep = 0;
    u.A = A + (size_t)pm * 256 * lda * 2; u.B = B + (size_t)pn * 256 * ldb * 2; return true;
  }
  __device__ __forceinline__ unsigned arow(const pg8::UnitG&, int r) const { return (unsigned)r; }
};

struct EpiStoreBf16 {
  static constexpr bool PERM = true, FP8 = false;
  bf16_t* O; int ldc;
  __device__ __forceinline__ void operator()(const f32x4 (&acc)[2][2][4][2], const pg8::UnitG& u, int wr, int wc, int fr, int fq) const {
    const int row0 = u.pm * 256 + wr * 64 + fr, col0 = u.pn * 256 + wc * 32 + 8 * fq;
#pragma unroll
    for (int ai = 0; ai < 2; ++ai)
#pragma unroll
      for (int m = 0; m < 4; ++m) { bf16_t* rowp = O + (size_t)(row0 + ai * 128 + m * 16) * ldc + col0;
#pragma unroll
        for (int bj = 0; bj < 2; ++bj) { const f32x4 v0 = acc[ai][bj][m][0], v1 = acc[ai][bj][m][1]; u32x4 w; w.x = pk2(v0[0], v0[1]); w.y = pk2(v0[2], v0[3]); w.z = pk2(v1[0], v1[1]); w.w = pk2(v1[2], v1[3]); *(u32x4*)(rowp + bj * 128) = w; } }
  }
};

struct SchedRglru {
  const char* XCR; const char* W; int G, c, nt4;
  __device__ __forceinline__ bool next(int i, pg8::UnitG& u) const {
    const int L = i * G + c; if (L >= 640) return false;
    const int blk = L >> 6, rem = L & 63; u.e = blk; u.pm = rem >> 1; u.pn = rem & 1; u.cnt = 0; u.mt = 0; u.row0 = u.pm * 256; u.nt = nt4; u.keep = 0;
    u.A = XCR + ((size_t)u.pm * 256 * RW + 256 * blk) * 2; u.B = W + ((size_t)(blk * 512 + u.pn * 256) * 256) * 2; return true;
  }
  __device__ __forceinline__ unsigned arow(const pg8::UnitG&, int r) const { return (unsigned)r; }
};
struct EpiRglru {
  static constexpr bool PERM = true, FP8 = false;
  const bf16_t* XCR; const float* ba; const float* bx; const float* C8; float* RA; bf16_t* RBo;
  __device__ __forceinline__ void operator()(const f32x4 (&acc)[2][2][4][2], const pg8::UnitG& u, int wr, int wc, int fr, int fq) const {
    const int row0 = u.pm * 256 + wr * 64 + fr;
#pragma unroll
    for (int n = 0; n < 2; ++n) {
      const int ch = 256 * u.e + 128 * u.pn + 32 * wc + 8 * fq + 4 * n;
      const f32x4 vba = *(const f32x4*)(ba + ch), vbx = *(const f32x4*)(bx + ch), c8 = *(const f32x4*)(C8 + ch);
      u32x2 xwa[8];
#pragma unroll
      for (int i = 0; i < 8; ++i) xwa[i] = *(const u32x2*)(XCR + (size_t)(row0 + (i >> 2) * 128 + (i & 3) * 16) * RW + ch);
#pragma unroll
      for (int ai = 0; ai < 2; ++ai)
#pragma unroll
        for (int m = 0; m < 4; ++m) {
          const size_t off = (size_t)(row0 + ai * 128 + m * 16) * RW + ch;
          const u32x2 xw = xwa[ai * 4 + m];
          const float xc[4] = {bflo(xw.x), bfhi(xw.x), bflo(xw.y), bfhi(xw.y)};
          f32x4 av; float bv[4];
#pragma unroll
          for (int j = 0; j < 4; ++j) {
            const float r = __builtin_amdgcn_rcpf(1.0f + __expf(-(acc[ai][0][m][n][j] + vba[j])));
            const float ig = __builtin_amdgcn_rcpf(1.0f + __expf(-(acc[ai][1][m][n][j] + vbx[j])));
            const float la = c8[j] * r;
            const float a = __expf(la);
            const float x2 = 2.0f * la;
            const float poly = -x2 * (1.0f + x2 * 0.5f * (1.0f + x2 * (1.0f / 3.0f) * (1.0f + x2 * 0.25f * (1.0f + x2 * 0.2f))));
            const float om = (x2 > -0.25f) ? poly : (1.0f - a * a);
            av[j] = a;
            bv[j] = sqrtf(fmaxf(om, 0.f)) * (ig * xc[j]);
          }
          *(f32x4*)(RA + off) = av;
          u32x2 w; w.x = pk2(bv[0], bv[1]); w.y = pk2(bv[2], bv[3]); *(u32x2*)(RBo + off) = w;
          asm volatile("" ::: "memory");
        }
    }
  }
};

struct SchedMerge {
  const char* YM; const char* YR; const char* WPM; const char* WPR; int G, c;
  __device__ __forceinline__ bool next(int i, pg8::UnitG& u) const {
    int pm, pn; if (!pg8::dense_order(i >> 1, G, c, NTOK / 256, DM / 256, pm, pn)) return false;
    const int seg = i & 1;
    u.pm = pm; u.pn = pn; u.e = seg; u.cnt = 0; u.mt = 0; u.row0 = pm * 256; u.nt = seg ? RW / 64 : MW / 64; u.keep = seg ? 0 : 1;
    u.A = (seg ? YR : YM) + (size_t)pm * 256 * RW * 2; u.B = (seg ? WPR : WPM) + (size_t)pn * 256 * RW * 2; return true;
  }
  __device__ __forceinline__ unsigned arow(const pg8::UnitG&, int r) const { return (unsigned)r; }
};
struct EpiMergeF {
  static constexpr bool PERM = true, FP8 = false;
  const bf16_t* PROJ; const float* bgate; bf16_t* MRG;
  __device__ __forceinline__ void operator()(f32x4 (&acc)[2][2][4][2], const pg8::UnitG& u, int wr, int wc, int fr, int fq) const {
    const int row0 = u.pm * 256 + wr * 64 + fr, col0 = u.pn * 256 + wc * 32 + 8 * fq;
    if (u.e == 0) {
#pragma unroll
      for (int bj = 0; bj < 2; ++bj) {
        const int col = col0 + bj * 128;
        const f32x4 b00 = *(const f32x4*)(bgate + col), b01 = *(const f32x4*)(bgate + col + 4), b10 = *(const f32x4*)(bgate + DM + col), b11 = *(const f32x4*)(bgate + DM + col + 4);
#pragma unroll
        for (int ai = 0; ai < 2; ++ai)
#pragma unroll
          for (int m = 0; m < 4; ++m) {
            const size_t row = (size_t)(row0 + ai * 128 + m * 16);
            const u32x4 g1w = *(const u32x4*)(PROJ + row * INC + O_G1 + col);
            const float g1p[8] = {bflo(g1w.x), bfhi(g1w.x), bflo(g1w.y), bfhi(g1w.y), bflo(g1w.z), bfhi(g1w.z), bflo(g1w.w), bfhi(g1w.w)};
            const u32x4 g0w = *(const u32x4*)(PROJ + row * INC + O_G0 + col);
            const float g0p[8] = {bflo(g0w.x), bfhi(g0w.x), bflo(g0w.y), bfhi(g0w.y), bflo(g0w.z), bfhi(g0w.z), bflo(g0w.w), bfhi(g0w.w)};
#pragma unroll
            for (int j = 0; j < 4; ++j) {
              acc[ai][bj][m][0][j] *= (1.0f + __expf(-(g1p[j] + b10[j]))) * __builtin_amdgcn_rcpf(1.0f + __expf(-(g0p[j] + b00[j])));
              acc[ai][bj][m][1][j] *= (1.0f + __expf(-(g1p[4 + j] + b11[j]))) * __builtin_amdgcn_rcpf(1.0f + __expf(-(g0p[4 + j] + b01[j])));
            }
            if (m & 1) asm volatile("" ::: "memory");
          }
      }
    } else {
#pragma unroll
      for (int bj = 0; bj < 2; ++bj) {
        const int col = col0 + bj * 128;
        const f32x4 b10 = *(const f32x4*)(bgate + DM + col), b11 = *(const f32x4*)(bgate + DM + col + 4);
#pragma unroll
        for (int ai = 0; ai < 2; ++ai) {
          u32x4 g1a[4];
#pragma unroll
          for (int m = 0; m < 4; ++m) g1a[m] = *(const u32x4*)(PROJ + (size_t)(row0 + ai * 128 + m * 16) * INC + O_G1 + col);
#pragma unroll
          for (int m = 0; m < 4; ++m) {
            const size_t row = (size_t)(row0 + ai * 128 + m * 16);
            const u32x4 g1w = g1a[m];
            const float g1p[8] = {bflo(g1w.x), bfhi(g1w.x), bflo(g1w.y), bfhi(g1w.y), bflo(g1w.z), bfhi(g1w.z), bflo(g1w.w), bfhi(g1w.w)};
            f32x4 v0, v1;
#pragma unroll
            for (int j = 0; j < 4; ++j) { v0[j] = acc[ai][bj][m][0][j] * __builtin_amdgcn_rcpf(1.0f + __expf(-(g1p[j] + b10[j]))); v1[j] = acc[ai][bj][m][1][j] * __builtin_amdgcn_rcpf(1.0f + __expf(-(g1p[4 + j] + b11[j]))); }
            u32x4 w; w.x = pk2(v0[0], v0[1]); w.y = pk2(v0[2], v0[3]); w.z = pk2(v1[0], v1[1]); w.w = pk2(v1[2], v1[3]); *(u32x4*)(MRG + row * DM + col) = w;
          }
        }
      }
    }
  }
};

struct EpiWo {
  static constexpr bool PERM = false, FP8 = false;
  const float* X; float* O;
  __device__ __forceinline__ void operator()(const f32x4 (&acc)[2][2][4][2], const pg8::UnitG& u, int wr, int wc, int fr, int fq) const {
    const int row0 = u.pm * 256 + wr * 64 + fr, col0 = u.pn * 256 + wc * 32 + 4 * fq;
#pragma unroll
    for (int ai = 0; ai < 2; ++ai) {
      f32x4 xa[4][4];
#pragma unroll
      for (int m = 0; m < 4; ++m) { const size_t off = (size_t)(row0 + ai * 128 + m * 16) * DM + col0;
#pragma unroll
        for (int q = 0; q < 4; ++q) xa[m][q] = *(const f32x4*)(X + off + (q >> 1) * 128 + (q & 1) * 16); }
#pragma unroll
      for (int m = 0; m < 4; ++m) { const size_t off = (size_t)(row0 + ai * 128 + m * 16) * DM + col0;
#pragma unroll
        for (int q = 0; q < 4; ++q) *(f32x4*)(O + off + (q >> 1) * 128 + (q & 1) * 16) = xa[m][q] * ALPHA + acc[ai][q >> 1][m][q & 1]; }
    }
  }
};

struct MoeTab { const LAS int* tp; const LAS int* cp; const LAS int* cnt; int n_rt; };
template <int NT  , int STAGE  >
struct SchedMoe {
  MoeTab T; const int* LIST; const char* Abase; const char* Wr; const char* Ws; int G, c, ntv;
  __device__ __forceinline__ bool next(int i, pg8::UnitG& u) const {
    const int L = i * G + c; const int total = NT * (T.n_rt + 32); if (L >= total) return false;
    const int rt = L / NT, pn = L % NT; u.pn = pn; u.nt = ntv; u.keep = 0;
    constexpr int KK = (STAGE == 1) ? DM / 2 : DE / 2;
    constexpr int NN = NT * 256;
    if (rt < T.n_rt) {
      const int e = __builtin_amdgcn_readfirstlane(T.tp[256 + rt]);
      const int mt = rt - __builtin_amdgcn_readfirstlane(T.tp[e]);
      u.e = e; u.mt = mt; u.cnt = __builtin_amdgcn_readfirstlane(T.cnt[e]); u.pm = rt; u.row0 = rt * 256;
      u.B = Wr + ((size_t)e * NN + (size_t)pn * 256) * KK * 2;
    } else {
      u.e = NE; u.mt = rt - T.n_rt; u.cnt = NTOK; u.pm = rt; u.row0 = rt * 256;
      u.B = Ws + (size_t)pn * 256 * KK * 2;
    }
    if (STAGE == 2) u.pm = __builtin_amdgcn_readfirstlane(T.cp[u.e]);
    if (STAGE == 1) u.A = Abase;
    else u.A = Abase + (size_t)rt * 256 * DE;
    return true;
  }
  __device__ __forceinline__ unsigned arow(const pg8::UnitG& u, int r) const {
    if (u.e < NE) { int slot = u.mt * 256 + r; if (slot >= u.cnt) slot = 0; return (unsigned)LIST[u.e * NTOK + slot]; }
    return (unsigned)(u.mt * 256 + r);
  }
};
struct EpiMoe1 {
  static constexpr bool PERM = true, FP8 = true;
  unsigned char* H;
  __device__ __forceinline__ void operator()(const f32x4 (&acc)[2][2][4][2], const pg8::UnitG& u, int wr, int wc, int fr, int fq) const {
    const int row0 = u.row0 + wr * 64 + fr, col0 = u.pn * 128 + wc * 32 + 8 * fq;
#pragma unroll
    for (int ai = 0; ai < 2; ++ai)
#pragma unroll
      for (int m = 0; m < 4; ++m) { unsigned char* rowp = H + (size_t)(row0 + ai * 128 + m * 16) * DE + col0;
        float v[8];
#pragma unroll
        for (int n = 0; n < 2; ++n) { const f32x4 g = acc[ai][0][m][n], up = acc[ai][1][m][n];
#pragma unroll
          for (int j = 0; j < 4; ++j) { const float gg = g[j] * 0.015625f; v[4 * n + j] = gg * __builtin_amdgcn_rcpf(1.0f + __expf(-gg)) * (up[j] * 0.015625f); } }
        int q0 = 0, q1 = 0; q0 = __builtin_amdgcn_cvt_pk_fp8_f32(v[0], v[1], q0, false); q0 = __builtin_amdgcn_cvt_pk_fp8_f32(v[2], v[3], q0, true); q1 = __builtin_amdgcn_cvt_pk_fp8_f32(v[4], v[5], q1, false); q1 = __builtin_amdgcn_cvt_pk_fp8_f32(v[6], v[7], q1, true);
        u32x2 w; w.x = (unsigned)q0; w.y = (unsigned)q1; *(u32x2*)rowp = w; }
  }
};
struct EpiMoe2 {
  static constexpr bool PERM = true, FP8 = true;
  bf16_t* YRM; const float* LISTW; bf16_t* DUMMY;
  __device__ __forceinline__ void operator()(const f32x4 (&acc)[2][2][4][2], const pg8::UnitG& u, int wr, int wc, int fr, int fq) const {
    const int slot0 = u.mt * 256 + wr * 64 + fr;
    bf16_t* base = YRM + (size_t)(u.pm + slot0) * DM + u.pn * 256 + wc * 32 + 8 * fq;
    bf16_t* sink = DUMMY + (size_t)blockIdx.x * 8192 + ((wr * 4 + wc) * 64 + fq * 16 + fr) * 8;
    const float* lw = LISTW + u.e * NTOK + slot0;
    float wv[8];
#pragma unroll
    for (int i = 0; i < 8; ++i) wv[i] = lw[(i >> 2) * 128 + (i & 3) * 16];
#pragma unroll
    for (int ai = 0; ai < 2; ++ai)
#pragma unroll
      for (int m = 0; m < 4; ++m) { const int ds = ai * 128 + m * 16;
        const float w = wv[ai * 4 + m] * 0.03125f;
        bf16_t* rowp = (slot0 + ds < u.cnt) ? base + (size_t)ds * DM : sink;
#pragma unroll
        for (int bj = 0; bj < 2; ++bj) { const f32x4 v0 = acc[ai][bj][m][0] * w, v1 = acc[ai][bj][m][1] * w; u32x4 q; q.x = pk2(v0[0], v0[1]); q.y = pk2(v0[2], v0[3]); q.z = pk2(v1[0], v1[1]); q.w = pk2(v1[2], v1[3]); *(u32x4*)(rowp + bj * 128) = q; } }
  }
};


#define XB_TMO      128
#define XB_XCNT(j)  (256  + 64 * (j))
#define XB_XSUB(j)  (1280 + 64 * (j))
#define XB_XGEN(j)  (2304 + 64 * (j))
#define XB_TOP      3328
#define XB_TOPGEN   3392
#define XCD_BAR_WORDS 3456
#define XB_SPIN_CAP (1u << 18)
__device__ __forceinline__ unsigned xb_ld(unsigned* p)              { return __hip_atomic_load(p, __ATOMIC_RELAXED, __HIP_MEMORY_SCOPE_AGENT); }
__device__ __forceinline__ unsigned xb_add(unsigned* p, unsigned v) { return __hip_atomic_fetch_add(p, v, __ATOMIC_RELAXED, __HIP_MEMORY_SCOPE_AGENT); }
__device__ __forceinline__ unsigned xb_xcc_id() { return (unsigned)__builtin_amdgcn_s_getreg((3 << 11) | 20) & 0xFu; }
#define XB_SPIN(cond, bar) do { unsigned _sp = 0; while (cond) { __builtin_amdgcn_s_sleep(1); \
    if ((++_sp & 255u) == 0u) { if (xb_ld(&(bar)[XB_TMO])) break; if (_sp > XB_SPIN_CAP) { atomicAdd(&(bar)[XB_TMO], 1u); break; } } } } while (0)
struct XcdBarrier { unsigned* bar; unsigned x; volatile LAS unsigned* st; };
__device__ __forceinline__ XcdBarrier xcd_barrier_post(unsigned* bar, volatile LAS unsigned* st) {
    XcdBarrier b; b.bar = bar; b.x = xb_xcc_id(); b.st = st;
    if (threadIdx.x == 0) (void)xb_add(&bar[XB_XCNT(b.x)], 1u);
    return b;
}
__device__ __forceinline__ void xcd_barrier_complete(unsigned* bar, unsigned x, unsigned& nloc, unsigned& nx) {
    const unsigned G = gridDim.x * gridDim.y * gridDim.z;
    unsigned sum, cnt, mine, sp = 0u;
    for (;;) {
        sum = 0u; cnt = 0u; mine = 0u;
#pragma unroll
        for (unsigned j = 0; j < 16; ++j) { const unsigned c = xb_ld(&bar[XB_XCNT(j)]); sum += c; cnt += (c > 0u) ? 1u : 0u; mine = (j == x) ? c : mine; }
        if (sum == G) break;
        __builtin_amdgcn_s_sleep(1);
        if ((++sp & 255u) == 0u) { if (xb_ld(&bar[XB_TMO])) break; if (sp > XB_SPIN_CAP) { atomicAdd(&bar[XB_TMO], 1u); break; } }
    }
    nloc = mine > 0u ? mine : 1u; nx = cnt > 0u ? cnt : 1u;
}
__device__ __forceinline__ void xcd_barrier(const XcdBarrier& b) {
    asm volatile("s_waitcnt vmcnt(0)" ::: "memory");
    __syncthreads();
    if (threadIdx.x == 0) {
        unsigned* bar = b.bar;
        __builtin_amdgcn_s_waitcnt(0);
        unsigned nloc = b.st[0], nx = b.st[1];
        if (nloc == 0u) { xcd_barrier_complete(bar, b.x, nloc, nx); b.st[0] = nloc; b.st[1] = nx; }
        const unsigned old = xb_add(&bar[XB_XSUB(b.x)], 1u);
        const unsigned gen = old / nloc;
        if (old + 1u == (gen + 1u) * nloc) {
            __builtin_amdgcn_fence(__ATOMIC_RELEASE, "agent");
            asm volatile("s_waitcnt vmcnt(0)" ::: "memory");
            const unsigned og = xb_add(&bar[XB_TOP], 1u);
            const unsigned tg = og / nx;
            if (og + 1u == (tg + 1u) * nx) xb_add(&bar[XB_TOPGEN], 1u);
            else XB_SPIN(xb_ld(&bar[XB_TOPGEN]) == tg, bar);
            __builtin_amdgcn_fence(__ATOMIC_ACQUIRE, "agent");
            xb_add(&bar[XB_XGEN(b.x)], 1u);
            asm volatile("s_waitcnt vmcnt(0)" ::: "memory");
        } else {
            XB_SPIN(xb_ld(&bar[XB_XGEN(b.x)]) == gen, bar);
            __builtin_amdgcn_fence(__ATOMIC_ACQUIRE, "agent");
            asm volatile("s_waitcnt vmcnt(0)" ::: "memory");
        }
    }
    __syncthreads();
}

template <class T> __device__ __forceinline__ T* as_global(T* p) { const unsigned long long v = (unsigned long long)p; return (T*)(__attribute__((address_space(1))) T*)v; }
template <class T> __device__ __forceinline__ T* opaque_global(T* p) { unsigned long long v = (unsigned long long)p; asm volatile("" : "+s"(v)); return (T*)(__attribute__((address_space(1))) T*)v; }
struct InPtrs { const float* const* p; __device__ __forceinline__ const float* operator[](int k) const { return as_global(p[k]); } };
struct Frame {
  LAS unsigned char* lds; int tid, lane, wave, G, bid; unsigned char* ws; InPtrs in; float* out;
};

struct TJob { const float* W; unsigned char* WT; int N, ldtB, k0, n0, up, mode; float sc; };
__device__ __forceinline__ int gu_row(int n, int up) { return 256 * (n >> 7) + (n & 127) + up * 128; }
constexpr int TR0 = 16 * 104, TR1 = 16 * 16, TR2 = 20 * 16, TR3 = 16 * 16, TR4 = 2 * 10 * 4, TR5 = 2 * 16 * 4, TR6 = 4 * 16, TR7 = 2 * 64 * 16 * 4, TR8 = 64 * 4 * 16;
constexpr int T_NITEMS = TR0 + TR1 + TR2 + TR3 + TR4 + TR5 + TR6 + TR7 + TR8;
__device__ __forceinline__ TJob tj_decode(const Frame& F, int it) {
  unsigned char* ws = F.ws; int r = it;
  if (r < TR0) { const int kb = r / 104, nb = r % 104; return TJob{F.in[1], ws + WS_WIN, INC, DM * 2, 128 * kb, 128 * nb, 0, 0, 1.f}; } r -= TR0;
  if (r < TR1) { const int kb = r / 16, nb = r % 16; return TJob{F.in[19], ws + WS_WPM, DM, RW * 2, 128 * kb, 128 * nb, 0, 0, 1.f}; } r -= TR1;
  if (r < TR2) { const int kb = r / 16, nb = r % 16; return TJob{F.in[20], ws + WS_WPR, DM, RW * 2, 128 * kb, 128 * nb, 0, 0, 1.f}; } r -= TR2;
  if (r < TR3) { const int kb = r / 16, nb = r % 16; return TJob{F.in[21], ws + WS_WO, DM, DM * 2, 128 * kb, 128 * nb, 0, 0, 1.f}; } r -= TR3;
  if (r < TR4) { const int which = r / 40, rr = r % 40, blk = rr / 4, q = rr % 4; return TJob{F.in[which ? 16 : 14] + (size_t)blk * 65536, ws + WS_WRAX + (size_t)blk * 512 * 256 * 2, 256, 256 * 2, 128 * (q >> 1), 128 * (q & 1), which, 1, 1.f}; } r -= TR4;
  if (r < TR5) { const int which = r / 64, q = r % 64, kb = q / 4, nb = q % 4; return TJob{F.in[which ? 30 : 29], ws + WS_WSGU, DE, DM, 128 * kb, 128 * nb, which, 3, 64.f}; } r -= TR5;
  if (r < TR6) { const int kb = r / 16, nb = r % 16; return TJob{F.in[31], ws + WS_WSD, DM, DE, 128 * kb, 128 * nb, 0, 2, 32.f}; } r -= TR6;
  if (r < TR7) { const int which = r / 4096, rr = r % 4096, e = rr / 64, q = rr % 64, kb = q / 4, nb = q % 4; return TJob{F.in[which ? 27 : 26] + (size_t)e * DM * DE, ws + WS_WEGU + (size_t)e * 1024 * DM, DE, DM, 128 * kb, 128 * nb, which, 3, 64.f}; } r -= TR7;
  { const int e = r / 64, q = r % 64, kb = q / 16, nb = q % 16; return TJob{F.in[28] + (size_t)e * DE * DM, ws + WS_WED + (size_t)e * DM * DE, DM, DE, 128 * kb, 128 * nb, 0, 2, 32.f}; }
}
__device__ __forceinline__ void tj_load(const TJob& j, f32x4 (&v)[8], int wave, int lane) {
  const float* p = j.W + (size_t)(j.k0 + 16 * wave + (lane >> 5)) * j.N + j.n0 + 4 * (lane & 31);
#pragma unroll
  for (int i = 0; i < 8; ++i) v[i] = __builtin_nontemporal_load((const f32x4*)(p + (size_t)(2 * i) * j.N));
}
__device__ __forceinline__ void tj_store(const TJob& j, const f32x4 (&v)[8], LAS float* scr, int wave, int lane, int tid) {
#pragma unroll
  for (int i = 0; i < 8; ++i) { LAS float* d = scr + (16 * wave + 2 * i + (lane >> 5)) * 129 + 4 * (lane & 31); d[0] = v[i][0]; d[1] = v[i][1]; d[2] = v[i][2]; d[3] = v[i][3]; }
  LBAR();
  if (j.mode < 2) {
#pragma unroll
    for (int it = 0; it < 4; ++it) { const int idx = it * 512 + tid, n = idx >> 4, c = idx & 15; const LAS float* s = scr + (8 * c) * 129 + n;
      u32x4 o; o.x = pk2(s[0 * 129], s[1 * 129]); o.y = pk2(s[2 * 129], s[3 * 129]); o.z = pk2(s[4 * 129], s[5 * 129]); o.w = pk2(s[6 * 129], s[7 * 129]);
      const int nn = j.n0 + n; const int row = j.mode ? gu_row(nn, j.up) : nn;
      *(u32x4*)(j.WT + (size_t)row * j.ldtB + (j.k0 + 8 * c) * 2) = o; }
  } else {
#pragma unroll
    for (int it = 0; it < 2; ++it) { const int idx = it * 512 + tid, n = idx >> 3, c = idx & 7; const LAS float* s = scr + (16 * c) * 129 + n;
      int w[4];
#pragma unroll
      for (int q = 0; q < 4; ++q) { int t = 0; t = __builtin_amdgcn_cvt_pk_fp8_f32(s[(4 * q) * 129] * j.sc, s[(4 * q + 1) * 129] * j.sc, t, false); t = __builtin_amdgcn_cvt_pk_fp8_f32(s[(4 * q + 2) * 129] * j.sc, s[(4 * q + 3) * 129] * j.sc, t, true); w[q] = t; }
      u32x4 o; o.x = (unsigned)w[0]; o.y = (unsigned)w[1]; o.z = (unsigned)w[2]; o.w = (unsigned)w[3];
      const int nn = j.n0 + n; const int row = (j.mode == 3) ? gu_row(nn, j.up) : nn;
      __builtin_nontemporal_store(o, (u32x4*)(j.WT + (size_t)row * j.ldtB + j.k0 + 16 * c)); }
  }
  LBAR();
}

__device__ __forceinline__ void tile_range(const Frame& F, const int it0, const int step, const int end) {
  LAS float* scr = (LAS float*)F.lds;
  f32x4 vA[8], vB[8]; TJob jA, jB;
  int it = it0;
  if (it < end) { jA = tj_decode(F, it); tj_load(jA, vA, F.wave, F.lane); }
  while (it < end) {
    { const int itn = it + step; jB = tj_decode(F, itn < end ? itn : end - 1); tj_load(jB, vB, F.wave, F.lane); }
    tj_store(jA, vA, scr, F.wave, F.lane, F.tid);
    it += step; if (it >= end) break;
    { const int itn = it + step; jA = tj_decode(F, itn < end ? itn : end - 1); tj_load(jA, vA, F.wave, F.lane); }
    tj_store(jB, vB, scr, F.wave, F.lane, F.tid);
    it += step;
  }
}
constexpr int KD1 = 16, KD3 = 16;
__device__ __forceinline__ int defer1_blocks(int G) { const int rem = (NTOK / 256) * (INC / 256) % G; return rem ? G - rem : 0; }
__device__ __forceinline__ int defer1_count(int G) { return defer1_blocks(G) * KD1; }
__device__ __forceinline__ int defer3_count(int G) { return (G - (G >> 1)) * KD3; }

__device__ __forceinline__ void phase_prologue(const Frame& F) {
  unsigned char* ws = F.ws;
  tile_range(F, F.bid, F.G, T_NITEMS - defer1_count(F.G) - defer3_count(F.G));
  const int gt = F.bid * 512 + F.tid, NGT = F.G * 512;
  { const float* x = F.in[0]; bf16_t* xb = (bf16_t*)(ws + WS_XB);
    for (int i = gt; i < NTOK * DM / 8; i += NGT) { const f32x4 a = *(const f32x4*)(x + (size_t)i * 8), b = *(const f32x4*)(x + (size_t)i * 8 + 4);
      u32x4 o; o.x = pk2(a[0], a[1]); o.y = pk2(a[2], a[3]); o.z = pk2(b[0], b[1]); o.w = pk2(b[2], b[3]); *(u32x4*)(xb + (size_t)i * 8) = o; } }
  { const float* wif = F.in[8]; bf16_t* wt = (bf16_t*)(ws + WS_SMALL + SM_WIFT);
    for (int i = gt; i < 16 * 6144; i += NGT) { const int n = i / 6144, k = i % 6144; float v = wif[k * 16 + n]; if (k >= 2048 && k < 4096) v *= 16.0f; wt[i] = (bf16_t)f2bf(v); } }
  { const float* lam = F.in[18]; float* c8 = (float*)(ws + WS_SMALL + SM_C8); for (int i = gt; i < RW; i += NGT) c8[i] = -8.0f * log1pf(expf(-lam[i])); }
  { const float* rwt = F.in[24]; bf16_t* rh = (bf16_t*)(ws + WS_SMALL + SM_RWH); bf16_t* rl = (bf16_t*)(ws + WS_SMALL + SM_RWL);
    for (int i = gt; i < NE * DM; i += NGT) { const int n = i / DM, k = i % DM; const float v = rwt[k * NE + n]; const unsigned h = f2bf(v); rh[i] = (bf16_t)h; rl[i] = (bf16_t)f2bf(v - __uint_as_float(h << 16)); } }
  { float* lw64 = (float*)(ws + WS_LISTW) + (size_t)NE * NTOK; for (int i = gt; i < NTOK; i += NGT) lw64[i] = 1.0f; }
  { int* ctl = (int*)(ws + WS_CTL); for (int i = gt; i < 4096; i += NGT) ctl[i] = 0; }
}

__device__ __forceinline__ void phase_mprep(const Frame& F) {
  unsigned char* ws = F.ws;
  const bf16_t* PROJ = (const bf16_t*)(ws + WS_PROJ);
  bf16_t* Q = (bf16_t*)(ws + WS_Q); bf16_t* Kb = (bf16_t*)(ws + WS_K); bf16_t* V = (bf16_t*)(ws + WS_V); bf16_t* XCM = (bf16_t*)(ws + WS_XCM);
  const bf16_t* WIFT = (const bf16_t*)(ws + WS_SMALL + SM_WIFT);
  float* IG = (float*)(ws + WS_SMALL + SM_IG); float* LF = (float*)(ws + WS_SMALL + SM_LF);
  const int g = F.tid;
  f32x4 cw[4]; for (int j = 0; j < 4; ++j) cw[j] = *(const f32x4*)(F.in[3] + j * MW + 4 * g);
  const f32x4 cb = *(const f32x4*)(F.in[4] + 4 * g);
  f32x4 wq[4], wk[4], wv[4];
  for (int i = 0; i < 4; ++i) { wq[i] = *(const f32x4*)(F.in[5] + g * 16 + 4 * i); wk[i] = *(const f32x4*)(F.in[6] + g * 16 + 4 * i); wv[i] = *(const f32x4*)(F.in[7] + g * 16 + 4 * i); }
  LAS unsigned char* AIMG = F.lds; LAS float* red = (LAS float*)(F.lds + 98432);
  const int r = F.lane & 15, gq = F.lane >> 4;
  for (int tile = F.bid; tile < NTOK / 8; tile += F.G) {
    const int t0 = tile * 8, s0 = t0 & (SEQ - 1);
    u32x2 rw[11];
#pragma unroll
    for (int j = 0; j < 11; ++j) { const int pos = s0 - 3 + j; rw[j] = (pos >= 0) ? *(const u32x2*)(PROJ + (size_t)(t0 - 3 + j) * INC + 4 * g) : (u32x2){0u, 0u}; }
#pragma unroll
    for (int tt = 0; tt < 8; ++tt) {
      const int t = t0 + tt;
      f32x4 xw[4];
#pragma unroll
      for (int j = 0; j < 4; ++j) xw[j] = (f32x4){bflo(rw[tt + j].x), bfhi(rw[tt + j].x), bflo(rw[tt + j].y), bfhi(rw[tt + j].y)};
      const f32x4 cv = cb + cw[0] * xw[0] + cw[1] * xw[1] + cw[2] * xw[2] + cw[3] * xw[3];
      f32x4 xc; for (int i = 0; i < 4; ++i) xc[i] = cv[i] * __builtin_amdgcn_rcpf(1.0f + __expf(-cv[i]));
      const f32x4 q = xc[0] * wq[0] + xc[1] * wq[1] + xc[2] * wq[2] + xc[3] * wq[3];
      f32x4 k = xc[0] * wk[0] + xc[1] * wk[1] + xc[2] * wk[2] + xc[3] * wk[3];
      const f32x4 v = xw[3][0] * wv[0] + xw[3][1] * wv[1] + xw[3][2] * wv[2] + xw[3][3] * wv[3];
      k = k * 0.0625f;
      const size_t o = (size_t)t * MW + 4 * g;
      u32x2 wqv, wkv, wvv, wxc;
      wqv.x = pk2(q[0], q[1]); wqv.y = pk2(q[2], q[3]); *(u32x2*)(Q + o) = wqv;
      wkv.x = pk2(k[0], k[1]); wkv.y = pk2(k[2], k[3]); *(u32x2*)(Kb + o) = wkv;
      wvv.x = pk2(v[0], v[1]); wvv.y = pk2(v[2], v[3]); *(u32x2*)(V + o) = wvv;
      wxc.x = pk2(xc[0], xc[1]); wxc.y = pk2(xc[2], xc[3]); *(u32x2*)(XCM + o) = wxc;
      LAS unsigned char* ar = AIMG + tt * 12304 + 8 * g;
      *(LAS u32x2*)(ar) = wqv; *(LAS u32x2*)(ar + 4096) = wkv; *(LAS u32x2*)(ar + 8192) = wvv;
    }
    LBAR();
    {
      f32x4 acc = (f32x4){0.f, 0.f, 0.f, 0.f};
#pragma unroll
      for (int ib = 0; ib < 3; ++ib) {
        bf16x8 bfr[8];
#pragma unroll
        for (int i = 0; i < 8; ++i) { const int ks = F.wave * 24 + ib * 8 + i; bfr[i] = *(const bf16x8*)(WIFT + (size_t)r * 6144 + ks * 32 + 8 * gq); }
#pragma unroll
        for (int i = 0; i < 8; ++i) { const int ks = F.wave * 24 + ib * 8 + i;
          const bf16x8 a = *(const LAS bf16x8*)(AIMG + (r & 7) * 12304 + (ks * 32 + 8 * gq) * 2);
          acc = __builtin_amdgcn_mfma_f32_16x16x32_bf16(a, bfr[i], acc, 0, 0, 0); }
      }
#pragma unroll
      for (int j = 0; j < 4; ++j) red[F.wave * 256 + (4 * gq + j) * 16 + r] = acc[j];
    }
    LBAR();
    if (F.tid < 128) {
      const int row = F.tid >> 4, n = F.tid & 15;
      float s = F.in[9][n];
#pragma unroll
      for (int w = 0; w < 8; ++w) s += red[w * 256 + F.tid];
      const int t = t0 + row, b = t >> 12, sp = t & (SEQ - 1);
      if (n < 8) IG[(size_t)(b * 8 + n) * SEQ + sp] = s;
      else LF[(size_t)(b * 8 + (n - 8)) * SEQ + sp] = fminf(s, 0.f) - log1pf(__expf(-fabsf(s)));
    }
    LBAR();
  }
}

__device__ __forceinline__ void phase_rconv(const Frame& F) {
  unsigned char* ws = F.ws;
  const bf16_t* PROJ = (const bf16_t*)(ws + WS_PROJ); bf16_t* XCR = (bf16_t*)(ws + WS_XCR);
  const int gt = F.bid * 512 + F.tid, NGT = F.G * 512;
  const int per = ((NTOK / 16) * 640 + F.G - 1) / F.G;
  for (int i2 = F.tid; i2 < per; i2 += 512) {
    const int it = F.bid * per + i2; if (it >= (NTOK / 16) * 640) break;
    const int tile = it / 640, g = it % 640, t0 = tile * 16, s0 = t0 & (SEQ - 1);
    f32x4 cw[4]; for (int j = 0; j < 4; ++j) cw[j] = *(const f32x4*)(F.in[12] + j * RW + 4 * g);
    const f32x4 cb = *(const f32x4*)(F.in[13] + 4 * g);
    u32x2 rw[19];
#pragma unroll
    for (int j = 0; j < 19; ++j) { const int pos = s0 - 3 + j; rw[j] = (pos >= 0) ? *(const u32x2*)(PROJ + (size_t)(t0 - 3 + j) * INC + O_XR + 4 * g) : (u32x2){0u, 0u}; }
#pragma unroll
    for (int tt = 0; tt < 16; ++tt) {
      f32x4 cv = cb;
#pragma unroll
      for (int j = 0; j < 4; ++j) cv = cv + cw[j] * (f32x4){bflo(rw[tt + j].x), bfhi(rw[tt + j].x), bflo(rw[tt + j].y), bfhi(rw[tt + j].y)};
      u32x2 w; w.x = pk2(cv[0], cv[1]); w.y = pk2(cv[2], cv[3]); *(u32x2*)(XCR + (size_t)(t0 + tt) * RW + 4 * g) = w;
    }
  }
}

__device__ __forceinline__ float chunk_m(const float* IG, const float* LF, int bh, int c, int lane, int wave, LAS float* CS) {
  for (int cc = wave; cc < c; cc += 8) {
    const float lf = LF[(size_t)bh * SEQ + 64 * cc + lane], ig = IG[(size_t)bh * SEQ + 64 * cc + lane];
    const float b = wave_scan_sum(lf, lane), gmax = wave_max(ig - b);
    if (lane == 63) { CS[cc] = b; CS[64 + cc] = b + gmax; }
  }
  __syncthreads();
  float A = 0.f, B = -INFINITY;
  if (lane < c) { A = CS[lane]; B = CS[64 + lane]; }
#pragma unroll
  for (int o = 1; o < 64; o <<= 1) { const float pA = __shfl_up(A, o), pB = __shfl_up(B, o); if (lane >= o) { B = fmaxf(pB + A, B); A = pA + A; } }
  const float mafter = fmaxf(A, B);
  const float mc = __shfl(mafter, c > 0 ? c - 1 : 0);
  return c > 0 ? mc : 0.f;
}

__device__ __forceinline__ void phase_m1(const Frame& F, const int bid2, const int G2) {
  unsigned char* ws = F.ws;
  const bf16_t* Q = (const bf16_t*)(ws + WS_Q); const bf16_t* Kb = (const bf16_t*)(ws + WS_K); const bf16_t* V = (const bf16_t*)(ws + WS_V);
  const float* IG = (const float*)(ws + WS_SMALL + SM_IG); const float* LF = (const float*)(ws + WS_SMALL + SM_LF);
  float* INTER = (float*)(ws + WS_SMALL + SM_INTER); float* EMR = (float*)(ws + WS_SMALL + SM_EMR); float* DENI = (float*)(ws + WS_SMALL + SM_DENI);
  bf16_t* HNI = (bf16_t*)(ws + WS_HNI);
  LAS unsigned char* QS = F.lds; LAS unsigned char* KS = F.lds + 33792; LAS unsigned char* VT = F.lds + 67584; LAS unsigned char* PS = F.lds + 104448;
  LAS float* SCg = (LAS float*)(F.lds + 113664); LAS float* SCM = SCg + 64;
  const int r = F.lane & 15, gq = F.lane >> 4, w = F.wave;
  for (int item = bid2; item < 16 * NCH; item += G2) {
    const int bh = item / NCH, c = item % NCH, b = bh >> 3, h = bh & 7, tok0 = b * SEQ + 64 * c;
    const float m = chunk_m(IG, LF, bh, c, F.lane, w, (LAS float*)(F.lds + 114176));
    const float lf_c = LF[(size_t)bh * SEQ + 64 * c + F.lane], ig_c = IG[(size_t)bh * SEQ + 64 * c + F.lane];
    const float b_l = wave_scan_sum(lf_c, F.lane), g_l = ig_c - b_l;
    const float M_l = fmaxf(m, wave_scan_max(g_l, F.lane));
    if (w == 0) { SCg[F.lane] = g_l; SCM[F.lane] = M_l; INTER[(size_t)(tok0 + F.lane) * 8 + h] = __expf(m - M_l); EMR[(size_t)(tok0 + F.lane) * 8 + h] = __expf(-(b_l + M_l)); }
#pragma unroll
    for (int i = 0; i < 4; ++i) {
      const int idx = i * 512 + F.tid, row = idx >> 5, c16 = idx & 31;
      const size_t go = (size_t)(tok0 + row) * MW + 256 * h + 8 * c16;
      *(LAS u32x4*)(QS + row * 528 + c16 * 16) = *(const u32x4*)(Q + go);
      *(LAS u32x4*)(KS + row * 528 + c16 * 16) = *(const u32x4*)(Kb + go);
    }
    {
      const int sp = F.tid & 31, cq = F.tid >> 5;
#pragma unroll
      for (int i = 0; i < 2; ++i) {
        const size_t go = (size_t)(tok0 + 2 * sp) * MW + 256 * h + 8 * (cq + 16 * i);
        const u32x4 v0 = *(const u32x4*)(V + go), v1 = *(const u32x4*)(V + go + MW);
        const unsigned a0[4] = {v0.x, v0.y, v0.z, v0.w}, a1[4] = {v1.x, v1.y, v1.z, v1.w};
#pragma unroll
        for (int e = 0; e < 4; ++e) { const int dv = 8 * (cq + 16 * i) + 2 * e;
          *(LAS unsigned*)(VT + dv * 144 + sp * 4) = (a0[e] & 0xffffu) | (a1[e] << 16);
          *(LAS unsigned*)(VT + (dv + 1) * 144 + sp * 4) = (a0[e] >> 16) | (a1[e] & 0xffff0000u); }
      }
    }
    __syncthreads();
    {
      const int mi = w & 3;
#pragma unroll
      for (int nn = 0; nn < 2; ++nn) {
        const int ni = 2 * (w >> 2) + nn;
        f32x4 acc = (f32x4){0.f, 0.f, 0.f, 0.f};
        if (ni <= mi) {
#pragma unroll
          for (int ks = 0; ks < 8; ++ks) {
            const bf16x8 a = *(const LAS bf16x8*)(QS + (16 * mi + r) * 528 + (32 * ks + 8 * gq) * 2);
            const bf16x8 bb = *(const LAS bf16x8*)(KS + (16 * ni + r) * 528 + (32 * ks + 8 * gq) * 2);
            acc = __builtin_amdgcn_mfma_f32_16x16x32_bf16(a, bb, acc, 0, 0, 0);
          }
        }
        const int s = 16 * ni + r; const float gs = SCg[s];
#pragma unroll
        for (int j = 0; j < 4; ++j) { const int l = 16 * mi + 4 * gq + j; const float p = (s <= l) ? acc[j] * __expf(gs - SCM[l]) : 0.f; *(LAS bf16_t*)(PS + l * 144 + s * 2) = (bf16_t)f2bf(p); }
      }
    }
    __syncthreads();
    if (F.tid < 64) { float s = 0.f; for (int k = 0; k < 64; ++k) s += bf1(*(const LAS bf16_t*)(PS + F.tid * 144 + k * 2)); DENI[(size_t)(tok0 + F.tid) * 8 + h] = s; }
#pragma unroll
    for (int nn = 0; nn < 2; ++nn) {
      const int ni = 2 * w + nn;
#pragma unroll
      for (int mi = 0; mi < 4; ++mi) {
        f32x4 acc = (f32x4){0.f, 0.f, 0.f, 0.f};
#pragma unroll
        for (int ks = 0; ks < 2; ++ks) {
          const bf16x8 a = *(const LAS bf16x8*)(PS + (16 * mi + r) * 144 + (32 * ks + 8 * gq) * 2);
          const bf16x8 bb = *(const LAS bf16x8*)(VT + (16 * ni + r) * 144 + (32 * ks + 8 * gq) * 2);
          acc = __builtin_amdgcn_mfma_f32_16x16x32_bf16(a, bb, acc, 0, 0, 0);
        }
#pragma unroll
        for (int j = 0; j < 4; ++j) HNI[(size_t)(tok0 + 16 * mi + 4 * gq + j) * MW + 256 * h + 16 * ni + r] = (bf16_t)f2bf(acc[j]);
      }
    }
    __syncthreads();
  }
}

__device__ __forceinline__ void phase_m2(const Frame& F, const int nblk) {
  unsigned char* ws = F.ws;
  const bf16_t* Q = (const bf16_t*)(ws + WS_Q); const bf16_t* Kb = (const bf16_t*)(ws + WS_K); const bf16_t* V = (const bf16_t*)(ws + WS_V);
  const float* IG = (const float*)(ws + WS_SMALL + SM_IG); const float* LF = (const float*)(ws + WS_SMALL + SM_LF);
  float* QN = (float*)(ws + WS_SMALL + SM_QN);
  bf16_t* HNE = (bf16_t*)(ws + WS_HNE);
  LAS unsigned char* QS = F.lds; LAS unsigned char* KT = F.lds + 33792; LAS unsigned char* WVT = F.lds + 70656; LAS unsigned char* CT = F.lds + 77568;
  LAS float* TD = (LAS float*)(F.lds + 111360); LAS float* CS = (LAS float*)(F.lds + 111616);
  float* DUMMY = (float*)(ws + WS_M2TAB + 4 * MiB);
  const int w = F.wave;
  for (int item = F.bid; item < 128; item += nblk) {
    const int bh = item >> 3, sl = item & 7, b = bh >> 3, h = bh & 7, dv0 = 32 * sl;
    float* TI = (float*)(ws + WS_M2TAB) + (size_t)item * 8192; float* TW = TI + 4096;
    const int lane = F.lane;
    for (int i = F.tid; i < (6912 + 33792) / 4; i += 512) *(LAS unsigned*)(WVT + 4 * i) = 0u;
    float gk[8], pk[8];
#pragma unroll
    for (int i = 0; i < 8; ++i) {
      const int cc = w + 8 * i;
      const float lf = LF[(size_t)bh * SEQ + 64 * cc + lane], ig = IG[(size_t)bh * SEQ + 64 * cc + lane];
      const float bl = wave_scan_sum(lf, lane), g = ig - bl;
      const float gmax = wave_max(g), pm = wave_scan_max(g, lane);
      gk[i] = g; pk[i] = pm;
      if (lane == 63) { CS[cc] = bl; CS[64 + cc] = bl + gmax; }
    }
    __syncthreads();
    {
      float A = CS[lane], B = CS[64 + lane]; const float gmx = B - A;
#pragma unroll
      for (int o = 1; o < 64; o <<= 1) { const float pA = __shfl_up(A, o), pB = __shfl_up(B, o); if (lane >= o) { B = fmaxf(pB + A, B); A = pA + A; } }
      const float mafter = fmaxf(A, B);
      float mstart = __shfl_up(mafter, 1); if (lane == 0) mstart = 0.f;
      const float M63 = fmaxf(mstart, gmx);
      if (w == 0) TD[lane] = __expf(mstart - M63);
#pragma unroll
      for (int i = 0; i < 8; ++i) {
        const int cc = w + 8 * i;
        const float ms = __shfl(mstart, cc), m6 = __shfl(M63, cc);
        TI[cc * 64 + lane] = __expf(ms - fmaxf(ms, pk[i])); TW[cc * 64 + lane] = __expf(gk[i] - m6);
      }
    }
    __threadfence(); __syncthreads();
    f32x4 acc[2][3];
#pragma unroll
    for (int a = 0; a < 2; ++a)
#pragma unroll
      for (int n = 0; n < 3; ++n) acc[a][n] = (f32x4){0.f, 0.f, 0.f, 0.f};
    u32x4 qrA[4], krA[2][2], vrA = (u32x4){0u, 0u, 0u, 0u}, qrB[4], krB[2][2], vrB = (u32x4){0u, 0u, 0u, 0u};
    float wsA = 0.f, wsB = 0.f; f32x4 ivA = (f32x4){0.f, 0.f, 0.f, 0.f}, ivB = ivA;
#define M2_LOAD(qreg, kreg, vreg, wsr, ivr, c) do { const int tk_ = b * SEQ + 64 * (c); \
      _Pragma("unroll") for (int i = 0; i < 4; ++i) { const int idx = i * 512 + tdx, row = idx >> 5, c16 = idx & 31; qreg[i] = *(const u32x4*)(Q + (size_t)(tk_ + row) * MW + 256 * h + 8 * c16); } \
      _Pragma("unroll") for (int i = 0; i < 2; ++i) { const size_t go = (size_t)(tk_ + 2 * sp) * MW + 256 * h + 8 * (cq + 16 * i); kreg[i][0] = *(const u32x4*)(Kb + go); kreg[i][1] = *(const u32x4*)(Kb + go + MW); } \
      vreg = *(const u32x4*)(V + (size_t)(tk_ + lane) * MW + 256 * h + dv0 + 8 * (w & 3)); \
      wsr = TW[(c) * 64 + lane]; \
      ivr = *(const f32x4*)(TI + (c) * 64 + 16 * (w & 3) + 4 * gq); } while (0)
#define M2_AMMA(mi, nt) \
        f32x4 a2 = (f32x4){0.f, 0.f, 0.f, 0.f}; \
        _Pragma("unroll") for (int ks = 0; ks < 8; ++ks) { \
          const bf16x8 a = *(const LAS bf16x8*)(QS + (16 * (mi) + r) * 528 + (32 * ks + 8 * gq) * 2); \
          const bf16x8 bb = *(const LAS bf16x8*)(CT + (16 * (nt) + r) * 528 + (32 * ks + 8 * gq) * 2); \
          a2 = __builtin_amdgcn_mfma_f32_16x16x32_bf16(a, bb, a2, 0, 0, 0); }
#define M2_ATILE_H(mi, nt, tok0, ivr) do { M2_AMMA(mi, nt) \
        _Pragma("unroll") for (int j = 0; j < 4; ++j) { const int l = 16 * (mi) + 4 * gq + j; \
          HNE[(size_t)((tok0) + l) * MW + 256 * h + dv0 + 16 * (nt) + r] = (bf16_t)f2bf(a2[j] * ivr[j]); } } while (0)
#define M2_ATILE_Q(mi, nt, tok0, ivr) do { M2_AMMA(mi, nt) \
        _Pragma("unroll") for (int j = 0; j < 4; ++j) { const int l = 16 * (mi) + 4 * gq + j; \
          float* qp = ((nt) == 2 && r == 0) ? (QN + (size_t)((tok0) + l) * 8 + h) : (DUMMY + tdx * 4 + j); *qp = a2[j] * ivr[j]; } } while (0)
#define M2_BODY(c, qreg, kreg, vreg, wsr, ivr) do { \
      int tdx = (int)threadIdx.x; asm volatile("" : "+v"(tdx)); \
      const int lane = tdx & 63, r = lane & 15, gq = lane >> 4, sp = tdx & 31, cq = tdx >> 5; \
      const int tok0 = b * SEQ + 64 * (c); \
      _Pragma("unroll") for (int i = 0; i < 4; ++i) { const int idx = i * 512 + tdx, row = idx >> 5, c16 = idx & 31; *(LAS u32x4*)(QS + row * 528 + c16 * 16) = qreg[i]; } \
      _Pragma("unroll") for (int i = 0; i < 2; ++i) { \
        const unsigned k0[4] = {kreg[i][0].x, kreg[i][0].y, kreg[i][0].z, kreg[i][0].w}, k1[4] = {kreg[i][1].x, kreg[i][1].y, kreg[i][1].z, kreg[i][1].w}; \
        _Pragma("unroll") for (int e = 0; e < 4; ++e) { const int dk = 8 * (cq + 16 * i) + 2 * e; \
          *(LAS unsigned*)(KT + dk * 144 + sp * 4) = (k0[e] & 0xffffu) | (k1[e] << 16); \
          *(LAS unsigned*)(KT + (dk + 1) * 144 + sp * 4) = (k0[e] >> 16) | (k1[e] & 0xffff0000u); } } \
      if (w < 4) { const unsigned vw[4] = {vreg.x, vreg.y, vreg.z, vreg.w}; \
        _Pragma("unroll") for (int e = 0; e < 4; ++e) { *(LAS bf16_t*)(WVT + (8 * w + 2 * e) * 144 + lane * 2) = (bf16_t)f2bf(bflo(vw[e]) * wsr); *(LAS bf16_t*)(WVT + (8 * w + 2 * e + 1) * 144 + lane * 2) = (bf16_t)f2bf(bfhi(vw[e]) * wsr); } \
      } else if (w == 4) { *(LAS bf16_t*)(WVT + 32 * 144 + lane * 2) = (bf16_t)f2bf(wsr); } \
      const f32x4 ivc = ivr; \
      { const int cn_ = ((c) + 2 < NCH) ? (c) + 2 : NCH - 1; M2_LOAD(qreg, kreg, vreg, wsr, ivr, cn_); } \
      LBAR(); \
      M2_ATILE_H(w & 3, w >> 2, tok0, ivc); \
      M2_ATILE_Q(w & 3, 2 + (w >> 2), tok0, ivc); \
      const float decay = TD[(c)]; \
      _Pragma("unroll") for (int mt = 0; mt < 2; ++mt) \
        _Pragma("unroll") for (int n2 = 0; n2 < 3; ++n2) { \
          f32x4 cacc = acc[mt][n2] * decay; \
          _Pragma("unroll") for (int ks = 0; ks < 2; ++ks) { \
            const bf16x8 a = *(const LAS bf16x8*)(KT + (32 * w + 16 * mt + r) * 144 + (32 * ks + 8 * gq) * 2); \
            const bf16x8 bb = *(const LAS bf16x8*)(WVT + (16 * n2 + r) * 144 + (32 * ks + 8 * gq) * 2); \
            cacc = __builtin_amdgcn_mfma_f32_16x16x32_bf16(a, bb, cacc, 0, 0, 0); } \
          acc[mt][n2] = cacc; } \
      LBAR(); \
      _Pragma("unroll") for (int mt = 0; mt < 2; ++mt) \
        _Pragma("unroll") for (int n2 = 0; n2 < 3; ++n2) { u32x2 q; q.x = pk2(acc[mt][n2][0], acc[mt][n2][1]); q.y = pk2(acc[mt][n2][2], acc[mt][n2][3]); \
          *(LAS u32x2*)(CT + (16 * n2 + r) * 528 + (32 * w + 16 * mt + 4 * gq) * 2) = q; } \
    } while (0)
    { const int tdx = F.tid, sp = tdx & 31, cq = tdx >> 5, gq = (tdx & 63) >> 4;
      M2_LOAD(qrA, krA, vrA, wsA, ivA, 0);
      M2_LOAD(qrB, krB, vrB, wsB, ivB, 1); }
    __syncthreads();
#pragma unroll 1
    for (int c = 0; c < NCH; c += 2) {
      M2_BODY(c, qrA, krA, vrA, wsA, ivA);
      M2_BODY(c + 1, qrB, krB, vrB, wsB, ivB);
    }
#undef M2_BODY
#undef M2_ATILE_H
#undef M2_ATILE_Q
#undef M2_AMMA
#undef M2_LOAD
    __syncthreads();
  }
}

__device__ __forceinline__ void phase_ragg(const Frame& F) {
  unsigned char* ws = F.ws;
  const float* RA = (const float*)(ws + WS_RA); const bf16_t* RBb = (const bf16_t*)(ws + WS_RB);
  float* AGGA = (float*)(ws + WS_SMALL + SM_AGGA); float* AGGB = (float*)(ws + WS_SMALL + SM_AGGB);
  const int gt = F.bid * 512 + F.tid, NGT = F.G * 512;
  const int per = (2 * NCH * (RW / 2) + F.G - 1) / F.G;
#pragma unroll 1
  for (int i2 = F.tid; i2 < per; i2 += 512) {
    const int it = F.bid * per + i2; if (it >= 2 * NCH * (RW / 2)) break;
    const int bc = it / (RW / 2), ch = 2 * (it - bc * (RW / 2));
    const float* pa = RA + (size_t)bc * 64 * RW + ch; const bf16_t* pb = RBb + (size_t)bc * 64 * RW + ch;
    float A0 = 1.f, B0 = 0.f, A1 = 1.f, B1 = 0.f;
#pragma unroll 1
    for (int tb = 0; tb < 8; ++tb) {
      f32x2 a[8]; unsigned bb[8];
#pragma unroll
      for (int t = 0; t < 8; ++t) { a[t] = *(const f32x2*)(pa + (size_t)(tb * 8 + t) * RW); bb[t] = *(const unsigned*)(pb + (size_t)(tb * 8 + t) * RW); }
#pragma unroll
      for (int t = 0; t < 8; ++t) { A0 *= a[t][0]; B0 = a[t][0] * B0 + bflo(bb[t]); A1 *= a[t][1]; B1 = a[t][1] * B1 + bfhi(bb[t]); }
    }
    *(f32x2*)(AGGA + (size_t)bc * RW + ch) = (f32x2){A0, A1}; *(f32x2*)(AGGB + (size_t)bc * RW + ch) = (f32x2){B0, B1};
  }
}
__device__ __forceinline__ float gelu_fast(float x) {
  const float u = 0.7978845608028654f * (x + 0.044715f * x * x * x); return x * __builtin_amdgcn_rcpf(1.0f + __expf(-2.0f * u)); }
__device__ __forceinline__ void phase_rscan(const Frame& F) {
  unsigned char* ws = F.ws;
  const float* RA = (const float*)(ws + WS_RA); const bf16_t* RBb = (const bf16_t*)(ws + WS_RB);
  const float* AGGA = (const float*)(ws + WS_SMALL + SM_AGGA); const float* AGGB = (const float*)(ws + WS_SMALL + SM_AGGB);
  const bf16_t* PROJ = (const bf16_t*)(ws + WS_PROJ); bf16_t* YR = (bf16_t*)(ws + WS_YR);
  const int gt = F.bid * 512 + F.tid, NGT = F.G * 512;
#define RS_LD(a, bb, xg, tb) do { _Pragma("unroll") for (int t = 0; t < 8; ++t) { const size_t o = (size_t)(t0 + (tb) * 8 + t) * RW + ch; \
      a[t] = __builtin_nontemporal_load((const f32x2*)(RA + o)); bb[t] = __builtin_nontemporal_load((const unsigned*)(RBb + o)); \
      xg[t] = __builtin_nontemporal_load((const unsigned*)(PROJ + (size_t)(t0 + (tb) * 8 + t) * INC + O_XG + ch)); } } while (0)
#define RS_DO(a, bb, xg, tb) do { _Pragma("unroll") for (int t = 0; t < 8; ++t) { h0 = a[t][0] * h0 + bflo(bb[t]); h1 = a[t][1] * h1 + bfhi(bb[t]); \
      *(unsigned*)(YR + (size_t)(t0 + (tb) * 8 + t) * RW + ch) = pk2(h0 * gelu_fast(bflo(xg[t])), h1 * gelu_fast(bfhi(xg[t]))); } } while (0)
#define RS_CLD(ca, cb, c0) do { _Pragma("unroll") for (int k = 0; k < 8; ++k) { const int cc = (c0) + k; const int j = (b * NCH + (cc < cidx ? cc : 0)) * RW + ch; ca[k] = *(const f32x2*)(AGGA + j); cb[k] = *(const f32x2*)(AGGB + j); } } while (0)
#define RS_CDO(ca, cb, c0) do { _Pragma("unroll") for (int k = 0; k < 8; ++k) { if ((c0) + k < cidx) { h0 = ca[k][0] * h0 + cb[k][0]; h1 = ca[k][1] * h1 + cb[k][1]; } } } while (0)
  const int per = (2 * NCH * (RW / 2) + F.G - 1) / F.G;
  for (int i2 = F.tid; i2 < per; i2 += 512) {
    const int it = F.bid * per + i2; if (it >= 2 * NCH * (RW / 2)) break;
    const int bc = it / (RW / 2), ch = 2 * (it % (RW / 2)), t0 = bc * 64, b = bc / NCH, cidx = bc % NCH;
    float h0 = 0.f, h1 = 0.f;
    f32x2 aA[8], aB[8]; unsigned bA[8], bB[8], xA[8], xB[8];
    RS_LD(aA, bA, xA, 0);
    {
      f32x2 caA[8], cbA[8], caB[8], cbB[8];
      RS_CLD(caA, cbA, 0);
      for (int c0 = 0; c0 < cidx; c0 += 16) {
        RS_CLD(caB, cbB, c0 + 8);
        RS_CDO(caA, cbA, c0);
        RS_CLD(caA, cbA, c0 + 16);
        RS_CDO(caB, cbB, c0 + 8);
      }
    }
#pragma unroll
    for (int tb = 0; tb < 8; tb += 2) {
      RS_LD(aB, bB, xB, tb + 1);
      RS_DO(aA, bA, xA, tb);
      if (tb + 2 < 8) RS_LD(aA, bA, xA, tb + 2);
      RS_DO(aB, bB, xB, tb + 1);
    }
  }
#undef RS_LD
#undef RS_DO
#undef RS_CLD
#undef RS_CDO
}

__device__ __forceinline__ void phase_ym(const Frame& F) {
  unsigned char* ws = F.ws;
  const bf16_t* HNI = (const bf16_t*)(ws + WS_HNI); const bf16_t* HNE = (const bf16_t*)(ws + WS_HNE);
  const float* EMR = (const float*)(ws + WS_SMALL + SM_EMR); const float* DENI = (const float*)(ws + WS_SMALL + SM_DENI); const float* QN = (const float*)(ws + WS_SMALL + SM_QN);
  const bf16_t* XCM = (const bf16_t*)(ws + WS_XCM); const bf16_t* PROJ = (const bf16_t*)(ws + WS_PROJ); bf16_t* YM = (bf16_t*)(ws + WS_YM);
  const float* normw = F.in[10]; const float* skip = F.in[11];
  const int gw = F.bid * 8 + F.wave, NGW = F.G * 8, lane = F.lane;
  for (int tA = gw; tA < NTOK; tA += 2 * NGW) {
    const int tBr = tA + NGW; const bool okB = tBr < NTOK; const int tB = okB ? tBr : tA;
    u32x2 a[2][8], e[2][8], xcw[2][8], zw[2][8]; float den[2][8], emr[2][8];
#pragma unroll
    for (int u = 0; u < 2; ++u) { const int t = u ? tB : tA;
#pragma unroll
      for (int h = 0; h < 8; ++h) {
        const size_t o = (size_t)t * MW + 256 * h + 4 * lane;
        a[u][h] = __builtin_nontemporal_load((const u32x2*)(HNI + o)); e[u][h] = __builtin_nontemporal_load((const u32x2*)(HNE + o)); xcw[u][h] = __builtin_nontemporal_load((const u32x2*)(XCM + o));
        zw[u][h] = __builtin_nontemporal_load((const u32x2*)(PROJ + (size_t)t * INC + O_Z + 256 * h + 4 * lane));
        den[u][h] = DENI[t * 8 + h] + QN[t * 8 + h]; emr[u][h] = EMR[t * 8 + h];
      } }
#pragma unroll
    for (int u = 0; u < 2; ++u) { const int t = u ? tB : tA;
      if (u == 0 || okB) {
#pragma unroll
      for (int h = 0; h < 8; ++h) {
        const int col = 256 * h + 4 * lane;
        const float inv = 1.0f / fmaxf(fabsf(den[u][h]), emr[u][h]);
        const float hv[4] = {(bflo(a[u][h].x) + bflo(e[u][h].x)) * inv, (bfhi(a[u][h].x) + bfhi(e[u][h].x)) * inv, (bflo(a[u][h].y) + bflo(e[u][h].y)) * inv, (bfhi(a[u][h].y) + bfhi(e[u][h].y)) * inv};
        const float mean = wave_sum((hv[0] + hv[1]) + (hv[2] + hv[3])) * (1.0f / 256.0f);
        float d[4]; float s2 = 0.f;
#pragma unroll
        for (int j = 0; j < 4; ++j) { d[j] = hv[j] - mean; s2 += d[j] * d[j]; }
        const float rstd = rsqrtf(wave_sum(s2) * (1.0f / 256.0f) + LN_EPS);
        const f32x4 nw = *(const f32x4*)(normw + col), sk = *(const f32x4*)(skip + col);
        const float xc[4] = {bflo(xcw[u][h].x), bfhi(xcw[u][h].x), bflo(xcw[u][h].y), bfhi(xcw[u][h].y)}, z[4] = {bflo(zw[u][h].x), bfhi(zw[u][h].x), bflo(zw[u][h].y), bfhi(zw[u][h].y)};
        float y[4];
#pragma unroll
        for (int j = 0; j < 4; ++j) y[j] = (d[j] * rstd * nw[j] + sk[j] * xc[j]) * siluf_(z[j]);
        u32x2 w; w.x = pk2(y[0], y[1]); w.y = pk2(y[2], y[3]); *(u32x2*)(YM + (size_t)t * RW + col) = w;
      } }
    }
  }
}

__device__ __forceinline__ void phase_ln_router(const Frame& F) {
  unsigned char* ws = F.ws;
  float* X1 = (float*)(ws + WS_X1); unsigned char* X1Q = ws + WS_X1B;
  int* CNT = (int*)(ws + WS_CTL); int* LIST = (int*)(ws + WS_LIST); float* LISTW = (float*)(ws + WS_LISTW); int* TOKES = (int*)(ws + WS_TOKES);
  const float* g1 = F.in[22]; const float* b1 = F.in[23]; const float* rw = F.in[24]; const float* rbias = F.in[25];
  LAS unsigned char* XH = F.lds; LAS unsigned char* XL = F.lds + 65792;
  const bf16_t* RWH = (const bf16_t*)(ws + WS_SMALL + SM_RWH); const bf16_t* RWL = (const bf16_t*)(ws + WS_SMALL + SM_RWL);
  const int w = F.wave;
  LAS int* lcnt = (LAS int*)(F.lds + LDS_X + 8192); LAS int* lbase = lcnt + 64;
  for (int tp = F.bid; tp < NTOK / 32; tp += F.G) {
  int lslot[2][2], rnk[2][2]; float wg[2][2];
  if (F.tid < 64) lcnt[F.tid] = 0;
#pragma unroll
  for (int kt = 0; kt < 2; ++kt) {
    const int tile = 2 * tp + kt;
    const int t0 = tile * 16;
    int lane = F.lane; asm volatile("" : "+v"(lane));
    const int r16 = lane & 15, gq = lane >> 4;
    f32x4 vq[2][8];
#pragma unroll
    for (int q = 0; q < 2; ++q)
#pragma unroll
      for (int j = 0; j < 8; ++j) vq[q][j] = *(const f32x4*)(X1 + (size_t)(t0 + 2 * w + q) * DM + 4 * lane + 256 * j);
#pragma unroll
    for (int q = 0; q < 2; ++q) {
      const int tl = 2 * w + q, t = t0 + tl;
      float* xr = X1 + (size_t)t * DM;
      f32x4 v[8]; float s = 0.f;
#pragma unroll
      for (int j = 0; j < 8; ++j) { v[j] = vq[q][j]; s += (v[j][0] + v[j][1]) + (v[j][2] + v[j][3]); }
      const float mean = wave_sum(s) * (1.0f / DM); float s2 = 0.f;
#pragma unroll
      for (int j = 0; j < 8; ++j) { v[j] = v[j] - mean; s2 += (v[j][0] * v[j][0] + v[j][1] * v[j][1]) + (v[j][2] * v[j][2] + v[j][3] * v[j][3]); }
      const float rstd = rsqrtf(wave_sum(s2) * (1.0f / DM) + LN_EPS);
#pragma unroll
      for (int j = 0; j < 8; ++j) {
        const int col = 4 * lane + 256 * j;
        const f32x4 gg = *(const f32x4*)(g1 + col), bb = *(const f32x4*)(b1 + col);
        const f32x4 o = v[j] * rstd * gg + bb;
        *(f32x4*)(xr + col) = o;
        u32x2 pw; pw.x = pk2(o[0], o[1]); pw.y = pk2(o[2], o[3]);
        { int q8 = 0; q8 = __builtin_amdgcn_cvt_pk_fp8_f32(o[0], o[1], q8, false); q8 = __builtin_amdgcn_cvt_pk_fp8_f32(o[2], o[3], q8, true); *(int*)(X1Q + (size_t)t * DM + col) = q8; }
        { float lo[4];
#pragma unroll
          for (int e = 0; e < 4; ++e) lo[e] = o[e] - __uint_as_float(f2bf(o[e]) << 16);
          *(LAS u32x2*)(XH + tl * 4112 + col * 2) = pw; u32x2 lw; lw.x = pk2(lo[0], lo[1]); lw.y = pk2(lo[2], lo[3]); *(LAS u32x2*)(XL + tl * 4112 + col * 2) = lw; }
      }
    }
    __syncthreads();
    f32x4 lacc[4];
    {
      const bf16_t* rh = RWH + (size_t)r16 * DM + 256 * w + 8 * gq; const bf16_t* rl = RWL + (size_t)r16 * DM + 256 * w + 8 * gq;
      const LAS unsigned char* xh = XH + r16 * 4112 + (256 * w + 8 * gq) * 2; const LAS unsigned char* xl = XL + r16 * 4112 + (256 * w + 8 * gq) * 2;
#define RT_LD(bh, bl, bidx) do { const int nt_ = (bidx) >> 1, kh_ = (bidx) & 1; _Pragma("unroll") for (int k2 = 0; k2 < 4; ++k2) { \
        bh[k2] = *(const bf16x8*)(rh + (size_t)(16 * nt_) * DM + 32 * (4 * kh_ + k2)); bl[k2] = *(const bf16x8*)(rl + (size_t)(16 * nt_) * DM + 32 * (4 * kh_ + k2)); } } while (0)
#define RT_MM(bh, bl, bidx) do { const int kh_ = (bidx) & 1; _Pragma("unroll") for (int k2 = 0; k2 < 4; ++k2) { \
        const bf16x8 ah = *(const LAS bf16x8*)(xh + 64 * (4 * kh_ + k2)); const bf16x8 al = *(const LAS bf16x8*)(xl + 64 * (4 * kh_ + k2)); \
        a4 = __builtin_amdgcn_mfma_f32_16x16x32_bf16(ah, bh[k2], a4, 0, 0, 0); a4 = __builtin_amdgcn_mfma_f32_16x16x32_bf16(al, bh[k2], a4, 0, 0, 0); \
        a4 = __builtin_amdgcn_mfma_f32_16x16x32_bf16(ah, bl[k2], a4, 0, 0, 0); } } while (0)
      bf16x8 bhA[4], blA[4], bhB[4], blB[4];
      RT_LD(bhA, blA, 0);
#pragma unroll
      for (int nt = 0; nt < 4; ++nt) {
        f32x4 a4 = (f32x4){0.f, 0.f, 0.f, 0.f};
        RT_LD(bhB, blB, 2 * nt + 1);
        RT_MM(bhA, blA, 2 * nt);
        asm volatile("" ::: "memory");
        if (nt < 3) RT_LD(bhA, blA, 2 * nt + 2);
        RT_MM(bhB, blB, 2 * nt + 1);
        asm volatile("" ::: "memory");
        lacc[nt] = a4;
      }
#undef RT_LD
#undef RT_MM
    }
    __syncthreads();
    LAS float* PART = (LAS float*)F.lds;
#pragma unroll
    for (int nt = 0; nt < 4; ++nt)
#pragma unroll
      for (int j = 0; j < 4; ++j) PART[(w * 16 + 4 * gq + j) * 64 + 16 * nt + r16] = lacc[nt][j];
    __syncthreads();
#pragma unroll
    for (int q = 0; q < 2; ++q) {
      const int tl = 2 * w + q;
      float logit = 0.f;
#pragma unroll
      for (int ww = 0; ww < 8; ++ww) logit += PART[(ww * 16 + tl) * 64 + lane];
      const float score = 1.0f / (1.0f + expf(-logit));
      const float biased = score + rbias[lane];
      int cnt = 0;
#pragma unroll
      for (int d = 1; d < 8; ++d) { const int other = (lane & ~7) | ((lane + d) & 7); const float ov = __shfl(biased, other); cnt += (ov > biased || (ov == biased && other < lane)) ? 1 : 0; }
      float gs = cnt < 2 ? biased : 0.f;
      gs += __shfl_xor(gs, 1); gs += __shfl_xor(gs, 2); gs += __shfl_xor(gs, 4);
      const int gi = lane >> 3; int grank = 0;
#pragma unroll
      for (int gg = 0; gg < 8; ++gg) { const float og = __shfl(gs, 8 * gg); grank += (og > gs || (og == gs && gg < gi)) ? 1 : 0; }
      const float val = grank < 4 ? biased : -INFINITY;
      int erank = 0;
      for (int e2 = 0; e2 < 64; ++e2) { const float ov = __shfl(val, e2); erank += (ov > val || (ov == val && e2 < lane)) ? 1 : 0; }
      const bool chosen = erank < 8;
      const float wsum = wave_sum(chosen ? score : 0.f);
      rnk[kt][q] = erank; wg[kt][q] = score / wsum * 2.5f; lslot[kt][q] = -1;
      if (chosen) lslot[kt][q] = atomicAdd((int*)(lcnt + lane), 1);
    }
    __syncthreads();
  }
    if (F.tid < 64) { const int c = lcnt[F.tid]; lbase[F.tid] = c ? atomicAdd(&CNT[F.tid * 64], c) : 0; }
    __syncthreads();
    { const int lane = F.lane;
#pragma unroll
    for (int kt = 0; kt < 2; ++kt)
#pragma unroll
      for (int q = 0; q < 2; ++q) {
        if (lslot[kt][q] >= 0) { const int t = (2 * tp + kt) * 16 + 2 * w + q; const int slot = lbase[lane] + lslot[kt][q];
          LIST[lane * NTOK + slot] = t; LISTW[lane * NTOK + slot] = wg[kt][q]; TOKES[t * 8 + rnk[kt][q]] = (lane << 16) | slot; }
      } }
    __syncthreads();
  }
}

__device__ __forceinline__ MoeTab build_moe_tab(const Frame& F) {
  LAS int* tp = (LAS int*)(F.lds + LDS_X); LAS int* cp = tp + 68; LAS int* cn = tp + 136;
  const int* CNT = (const int*)(F.ws + WS_CTL);
  if (F.tid == 0) { int a = 0, b = 0; for (int e = 0; e < NE; ++e) { const int c = CNT[e * 64]; tp[e] = a; cp[e] = b; cn[e] = c; a += (c + 255) >> 8; b += c; } tp[NE] = a; cp[NE] = b; }
  __syncthreads();
  { LAS int* rt = tp + 256; if (F.tid < 384) { int e = 0; for (int k = 0; k < NE; ++k) { if (tp[k + 1] <= F.tid) e = k + 1; } rt[F.tid] = e < NE ? e : NE - 1; } }
  __syncthreads();
  MoeTab T; T.tp = tp; T.cp = cp; T.cnt = cn; T.n_rt = __builtin_amdgcn_readfirstlane(tp[NE]);
  return T;
}

__device__ __forceinline__ void phase_final(const Frame& F, const MoeTab& T) {
  unsigned char* ws = F.ws;
  const bf16_t* YRM = (const bf16_t*)(ws + WS_YRM); const int* TOKES = (const int*)(ws + WS_TOKES);
  const float* g2 = F.in[32]; const float* b2 = F.in[33];
  const int gw = F.bid * 8 + F.wave, NGW = F.G * 8, lane = F.lane;
  for (int t = gw; t < NTOK; t += NGW) {
    float* orow = F.out + (size_t)t * DM;
    f32x4 v[8];
    { const float* xrow = (const float*)(ws + WS_X1) + (size_t)t * DM; const bf16_t* ys = YRM + (size_t)(NTOK * 8 + t) * DM;
#pragma unroll
      for (int j = 0; j < 8; ++j) { const u32x2 wv = __builtin_nontemporal_load((const u32x2*)(ys + 4 * lane + 256 * j)); v[j] = *(const f32x4*)(xrow + 4 * lane + 256 * j) * ALPHA; v[j][0] += bflo(wv.x); v[j][1] += bfhi(wv.x); v[j][2] += bflo(wv.y); v[j][3] += bfhi(wv.y); } }
    const int esl = TOKES[t * 8 + (lane & 7)];
#pragma unroll
    for (int kb = 0; kb < 2; ++kb) {
      u32x2 yv[4][8];
#pragma unroll
      for (int k = 0; k < 4; ++k) {
        const int es = __shfl(esl, kb * 4 + k); const int e = es >> 16, slot = es & 0xffff;
        const bf16_t* yr = YRM + (size_t)(T.cp[e] + slot) * DM;
#pragma unroll
        for (int j = 0; j < 8; ++j) yv[k][j] = __builtin_nontemporal_load((const u32x2*)(yr + 4 * lane + 256 * j));
      }
#pragma unroll
      for (int k = 0; k < 4; ++k)
#pragma unroll
        for (int j = 0; j < 8; ++j) { v[j][0] += bflo(yv[k][j].x); v[j][1] += bfhi(yv[k][j].x); v[j][2] += bflo(yv[k][j].y); v[j][3] += bfhi(yv[k][j].y); }
    }
    float s = 0.f;
#pragma unroll
    for (int j = 0; j < 8; ++j) s += (v[j][0] + v[j][1]) + (v[j][2] + v[j][3]);
    const float mean = wave_sum(s) * (1.0f / DM); float s2 = 0.f;
#pragma unroll
    for (int j = 0; j < 8; ++j) { v[j] = v[j] - mean; s2 += (v[j][0] * v[j][0] + v[j][1] * v[j][1]) + (v[j][2] * v[j][2] + v[j][3] * v[j][3]); }
    const float rstd = rsqrtf(wave_sum(s2) * (1.0f / DM) + LN_EPS);
#pragma unroll
    for (int j = 0; j < 8; ++j) { const int col = 4 * lane + 256 * j; const f32x4 gg = *(const f32x4*)(g2 + col), bb = *(const f32x4*)(b2 + col); *(f32x4*)(orow + col) = v[j] * rstd * gg + bb; }
  }
}

__global__ void __launch_bounds__(512, 2) fwd_megakernel(Params p, int ph_lo, int ph_hi) {
  extern __shared__ __attribute__((aligned(16))) unsigned char lds_raw[];
  Frame F;
  F.lds = (LAS unsigned char*)lds_raw; F.tid = threadIdx.x; F.lane = F.tid & 63; F.wave = __builtin_amdgcn_readfirstlane(F.tid >> 6);
  F.G = gridDim.x; F.bid = blockIdx.x; F.ws = as_global(p.ws); F.in = InPtrs{p.in}; F.out = as_global(p.out);
  unsigned char* ws = as_global(p.ws);
#ifndef PHMASK
#define PHMASK 0xFFF
#endif
#define IN(k) (((PHMASK >> (k)) & 1) && ph_lo <= (k) && (k) < ph_hi)
#ifndef RPTMASK
#define RPTMASK 0
#endif
#define RPT(k) for (int _rp = 0; _rp < 1 + ((RPTMASK >> (k)) & 1); ++_rp)
#define FRESH() do { unsigned char* w2_ = opaque_global(p.ws); ws = w2_; F.ws = w2_; int l2_ = (int)__builtin_amdgcn_mbcnt_hi(~0u, __builtin_amdgcn_mbcnt_lo(~0u, 0u)); asm volatile("" : "+v"(l2_)); F.lane = l2_; F.tid = F.wave * 64 + l2_; } while (0)
#define SYNC(k) do { if (IN(k) && IN((k) + 1)) { xcd_barrier(xbar); } } while (0)
  { volatile LAS unsigned* st = (volatile LAS unsigned*)(F.lds + LDS_X + 4096); if (F.tid < 4) st[F.tid] = 0u; }
  __syncthreads();
  const XcdBarrier xbar = xcd_barrier_post((unsigned*)(ws + WS_CTL + 16384), (volatile LAS unsigned*)(F.lds + LDS_X + 4096));

  FRESH();
  if (IN(0)) RPT(0) { if (_rp) xcd_barrier(xbar); phase_prologue(F); }
  SYNC(0);
  FRESH();
  if (IN(1)) RPT(1) { if (_rp) xcd_barrier(xbar);
    SchedDense S{(const char*)(ws + WS_XB), (const char*)(ws + WS_WIN), NTOK / 256, INC / 256, F.G, F.bid, DM, DM, DM / 64};
    EpiStoreBf16 E{(bf16_t*)(ws + WS_PROJ), INC};
    pg8::gemm_phase<EpiStoreBf16, SchedDense, false>(F.lds, DM, DM, S, E);
    { const int nb = defer1_blocks(F.G), first = F.G - nb;
      if (nb && F.bid >= first) { const int base = T_NITEMS - defer1_count(F.G) - defer3_count(F.G); tile_range(F, base + (F.bid - first), nb, base + defer1_count(F.G)); } }
  }
  SYNC(1);
  FRESH();
  if (IN(2)) RPT(2) { if (_rp) xcd_barrier(xbar); phase_mprep(F); phase_rconv(F); }
  SYNC(2);
  FRESH();
  if (IN(3)) RPT(3) { if (_rp) xcd_barrier(xbar);
    const int nm2 = F.G >> 1;
    if (F.bid < nm2) phase_m2(F, nm2);
    else {
      const int bid2 = F.bid - nm2, G2 = F.G - nm2;
      phase_m1(F, bid2, G2);
      int Kr = 4; asm volatile("" : "+s"(Kr));
      SchedRglru S{(const char*)(ws + WS_XCR), (const char*)(ws + WS_WRAX), G2, bid2, Kr};
      EpiRglru E{(const bf16_t*)(ws + WS_XCR), p.in[15], p.in[17], (const float*)(ws + WS_SMALL + SM_C8), (float*)(ws + WS_RA), (bf16_t*)(ws + WS_RB)};
      pg8::gemm_phase<EpiRglru, SchedRglru, false>(F.lds, RW, 256, S, E);
      { const int base = T_NITEMS - defer3_count(F.G); if (defer3_count(F.G)) tile_range(F, base + bid2, G2, T_NITEMS); }
    }
  }
  SYNC(3);
  FRESH();
  if (IN(4)) RPT(4) { if (_rp) xcd_barrier(xbar); phase_ragg(F); phase_ym(F); }
  SYNC(4);
  FRESH();
  if (IN(5)) RPT(5) { if (_rp) xcd_barrier(xbar); phase_rscan(F); }
  SYNC(5);
  FRESH();
  if (IN(6)) RPT(6) { if (_rp) xcd_barrier(xbar);
    SchedMerge S{(const char*)(ws + WS_YM), (const char*)(ws + WS_YR), (const char*)(ws + WS_WPM), (const char*)(ws + WS_WPR), F.G, F.bid};
    EpiMergeF E{(const bf16_t*)(ws + WS_PROJ), p.in[2], (bf16_t*)(ws + WS_MERGED)};
    pg8::gemm_phase<EpiMergeF, SchedMerge, false>(F.lds, RW, RW, S, E);
  }
  SYNC(6);
  FRESH();
  if (IN(7)) RPT(7) { if (_rp) xcd_barrier(xbar);
    SchedDense S{(const char*)(ws + WS_MERGED), (const char*)(ws + WS_WO), NTOK / 256, DM / 256, F.G, F.bid, DM, DM, DM / 64};
    EpiWo E{p.in[0], (float*)(ws + WS_X1)};
    pg8::gemm_phase<EpiWo, SchedDense, false>(F.lds, DM, DM, S, E);
  }
  SYNC(7);
  FRESH();
  if (IN(8)) phase_ln_router(F);
  SYNC(8);
  FRESH();
  if (IN(9)) RPT(9) { if (_rp) xcd_barrier(xbar);
    const MoeTab T = build_moe_tab(F);
    SchedMoe<4, 1> S{T, (const int*)(ws + WS_LIST), (const char*)(ws + WS_X1B), (const char*)(ws + WS_WEGU), (const char*)(ws + WS_WSGU), F.G, F.bid, DM / 128};
    EpiMoe1 E{ws + WS_HMOE};
    pg8::gemm_phase<EpiMoe1, SchedMoe<4, 1>, true>(F.lds, DM / 2, DM / 2, S, E);
  }
  SYNC(9);
  FRESH();
  if (IN(10)) RPT(10) { if (_rp) xcd_barrier(xbar);
    const MoeTab T = build_moe_tab(F);
    int nt2 = DE / 128; asm volatile("" : "+s"(nt2));
    SchedMoe<8, 2> S{T, (const int*)(ws + WS_LIST), (const char*)(ws + WS_HMOE), (const char*)(ws + WS_WED), (const char*)(ws + WS_WSD), F.G, F.bid, nt2};
    EpiMoe2 E{(bf16_t*)(ws + WS_YRM), (const float*)(ws + WS_LISTW), (bf16_t*)(ws + WS_WIN)};
    pg8::gemm_phase<EpiMoe2, SchedMoe<8, 2>, false>(F.lds, DE / 2, DE / 2, S, E);
  }
  SYNC(10);
  FRESH();
  if (IN(11)) { const MoeTab T = build_moe_tab(F); phase_final(F, T); }
#undef IN
#undef SYNC
}

#ifndef N_LAUNCH_SPLIT
#define N_LAUNCH_SPLIT 0
#endif
extern "C" void kernel_launch(void* const* d_in, const int* in_sizes, int n_in, void* d_out, int out_size, void* d_ws, size_t ws_size, hipStream_t stream) {
  static int grid_blocks = 0;
  if (grid_blocks == 0) {
    int dev = 0, cus = 0, per_cu = 0;
    (void)hipGetDevice(&dev);
    (void)hipDeviceGetAttribute(&cus, hipDeviceAttributeMultiprocessorCount, dev);
    (void)hipFuncSetAttribute((const void*)fwd_megakernel, hipFuncAttributeMaxDynamicSharedMemorySize, LDS_BYTES);
    (void)hipOccupancyMaxActiveBlocksPerMultiprocessor(&per_cu, fwd_megakernel, 512, LDS_BYTES);
    if (per_cu < 1) { fprintf(stderr, "kernel_launch: occupancy query says %d blocks per CU\n", per_cu); per_cu = 1; }
    grid_blocks = cus * per_cu;
    fprintf(stderr, "kernel_launch: cus %d per_cu %d grid %d ws_size %zu (need %zu) n_in %d\n", cus, per_cu, grid_blocks, ws_size, (size_t)WS_END, n_in);
    if (ws_size < WS_END || n_in != 34) { fprintf(stderr, "kernel_launch: workspace too small or unexpected inputs; nothing launched\n"); grid_blocks = -1; }
  }
  if (grid_blocks < 0) return;
  (void)hipMemsetAsync((char*)d_ws + WS_CTL, 0, 65536, stream);
  Params p{};
  for (int i = 0; i < 34; ++i) p.in[i] = (const float*)d_in[i];
  p.out = (float*)d_out; p.ws = (unsigned char*)d_ws;
#if N_LAUNCH_SPLIT
  for (int ph = 0; ph < 12; ++ph) { hipLaunchKernelGGL(fwd_megakernel, dim3(grid_blocks), dim3(512), LDS_BYTES, stream, p, ph, ph + 1); }
#else
  int lo = 0, hi = 12;
  void* args[] = {&p, &lo, &hi};
  hipError_t e = hipLaunchCooperativeKernel((void*)fwd_megakernel, dim3(grid_blocks), dim3(512), args, LDS_BYTES, stream);
  if (e != hipSuccess) fprintf(stderr, "cooperative launch failed: %s (grid %d)\n", hipGetErrorString(e), grid_blocks);
#endif
}
```

```cpp
#include <hip/hip_runtime.h>
#include <hip/hip_cooperative_groups.h>
#include <cstdio>
#include <cstdint>
namespace cg = cooperative_groups;

#define LAS __attribute__((address_space(3)))
typedef unsigned short bf16_t;
typedef short bf16x8 __attribute__((ext_vector_type(8)));
typedef float f32x4 __attribute__((ext_vector_type(4)));
typedef float f32x2 __attribute__((ext_vector_type(2)));
typedef unsigned u32x4 __attribute__((ext_vector_type(4)));
typedef unsigned u32x2 __attribute__((ext_vector_type(2)));
typedef int i32x8 __attribute__((ext_vector_type(8)));
typedef int i32x4 __attribute__((ext_vector_type(4)));

constexpr int NTOK = 8192, DM = 2048, SEQ = 4096, MW = 2048, RW = 2560, INC = 13312, NH = 8, HD = 256, NE = 64, DE = 512;
constexpr int O_Z = 2048, O_XR = 4096, O_XG = 6656, O_G0 = 9216, O_G1 = 11264;
constexpr float LN_EPS = 1e-5f;
constexpr float ALPHA = 1.189207115002721f;
constexpr int NCH = 64;

constexpr size_t MiB = 1u << 20;
constexpr size_t WS_CTL = 0;
constexpr size_t WS_WIN = 1 * MiB, WS_RB = 1 * MiB, WS_M2TAB = 41 * MiB;
constexpr size_t WS_WPM = 53 * MiB  , WS_WPR = 63 * MiB, WS_WO = 73 * MiB, WS_WRAX = 81 * MiB, WS_WSGU = 84 * MiB, WS_WSD = 1014 * MiB;
constexpr size_t WS_WEGU = 88 * MiB, WS_WED = 344 * MiB;
constexpr size_t WS_XB = 472 * MiB, WS_HNI = 472 * MiB, WS_HMOE = 472 * MiB;
constexpr size_t WS_PROJ = 504 * MiB;
constexpr size_t WS_YRM = 560 * MiB;
constexpr size_t WS_Q = 712 * MiB, WS_K = 744 * MiB, WS_V = 776 * MiB, WS_YM = 712 * MiB  , WS_YR = 752 * MiB;
constexpr size_t WS_XCM = 808 * MiB, WS_MERGED = 808 * MiB;
constexpr size_t WS_XCR = 840 * MiB;
constexpr size_t WS_SMALL = 880 * MiB;
constexpr size_t WS_RA = 886 * MiB, WS_T1 = 886 * MiB, WS_X1B = 886 * MiB  ;
constexpr size_t WS_LIST = 918 * MiB, WS_LISTW = 920 * MiB  , WS_TOKES = 923 * MiB;
constexpr size_t WS_X1 = 950 * MiB;
constexpr size_t WS_HNE = 966 * MiB;
constexpr size_t WS_END = 1016 * MiB;
constexpr size_t SM_IG = 0, SM_LF = 256 * 1024, SM_INTER = 512 * 1024, SM_EMR = 768 * 1024, SM_DENI = 1024 * 1024, SM_QN = 1280 * 1024;
constexpr size_t SM_WIFT = 1536 * 1024;
constexpr size_t SM_C8 = 1792 * 1024;
constexpr size_t SM_RWH = 4608 * 1024, SM_RWL = 4864 * 1024;
constexpr size_t SM_AGGA = 2 * MiB, SM_AGGB = 2 * MiB + 1310720;

constexpr int LDS_BYTES = 147456;
constexpr int LDS_X = 131072;

struct Params {
  const float* in[34];
  float* out;
  unsigned char* ws;
};

typedef __bf16 hbf2_t __attribute__((ext_vector_type(2)));
typedef float hf2_t __attribute__((ext_vector_type(2)));
__device__ __forceinline__ unsigned pk2(float lo, float hi) { const hf2_t f = {lo, hi}; return __builtin_bit_cast(unsigned, __builtin_convertvector(f, hbf2_t)); }
__device__ __forceinline__ unsigned f2bf(float f) { return pk2(f, 0.f) & 0xffffu; }
__device__ __forceinline__ float bflo(unsigned w) { return __uint_as_float(w << 16); }
__device__ __forceinline__ float bfhi(unsigned w) { return __uint_as_float(w & 0xffff0000u); }
__device__ __forceinline__ float bf1(bf16_t b) { return __uint_as_float(((unsigned)b) << 16); }
__device__ __forceinline__ float sigmoidf_(float x) { return 1.0f / (1.0f + __expf(-x)); }
__device__ __forceinline__ float siluf_(float x) { return x / (1.0f + __expf(-x)); }
__device__ __forceinline__ float gelu_tanh(float x) { const float u = 0.7978845608028654f * (x + 0.044715f * x * x * x); return 0.5f * x * (1.0f + tanhf(u)); }
__device__ __forceinline__ float wave_sum(float v) {
#pragma unroll
  for (int o = 1; o < 64; o <<= 1) v += __shfl_xor(v, o);
  return v;
}
__device__ __forceinline__ float wave_max(float v) {
#pragma unroll
  for (int o = 1; o < 64; o <<= 1) v = fmaxf(v, __shfl_xor(v, o));
  return v;
}
__device__ __forceinline__ float wave_scan_sum(float v, int lane) {
#pragma unroll
  for (int o = 1; o < 64; o <<= 1) { const float t = __shfl_up(v, o); if (lane >= o) v += t; }
  return v;
}
__device__ __forceinline__ float wave_scan_max(float v, int lane) {
#pragma unroll
  for (int o = 1; o < 64; o <<= 1) { const float t = __shfl_up(v, o); if (lane >= o) v = fmaxf(v, t); }
  return v;
}
#define LDS_WAIT() asm volatile("s_waitcnt lgkmcnt(0)" ::: "memory")
#define LBAR() do { asm volatile("s_waitcnt lgkmcnt(0)" ::: "memory"); __builtin_amdgcn_s_barrier(); asm volatile("" ::: "memory"); } while (0)

namespace pg8 {
constexpr int BM = 256, BK = 64, HALF = 128, HTB = HALF * BK * 2, NXCD = 8, WGM = 8;
__device__ __forceinline__ int lds_byte(int r, int c) { const int st = (r >> 4) * 2 + (c >> 5), rr = r & 15, cc = c & 31, ob = rr * 64 + cc * 2; return st * 1024 + (ob ^ (((ob >> 9) & 1) << 5)); }
__device__ __forceinline__ void stage_rc(int b, int& R, int& C) { const int st = b / 1024, sb = b % 1024, swz = sb ^ (((sb >> 9) & 1) << 5); R = (st >> 1) * 16 + swz / 64; C = (st & 1) * 32 + (swz % 64) / 2; }

__device__ __forceinline__ int perm32(int rho) { const int n = rho >> 4, i = rho & 15; return 8 * (i >> 2) + 4 * n + (i & 3); }
struct UnitG { const char* A; const char* B; int pm, pn, e, cnt, mt, row0, nt, keep; };

__device__ __forceinline__ bool dense_order(int i, int G, int c, int nM, int nN, int& pm, int& pn) {
  const int nwg = nM * nN; const long L = (long)i * G + c; if (L >= nwg) return false;
  int wgid = (int)L; { const int q = nwg / NXCD, r = nwg % NXCD, xcd = wgid % NXCD, off = wgid / NXCD; wgid = (xcd < r ? xcd * (q + 1) : r * (q + 1) + (xcd - r) * q) + off; }
  const int nig = WGM * nN, gid = wgid / nig, fm = gid * WGM, gsz = (nM - fm) < WGM ? (nM - fm) : WGM;
  pm = fm + ((wgid % nig) % gsz); pn = (wgid % nig) / gsz; return true;
}

template <class Epi, class Sched, bool GATHER>
__device__ __forceinline__ void gemm_phase(LAS unsigned char* lds, const int lda, const int ldb, const Sched& S, const Epi& E) {
  const int tid = threadIdx.x, wid = __builtin_amdgcn_readfirstlane(tid >> 6), lane = tid & 63, wr = wid >> 2, wc = wid & 3, fr = lane & 15, fq = lane >> 4;
  int Rr[2], Cc[2];
  unsigned voffB[2];
  unsigned vA[2][2];
  unsigned nvA[2][2];
#pragma unroll
  for (int i = 0; i < 2; ++i) { stage_rc(tid * 16 + i * 8192, Rr[i], Cc[i]); const int Rb = Epi::PERM ? ((Rr[i] & ~31) + perm32(Rr[i] & 31)) : Rr[i]; voffB[i] = (unsigned)(Rb * ldb + Cc[i]) * 2u; }
  const size_t kstep = (size_t)(BK * 2);
  const size_t hstepA = (size_t)HALF * lda * 2, hstepB = (size_t)HALF * ldb * 2;
  const unsigned ldsw = (unsigned)wid * 1024u;
  const int aoff = lds_byte(wr * 64 + fr, fq * 8), boff = lds_byte(wc * 32 + fr, fq * 8);
#define PG8_SA(b, h) (((b) * 2 + (h)) * HTB)
#define PG8_SB(b, h) ((4 + (b) * 2 + (h)) * HTB)
#define PG8_STAGE_B(bufoff, gbase) do { _Pragma("unroll") for (int _i = 0; _i < 2; ++_i) \
    __builtin_amdgcn_global_load_lds((const unsigned*)((const char*)(gbase) + voffB[_i]), (LAS unsigned*)(lds + (bufoff) + ldsw + _i * 8192), 16, 0, 0); } while (0)
#define PG8_STAGE_A(bufoff, gbase, h) do { _Pragma("unroll") for (int _i = 0; _i < 2; ++_i) { \
    const char* _p = GATHER ? ((const char*)(gbase) + vA[h][_i]) : ((const char*)(gbase) + (h) * hstepA + vA[0][_i]); \
    __builtin_amdgcn_global_load_lds((const unsigned*)_p, (LAS unsigned*)(lds + (bufoff) + ldsw + _i * 8192), 16, 0, 0); } } while (0)
#define PG8_LD8(p) __builtin_shufflevector(*(const LAS i32x4*)(p), *(const LAS i32x4*)((p) + 1024), 0, 1, 2, 3, 4, 5, 6, 7)
#define PG8_LO(x) __builtin_bit_cast(bf16x8, __builtin_shufflevector(x, x, 0, 1, 2, 3))
#define PG8_HI(x) __builtin_bit_cast(bf16x8, __builtin_shufflevector(x, x, 4, 5, 6, 7))
#define PG8_LDA(dst, b, h) do { _Pragma("unroll") for (int m = 0; m < 4; ++m) dst[m] = PG8_LD8(lds + PG8_SA(b, h) + aoff + m * 2048); } while (0)
#define PG8_LDB(dst, b, h) do { _Pragma("unroll") for (int n = 0; n < 2; ++n) dst[n] = PG8_LD8(lds + PG8_SB(b, h) + boff + n * 2048); } while (0)
#define PG8_MMA(ai, bj, At, Bt) do { __builtin_amdgcn_s_setprio(1); _Pragma("unroll") for (int m = 0; m < 4; ++m) _Pragma("unroll") for (int n = 0; n < 2; ++n) { \
    acc[ai][bj][m][n] = __builtin_amdgcn_mfma_f32_16x16x32_bf16(PG8_LO(Bt[n]), PG8_LO(At[m]), acc[ai][bj][m][n], 0, 0, 0); \
    acc[ai][bj][m][n] = __builtin_amdgcn_mfma_f32_16x16x32_bf16(PG8_HI(Bt[n]), PG8_HI(At[m]), acc[ai][bj][m][n], 0, 0, 0); } __builtin_amdgcn_s_setprio(0); } while (0)
#define PG8_MMA8(ai, bj, At, Bt) do { __builtin_amdgcn_s_setprio(1); _Pragma("unroll") for (int m = 0; m < 4; ++m) _Pragma("unroll") for (int n = 0; n < 2; ++n) \
    acc[ai][bj][m][n] = __builtin_amdgcn_mfma_scale_f32_16x16x128_f8f6f4(Bt[n], At[m], acc[ai][bj][m][n], 0, 0, 0, 0x7F7F7F7F, 0, 0x7F7F7F7F); __builtin_amdgcn_s_setprio(0); } while (0)
#define PG8_MM(ai, bj, At, Bt) do { if (Epi::FP8) PG8_MMA8(ai, bj, At, Bt); else PG8_MMA(ai, bj, At, Bt); } while (0)
#define PG8_WAIT_V(n) asm volatile("s_waitcnt vmcnt(" #n ")" ::: "memory")
#define PG8_WAIT_L(n) asm volatile("s_waitcnt lgkmcnt(" #n ")" ::: "memory")
#define PG8_BAR __builtin_amdgcn_s_barrier()
#define PG8_SCHED __builtin_amdgcn_sched_barrier(0)
  UnitG cur, nxt; int ui = 0;
  if (!S.next(0, cur)) return;
#pragma unroll
  for (int h = 0; h < 2; ++h)
#pragma unroll
    for (int i = 0; i < 2; ++i) {
      if (GATHER) vA[h][i] = (unsigned)(S.arow(cur, h * HALF + Rr[i]) * lda + Cc[i]) * 2u;
      else vA[h][i] = (unsigned)(Rr[i] * lda + Cc[i]) * 2u;
      nvA[h][i] = vA[h][i];
    }
  f32x4 acc[2][2][4][2];
#pragma unroll
  for (int a = 0; a < 2; ++a)
#pragma unroll
    for (int b = 0; b < 2; ++b)
#pragma unroll
      for (int m = 0; m < 4; ++m)
#pragma unroll
        for (int n = 0; n < 2; ++n) acc[a][b][m][n] = (f32x4){0.f, 0.f, 0.f, 0.f};
  i32x8 At[4], B0[2], B1[2];
  const char* cA = cur.A; const char* cB = cur.B;
  { const char* pB0 = cB; const char* pB1 = cB + hstepB; const char* pA0 = cA; const char* pB2 = cB + kstep; const char* pA1 = cA + kstep; const char* pB3 = cB + hstepB + kstep;
    asm volatile("" : "+s"(pB0), "+s"(pB1), "+s"(pA0), "+s"(pB2), "+s"(pA1), "+s"(pB3));
  PG8_STAGE_B(PG8_SB(0, 0), pB0); PG8_STAGE_B(PG8_SB(0, 1), pB1); PG8_STAGE_A(PG8_SA(0, 0), pA0, 0); PG8_STAGE_A(PG8_SA(0, 1), pA0, 1);
  if (wr == 1) PG8_BAR;
  PG8_WAIT_V(2); PG8_BAR;
  PG8_STAGE_B(PG8_SB(1, 0), pB2); PG8_STAGE_A(PG8_SA(1, 0), pA1, 0); PG8_STAGE_B(PG8_SB(1, 1), pB3); }
  PG8_WAIT_V(6); PG8_BAR;
  for (;;) {
    const bool has_next = S.next(ui + 1, nxt);
    const char* nA = has_next ? nxt.A : cA; const char* nB = has_next ? nxt.B : cB;
    if (GATHER) {
      if (has_next) {
#pragma unroll
        for (int h = 0; h < 2; ++h)
#pragma unroll
          for (int i = 0; i < 2; ++i) nvA[h][i] = (unsigned)(S.arow(nxt, h * HALF + Rr[i]) * lda + Cc[i]) * 2u;
      }
    }
    const int nt = cur.nt;
#pragma unroll 1
    for (int t = 0; t < nt; t += 2) {
      const bool last = (t == nt - 2);
      const char* a1 = cA + (size_t)(t + 1) * kstep;
      const char* a2 = last ? nA : cA + (size_t)(t + 2) * kstep; const char* b2 = last ? nB : cB + (size_t)(t + 2) * kstep;
      const char* a3 = a2 + kstep; const char* b3 = b2 + kstep;
      asm volatile("" : "+s"(a1), "+s"(a2), "+s"(a3), "+s"(b2), "+s"(b3));
      PG8_LDB(B0, 0, 0); PG8_LDB(B1, 0, 1); PG8_SCHED; PG8_LDA(At, 0, 0); PG8_STAGE_A(PG8_SA(1, 1), a1, 1);
      if (GATHER) { if (last) {
#pragma unroll
        for (int h = 0; h < 2; ++h)
#pragma unroll
          for (int i = 0; i < 2; ++i) vA[h][i] = nvA[h][i]; } }
      PG8_WAIT_V(8); PG8_WAIT_L(0); PG8_BAR; PG8_MM(0, 0, At, B0); PG8_MM(0, 1, At, B1); PG8_BAR; PG8_SCHED;
      PG8_LDA(At, 0, 1); PG8_STAGE_B(PG8_SB(0, 0), b2); PG8_STAGE_B(PG8_SB(0, 1), b2 + hstepB); PG8_STAGE_A(PG8_SA(0, 0), a2, 0);
      PG8_WAIT_V(8); PG8_WAIT_L(0); PG8_BAR; PG8_MM(1, 0, At, B0); PG8_MM(1, 1, At, B1); PG8_BAR; PG8_SCHED;
      PG8_LDB(B0, 1, 0); PG8_LDB(B1, 1, 1); PG8_SCHED; PG8_LDA(At, 1, 0); PG8_STAGE_A(PG8_SA(0, 1), a2, 1);
      PG8_WAIT_V(8); PG8_WAIT_L(0); PG8_BAR; PG8_MM(0, 0, At, B0); PG8_MM(0, 1, At, B1); PG8_BAR; PG8_SCHED;
      PG8_LDA(At, 1, 1); PG8_STAGE_B(PG8_SB(1, 0), b3); PG8_STAGE_B(PG8_SB(1, 1), b3 + hstepB); PG8_STAGE_A(PG8_SA(1, 0), a3, 0);
      PG8_WAIT_V(8); PG8_WAIT_L(0); PG8_BAR; PG8_MM(1, 0, At, B0); PG8_MM(1, 1, At, B1); PG8_BAR; PG8_SCHED;
    }
    if (wr == 0) PG8_BAR;
    { int l2 = (int)__builtin_amdgcn_mbcnt_hi(~0u, __builtin_amdgcn_mbcnt_lo(~0u, 0u)); asm volatile("" : "+v"(l2));
      E(acc, cur, wr, wc, l2 & 15, l2 >> 4); }
    if (!has_next) break;
    if (!cur.keep) {
#pragma unroll
      for (int a = 0; a < 2; ++a)
#pragma unroll
        for (int b = 0; b < 2; ++b)
#pragma unroll
          for (int m = 0; m < 4; ++m)
#pragma unroll
            for (int n = 0; n < 2; ++n) acc[a][b][m][n] = (f32x4){0.f, 0.f, 0.f, 0.f};
    }
    cur = nxt; cA = nA; cB = nB; ++ui;
    if (wr == 1) PG8_BAR;
  }
  PG8_WAIT_V(0);
  PG8_BAR;
#undef PG8_SA
#undef PG8_SB
#undef PG8_STAGE_A
#undef PG8_STAGE_B
#undef PG8_LDA
#undef PG8_LDB
#undef PG8_MMA
#undef PG8_MMA8
#undef PG8_MM
#undef PG8_LD8
#undef PG8_LO
#undef PG8_HI
#undef PG8_WAIT_V
#undef PG8_WAIT_L
#undef PG8_BAR
#undef PG8_SCHED
}
}

__device__ __forceinline__ const char* uni_ptr(const char* p) {
  const unsigned long long v = (unsigned long long)p;
  const unsigned lo = __builtin_amdgcn_readfirstlane((unsigned)v), hi = __builtin_amdgcn_readfirstlane((unsigned)(v >> 32));
  return (const char*)(((unsigned long long)hi << 32) | lo);
}

struct SchedDense {
  const char* A; const char* B; int nM, nN, G, c, lda, ldb, nt;
  __device__ __forceinline__ bool next(int i, pg8::UnitG& u) const {
    int pm, pn; if (!pg8::dense_order(i, G, c, nM, nN, pm, pn)) return false;
    u.pm = pm; u.pn = pn; u.e = 0; u.cnt = 0; u.mt = 0; u.row0 = pm * 256; u.nt = nt; u.keep = 0;
    u.A = A + (size_t)pm * 256 * lda * 2; u.B = B + (size_t)pn * 256 * ldb * 2; return true;
  }
  __device__ __forceinline__ unsigned arow(const pg8::UnitG&, int r) const { return (unsigned)r; }
};

struct EpiStoreBf16 {
  static constexpr bool PERM = true, FP8 = false;
  bf16_t* O; int ldc;
  __device__ __forceinline__ void operator()(const f32x4 (&acc)[2][2][4][2], const pg8::UnitG& u, int wr, int wc, int fr, int fq) const {
    const int row0 = u.pm * 256 + wr * 64 + fr, col0 = u.pn * 256 + wc * 32 + 8 * fq;
#pragma unroll
    for (int ai = 0; ai < 2; ++ai)
#pragma unroll
      for (int m = 0; m < 4; ++m) { bf16_t* rowp = O + (size_t)(row0 + ai * 128 + m * 16) * ldc + col0;
#pragma unroll
        for (int bj = 0; bj < 2; ++bj) { const f32x4 v0 = acc[ai][bj][m][0], v1 = acc[ai][bj][m][1]; u32x4 w; w.x = pk2(v0[0], v0[1]); w.y = pk2(v0[2], v0[3]); w.z = pk2(v1[0], v1[1]); w.w = pk2(v1[2], v1[3]); *(u32x4*)(rowp + bj * 128) = w; } }
  }
};

struct SchedRglru {
  const char* XCR; const char* W; int G, c, nt4;
  __device__ __forceinline__ bool next(int i, pg8::UnitG& u) const {
    const int L = i * G + c; if (L >= 640) return false;
    const int blk = L >> 6, rem = L & 63; u.e = blk; u.pm = rem >> 1; u.pn = rem & 1; u.cnt = 0; u.mt = 0; u.row0 = u.pm * 256; u.nt = nt4; u.keep = 0;
    u.A = XCR + ((size_t)u.pm * 256 * RW + 256 * blk) * 2; u.B = W + ((size_t)(blk * 512 + u.pn * 256) * 256) * 2; return true;
  }
  __device__ __forceinline__ unsigned arow(const pg8::UnitG&, int r) const { return (unsigned)r; }
};
struct EpiRglru {
  static constexpr bool PERM = true, FP8 = false;
  const bf16_t* XCR; const float* ba; const float* bx; const float* C8; float* RA; bf16_t* RBo;
  __device__ __forceinline__ void operator()(const f32x4 (&acc)[2][2][4][2], const pg8::UnitG& u, int wr, int wc, int fr, int fq) const {
    const int row0 = u.pm * 256 + wr * 64 + fr;
#pragma unroll
    for (int n = 0; n < 2; ++n) {
      const int ch = 256 * u.e + 128 * u.pn + 32 * wc + 8 * fq + 4 * n;
      const f32x4 vba = *(const f32x4*)(ba + ch), vbx = *(const f32x4*)(bx + ch), c8 = *(const f32x4*)(C8 + ch);
      u32x2 xwa[8];
#pragma unroll
      for (int i = 0; i < 8; ++i) xwa[i] = *(const u32x2*)(XCR + (size_t)(row0 + (i >> 2) * 128 + (i & 3) * 16) * RW + ch);
#pragma unroll
      for (int ai = 0; ai < 2; ++ai)
#pragma unroll
        for (int m = 0; m < 4; ++m) {
          const size_t off = (size_t)(row0 + ai * 128 + m * 16) * RW + ch;
          const u32x2 xw = xwa[ai * 4 + m];
          const float xc[4] = {bflo(xw.x), bfhi(xw.x), bflo(xw.y), bfhi(xw.y)};
          f32x4 av; float bv[4];
#pragma unroll
          for (int j = 0; j < 4; ++j) {
            const float r = __builtin_amdgcn_rcpf(1.0f + __expf(-(acc[ai][0][m][n][j] + vba[j])));
            const float ig = __builtin_amdgcn_rcpf(1.0f + __expf(-(acc[ai][1][m][n][j] + vbx[j])));
            const float la = c8[j] * r;
            const float a = __expf(la);
            const float x2 = 2.0f * la;
            const float poly = -x2 * (1.0f + x2 * 0.5f * (1.0f + x2 * (1.0f / 3.0f) * (1.0f + x2 * 0.25f * (1.0f + x2 * 0.2f))));
            const float om = (x2 > -0.25f) ? poly : (1.0f - a * a);
            av[j] = a;
            bv[j] = sqrtf(fmaxf(om, 0.f)) * (ig * xc[j]);
          }
          *(f32x4*)(RA + off) = av;
          u32x2 w; w.x = pk2(bv[0], bv[1]); w.y = pk2(bv[2], bv[3]); *(u32x2*)(RBo + off) = w;
          asm volatile("" ::: "memory");
        }
    }
  }
};

struct SchedMerge {
  const char* YM; const char* YR; const char* WPM; const char* WPR; int G, c;
  __device__ __forceinline__ bool next(int i, pg8::UnitG& u) const {
    int pm, pn; if (!pg8::dense_order(i >> 1, G, c, NTOK / 256, DM / 256, pm, pn)) return false;
    const int seg = i & 1;
    u.pm = pm; u.pn = pn; u.e = seg; u.cnt = 0; u.mt = 0; u.row0 = pm * 256; u.nt = seg ? RW / 64 : MW / 64; u.keep = seg ? 0 : 1;
    u.A = (seg ? YR : YM) + (size_t)pm * 256 * RW * 2; u.B = (seg ? WPR : WPM) + (size_t)pn * 256 * RW * 2; return true;
  }
  __device__ __forceinline__ unsigned arow(const pg8::UnitG&, int r) const { return (unsigned)r; }
};
struct EpiMergeF {
  static constexpr bool PERM = true, FP8 = false;
  const bf16_t* PROJ; const float* bgate; bf16_t* MRG;
  __device__ __forceinline__ void operator()(f32x4 (&acc)[2][2][4][2], const pg8::UnitG& u, int wr, int wc, int fr, int fq) const {
    const int row0 = u.pm * 256 + wr * 64 + fr, col0 = u.pn * 256 + wc * 32 + 8 * fq;
    if (u.e == 0) {
#pragma unroll
      for (int bj = 0; bj < 2; ++bj) {
        const int col = col0 + bj * 128;
        const f32x4 b00 = *(const f32x4*)(bgate + col), b01 = *(const f32x4*)(bgate + col + 4), b10 = *(const f32x4*)(bgate + DM + col), b11 = *(const f32x4*)(bgate + DM + col + 4);
#pragma unroll
        for (int ai = 0; ai < 2; ++ai)
#pragma unroll
          for (int m = 0; m < 4; ++m) {
            const size_t row = (size_t)(row0 + ai * 128 + m * 16);
            const u32x4 g1w = *(const u32x4*)(PROJ + row * INC + O_G1 + col);
            const float g1p[8] = {bflo(g1w.x), bfhi(g1w.x), bflo(g1w.y), bfhi(g1w.y), bflo(g1w.z), bfhi(g1w.z), bflo(g1w.w), bfhi(g1w.w)};
            const u32x4 g0w = *(const u32x4*)(PROJ + row * INC + O_G0 + col);
            const float g0p[8] = {bflo(g0w.x), bfhi(g0w.x), bflo(g0w.y), bfhi(g0w.y), bflo(g0w.z), bfhi(g0w.z), bflo(g0w.w), bfhi(g0w.w)};
#pragma unroll
            for (int j = 0; j < 4; ++j) {
              acc[ai][bj][m][0][j] *= (1.0f + __expf(-(g1p[j] + b10[j]))) * __builtin_amdgcn_rcpf(1.0f + __expf(-(g0p[j] + b00[j])));
              acc[ai][bj][m][1][j] *= (1.0f + __expf(-(g1p[4 + j] + b11[j]))) * __builtin_amdgcn_rcpf(1.0f + __expf(-(g0p[4 + j] + b01[j])));
            }
            if (m & 1) asm volatile("" ::: "memory");
          }
      }
    } else {
#pragma unroll
      for (int bj = 0; bj < 2; ++bj) {
        const int col = col0 + bj * 128;
        const f32x4 b10 = *(const f32x4*)(bgate + DM + col), b11 = *(const f32x4*)(bgate + DM + col + 4);
#pragma unroll
        for (int ai = 0; ai < 2; ++ai) {
          u32x4 g1a[4];
#pragma unroll
          for (int m = 0; m < 4; ++m) g1a[m] = *(const u32x4*)(PROJ + (size_t)(row0 + ai * 128 + m * 16) * INC + O_G1 + col);
#pragma unroll
          for (int m = 0; m < 4; ++m) {
            const size_t row = (size_t)(row0 + ai * 128 + m * 16);
            const u32x4 g1w = g1a[m];
            const float g1p[8] = {bflo(g1w.x), bfhi(g1w.x), bflo(g1w.y), bfhi(g1w.y), bflo(g1w.z), bfhi(g1w.z), bflo(g1w.w), bfhi(g1w.w)};
            f32x4 v0, v1;
#pragma unroll
            for (int j = 0; j < 4; ++j) { v0[j] = acc[ai][bj][m][0][j] * __builtin_amdgcn_rcpf(1.0f + __expf(-(g1p[j] + b10[j]))); v1[j] = acc[ai][bj][m][1][j] * __builtin_amdgcn_rcpf(1.0f + __expf(-(g1p[4 + j] + b11[j]))); }
            u32x4 w; w.x = pk2(v0[0], v0[1]); w.y = pk2(v0[2], v0[3]); w.z = pk2(v1[0], v1[1]); w.w = pk2(v1[2], v1[3]); *(u32x4*)(MRG + row * DM + col) = w;
          }
        }
      }
    }
  }
};

struct EpiWo {
  static constexpr bool PERM = false, FP8 = false;
  const float* X; float* O;
  __device__ __forceinline__ void operator()(const f32x4 (&acc)[2][2][4][2], const pg8::UnitG& u, int wr, int wc, int fr, int fq) const {
    const int row0 = u.pm * 256 + wr * 64 + fr, col0 = u.pn * 256 + wc * 32 + 4 * fq;
#pragma unroll
    for (int ai = 0; ai < 2; ++ai) {
      f32x4 xa[4][4];
#pragma unroll
      for (int m = 0; m < 4; ++m) { const size_t off = (size_t)(row0 + ai * 128 + m * 16) * DM + col0;
#pragma unroll
        for (int q = 0; q < 4; ++q) xa[m][q] = *(const f32x4*)(X + off + (q >> 1) * 128 + (q & 1) * 16); }
#pragma unroll
      for (int m = 0; m < 4; ++m) { const size_t off = (size_t)(row0 + ai * 128 + m * 16) * DM + col0;
#pragma unroll
        for (int q = 0; q < 4; ++q) *(f32x4*)(O + off + (q >> 1) * 128 + (q & 1) * 16) = xa[m][q] * ALPHA + acc[ai][q >> 1][m][q & 1]; }
    }
  }
};

struct MoeTab { const LAS int* tp; const LAS int* cp; const LAS int* cnt; int n_rt; };
template <int NT  , int STAGE  >
struct SchedMoe {
  MoeTab T; const int* LIST; const char* Abase; const char* Wr; const char* Ws; int G, c, ntv;
  __device__ __forceinline__ bool next(int i, pg8::UnitG& u) const {
    const int L = i * G + c; const int total = NT * (T.n_rt + 32); if (L >= total) return false;
    const int rt = L / NT, pn = L % NT; u.pn = pn; u.nt = ntv; u.keep = 0;
    constexpr int KK = (STAGE == 1) ? DM / 2 : DE / 2;
    constexpr int NN = NT * 256;
    if (rt < T.n_rt) {
      const int e = __builtin_amdgcn_readfirstlane(T.tp[256 + rt]);
      const int mt = rt - __builtin_amdgcn_readfirstlane(T.tp[e]);
      u.e = e; u.mt = mt; u.cnt = __builtin_amdgcn_readfirstlane(T.cnt[e]); u.pm = rt; u.row0 = rt * 256;
      u.B = Wr + ((size_t)e * NN + (size_t)pn * 256) * KK * 2;
    } else {
      u.e = NE; u.mt = rt - T.n_rt; u.cnt = NTOK; u.pm = rt; u.row0 = rt * 256;
      u.B = Ws + (size_t)pn * 256 * KK * 2;
    }
    if (STAGE == 2) u.pm = __builtin_amdgcn_readfirstlane(T.cp[u.e]);
    if (STAGE == 1) u.A = Abase;
    else u.A = Abase + (size_t)rt * 256 * DE;
    return true;
  }
  __device__ __forceinline__ unsigned arow(const pg8::UnitG& u, int r) const {
    if (u.e < NE) { int slot = u.mt * 256 + r; if (slot >= u.cnt) slot = 0; return (unsigned)LIST[u.e * NTOK + slot]; }
    return (unsigned)(u.mt * 256 + r);
  }
};
struct EpiMoe1 {
  static constexpr bool PERM = true, FP8 = true;
  unsigned char* H;
  __device__ __forceinline__ void operator()(const f32x4 (&acc)[2][2][4][2], const pg8::UnitG& u, int wr, int wc, int fr, int fq) const {
    const int row0 = u.row0 + wr * 64 + fr, col0 = u.pn * 128 + wc * 32 + 8 * fq;
#pragma unroll
    for (int ai = 0; ai < 2; ++ai)
#pragma unroll
      for (int m = 0; m < 4; ++m) { unsigned char* rowp = H + (size_t)(row0 + ai * 128 + m * 16) * DE + col0;
        float v[8];
#pragma unroll
        for (int n = 0; n < 2; ++n) { const f32x4 g = acc[ai][0][m][n], up = acc[ai][1][m][n];
#pragma unroll
          for (int j = 0; j < 4; ++j) { const float gg = g[j] * 0.015625f; v[4 * n + j] = gg * __builtin_amdgcn_rcpf(1.0f + __expf(-gg)) * (up[j] * 0.015625f); } }
        int q0 = 0, q1 = 0; q0 = __builtin_amdgcn_cvt_pk_fp8_f32(v[0], v[1], q0, false); q0 = __builtin_amdgcn_cvt_pk_fp8_f32(v[2], v[3], q0, true); q1 = __builtin_amdgcn_cvt_pk_fp8_f32(v[4], v[5], q1, false); q1 = __builtin_amdgcn_cvt_pk_fp8_f32(v[6], v[7], q1, true);
        u32x2 w; w.x = (unsigned)q0; w.y = (unsigned)q1; *(u32x2*)rowp = w; }
  }
};
struct EpiMoe2 {
  static constexpr bool PERM = true, FP8 = true;
  bf16_t* YRM; const float* LISTW; bf16_t* DUMMY;
  __device__ __forceinline__ void operator()(const f32x4 (&acc)[2][2][4][2], const pg8::UnitG& u, int wr, int wc, int fr, int fq) const {
    const int slot0 = u.mt * 256 + wr * 64 + fr;
    bf16_t* base = YRM + (size_t)(u.pm + slot0) * DM + u.pn * 256 + wc * 32 + 8 * fq;
    bf16_t* sink = DUMMY + (size_t)blockIdx.x * 8192 + ((wr * 4 + wc) * 64 + fq * 16 + fr) * 8;
    const float* lw = LISTW + u.e * NTOK + slot0;
    float wv[8];
#pragma unroll
    for (int i = 0; i < 8; ++i) wv[i] = lw[(i >> 2) * 128 + (i & 3) * 16];
#pragma unroll
    for (int ai = 0; ai < 2; ++ai)
#pragma unroll
      for (int m = 0; m < 4; ++m) { const int ds = ai * 128 + m * 16;
        const float w = wv[ai * 4 + m] * 0.03125f;
        bf16_t* rowp = (slot0 + ds < u.cnt) ? base + (size_t)ds * DM : sink;
#pragma unroll
        for (int bj = 0; bj < 2; ++bj) { const f32x4 v0 = acc[ai][bj][m][0] * w, v1 = acc[ai][bj][m][1] * w; u32x4 q; q.x = pk2(v0[0], v0[1]); q.y = pk2(v0[2], v0[3]); q.z = pk2(v1[0], v1[1]); q.w = pk2(v1[2], v1[3]); *(u32x4*)(rowp + bj * 128) = q; } }
  }
};


#define XB_TMO      128
#define XB_XCNT(j)  (256  + 64 * (j))
#define XB_XSUB(j)  (1280 + 64 * (j))
#define XB_XGEN(j)  (2304 + 64 * (j))
#define XB_TOP      3328
#define XB_TOPGEN   3392
#define XCD_BAR_WORDS 3456
#define XB_SPIN_CAP (1u << 18)
__device__ __forceinline__ unsigned xb_ld(unsigned* p)              { return __hip_atomic_load(p, __ATOMIC_RELAXED, __HIP_MEMORY_SCOPE_AGENT); }
__device__ __forceinline__ unsigned xb_add(unsigned* p, unsigned v) { return __hip_atomic_fetch_add(p, v, __ATOMIC_RELAXED, __HIP_MEMORY_SCOPE_AGENT); }
__device__ __forceinline__ unsigned xb_xcc_id() { return (unsigned)__builtin_amdgcn_s_getreg((3 << 11) | 20) & 0xFu; }
#define XB_SPIN(cond, bar) do { unsigned _sp = 0; while (cond) { __builtin_amdgcn_s_sleep(1); \
    if ((++_sp & 255u) == 0u) { if (xb_ld(&(bar)[XB_TMO])) break; if (_sp > XB_SPIN_CAP) { atomicAdd(&(bar)[XB_TMO], 1u); break; } } } } while (0)
struct XcdBarrier { unsigned* bar; unsigned x; volatile LAS unsigned* st; };
__device__ __forceinline__ XcdBarrier xcd_barrier_post(unsigned* bar, volatile LAS unsigned* st) {
    XcdBarrier b; b.bar = bar; b.x = xb_xcc_id(); b.st = st;
    if (threadIdx.x == 0) (void)xb_add(&bar[XB_XCNT(b.x)], 1u);
    return b;
}
__device__ __forceinline__ void xcd_barrier_complete(unsigned* bar, unsigned x, unsigned& nloc, unsigned& nx) {
    const unsigned G = gridDim.x * gridDim.y * gridDim.z;
    unsigned sum, cnt, mine, sp = 0u;
    for (;;) {
        sum = 0u; cnt = 0u; mine = 0u;
#pragma unroll
        for (unsigned j = 0; j < 16; ++j) { const unsigned c = xb_ld(&bar[XB_XCNT(j)]); sum += c; cnt += (c > 0u) ? 1u : 0u; mine = (j == x) ? c : mine; }
        if (sum == G) break;
        __builtin_amdgcn_s_sleep(1);
        if ((++sp & 255u) == 0u) { if (xb_ld(&bar[XB_TMO])) break; if (sp > XB_SPIN_CAP) { atomicAdd(&bar[XB_TMO], 1u); break; } }
    }
    nloc = mine > 0u ? mine : 1u; nx = cnt > 0u ? cnt : 1u;
}
__device__ __forceinline__ void xcd_barrier(const XcdBarrier& b) {
    asm volatile("s_waitcnt vmcnt(0)" ::: "memory");
    __syncthreads();
    if (threadIdx.x == 0) {
        unsigned* bar = b.bar;
        __builtin_amdgcn_s_waitcnt(0);
        unsigned nloc = b.st[0], nx = b.st[1];
        if (nloc == 0u) { xcd_barrier_complete(bar, b.x, nloc, nx); b.st[0] = nloc; b.st[1] = nx; }
        const unsigned old = xb_add(&bar[XB_XSUB(b.x)], 1u);
        const unsigned gen = old / nloc;
        if (old + 1u == (gen + 1u) * nloc) {
            __builtin_amdgcn_fence(__ATOMIC_RELEASE, "agent");
            asm volatile("s_waitcnt vmcnt(0)" ::: "memory");
            const unsigned og = xb_add(&bar[XB_TOP], 1u);
            const unsigned tg = og / nx;
            if (og + 1u == (tg + 1u) * nx) xb_add(&bar[XB_TOPGEN], 1u);
            else XB_SPIN(xb_ld(&bar[XB_TOPGEN]) == tg, bar);
            __builtin_amdgcn_fence(__ATOMIC_ACQUIRE, "agent");
            xb_add(&bar[XB_XGEN(b.x)], 1u);
            asm volatile("s_waitcnt vmcnt(0)" ::: "memory");
        } else {
            XB_SPIN(xb_ld(&bar[XB_XGEN(b.x)]) == gen, bar);
            __builtin_amdgcn_fence(__ATOMIC_ACQUIRE, "agent");
            asm volatile("s_waitcnt vmcnt(0)" ::: "memory");
        }
    }
    __syncthreads();
}

template <class T> __device__ __forceinline__ T* as_global(T* p) { const unsigned long long v = (unsigned long long)p; return (T*)(__attribute__((address_space(1))) T*)v; }
template <class T> __device__ __forceinline__ T* opaque_global(T* p) { unsigned long long v = (unsigned long long)p; asm volatile("" : "+s"(v)); return (T*)(__attribute__((address_space(1))) T*)v; }
struct InPtrs { const float* const* p; __device__ __forceinline__ const float* operator[](int k) const { return as_global(p[k]); } };
struct Frame {
  LAS unsigned char* lds; int tid, lane, wave, G, bid; unsigned char* ws; InPtrs in; float* out;
};

struct TJob { const float* W; unsigned char* WT; int N, ldtB, k0, n0, up, mode; float sc; };
__device__ __forceinline__ int gu_row(int n, int up) { return 256 * (n >> 7) + (n & 127) + up * 128; }
constexpr int TR0 = 16 * 104, TR1 = 16 * 16, TR2 = 20 * 16, TR3 = 16 * 16, TR4 = 2 * 10 * 4, TR5 = 2 * 16 * 4, TR6 = 4 * 16, TR7 = 2 * 64 * 16 * 4, TR8 = 64 * 4 * 16;
constexpr int T_NITEMS = TR0 + TR1 + TR2 + TR3 + TR4 + TR5 + TR6 + TR7 + TR8;
__device__ __forceinline__ TJob tj_decode(const Frame& F, int it) {
  unsigned char* ws = F.ws; int r = it;
  if (r < TR0) { const int kb = r / 104, nb = r % 104; return TJob{F.in[1], ws + WS_WIN, INC, DM * 2, 128 * kb, 128 * nb, 0, 0, 1.f}; } r -= TR0;
  if (r < TR1) { const int kb = r / 16, nb = r % 16; return TJob{F.in[19], ws + WS_WPM, DM, RW * 2, 128 * kb, 128 * nb, 0, 0, 1.f}; } r -= TR1;
  if (r < TR2) { const int kb = r / 16, nb = r % 16; return TJob{F.in[20], ws + WS_WPR, DM, RW * 2, 128 * kb, 128 * nb, 0, 0, 1.f}; } r -= TR2;
  if (r < TR3) { const int kb = r / 16, nb = r % 16; return TJob{F.in[21], ws + WS_WO, DM, DM * 2, 128 * kb, 128 * nb, 0, 0, 1.f}; } r -= TR3;
  if (r < TR4) { const int which = r / 40, rr = r % 40, blk = rr / 4, q = rr % 4; return TJob{F.in[which ? 16 : 14] + (size_t)blk * 65536, ws + WS_WRAX + (size_t)blk * 512 * 256 * 2, 256, 256 * 2, 128 * (q >> 1), 128 * (q & 1), which, 1, 1.f}; } r -= TR4;
  if (r < TR5) { const int which = r / 64, q = r % 64, kb = q / 4, nb = q % 4; return TJob{F.in[which ? 30 : 29], ws + WS_WSGU, DE, DM, 128 * kb, 128 * nb, which, 3, 64.f}; } r -= TR5;
  if (r < TR6) { const int kb = r / 16, nb = r % 16; return TJob{F.in[31], ws + WS_WSD, DM, DE, 128 * kb, 128 * nb, 0, 2, 32.f}; } r -= TR6;
  if (r < TR7) { const int which = r / 4096, rr = r % 4096, e = rr / 64, q = rr % 64, kb = q / 4, nb = q % 4; return TJob{F.in[which ? 27 : 26] + (size_t)e * DM * DE, ws + WS_WEGU + (size_t)e * 1024 * DM, DE, DM, 128 * kb, 128 * nb, which, 3, 64.f}; } r -= TR7;
  { const int e = r / 64, q = r % 64, kb = q / 16, nb = q % 16; return TJob{F.in[28] + (size_t)e * DE * DM, ws + WS_WED + (size_t)e * DM * DE, DM, DE, 128 * kb, 128 * nb, 0, 2, 32.f}; }
}
__device__ __forceinline__ void tj_load(const TJob& j, f32x4 (&v)[8], int wave, int lane) {
  const float* p = j.W + (size_t)(j.k0 + 16 * wave + (lane >> 5)) * j.N + j.n0 + 4 * (lane & 31);
#pragma unroll
  for (int i = 0; i < 8; ++i) v[i] = __builtin_nontemporal_load((const f32x4*)(p + (size_t)(2 * i) * j.N));
}
__device__ __forceinline__ void tj_store(const TJob& j, const f32x4 (&v)[8], LAS float* scr, int wave, int lane, int tid) {
#pragma unroll
  for (int i = 0; i < 8; ++i) { LAS float* d = scr + (16 * wave + 2 * i + (lane >> 5)) * 129 + 4 * (lane & 31); d[0] = v[i][0]; d[1] = v[i][1]; d[2] = v[i][2]; d[3] = v[i][3]; }
  LBAR();
  if (j.mode < 2) {
#pragma unroll
    for (int it = 0; it < 4; ++it) { const int idx = it * 512 + tid, n = idx >> 4, c = idx & 15; const LAS float* s = scr + (8 * c) * 129 + n;
      u32x4 o; o.x = pk2(s[0 * 129], s[1 * 129]); o.y = pk2(s[2 * 129], s[3 * 129]); o.z = pk2(s[4 * 129], s[5 * 129]); o.w = pk2(s[6 * 129], s[7 * 129]);
      const int nn = j.n0 + n; const int row = j.mode ? gu_row(nn, j.up) : nn;
      *(u32x4*)(j.WT + (size_t)row * j.ldtB + (j.k0 + 8 * c) * 2) = o; }
  } else {
#pragma unroll
    for (int it = 0; it < 2; ++it) { const int idx = it * 512 + tid, n = idx >> 3, c = idx & 7; const LAS float* s = scr + (16 * c) * 129 + n;
      int w[4];
#pragma unroll
      for (int q = 0; q < 4; ++q) { int t = 0; t = __builtin_amdgcn_cvt_pk_fp8_f32(s[(4 * q) * 129] * j.sc, s[(4 * q + 1) * 129] * j.sc, t, false); t = __builtin_amdgcn_cvt_pk_fp8_f32(s[(4 * q + 2) * 129] * j.sc, s[(4 * q + 3) * 129] * j.sc, t, true); w[q] = t; }
      u32x4 o; o.x = (unsigned)w[0]; o.y = (unsigned)w[1]; o.z = (unsigned)w[2]; o.w = (unsigned)w[3];
      const int nn = j.n0 + n; const int row = (j.mode == 3) ? gu_row(nn, j.up) : nn;
      __builtin_nontemporal_store(o, (u32x4*)(j.WT + (size_t)row * j.ldtB + j.k0 + 16 * c)); }
  }
  LBAR();
}

__device__ __forceinline__ void tile_range(const Frame& F, const int it0, const int step, const int end) {
  LAS float* scr = (LAS float*)F.lds;
  f32x4 vA[8], vB[8]; TJob jA, jB;
  int it = it0;
  if (it < end) { jA = tj_decode(F, it); tj_load(jA, vA, F.wave, F.lane); }
  while (it < end) {
    { const int itn = it + step; jB = tj_decode(F, itn < end ? itn : end - 1); tj_load(jB, vB, F.wave, F.lane); }
    tj_store(jA, vA, scr, F.wave, F.lane, F.tid);
    it += step; if (it >= end) break;
    { const int itn = it + step; jA = tj_decode(F, itn < end ? itn : end - 1); tj_load(jA, vA, F.wave, F.lane); }
    tj_store(jB, vB, scr, F.wave, F.lane, F.tid);
    it += step;
  }
}
constexpr int KD1 = 16, KD3 = 16;
__device__ __forceinline__ int defer1_blocks(int G) { const int rem = (NTOK / 256) * (INC / 256) % G; return rem ? G - rem : 0; }
__device__ __forceinline__ int defer1_count(int G) { return defer1_blocks(G) * KD1; }
__device__ __forceinline__ int defer3_count(int G) { return (G - (G >> 1)) * KD3; }

__device__ __forceinline__ void phase_prologue(const Frame& F) {
  unsigned char* ws = F.ws;
  tile_range(F, F.bid, F.G, T_NITEMS - defer1_count(F.G) - defer3_count(F.G));
  const int gt = F.bid * 512 + F.tid, NGT = F.G * 512;
  { const float* x = F.in[0]; bf16_t* xb = (bf16_t*)(ws + WS_XB);
    for (int i = gt; i < NTOK * DM / 8; i += NGT) { const f32x4 a = *(const f32x4*)(x + (size_t)i * 8), b = *(const f32x4*)(x + (size_t)i * 8 + 4);
      u32x4 o; o.x = pk2(a[0], a[1]); o.y = pk2(a[2], a[3]); o.z = pk2(b[0], b[1]); o.w = pk2(b[2], b[3]); *(u32x4*)(xb + (size_t)i * 8) = o; } }
  { const float* wif = F.in[8]; bf16_t* wt = (bf16_t*)(ws + WS_SMALL + SM_WIFT);
    for (int i = gt; i < 16 * 6144; i += NGT) { const int n = i / 6144, k = i % 6144; float v = wif[k * 16 + n]; if (k >= 2048 && k < 4096) v *= 16.0f; wt[i] = (bf16_t)f2bf(v); } }
  { const float* lam = F.in[18]; float* c8 = (float*)(ws + WS_SMALL + SM_C8); for (int i = gt; i < RW; i += NGT) c8[i] = -8.0f * log1pf(expf(-lam[i])); }
  { const float* rwt = F.in[24]; bf16_t* rh = (bf16_t*)(ws + WS_SMALL + SM_RWH); bf16_t* rl = (bf16_t*)(ws + WS_SMALL + SM_RWL);
    for (int i = gt; i < NE * DM; i += NGT) { const int n = i / DM, k = i % DM; const float v = rwt[k * NE + n]; const unsigned h = f2bf(v); rh[i] = (bf16_t)h; rl[i] = (bf16_t)f2bf(v - __uint_as_float(h << 16)); } }
  { float* lw64 = (float*)(ws + WS_LISTW) + (size_t)NE * NTOK; for (int i = gt; i < NTOK; i += NGT) lw64[i] = 1.0f; }
  { int* ctl = (int*)(ws + WS_CTL); for (int i = gt; i < 4096; i += NGT) ctl[i] = 0; }
}

__device__ __forceinline__ void phase_mprep(const Frame& F) {
  unsigned char* ws = F.ws;
  const bf16_t* PROJ = (const bf16_t*)(ws + WS_PROJ);
  bf16_t* Q = (bf16_t*)(ws + WS_Q); bf16_t* Kb = (bf16_t*)(ws + WS_K); bf16_t* V = (bf16_t*)(ws + WS_V); bf16_t* XCM = (bf16_t*)(ws + WS_XCM);
  const bf16_t* WIFT = (const bf16_t*)(ws + WS_SMALL + SM_WIFT);
  float* IG = (float*)(ws + WS_SMALL + SM_IG); float* LF = (float*)(ws + WS_SMALL + SM_LF);
  const int g = F.tid;
  f32x4 cw[4]; for (int j = 0; j < 4; ++j) cw[j] = *(const f32x4*)(F.in[3] + j * MW + 4 * g);
  const f32x4 cb = *(const f32x4*)(F.in[4] + 4 * g);
  f32x4 wq[4], wk[4], wv[4];
  for (int i = 0; i < 4; ++i) { wq[i] = *(const f32x4*)(F.in[5] + g * 16 + 4 * i); wk[i] = *(const f32x4*)(F.in[6] + g * 16 + 4 * i); wv[i] = *(const f32x4*)(F.in[7] + g * 16 + 4 * i); }
  LAS unsigned char* AIMG = F.lds; LAS float* red = (LAS float*)(F.lds + 98432);
  const int r = F.lane & 15, gq = F.lane >> 4;
  for (int tile = F.bid; tile < NTOK / 8; tile += F.G) {
    const int t0 = tile * 8, s0 = t0 & (SEQ - 1);
    u32x2 rw[11];
#pragma unroll
    for (int j = 0; j < 11; ++j) { const int pos = s0 - 3 + j; rw[j] = (pos >= 0) ? __builtin_nontemporal_load((const u32x2*)(PROJ + (size_t)(t0 - 3 + j) * INC + 4 * g)) : (u32x2){0u, 0u}; }
#pragma unroll
    for (int tt = 0; tt < 8; ++tt) {
      const int t = t0 + tt;
      f32x4 xw[4];
#pragma unroll
      for (int j = 0; j < 4; ++j) xw[j] = (f32x4){bflo(rw[tt + j].x), bfhi(rw[tt + j].x), bflo(rw[tt + j].y), bfhi(rw[tt + j].y)};
      const f32x4 cv = cb + cw[0] * xw[0] + cw[1] * xw[1] + cw[2] * xw[2] + cw[3] * xw[3];
      f32x4 xc; for (int i = 0; i < 4; ++i) xc[i] = cv[i] * __builtin_amdgcn_rcpf(1.0f + __expf(-cv[i]));
      const f32x4 q = xc[0] * wq[0] + xc[1] * wq[1] + xc[2] * wq[2] + xc[3] * wq[3];
      f32x4 k = xc[0] * wk[0] + xc[1] * wk[1] + xc[2] * wk[2] + xc[3] * wk[3];
      const f32x4 v = xw[3][0] * wv[0] + xw[3][1] * wv[1] + xw[3][2] * wv[2] + xw[3][3] * wv[3];
      k = k * 0.0625f;
      const size_t o = (size_t)t * MW + 4 * g;
      u32x2 wqv, wkv, wvv, wxc;
      wqv.x = pk2(q[0], q[1]); wqv.y = pk2(q[2], q[3]); *(u32x2*)(Q + o) = wqv;
      wkv.x = pk2(k[0], k[1]); wkv.y = pk2(k[2], k[3]); *(u32x2*)(Kb + o) = wkv;
      wvv.x = pk2(v[0], v[1]); wvv.y = pk2(v[2], v[3]); *(u32x2*)(V + o) = wvv;
      wxc.x = pk2(xc[0], xc[1]); wxc.y = pk2(xc[2], xc[3]); *(u32x2*)(XCM + o) = wxc;
      LAS unsigned char* ar = AIMG + tt * 12304 + 8 * g;
      *(LAS u32x2*)(ar) = wqv; *(LAS u32x2*)(ar + 4096) = wkv; *(LAS u32x2*)(ar + 8192) = wvv;
    }
    LBAR();
    {
      f32x4 acc = (f32x4){0.f, 0.f, 0.f, 0.f};
#pragma unroll
      for (int ib = 0; ib < 3; ++ib) {
        bf16x8 bfr[8];
#pragma unroll
        for (int i = 0; i < 8; ++i) { const int ks = F.wave * 24 + ib * 8 + i; bfr[i] = *(const bf16x8*)(WIFT + (size_t)r * 6144 + ks * 32 + 8 * gq); }
#pragma unroll
        for (int i = 0; i < 8; ++i) { const int ks = F.wave * 24 + ib * 8 + i;
          const bf16x8 a = *(const LAS bf16x8*)(AIMG + (r & 7) * 12304 + (ks * 32 + 8 * gq) * 2);
          acc = __builtin_amdgcn_mfma_f32_16x16x32_bf16(a, bfr[i], acc, 0, 0, 0); }
      }
#pragma unroll
      for (int j = 0; j < 4; ++j) red[F.wave * 256 + (4 * gq + j) * 16 + r] = acc[j];
    }
    LBAR();
    if (F.tid < 128) {
      const int row = F.tid >> 4, n = F.tid & 15;
      float s = F.in[9][n];
#pragma unroll
      for (int w = 0; w < 8; ++w) s += red[w * 256 + F.tid];
      const int t = t0 + row, b = t >> 12, sp = t & (SEQ - 1);
      if (n < 8) IG[(size_t)(b * 8 + n) * SEQ + sp] = s;
      else LF[(size_t)(b * 8 + (n - 8)) * SEQ + sp] = fminf(s, 0.f) - log1pf(__expf(-fabsf(s)));
    }
    LBAR();
  }
}

__device__ __forceinline__ void phase_rconv(const Frame& F) {
  unsigned char* ws = F.ws;
  const bf16_t* PROJ = (const bf16_t*)(ws + WS_PROJ); bf16_t* XCR = (bf16_t*)(ws + WS_XCR);
  const int gt = F.bid * 512 + F.tid, NGT = F.G * 512;
  const int per = ((NTOK / 16) * 640 + F.G - 1) / F.G;
  for (int i2 = F.tid; i2 < per; i2 += 512) {
    const int it = F.bid * per + i2; if (it >= (NTOK / 16) * 640) break;
    const int tile = it / 640, g = it % 640, t0 = tile * 16, s0 = t0 & (SEQ - 1);
    f32x4 cw[4]; for (int j = 0; j < 4; ++j) cw[j] = *(const f32x4*)(F.in[12] + j * RW + 4 * g);
    const f32x4 cb = *(const f32x4*)(F.in[13] + 4 * g);
    u32x2 rw[19];
#pragma unroll
    for (int j = 0; j < 19; ++j) { const int pos = s0 - 3 + j; rw[j] = (pos >= 0) ? __builtin_nontemporal_load((const u32x2*)(PROJ + (size_t)(t0 - 3 + j) * INC + O_XR + 4 * g)) : (u32x2){0u, 0u}; }
#pragma unroll
    for (int tt = 0; tt < 16; ++tt) {
      f32x4 cv = cb;
#pragma unroll
      for (int j = 0; j < 4; ++j) cv = cv + cw[j] * (f32x4){bflo(rw[tt + j].x), bfhi(rw[tt + j].x), bflo(rw[tt + j].y), bfhi(rw[tt + j].y)};
      u32x2 w; w.x = pk2(cv[0], cv[1]); w.y = pk2(cv[2], cv[3]); *(u32x2*)(XCR + (size_t)(t0 + tt) * RW + 4 * g) = w;
    }
  }
}

__device__ __forceinline__ float chunk_m(const float* IG, const float* LF, int bh, int c, int lane, int wave, LAS float* CS) {
  for (int cc = wave; cc < c; cc += 8) {
    const float lf = LF[(size_t)bh * SEQ + 64 * cc + lane], ig = IG[(size_t)bh * SEQ + 64 * cc + lane];
    const float b = wave_scan_sum(lf, lane), gmax = wave_max(ig - b);
    if (lane == 63) { CS[cc] = b; CS[64 + cc] = b + gmax; }
  }
  __syncthreads();
  float A = 0.f, B = -INFINITY;
  if (lane < c) { A = CS[lane]; B = CS[64 + lane]; }
#pragma unroll
  for (int o = 1; o < 64; o <<= 1) { const float pA = __shfl_up(A, o), pB = __shfl_up(B, o); if (lane >= o) { B = fmaxf(pB + A, B); A = pA + A; } }
  const float mafter = fmaxf(A, B);
  const float mc = __shfl(mafter, c > 0 ? c - 1 : 0);
  return c > 0 ? mc : 0.f;
}

__device__ __forceinline__ void phase_m1(const Frame& F, const int bid2, const int G2) {
  unsigned char* ws = F.ws;
  const bf16_t* Q = (const bf16_t*)(ws + WS_Q); const bf16_t* Kb = (const bf16_t*)(ws + WS_K); const bf16_t* V = (const bf16_t*)(ws + WS_V);
  const float* IG = (const float*)(ws + WS_SMALL + SM_IG); const float* LF = (const float*)(ws + WS_SMALL + SM_LF);
  float* INTER = (float*)(ws + WS_SMALL + SM_INTER); float* EMR = (float*)(ws + WS_SMALL + SM_EMR); float* DENI = (float*)(ws + WS_SMALL + SM_DENI);
  bf16_t* HNI = (bf16_t*)(ws + WS_HNI);
  LAS unsigned char* QS = F.lds; LAS unsigned char* KS = F.lds + 33792; LAS unsigned char* VT = F.lds + 67584; LAS unsigned char* PS = F.lds + 104448;
  LAS float* SCg = (LAS float*)(F.lds + 113664); LAS float* SCM = SCg + 64;
  const int r = F.lane & 15, gq = F.lane >> 4, w = F.wave;
  for (int item = bid2; item < 16 * NCH; item += G2) {
    const int bh = item / NCH, c = item % NCH, b = bh >> 3, h = bh & 7, tok0 = b * SEQ + 64 * c;
    const float m = chunk_m(IG, LF, bh, c, F.lane, w, (LAS float*)(F.lds + 114176));
    const float lf_c = LF[(size_t)bh * SEQ + 64 * c + F.lane], ig_c = IG[(size_t)bh * SEQ + 64 * c + F.lane];
    const float b_l = wave_scan_sum(lf_c, F.lane), g_l = ig_c - b_l;
    const float M_l = fmaxf(m, wave_scan_max(g_l, F.lane));
    if (w == 0) { SCg[F.lane] = g_l; SCM[F.lane] = M_l; INTER[(size_t)(tok0 + F.lane) * 8 + h] = __expf(m - M_l); EMR[(size_t)(tok0 + F.lane) * 8 + h] = __expf(-(b_l + M_l)); }
#pragma unroll
    for (int i = 0; i < 4; ++i) {
      const int idx = i * 512 + F.tid, row = idx >> 5, c16 = idx & 31;
      const size_t go = (size_t)(tok0 + row) * MW + 256 * h + 8 * c16;
      *(LAS u32x4*)(QS + row * 528 + c16 * 16) = *(const u32x4*)(Q + go);
      *(LAS u32x4*)(KS + row * 528 + c16 * 16) = *(const u32x4*)(Kb + go);
    }
    {
      const int sp = F.tid & 31, cq = F.tid >> 5;
#pragma unroll
      for (int i = 0; i < 2; ++i) {
        const size_t go = (size_t)(tok0 + 2 * sp) * MW + 256 * h + 8 * (cq + 16 * i);
        const u32x4 v0 = *(const u32x4*)(V + go), v1 = *(const u32x4*)(V + go + MW);
        const unsigned a0[4] = {v0.x, v0.y, v0.z, v0.w}, a1[4] = {v1.x, v1.y, v1.z, v1.w};
#pragma unroll
        for (int e = 0; e < 4; ++e) { const int dv = 8 * (cq + 16 * i) + 2 * e;
          *(LAS unsigned*)(VT + dv * 144 + sp * 4) = (a0[e] & 0xffffu) | (a1[e] << 16);
          *(LAS unsigned*)(VT + (dv + 1) * 144 + sp * 4) = (a0[e] >> 16) | (a1[e] & 0xffff0000u); }
      }
    }
    __syncthreads();
    {
      const int mi = w & 3;
#pragma unroll
      for (int nn = 0; nn < 2; ++nn) {
        const int ni = 2 * (w >> 2) + nn;
        f32x4 acc = (f32x4){0.f, 0.f, 0.f, 0.f};
        if (ni <= mi) {
#pragma unroll
          for (int ks = 0; ks < 8; ++ks) {
            const bf16x8 a = *(const LAS bf16x8*)(QS + (16 * mi + r) * 528 + (32 * ks + 8 * gq) * 2);
            const bf16x8 bb = *(const LAS bf16x8*)(KS + (16 * ni + r) * 528 + (32 * ks + 8 * gq) * 2);
            acc = __builtin_amdgcn_mfma_f32_16x16x32_bf16(a, bb, acc, 0, 0, 0);
          }
        }
        const int s = 16 * ni + r; const float gs = SCg[s];
#pragma unroll
        for (int j = 0; j < 4; ++j) { const int l = 16 * mi + 4 * gq + j; const float p = (s <= l) ? acc[j] * __expf(gs - SCM[l]) : 0.f; *(LAS bf16_t*)(PS + l * 144 + s * 2) = (bf16_t)f2bf(p); }
      }
    }
    __syncthreads();
    if (F.tid < 64) { float s = 0.f; for (int k = 0; k < 64; ++k) s += bf1(*(const LAS bf16_t*)(PS + F.tid * 144 + k * 2)); DENI[(size_t)(tok0 + F.tid) * 8 + h] = s; }
#pragma unroll
    for (int nn = 0; nn < 2; ++nn) {
      const int ni = 2 * w + nn;
#pragma unroll
      for (int mi = 0; mi < 4; ++mi) {
        f32x4 acc = (f32x4){0.f, 0.f, 0.f, 0.f};
#pragma unroll
        for (int ks = 0; ks < 2; ++ks) {
          const bf16x8 a = *(const LAS bf16x8*)(PS + (16 * mi + r) * 144 + (32 * ks + 8 * gq) * 2);
          const bf16x8 bb = *(const LAS bf16x8*)(VT + (16 * ni + r) * 144 + (32 * ks + 8 * gq) * 2);
          acc = __builtin_amdgcn_mfma_f32_16x16x32_bf16(a, bb, acc, 0, 0, 0);
        }
#pragma unroll
        for (int j = 0; j < 4; ++j) HNI[(size_t)(tok0 + 16 * mi + 4 * gq + j) * MW + 256 * h + 16 * ni + r] = (bf16_t)f2bf(acc[j]);
      }
    }
    __syncthreads();
  }
}

__device__ __forceinline__ void phase_m2(const Frame& F, const int nblk) {
  unsigned char* ws = F.ws;
  const bf16_t* Q = (const bf16_t*)(ws + WS_Q); const bf16_t* Kb = (const bf16_t*)(ws + WS_K); const bf16_t* V = (const bf16_t*)(ws + WS_V);
  const float* IG = (const float*)(ws + WS_SMALL + SM_IG); const float* LF = (const float*)(ws + WS_SMALL + SM_LF);
  float* QN = (float*)(ws + WS_SMALL + SM_QN);
  bf16_t* HNE = (bf16_t*)(ws + WS_HNE);
  LAS unsigned char* QS = F.lds; LAS unsigned char* KT = F.lds + 33792; LAS unsigned char* WVT = F.lds + 70656; LAS unsigned char* CT = F.lds + 77568;
  LAS float* TD = (LAS float*)(F.lds + 111360); LAS float* CS = (LAS float*)(F.lds + 111616);
  float* DUMMY = (float*)(ws + WS_M2TAB + 4 * MiB);
  const int w = F.wave;
  for (int item = F.bid; item < 128; item += nblk) {
    const int bh = item >> 3, sl = item & 7, b = bh >> 3, h = bh & 7, dv0 = 32 * sl;
    float* TI = (float*)(ws + WS_M2TAB) + (size_t)item * 8192; float* TW = TI + 4096;
    const int lane = F.lane;
    for (int i = F.tid; i < (6912 + 33792) / 4; i += 512) *(LAS unsigned*)(WVT + 4 * i) = 0u;
    float gk[8], pk[8];
#pragma unroll
    for (int i = 0; i < 8; ++i) {
      const int cc = w + 8 * i;
      const float lf = LF[(size_t)bh * SEQ + 64 * cc + lane], ig = IG[(size_t)bh * SEQ + 64 * cc + lane];
      const float bl = wave_scan_sum(lf, lane), g = ig - bl;
      const float gmax = wave_max(g), pm = wave_scan_max(g, lane);
      gk[i] = g; pk[i] = pm;
      if (lane == 63) { CS[cc] = bl; CS[64 + cc] = bl + gmax; }
    }
    __syncthreads();
    {
      float A = CS[lane], B = CS[64 + lane]; const float gmx = B - A;
#pragma unroll
      for (int o = 1; o < 64; o <<= 1) { const float pA = __shfl_up(A, o), pB = __shfl_up(B, o); if (lane >= o) { B = fmaxf(pB + A, B); A = pA + A; } }
      const float mafter = fmaxf(A, B);
      float mstart = __shfl_up(mafter, 1); if (lane == 0) mstart = 0.f;
      const float M63 = fmaxf(mstart, gmx);
      if (w == 0) TD[lane] = __expf(mstart - M63);
#pragma unroll
      for (int i = 0; i < 8; ++i) {
        const int cc = w + 8 * i;
        const float ms = __shfl(mstart, cc), m6 = __shfl(M63, cc);
        TI[cc * 64 + lane] = __expf(ms - fmaxf(ms, pk[i])); TW[cc * 64 + lane] = __expf(gk[i] - m6);
      }
    }
    __threadfence(); __syncthreads();
    f32x4 acc[2][3];
#pragma unroll
    for (int a = 0; a < 2; ++a)
#pragma unroll
      for (int n = 0; n < 3; ++n) acc[a][n] = (f32x4){0.f, 0.f, 0.f, 0.f};
    u32x4 qrA[4], krA[2][2], vrA = (u32x4){0u, 0u, 0u, 0u}, qrB[4], krB[2][2], vrB = (u32x4){0u, 0u, 0u, 0u};
    float wsA = 0.f, wsB = 0.f; f32x4 ivA = (f32x4){0.f, 0.f, 0.f, 0.f}, ivB = ivA;
#define M2_LOAD(qreg, kreg, vreg, wsr, ivr, c) do { const int tk_ = b * SEQ + 64 * (c); \
      _Pragma("unroll") for (int i = 0; i < 4; ++i) { const int idx = i * 512 + tdx, row = idx >> 5, c16 = idx & 31; qreg[i] = *(const u32x4*)(Q + (size_t)(tk_ + row) * MW + 256 * h + 8 * c16); } \
      _Pragma("unroll") for (int i = 0; i < 2; ++i) { const size_t go = (size_t)(tk_ + 2 * sp) * MW + 256 * h + 8 * (cq + 16 * i); kreg[i][0] = *(const u32x4*)(Kb + go); kreg[i][1] = *(const u32x4*)(Kb + go + MW); } \
      vreg = *(const u32x4*)(V + (size_t)(tk_ + lane) * MW + 256 * h + dv0 + 8 * (w & 3)); \
      wsr = TW[(c) * 64 + lane]; \
      ivr = *(const f32x4*)(TI + (c) * 64 + 16 * (w & 3) + 4 * gq); } while (0)
#define M2_AMMA(mi, nt) \
        f32x4 a2 = (f32x4){0.f, 0.f, 0.f, 0.f}; \
        _Pragma("unroll") for (int ks = 0; ks < 8; ++ks) { \
          const bf16x8 a = *(const LAS bf16x8*)(QS + (16 * (mi) + r) * 528 + (32 * ks + 8 * gq) * 2); \
          const bf16x8 bb = *(const LAS bf16x8*)(CT + (16 * (nt) + r) * 528 + (32 * ks + 8 * gq) * 2); \
          a2 = __builtin_amdgcn_mfma_f32_16x16x32_bf16(a, bb, a2, 0, 0, 0); }
#define M2_ATILE_H(mi, nt, tok0, ivr) do { M2_AMMA(mi, nt) \
        _Pragma("unroll") for (int j = 0; j < 4; ++j) { const int l = 16 * (mi) + 4 * gq + j; \
          HNE[(size_t)((tok0) + l) * MW + 256 * h + dv0 + 16 * (nt) + r] = (bf16_t)f2bf(a2[j] * ivr[j]); } } while (0)
#define M2_ATILE_Q(mi, nt, tok0, ivr) do { M2_AMMA(mi, nt) \
        _Pragma("unroll") for (int j = 0; j < 4; ++j) { const int l = 16 * (mi) + 4 * gq + j; \
          float* qp = ((nt) == 2 && r == 0) ? (QN + (size_t)((tok0) + l) * 8 + h) : (DUMMY + tdx * 4 + j); *qp = a2[j] * ivr[j]; } } while (0)
#define M2_BODY(c, qreg, kreg, vreg, wsr, ivr) do { \
      int tdx = (int)threadIdx.x; asm volatile("" : "+v"(tdx)); \
      const int lane = tdx & 63, r = lane & 15, gq = lane >> 4, sp = tdx & 31, cq = tdx >> 5; \
      const int tok0 = b * SEQ + 64 * (c); \
      _Pragma("unroll") for (int i = 0; i < 4; ++i) { const int idx = i * 512 + tdx, row = idx >> 5, c16 = idx & 31; *(LAS u32x4*)(QS + row * 528 + c16 * 16) = qreg[i]; } \
      _Pragma("unroll") for (int i = 0; i < 2; ++i) { \
        const unsigned k0[4] = {kreg[i][0].x, kreg[i][0].y, kreg[i][0].z, kreg[i][0].w}, k1[4] = {kreg[i][1].x, kreg[i][1].y, kreg[i][1].z, kreg[i][1].w}; \
        _Pragma("unroll") for (int e = 0; e < 4; ++e) { const int dk = 8 * (cq + 16 * i) + 2 * e; \
          *(LAS unsigned*)(KT + dk * 144 + sp * 4) = (k0[e] & 0xffffu) | (k1[e] << 16); \
          *(LAS unsigned*)(KT + (dk + 1) * 144 + sp * 4) = (k0[e] >> 16) | (k1[e] & 0xffff0000u); } } \
      if (w < 4) { const unsigned vw[4] = {vreg.x, vreg.y, vreg.z, vreg.w}; \
        _Pragma("unroll") for (int e = 0; e < 4; ++e) { *(LAS bf16_t*)(WVT + (8 * w + 2 * e) * 144 + lane * 2) = (bf16_t)f2bf(bflo(vw[e]) * wsr); *(LAS bf16_t*)(WVT + (8 * w + 2 * e + 1) * 144 + lane * 2) = (bf16_t)f2bf(bfhi(vw[e]) * wsr); } \
      } else if (w == 4) { *(LAS bf16_t*)(WVT + 32 * 144 + lane * 2) = (bf16_t)f2bf(wsr); } \
      const f32x4 ivc = ivr; \
      { const int cn_ = ((c) + 2 < NCH) ? (c) + 2 : NCH - 1; M2_LOAD(qreg, kreg, vreg, wsr, ivr, cn_); } \
      LBAR(); \
      M2_ATILE_H(w & 3, w >> 2, tok0, ivc); \
      M2_ATILE_Q(w & 3, 2 + (w >> 2), tok0, ivc); \
      const float decay = TD[(c)]; \
      _Pragma("unroll") for (int mt = 0; mt < 2; ++mt) \
        _Pragma("unroll") for (int n2 = 0; n2 < 3; ++n2) { \
          f32x4 cacc = acc[mt][n2] * decay; \
          _Pragma("unroll") for (int ks = 0; ks < 2; ++ks) { \
            const bf16x8 a = *(const LAS bf16x8*)(KT + (32 * w + 16 * mt + r) * 144 + (32 * ks + 8 * gq) * 2); \
            const bf16x8 bb = *(const LAS bf16x8*)(WVT + (16 * n2 + r) * 144 + (32 * ks + 8 * gq) * 2); \
            cacc = __builtin_amdgcn_mfma_f32_16x16x32_bf16(a, bb, cacc, 0, 0, 0); } \
          acc[mt][n2] = cacc; } \
      LBAR(); \
      _Pragma("unroll") for (int mt = 0; mt < 2; ++mt) \
        _Pragma("unroll") for (int n2 = 0; n2 < 3; ++n2) { u32x2 q; q.x = pk2(acc[mt][n2][0], acc[mt][n2][1]); q.y = pk2(acc[mt][n2][2], acc[mt][n2][3]); \
          *(LAS u32x2*)(CT + (16 * n2 + r) * 528 + (32 * w + 16 * mt + 4 * gq) * 2) = q; } \
    } while (0)
    { const int tdx = F.tid, sp = tdx & 31, cq = tdx >> 5, gq = (tdx & 63) >> 4;
      M2_LOAD(qrA, krA, vrA, wsA, ivA, 0);
      M2_LOAD(qrB, krB, vrB, wsB, ivB, 1); }
    __syncthreads();
#pragma unroll 1
    for (int c = 0; c < NCH; c += 2) {
      M2_BODY(c, qrA, krA, vrA, wsA, ivA);
      M2_BODY(c + 1, qrB, krB, vrB, wsB, ivB);
    }
#undef M2_BODY
#undef M2_ATILE_H
#undef M2_ATILE_Q
#undef M2_AMMA
#undef M2_LOAD
    __syncthreads();
  }
}

__device__ __forceinline__ void phase_ragg(const Frame& F) {
  unsigned char* ws = F.ws;
  const float* RA = (const float*)(ws + WS_RA); const bf16_t* RBb = (const bf16_t*)(ws + WS_RB);
  float* AGGA = (float*)(ws + WS_SMALL + SM_AGGA); float* AGGB = (float*)(ws + WS_SMALL + SM_AGGB);
  const int gt = F.bid * 512 + F.tid, NGT = F.G * 512;
  const int per = (2 * NCH * (RW / 2) + F.G - 1) / F.G;
#pragma unroll 1
  for (int i2 = F.tid; i2 < per; i2 += 512) {
    const int it = F.bid * per + i2; if (it >= 2 * NCH * (RW / 2)) break;
    const int bc = it / (RW / 2), ch = 2 * (it - bc * (RW / 2));
    const float* pa = RA + (size_t)bc * 64 * RW + ch; const bf16_t* pb = RBb + (size_t)bc * 64 * RW + ch;
    float A0 = 1.f, B0 = 0.f, A1 = 1.f, B1 = 0.f;
#pragma unroll 1
    for (int tb = 0; tb < 8; ++tb) {
      f32x2 a[8]; unsigned bb[8];
#pragma unroll
      for (int t = 0; t < 8; ++t) { a[t] = *(const f32x2*)(pa + (size_t)(tb * 8 + t) * RW); bb[t] = *(const unsigned*)(pb + (size_t)(tb * 8 + t) * RW); }
#pragma unroll
      for (int t = 0; t < 8; ++t) { A0 *= a[t][0]; B0 = a[t][0] * B0 + bflo(bb[t]); A1 *= a[t][1]; B1 = a[t][1] * B1 + bfhi(bb[t]); }
    }
    *(f32x2*)(AGGA + (size_t)bc * RW + ch) = (f32x2){A0, A1}; *(f32x2*)(AGGB + (size_t)bc * RW + ch) = (f32x2){B0, B1};
  }
}
__device__ __forceinline__ float gelu_fast(float x) {
  const float u = 0.7978845608028654f * (x + 0.044715f * x * x * x); return x * __builtin_amdgcn_rcpf(1.0f + __expf(-2.0f * u)); }
__device__ __forceinline__ void phase_rscan(const Frame& F) {
  unsigned char* ws = F.ws;
  const float* RA = (const float*)(ws + WS_RA); const bf16_t* RBb = (const bf16_t*)(ws + WS_RB);
  const float* AGGA = (const float*)(ws + WS_SMALL + SM_AGGA); const float* AGGB = (const float*)(ws + WS_SMALL + SM_AGGB);
  const bf16_t* PROJ = (const bf16_t*)(ws + WS_PROJ); bf16_t* YR = (bf16_t*)(ws + WS_YR);
  const int gt = F.bid * 512 + F.tid, NGT = F.G * 512;
#define RS_LD(a, bb, xg, tb) do { _Pragma("unroll") for (int t = 0; t < 8; ++t) { const size_t o = (size_t)(t0 + (tb) * 8 + t) * RW + ch; \
      a[t] = __builtin_nontemporal_load((const f32x2*)(RA + o)); bb[t] = __builtin_nontemporal_load((const unsigned*)(RBb + o)); \
      xg[t] = __builtin_nontemporal_load((const unsigned*)(PROJ + (size_t)(t0 + (tb) * 8 + t) * INC + O_XG + ch)); } } while (0)
#define RS_DO(a, bb, xg, tb) do { _Pragma("unroll") for (int t = 0; t < 8; ++t) { h0 = a[t][0] * h0 + bflo(bb[t]); h1 = a[t][1] * h1 + bfhi(bb[t]); \
      *(unsigned*)(YR + (size_t)(t0 + (tb) * 8 + t) * RW + ch) = pk2(h0 * gelu_fast(bflo(xg[t])), h1 * gelu_fast(bfhi(xg[t]))); } } while (0)
#define RS_CLD(ca, cb, c0) do { _Pragma("unroll") for (int k = 0; k < 8; ++k) { const int cc = (c0) + k; const int j = (b * NCH + (cc < cidx ? cc : 0)) * RW + ch; ca[k] = *(const f32x2*)(AGGA + j); cb[k] = *(const f32x2*)(AGGB + j); } } while (0)
#define RS_CDO(ca, cb, c0) do { _Pragma("unroll") for (int k = 0; k < 8; ++k) { if ((c0) + k < cidx) { h0 = ca[k][0] * h0 + cb[k][0]; h1 = ca[k][1] * h1 + cb[k][1]; } } } while (0)
  const int per = (2 * NCH * (RW / 2) + F.G - 1) / F.G;
  for (int i2 = F.tid; i2 < per; i2 += 512) {
    const int it = F.bid * per + i2; if (it >= 2 * NCH * (RW / 2)) break;
    const int bc = it / (RW / 2), ch = 2 * (it % (RW / 2)), t0 = bc * 64, b = bc / NCH, cidx = bc % NCH;
    float h0 = 0.f, h1 = 0.f;
    f32x2 aA[8], aB[8]; unsigned bA[8], bB[8], xA[8], xB[8];
    RS_LD(aA, bA, xA, 0);
    {
      f32x2 caA[8], cbA[8], caB[8], cbB[8];
      RS_CLD(caA, cbA, 0);
      for (int c0 = 0; c0 < cidx; c0 += 16) {
        RS_CLD(caB, cbB, c0 + 8);
        RS_CDO(caA, cbA, c0);
        RS_CLD(caA, cbA, c0 + 16);
        RS_CDO(caB, cbB, c0 + 8);
      }
    }
#pragma unroll
    for (int tb = 0; tb < 8; tb += 2) {
      RS_LD(aB, bB, xB, tb + 1);
      RS_DO(aA, bA, xA, tb);
      if (tb + 2 < 8) RS_LD(aA, bA, xA, tb + 2);
      RS_DO(aB, bB, xB, tb + 1);
    }
  }
#undef RS_LD
#undef RS_DO
#undef RS_CLD
#undef RS_CDO
}

__device__ __forceinline__ void phase_ym(const Frame& F) {
  unsigned char* ws = F.ws;
  const bf16_t* HNI = (const bf16_t*)(ws + WS_HNI); const bf16_t* HNE = (const bf16_t*)(ws + WS_HNE);
  const float* EMR = (const float*)(ws + WS_SMALL + SM_EMR); const float* DENI = (const float*)(ws + WS_SMALL + SM_DENI); const float* QN = (const float*)(ws + WS_SMALL + SM_QN);
  const bf16_t* XCM = (const bf16_t*)(ws + WS_XCM); const bf16_t* PROJ = (const bf16_t*)(ws + WS_PROJ); bf16_t* YM = (bf16_t*)(ws + WS_YM);
  const float* normw = F.in[10]; const float* skip = F.in[11];
  const int gw = F.bid * 8 + F.wave, NGW = F.G * 8, lane = F.lane;
  for (int tA = gw; tA < NTOK; tA += 2 * NGW) {
    const int tBr = tA + NGW; const bool okB = tBr < NTOK; const int tB = okB ? tBr : tA;
    u32x2 a[2][8], e[2][8], xcw[2][8], zw[2][8]; float den[2][8], emr[2][8];
#pragma unroll
    for (int u = 0; u < 2; ++u) { const int t = u ? tB : tA;
#pragma unroll
      for (int h = 0; h < 8; ++h) {
        const size_t o = (size_t)t * MW + 256 * h + 4 * lane;
        a[u][h] = __builtin_nontemporal_load((const u32x2*)(HNI + o)); e[u][h] = __builtin_nontemporal_load((const u32x2*)(HNE + o)); xcw[u][h] = __builtin_nontemporal_load((const u32x2*)(XCM + o));
        zw[u][h] = __builtin_nontemporal_load((const u32x2*)(PROJ + (size_t)t * INC + O_Z + 256 * h + 4 * lane));
        den[u][h] = DENI[t * 8 + h] + QN[t * 8 + h]; emr[u][h] = EMR[t * 8 + h];
      } }
#pragma unroll
    for (int u = 0; u < 2; ++u) { const int t = u ? tB : tA;
      if (u == 0 || okB) {
#pragma unroll
      for (int h = 0; h < 8; ++h) {
        const int col = 256 * h + 4 * lane;
        const float inv = 1.0f / fmaxf(fabsf(den[u][h]), emr[u][h]);
        const float hv[4] = {(bflo(a[u][h].x) + bflo(e[u][h].x)) * inv, (bfhi(a[u][h].x) + bfhi(e[u][h].x)) * inv, (bflo(a[u][h].y) + bflo(e[u][h].y)) * inv, (bfhi(a[u][h].y) + bfhi(e[u][h].y)) * inv};
        const float mean = wave_sum((hv[0] + hv[1]) + (hv[2] + hv[3])) * (1.0f / 256.0f);
        float d[4]; float s2 = 0.f;
#pragma unroll
        for (int j = 0; j < 4; ++j) { d[j] = hv[j] - mean; s2 += d[j] * d[j]; }
        const float rstd = rsqrtf(wave_sum(s2) * (1.0f / 256.0f) + LN_EPS);
        const f32x4 nw = *(const f32x4*)(normw + col), sk = *(const f32x4*)(skip + col);
        const float xc[4] = {bflo(xcw[u][h].x), bfhi(xcw[u][h].x), bflo(xcw[u][h].y), bfhi(xcw[u][h].y)}, z[4] = {bflo(zw[u][h].x), bfhi(zw[u][h].x), bflo(zw[u][h].y), bfhi(zw[u][h].y)};
        float y[4];
#pragma unroll
        for (int j = 0; j < 4; ++j) y[j] = (d[j] * rstd * nw[j] + sk[j] * xc[j]) * siluf_(z[j]);
        u32x2 w; w.x = pk2(y[0], y[1]); w.y = pk2(y[2], y[3]); *(u32x2*)(YM + (size_t)t * RW + col) = w;
      } }
    }
  }
}

__device__ __forceinline__ void phase_ln_router(const Frame& F) {
  unsigned char* ws = F.ws;
  float* X1 = (float*)(ws + WS_X1); unsigned char* X1Q = ws + WS_X1B;
  int* CNT = (int*)(ws + WS_CTL); int* LIST = (int*)(ws + WS_LIST); float* LISTW = (float*)(ws + WS_LISTW); int* TOKES = (int*)(ws + WS_TOKES);
  const float* g1 = F.in[22]; const float* b1 = F.in[23]; const float* rw = F.in[24]; const float* rbias = F.in[25];
  LAS unsigned char* XH = F.lds; LAS unsigned char* XL = F.lds + 65792;
  const bf16_t* RWH = (const bf16_t*)(ws + WS_SMALL + SM_RWH); const bf16_t* RWL = (const bf16_t*)(ws + WS_SMALL + SM_RWL);
  const int w = F.wave;
  LAS int* lcnt = (LAS int*)(F.lds + LDS_X + 8192); LAS int* lbase = lcnt + 64;
  for (int tp = F.bid; tp < NTOK / 32; tp += F.G) {
  int lslot[2][2], rnk[2][2]; float wg[2][2];
  if (F.tid < 64) lcnt[F.tid] = 0;
#pragma unroll
  for (int kt = 0; kt < 2; ++kt) {
    const int tile = 2 * tp + kt;
    const int t0 = tile * 16;
    int lane = F.lane; asm volatile("" : "+v"(lane));
    const int r16 = lane & 15, gq = lane >> 4;
    f32x4 vq[2][8];
#pragma unroll
    for (int q = 0; q < 2; ++q)
#pragma unroll
      for (int j = 0; j < 8; ++j) vq[q][j] = __builtin_nontemporal_load((const f32x4*)(X1 + (size_t)(t0 + 2 * w + q) * DM + 4 * lane + 256 * j));
#pragma unroll
    for (int q = 0; q < 2; ++q) {
      const int tl = 2 * w + q, t = t0 + tl;
      float* xr = X1 + (size_t)t * DM;
      f32x4 v[8]; float s = 0.f;
#pragma unroll
      for (int j = 0; j < 8; ++j) { v[j] = vq[q][j]; s += (v[j][0] + v[j][1]) + (v[j][2] + v[j][3]); }
      const float mean = wave_sum(s) * (1.0f / DM); float s2 = 0.f;
#pragma unroll
      for (int j = 0; j < 8; ++j) { v[j] = v[j] - mean; s2 += (v[j][0] * v[j][0] + v[j][1] * v[j][1]) + (v[j][2] * v[j][2] + v[j][3] * v[j][3]); }
      const float rstd = rsqrtf(wave_sum(s2) * (1.0f / DM) + LN_EPS);
#pragma unroll
      for (int j = 0; j < 8; ++j) {
        const int col = 4 * lane + 256 * j;
        const f32x4 gg = *(const f32x4*)(g1 + col), bb = *(const f32x4*)(b1 + col);
        const f32x4 o = v[j] * rstd * gg + bb;
        *(f32x4*)(xr + col) = o;
        u32x2 pw; pw.x = pk2(o[0], o[1]); pw.y = pk2(o[2], o[3]);
        { int q8 = 0; q8 = __builtin_amdgcn_cvt_pk_fp8_f32(o[0], o[1], q8, false); q8 = __builtin_amdgcn_cvt_pk_fp8_f32(o[2], o[3], q8, true); *(int*)(X1Q + (size_t)t * DM + col) = q8; }
        { float lo[4];
#pragma unroll
          for (int e = 0; e < 4; ++e) lo[e] = o[e] - __uint_as_float(f2bf(o[e]) << 16);
          *(LAS u32x2*)(XH + tl * 4112 + col * 2) = pw; u32x2 lw; lw.x = pk2(lo[0], lo[1]); lw.y = pk2(lo[2], lo[3]); *(LAS u32x2*)(XL + tl * 4112 + col * 2) = lw; }
      }
    }
    __syncthreads();
    f32x4 lacc[4];
    {
      const bf16_t* rh = RWH + (size_t)r16 * DM + 256 * w + 8 * gq; const bf16_t* rl = RWL + (size_t)r16 * DM + 256 * w + 8 * gq;
      const LAS unsigned char* xh = XH + r16 * 4112 + (256 * w + 8 * gq) * 2; const LAS unsigned char* xl = XL + r16 * 4112 + (256 * w + 8 * gq) * 2;
#define RT_LD(bh, bl, bidx) do { const int nt_ = (bidx) >> 1, kh_ = (bidx) & 1; _Pragma("unroll") for (int k2 = 0; k2 < 4; ++k2) { \
        bh[k2] = *(const bf16x8*)(rh + (size_t)(16 * nt_) * DM + 32 * (4 * kh_ + k2)); bl[k2] = *(const bf16x8*)(rl + (size_t)(16 * nt_) * DM + 32 * (4 * kh_ + k2)); } } while (0)
#define RT_MM(bh, bl, bidx) do { const int kh_ = (bidx) & 1; _Pragma("unroll") for (int k2 = 0; k2 < 4; ++k2) { \
        const bf16x8 ah = *(const LAS bf16x8*)(xh + 64 * (4 * kh_ + k2)); const bf16x8 al = *(const LAS bf16x8*)(xl + 64 * (4 * kh_ + k2)); \
        a4 = __builtin_amdgcn_mfma_f32_16x16x32_bf16(ah, bh[k2], a4, 0, 0, 0); a4 = __builtin_amdgcn_mfma_f32_16x16x32_bf16(al, bh[k2], a4, 0, 0, 0); \
        a4 = __builtin_amdgcn_mfma_f32_16x16x32_bf16(ah, bl[k2], a4, 0, 0, 0); } } while (0)
      bf16x8 bhA[4], blA[4], bhB[4], blB[4];
      RT_LD(bhA, blA, 0);
#pragma unroll
      for (int nt = 0; nt < 4; ++nt) {
        f32x4 a4 = (f32x4){0.f, 0.f, 0.f, 0.f};
        RT_LD(bhB, blB, 2 * nt + 1);
        RT_MM(bhA, blA, 2 * nt);
        asm volatile("" ::: "memory");
        if (nt < 3) RT_LD(bhA, blA, 2 * nt + 2);
        RT_MM(bhB, blB, 2 * nt + 1);
        asm volatile("" ::: "memory");
        lacc[nt] = a4;
      }
#undef RT_LD
#undef RT_MM
    }
    __syncthreads();
    LAS float* PART = (LAS float*)F.lds;
#pragma unroll
    for (int nt = 0; nt < 4; ++nt)
#pragma unroll
      for (int j = 0; j < 4; ++j) PART[(w * 16 + 4 * gq + j) * 64 + 16 * nt + r16] = lacc[nt][j];
    __syncthreads();
#pragma unroll
    for (int q = 0; q < 2; ++q) {
      const int tl = 2 * w + q;
      float logit = 0.f;
#pragma unroll
      for (int ww = 0; ww < 8; ++ww) logit += PART[(ww * 16 + tl) * 64 + lane];
      const float score = 1.0f / (1.0f + expf(-logit));
      const float biased = score + rbias[lane];
      int cnt = 0;
#pragma unroll
      for (int d = 1; d < 8; ++d) { const int other = (lane & ~7) | ((lane + d) & 7); const float ov = __shfl(biased, other); cnt += (ov > biased || (ov == biased && other < lane)) ? 1 : 0; }
      float gs = cnt < 2 ? biased : 0.f;
      gs += __shfl_xor(gs, 1); gs += __shfl_xor(gs, 2); gs += __shfl_xor(gs, 4);
      const int gi = lane >> 3; int grank = 0;
#pragma unroll
      for (int gg = 0; gg < 8; ++gg) { const float og = __shfl(gs, 8 * gg); grank += (og > gs || (og == gs && gg < gi)) ? 1 : 0; }
      const float val = grank < 4 ? biased : -INFINITY;
      int erank = 0;
      for (int e2 = 0; e2 < 64; ++e2) { const float ov = __shfl(val, e2); erank += (ov > val || (ov == val && e2 < lane)) ? 1 : 0; }
      const bool chosen = erank < 8;
      const float wsum = wave_sum(chosen ? score : 0.f);
      rnk[kt][q] = erank; wg[kt][q] = score / wsum * 2.5f; lslot[kt][q] = -1;
      if (chosen) lslot[kt][q] = atomicAdd((int*)(lcnt + lane), 1);
    }
    __syncthreads();
  }
    if (F.tid < 64) { const int c = lcnt[F.tid]; lbase[F.tid] = c ? atomicAdd(&CNT[F.tid * 64], c) : 0; }
    __syncthreads();
    { const int lane = F.lane;
#pragma unroll
    for (int kt = 0; kt < 2; ++kt)
#pragma unroll
      for (int q = 0; q < 2; ++q) {
        if (lslot[kt][q] >= 0) { const int t = (2 * tp + kt) * 16 + 2 * w + q; const int slot = lbase[lane] + lslot[kt][q];
          LIST[lane * NTOK + slot] = t; LISTW[lane * NTOK + slot] = wg[kt][q]; TOKES[t * 8 + rnk[kt][q]] = (lane << 16) | slot; }
      } }
    __syncthreads();
  }
}

__device__ __forceinline__ MoeTab build_moe_tab(const Frame& F) {
  LAS int* tp = (LAS int*)(F.lds + LDS_X); LAS int* cp = tp + 68; LAS int* cn = tp + 136;
  const int* CNT = (const int*)(F.ws + WS_CTL);
  if (F.tid == 0) { int a = 0, b = 0; for (int e = 0; e < NE; ++e) { const int c = CNT[e * 64]; tp[e] = a; cp[e] = b; cn[e] = c; a += (c + 255) >> 8; b += c; } tp[NE] = a; cp[NE] = b; }
  __syncthreads();
  { LAS int* rt = tp + 256; if (F.tid < 384) { int e = 0; for (int k = 0; k < NE; ++k) { if (tp[k + 1] <= F.tid) e = k + 1; } rt[F.tid] = e < NE ? e : NE - 1; } }
  __syncthreads();
  MoeTab T; T.tp = tp; T.cp = cp; T.cnt = cn; T.n_rt = __builtin_amdgcn_readfirstlane(tp[NE]);
  return T;
}

__device__ __forceinline__ void phase_final(const Frame& F, const MoeTab& T) {
  unsigned char* ws = F.ws;
  const bf16_t* YRM = (const bf16_t*)(ws + WS_YRM); const int* TOKES = (const int*)(ws + WS_TOKES);
  const float* g2 = F.in[32]; const float* b2 = F.in[33];
  const int gw = F.bid * 8 + F.wave, NGW = F.G * 8, lane = F.lane;
  for (int t = gw; t < NTOK; t += NGW) {
    float* orow = F.out + (size_t)t * DM;
    f32x4 v[8];
    { const float* xrow = (const float*)(ws + WS_X1) + (size_t)t * DM; const bf16_t* ys = YRM + (size_t)(NTOK * 8 + t) * DM;
#pragma unroll
      for (int j = 0; j < 8; ++j) { const u32x2 wv = __builtin_nontemporal_load((const u32x2*)(ys + 4 * lane + 256 * j)); v[j] = __builtin_nontemporal_load((const f32x4*)(xrow + 4 * lane + 256 * j)) * ALPHA; v[j][0] += bflo(wv.x); v[j][1] += bfhi(wv.x); v[j][2] += bflo(wv.y); v[j][3] += bfhi(wv.y); } }
    const int esl = TOKES[t * 8 + (lane & 7)];
#pragma unroll
    for (int kb = 0; kb < 2; ++kb) {
      u32x2 yv[4][8];
#pragma unroll
      for (int k = 0; k < 4; ++k) {
        const int es = __shfl(esl, kb * 4 + k); const int e = es >> 16, slot = es & 0xffff;
        const bf16_t* yr = YRM + (size_t)(T.cp[e] + slot) * DM;
#pragma unroll
        for (int j = 0; j < 8; ++j) yv[k][j] = __builtin_nontemporal_load((const u32x2*)(yr + 4 * lane + 256 * j));
      }
#pragma unroll
      for (int k = 0; k < 4; ++k)
#pragma unroll
        for (int j = 0; j < 8; ++j) { v[j][0] += bflo(yv[k][j].x); v[j][1] += bfhi(yv[k][j].x); v[j][2] += bflo(yv[k][j].y); v[j][3] += bfhi(yv[k][j].y); }
    }
    float s = 0.f;
#pragma unroll
    for (int j = 0; j < 8; ++j) s += (v[j][0] + v[j][1]) + (v[j][2] + v[j][3]);
    const float mean = wave_sum(s) * (1.0f / DM); float s2 = 0.f;
#pragma unroll
    for (int j = 0; j < 8; ++j) { v[j] = v[j] - mean; s2 += (v[j][0] * v[j][0] + v[j][1] * v[j][1]) + (v[j][2] * v[j][2] + v[j][3] * v[j][3]); }
    const float rstd = rsqrtf(wave_sum(s2) * (1.0f / DM) + LN_EPS);
#pragma unroll
    for (int j = 0; j < 8; ++j) { const int col = 4 * lane + 256 * j; const f32x4 gg = *(const f32x4*)(g2 + col), bb = *(const f32x4*)(b2 + col); __builtin_nontemporal_store(v[j] * rstd * gg + bb, (f32x4*)(orow + col)); }
  }
}

__global__ void __launch_bounds__(512, 2) fwd_megakernel(Params p, int ph_lo, int ph_hi) {
  extern __shared__ __attribute__((aligned(16))) unsigned char lds_raw[];
  Frame F;
  F.lds = (LAS unsigned char*)lds_raw; F.tid = threadIdx.x; F.lane = F.tid & 63; F.wave = __builtin_amdgcn_readfirstlane(F.tid >> 6);
  F.G = gridDim.x; F.bid = blockIdx.x; F.ws = as_global(p.ws); F.in = InPtrs{p.in}; F.out = as_global(p.out);
  unsigned char* ws = as_global(p.ws);
#ifndef PHMASK
#define PHMASK 0xFFF
#endif
#define IN(k) (((PHMASK >> (k)) & 1) && ph_lo <= (k) && (k) < ph_hi)
#ifndef RPTMASK
#define RPTMASK 0
#endif
#define RPT(k) for (int _rp = 0; _rp < 1 + ((RPTMASK >> (k)) & 1); ++_rp)
#define FRESH() do { unsigned char* w2_ = opaque_global(p.ws); ws = w2_; F.ws = w2_; int l2_ = (int)__builtin_amdgcn_mbcnt_hi(~0u, __builtin_amdgcn_mbcnt_lo(~0u, 0u)); asm volatile("" : "+v"(l2_)); F.lane = l2_; F.tid = F.wave * 64 + l2_; } while (0)
#define SYNC(k) do { if (IN(k) && IN((k) + 1)) { xcd_barrier(xbar); } } while (0)
  { volatile LAS unsigned* st = (volatile LAS unsigned*)(F.lds + LDS_X + 4096); if (F.tid < 4) st[F.tid] = 0u; }
  __syncthreads();
  const XcdBarrier xbar = xcd_barrier_post((unsigned*)(ws + WS_CTL + 16384), (volatile LAS unsigned*)(F.lds + LDS_X + 4096));

  FRESH();
  if (IN(0)) RPT(0) { if (_rp) xcd_barrier(xbar); phase_prologue(F); }
  SYNC(0);
  FRESH();
  if (IN(1)) RPT(1) { if (_rp) xcd_barrier(xbar);
    SchedDense S{(const char*)(ws + WS_XB), (const char*)(ws + WS_WIN), NTOK / 256, INC / 256, F.G, F.bid, DM, DM, DM / 64};
    EpiStoreBf16 E{(bf16_t*)(ws + WS_PROJ), INC};
    pg8::gemm_phase<EpiStoreBf16, SchedDense, false>(F.lds, DM, DM, S, E);
    { const int nb = defer1_blocks(F.G), first = F.G - nb;
      if (nb && F.bid >= first) { const int base = T_NITEMS - defer1_count(F.G) - defer3_count(F.G); tile_range(F, base + (F.bid - first), nb, base + defer1_count(F.G)); } }
  }
  SYNC(1);
  FRESH();
  if (IN(2)) RPT(2) { if (_rp) xcd_barrier(xbar); phase_mprep(F); phase_rconv(F); }
  SYNC(2);
  FRESH();
  if (IN(3)) RPT(3) { if (_rp) xcd_barrier(xbar);
    const int nm2 = F.G >> 1;
    if (F.bid < nm2) phase_m2(F, nm2);
    else {
      const int bid2 = F.bid - nm2, G2 = F.G - nm2;
      phase_m1(F, bid2, G2);
      int Kr = 4; asm volatile("" : "+s"(Kr));
      SchedRglru S{(const char*)(ws + WS_XCR), (const char*)(ws + WS_WRAX), G2, bid2, Kr};
      EpiRglru E{(const bf16_t*)(ws + WS_XCR), p.in[15], p.in[17], (const float*)(ws + WS_SMALL + SM_C8), (float*)(ws + WS_RA), (bf16_t*)(ws + WS_RB)};
      pg8::gemm_phase<EpiRglru, SchedRglru, false>(F.lds, RW, 256, S, E);
      { const int base = T_NITEMS - defer3_count(F.G); if (defer3_count(F.G)) tile_range(F, base + bid2, G2, T_NITEMS); }
    }
  }
  SYNC(3);
  FRESH();
  if (IN(4)) RPT(4) { if (_rp) xcd_barrier(xbar); phase_ragg(F); phase_ym(F); }
  SYNC(4);
  FRESH();
  if (IN(5)) RPT(5) { if (_rp) xcd_barrier(xbar); phase_rscan(F); }
  SYNC(5);
  FRESH();
  if (IN(6)) RPT(6) { if (_rp) xcd_barrier(xbar);
    SchedMerge S{(const char*)(ws + WS_YM), (const char*)(ws + WS_YR), (const char*)(ws + WS_WPM), (const char*)(ws + WS_WPR), F.G, F.bid};
    EpiMergeF E{(const bf16_t*)(ws + WS_PROJ), p.in[2], (bf16_t*)(ws + WS_MERGED)};
    pg8::gemm_phase<EpiMergeF, SchedMerge, false>(F.lds, RW, RW, S, E);
  }
  SYNC(6);
  FRESH();
  if (IN(7)) RPT(7) { if (_rp) xcd_barrier(xbar);
    SchedDense S{(const char*)(ws + WS_MERGED), (const char*)(ws + WS_WO), NTOK / 256, DM / 256, F.G, F.bid, DM, DM, DM / 64};
    EpiWo E{p.in[0], (float*)(ws + WS_X1)};
    pg8::gemm_phase<EpiWo, SchedDense, false>(F.lds, DM, DM, S, E);
  }
  SYNC(7);
  FRESH();
  if (IN(8)) phase_ln_router(F);
  SYNC(8);
  FRESH();
  if (IN(9)) RPT(9) { if (_rp) xcd_barrier(xbar);
    const MoeTab T = build_moe_tab(F);
    SchedMoe<4, 1> S{T, (const int*)(ws + WS_LIST), (const char*)(ws + WS_X1B), (const char*)(ws + WS_WEGU), (const char*)(ws + WS_WSGU), F.G, F.bid, DM / 128};
    EpiMoe1 E{ws + WS_HMOE};
    pg8::gemm_phase<EpiMoe1, SchedMoe<4, 1>, true>(F.lds, DM / 2, DM / 2, S, E);
  }
  SYNC(9);
  FRESH();
  if (IN(10)) RPT(10) { if (_rp) xcd_barrier(xbar);
    const MoeTab T = build_moe_tab(F);
    int nt2 = DE / 128; asm volatile("" : "+s"(nt2));
    SchedMoe<8, 2> S{T, (const int*)(ws + WS_LIST), (const char*)(ws + WS_HMOE), (const char*)(ws + WS_WED), (const char*)(ws + WS_WSD), F.G, F.bid, nt2};
    EpiMoe2 E{(bf16_t*)(ws + WS_YRM), (const float*)(ws + WS_LISTW), (bf16_t*)(ws + WS_WIN)};
    pg8::gemm_phase<EpiMoe2, SchedMoe<8, 2>, false>(F.lds, DE / 2, DE / 2, S, E);
  }
  SYNC(10);
  FRESH();
  if (IN(11)) { const MoeTab T = build_moe_tab(F); phase_final(F, T); }
#undef IN
#undef SYNC
}

#ifndef N_LAUNCH_SPLIT
#define N_LAUNCH_SPLIT 0
#endif
extern "C" void kernel_launch(void* const* d_in, const int* in_sizes, int n_in, void* d_out, int out_size, void* d_ws, size_t ws_size, hipStream_t stream) {
  static int grid_blocks = 0;
  if (grid_blocks == 0) {
    int dev = 0, cus = 0, per_cu = 0;
    (void)hipGetDevice(&dev);
    (void)hipDeviceGetAttribute(&cus, hipDeviceAttributeMultiprocessorCount, dev);
    (void)hipFuncSetAttribute((const void*)fwd_megakernel, hipFuncAttributeMaxDynamicSharedMemorySize, LDS_BYTES);
    (void)hipOccupancyMaxActiveBlocksPerMultiprocessor(&per_cu, fwd_megakernel, 512, LDS_BYTES);
    if (per_cu < 1) { fprintf(stderr, "kernel_launch: occupancy query says %d blocks per CU\n", per_cu); per_cu = 1; }
    grid_blocks = cus * per_cu;
    fprintf(stderr, "kernel_launch: cus %d per_cu %d grid %d ws_size %zu (need %zu) n_in %d\n", cus, per_cu, grid_blocks, ws_size, (size_t)WS_END, n_in);
    if (ws_size < WS_END || n_in != 34) { fprintf(stderr, "kernel_launch: workspace too small or unexpected inputs; nothing launched\n"); grid_blocks = -1; }
  }
  if (grid_blocks < 0) return;
  (void)hipMemsetAsync((char*)d_ws + WS_CTL, 0, 65536, stream);
  Params p{};
  for (int i = 0; i < 34; ++i) p.in[i] = (const float*)d_in[i];
  p.out = (float*)d_out; p.ws = (unsigned char*)d_ws;
#if N_LAUNCH_SPLIT
  for (int ph = 0; ph < 12; ++ph) { hipLaunchKernelGGL(fwd_megakernel, dim3(grid_blocks), dim3(512), LDS_BYTES, stream, p, ph, ph + 1); }
#else
  int lo = 0, hi = 12;
  void* args[] = {&p, &lo, &hi};
  hipError_t e = hipLaunchCooperativeKernel((void*)fwd_megakernel, dim3(grid_blocks), dim3(512), args, LDS_BYTES, stream);
  if (e != hipSuccess) fprintf(stderr, "cooperative launch failed: %s (grid %d)\n", hipGetErrorString(e), grid_blocks);
#endif
}
```
